# Optimizing an MI355X kernel written in HIP

```python
import math
import jax
import jax.numpy as jnp
from jax import lax
import numpy as np


D_MODEL = 2048
BATCH = 1
SEQ = 8192
DEPTH = 4

CHUNK = 64
Q_BLOCK = 128
HEAD_DIM = 128
N_HEADS = D_MODEL // HEAD_DIM
H_SB = N_HEADS // 3
H_FOX = N_HEADS // 3
H_DIFF = N_HEADS - H_SB - H_FOX
MIX_WIDTH = N_HEADS * HEAD_DIM
DIFF_HALF = HEAD_DIM // 2
N_IN = 3 * MIX_WIDTH + H_FOX
N_EXPERTS = 16
N_GROUPS = 4
EXPERTS_PER_GROUP = N_EXPERTS // N_GROUPS
TOP_K = 2
D_EXPERT = D_MODEL // 4
EPS = 1e-6

kernel_name = 'hybrid_diff_sb_fox_groupmoe_trunk'


def _split_points():
    wa, wb, wc = H_DIFF * HEAD_DIM, H_SB * HEAD_DIM, H_FOX * HEAD_DIM
    widths = [wa, wa, wa, wb, wb, wb, wc, wc, wc]
    pts, acc = [], 0
    for w in widths:
        acc += w
        pts.append(acc)
    return pts


def rms_norm(x, g):
    xf = x.astype(jnp.float32)
    y = xf * lax.rsqrt(jnp.mean(xf * xf, axis=-1, keepdims=True) + EPS)
    return (y * g.astype(jnp.float32)).astype(x.dtype)


def to_heads(t, n_heads, d):
    b, s, _ = t.shape
    return t.reshape(b, s, n_heads, d).transpose(0, 2, 1, 3)


def from_heads(t):
    b, h, s, d = t.shape
    return t.transpose(0, 2, 1, 3).reshape(b, s, h * d)


def _to_blocks(t):
    b, h, s = t.shape[:3]
    t = t.reshape((b, h, s // Q_BLOCK, Q_BLOCK) + t.shape[3:])
    return jnp.moveaxis(t, 2, 0)


def _from_blocks(o):
    o = jnp.moveaxis(o, 0, 2)
    b, h, nb, qb, d = o.shape
    return o.reshape(b, h, nb * qb, d)


def diff_attention(q1, q2, k1, k2, v, lam, slopes):
    seq = k1.shape[2]
    kpos = jnp.arange(seq)
    scale = DIFF_HALF ** -0.5

    def block(args):
        q1b, q2b, start = args
        qpos = start + jnp.arange(Q_BLOCK)
        allowed = (kpos[None, :] // CHUNK) <= (qpos[:, None] // CHUNK)
        dist = jnp.abs(qpos[:, None] - kpos[None, :]).astype(jnp.float32)
        bias = jnp.where(allowed[None], -slopes[:, None, None] * dist[None], -jnp.inf)
        s1 = jnp.einsum('bhqd,bhkd->bhqk', q1b, k1).astype(jnp.float32) * scale + bias
        s2 = jnp.einsum('bhqd,bhkd->bhqk', q2b, k2).astype(jnp.float32) * scale + bias
        w = jax.nn.softmax(s1, axis=-1) - lam * jax.nn.softmax(s2, axis=-1)
        return jnp.einsum('bhqk,bhkd->bhqd', w.astype(v.dtype), v)

    starts = jnp.arange(seq // Q_BLOCK) * Q_BLOCK
    return _from_blocks(lax.map(block, (_to_blocks(q1), _to_blocks(q2), starts)))


def stick_breaking_attention(q, k, v):
    seq = k.shape[2]
    kpos = jnp.arange(seq)
    scale = HEAD_DIM ** -0.5

    def block(args):
        qb, start = args
        qpos = start + jnp.arange(Q_BLOCK)
        strict = kpos[None, :] < qpos[:, None]
        z = jnp.einsum('bhqd,bhkd->bhqk', qb, k).astype(jnp.float32) * scale
        log_keep = jnp.where(strict, jax.nn.log_sigmoid(-z), 0.0)
        between = lax.cumsum(log_keep, axis=3, reverse=True) - log_keep
        a = jnp.where(strict, jnp.exp(jax.nn.log_sigmoid(z) + between), 0.0)
        return jnp.einsum('bhqk,bhkd->bhqd', a.astype(v.dtype), v)

    starts = jnp.arange(seq // Q_BLOCK) * Q_BLOCK
    return _from_blocks(lax.map(block, (_to_blocks(q), starts)))


def forgetting_attention(q, k, v, dcum):
    seq = k.shape[2]
    kpos = jnp.arange(seq)
    scale = HEAD_DIM ** -0.5

    def block(args):
        qb, dq, start = args
        qpos = start + jnp.arange(Q_BLOCK)
        causal = kpos[None, :] <= qpos[:, None]
        logits = jnp.einsum('bhqd,bhkd->bhqk', qb, k).astype(jnp.float32) * scale
        logits = logits + dq[..., :, None] - dcum[:, :, None, :]
        logits = jnp.where(causal, logits, -jnp.inf)
        p = jax.nn.softmax(logits, axis=-1)
        return jnp.einsum('bhqk,bhkd->bhqd', p.astype(v.dtype), v)

    starts = jnp.arange(seq // Q_BLOCK) * Q_BLOCK
    return _from_blocks(lax.map(block, (_to_blocks(q), _to_blocks(dcum), starts)))


def moe_ffn(h, w_router, router_bias, wg, wu, wd):
    b, s, d = h.shape
    t = h.reshape(b * s, d)
    scores = jax.nn.sigmoid((t @ w_router).astype(jnp.float32))
    sel = scores + router_bias.astype(jnp.float32)
    grp = sel.reshape(-1, N_GROUPS, EXPERTS_PER_GROUP)
    group_score = lax.top_k(grp, TOP_K)[0].sum(-1)
    best_group = jnp.argmax(group_score, axis=-1)
    in_group = (jnp.arange(N_EXPERTS) // EXPERTS_PER_GROUP)[None, :] == best_group[:, None]
    _, idx = lax.top_k(jnp.where(in_group, sel, -jnp.inf), TOP_K)
    gate = jnp.take_along_axis(scores, idx, axis=-1)
    gate = gate / jnp.sum(gate, axis=-1, keepdims=True)
    combine = jnp.sum(jax.nn.one_hot(idx, N_EXPERTS, dtype=jnp.float32) * gate[..., None], axis=1)
    hg = jnp.einsum('nd,edf->nef', t, wg)
    hu = jnp.einsum('nd,edf->nef', t, wu)
    act = jax.nn.silu(hg) * hu * combine[:, :, None].astype(t.dtype)
    out = jnp.einsum('nef,efd->nd', act, wd)
    return out.reshape(b, s, d)


def setup_inputs(seed: int = 0) -> dict:
    key = jax.random.key(seed)
    ks = jax.random.split(key, 24)
    f32 = jnp.float32
    nrm = lambda k, shape, sc: jax.random.normal(k, shape, f32) * sc
    gain = lambda k, shape: 1.0 + 0.02 * jax.random.normal(k, shape, f32)
    res_scale = (2.0 * DEPTH) ** -0.5
    return {
        'x': jax.random.normal(ks[0], (BATCH, SEQ, D_MODEL), f32),
        'attn_norm': gain(ks[1], (DEPTH, D_MODEL)),
        'w_in': nrm(ks[2], (DEPTH, D_MODEL, N_IN), D_MODEL ** -0.5),
        'b_forget': jax.random.uniform(ks[3], (DEPTH, H_FOX), f32, 1.0, 6.0),
        'qnorm_diff': gain(ks[4], (DEPTH, DIFF_HALF)),
        'knorm_diff': gain(ks[5], (DEPTH, DIFF_HALF)),
        'lam_q1': nrm(ks[6], (DEPTH, DIFF_HALF), 0.1),
        'lam_k1': nrm(ks[7], (DEPTH, DIFF_HALF), 0.1),
        'lam_q2': nrm(ks[8], (DEPTH, DIFF_HALF), 0.1),
        'lam_k2': nrm(ks[9], (DEPTH, DIFF_HALF), 0.1),
        'subln_diff': gain(ks[10], (DEPTH, HEAD_DIM)),
        'onorm_sb': gain(ks[11], (DEPTH, HEAD_DIM)),
        'qnorm_fox': gain(ks[12], (DEPTH, HEAD_DIM)),
        'knorm_fox': gain(ks[13], (DEPTH, HEAD_DIM)),
        'onorm_fox': gain(ks[14], (DEPTH, HEAD_DIM)),
        'w_out': nrm(ks[15], (DEPTH, MIX_WIDTH, D_MODEL), MIX_WIDTH ** -0.5 * res_scale),
        'ffn_norm': gain(ks[16], (DEPTH, D_MODEL)),
        'w_router': nrm(ks[17], (D_MODEL, N_EXPERTS), D_MODEL ** -0.5),
        'router_bias': nrm(ks[18], (N_EXPERTS,), 0.01),
        'w_gate': nrm(ks[19], (DEPTH, N_EXPERTS, D_MODEL, D_EXPERT), D_MODEL ** -0.5),
        'w_up': nrm(ks[20], (DEPTH, N_EXPERTS, D_MODEL, D_EXPERT), D_MODEL ** -0.5),
        'w_down': nrm(ks[21], (DEPTH, N_EXPERTS, D_EXPERT, D_MODEL), D_EXPERT ** -0.5 * res_scale),
    }


def reference(x, attn_norm, w_in, b_forget, qnorm_diff, knorm_diff, lam_q1, lam_k1, lam_q2, lam_k2,
              subln_diff, onorm_sb, qnorm_fox, knorm_fox, onorm_fox, w_out, ffn_norm,
              w_router, router_bias, w_gate, w_up, w_down):
    b, s, _ = x.shape
    slopes = jnp.exp2(-8.0 * jnp.arange(1, H_DIFF + 1, dtype=jnp.float32) / H_DIFF)
    pts = _split_points()
    for l in range(DEPTH):
        xn = rms_norm(x, attn_norm[l])
        proj = xn @ w_in[l]
        qa, ka, va, qb, kb, vb, qc, kc, vc, fc = jnp.split(proj, pts, axis=-1)

        qa = rms_norm(qa.reshape(b, s, H_DIFF, 2, DIFF_HALF).transpose(0, 2, 1, 3, 4), qnorm_diff[l])
        ka = rms_norm(ka.reshape(b, s, H_DIFF, 2, DIFF_HALF).transpose(0, 2, 1, 3, 4), knorm_diff[l])
        lam_init = 0.8 - 0.6 * math.exp(-0.3 * l)
        lam = (jnp.exp(jnp.sum(lam_q1[l].astype(jnp.float32) * lam_k1[l].astype(jnp.float32)))
               - jnp.exp(jnp.sum(lam_q2[l].astype(jnp.float32) * lam_k2[l].astype(jnp.float32)))
               + lam_init)
        oa = diff_attention(qa[..., 0, :], qa[..., 1, :], ka[..., 0, :], ka[..., 1, :],
                            to_heads(va, H_DIFF, HEAD_DIM), lam, slopes)
        oa = rms_norm(oa, subln_diff[l]) * (1.0 - lam_init)

        ob = stick_breaking_attention(to_heads(qb, H_SB, HEAD_DIM), to_heads(kb, H_SB, HEAD_DIM),
                                      to_heads(vb, H_SB, HEAD_DIM))
        ob = rms_norm(ob, onorm_sb[l])

        log_f = jax.nn.log_sigmoid((fc + b_forget[l]).astype(jnp.float32))
        dcum = jnp.cumsum(log_f, axis=1).transpose(0, 2, 1)
        oc = forgetting_attention(rms_norm(to_heads(qc, H_FOX, HEAD_DIM), qnorm_fox[l]),
                                  rms_norm(to_heads(kc, H_FOX, HEAD_DIM), knorm_fox[l]),
                                  to_heads(vc, H_FOX, HEAD_DIM), dcum)
        oc = rms_norm(oc, onorm_fox[l])

        mixed = jnp.concatenate([from_heads(oa), from_heads(ob), from_heads(oc)], axis=-1)
        x = x + mixed @ w_out[l]
        x = x + moe_ffn(rms_norm(x, ffn_norm[l]), w_router, router_bias, w_gate[l], w_up[l], w_down[l])
    return x
```

```cpp
#include <hip/hip_runtime.h>
#include <cstdio>
#include <cstdint>

#ifndef MK_ONE_LAUNCH
#define MK_ONE_LAUNCH 1
#endif
#ifndef PHASE_MASK
#define PHASE_MASK 0xff
#endif
#define PK(k) (((PHASE_MASK) >> (k)) & 1)
#ifndef DUP_PHASE
#define DUP_PHASE -1
#endif
#ifndef ATT_MASK2
#define ATT_MASK2 7
#endif
#ifndef SKIP_A
#define SKIP_A 1
#endif
#ifndef SKIP_B
#define SKIP_B 3
#endif
#ifndef SKIP_C
#define SKIP_C 1
#endif

#define GAS __attribute__((address_space(1)))
#define LAS __attribute__((address_space(3)))
typedef unsigned short bf16_t;
typedef short bf16x8 __attribute__((ext_vector_type(8)));
typedef float f32x4 __attribute__((ext_vector_type(4)));
typedef float f32x16 __attribute__((ext_vector_type(16)));
typedef unsigned u32x4 __attribute__((ext_vector_type(4)));
typedef unsigned u32x2 __attribute__((ext_vector_type(2)));
typedef int i32x4 __attribute__((ext_vector_type(4)));

constexpr int SEQ = 8192, DM = 2048, DEPTH = 4, NQK = 4096, NV = 2048, NEXP = 16, FEXP = 512, NIN = 6149;
constexpr int HD = 128, H_DIFF = 6, H_SB = 5, H_FOX = 5;
constexpr float EPS = 1e-6f;
constexpr float LOG2E = 1.4426950408889634f;
constexpr int MOE_ROWS = 16384 + 16 * 256;

constexpr size_t MiB = 1u << 20;
constexpr size_t WS_CTL = 0, CTL_ZERO_BYTES = 1 * MiB;
constexpr size_t WS_WF = 1 * MiB;
constexpr size_t WS_LAM = 1 * MiB + 512 * 1024;
constexpr size_t WS_LOGF = 2 * MiB;
constexpr size_t WS_DC2 = 3 * MiB;
constexpr size_t WS_TOK = 4 * MiB;
constexpr size_t WS_GATE = 5 * MiB;
constexpr size_t WS_TSEL = 6 * MiB;
constexpr size_t WS_WRT = 7 * MiB;
constexpr size_t WS_RSTD = 8 * MiB;
constexpr size_t WS_WQK = 16 * MiB;
constexpr size_t WS_WV = 80 * MiB;
constexpr size_t WS_WO = 112 * MiB;
constexpr size_t WS_WGU = 144 * MiB;
constexpr size_t WS_WD = 400 * MiB;
constexpr size_t WS_XN = 528 * MiB;
constexpr size_t WS_QKB = 560 * MiB;
constexpr size_t WS_VT = 624 * MiB;
constexpr size_t WS_MIX = 656 * MiB;
constexpr size_t WS_ACT = 688 * MiB;
constexpr size_t WS_Y = 708 * MiB;
constexpr size_t WS_PART = 788 * MiB;
constexpr size_t WS_OUTB = 828 * MiB;
constexpr size_t WS_END = 862 * MiB;
constexpr int CW_BAR = 4096;
constexpr int CW_ATTQ = 16384;
constexpr int CW_CNT = 32768;
constexpr int CW_AFLAG = 65536;
constexpr int CW_WOC = 233472;
constexpr int CW_GUC = 212992;

constexpr int RING_BYTES = 131072;
constexpr int TBL_OFF = RING_BYTES;
constexpr int MISC_OFF = RING_BYTES + 8192;
constexpr int LDS_BYTES = 147456;

typedef float f32x2_t __attribute__((ext_vector_type(2)));
typedef __bf16 bf16x2_t __attribute__((ext_vector_type(2)));
__device__ __forceinline__ unsigned cvtpk(float lo, float hi) { const f32x2_t v = {lo, hi}; const bf16x2_t b = __builtin_convertvector(v, bf16x2_t); return __builtin_bit_cast(unsigned, b); }
__device__ __forceinline__ float bf_lo(unsigned u) { return __uint_as_float(u << 16); }
__device__ __forceinline__ float bf_hi(unsigned u) { return __uint_as_float(u & 0xffff0000u); }
__device__ __forceinline__ float fexp2(float x) { return __builtin_amdgcn_exp2f(x); }
__device__ __forceinline__ float flog2(float x) { return __builtin_amdgcn_logf(x); }
__device__ __forceinline__ int otid(int wv) { int t; asm volatile("v_mbcnt_lo_u32_b32 %0, -1, 0\n\tv_mbcnt_hi_u32_b32 %0, -1, %0" : "=v"(t)); return wv * 64 + t; }
template <int M> __device__ __forceinline__ float swz_xor(float v) { return __int_as_float(__builtin_amdgcn_ds_swizzle(__float_as_int(v), 0x1F | (M << 10))); }
__device__ __forceinline__ float sum_xor32(float v) { auto rr = __builtin_amdgcn_permlane32_swap(__float_as_uint(v), __float_as_uint(v), false, false); return __uint_as_float(rr[0]) + __uint_as_float(rr[1]); }
__device__ __forceinline__ float wave_sum(float v) {
    v += swz_xor<1>(v); v += swz_xor<2>(v); v += swz_xor<4>(v); v += swz_xor<8>(v); v += swz_xor<16>(v);
    return sum_xor32(v);
}

namespace pg8 {
constexpr int BM = 256, BK = 64, HALF = 128, HTB = HALF * BK * 2, STAGE_BYTES = 8 * HTB, NXCD = 8, WGM = 8;
__host__ __device__ __forceinline__ int lds_byte(int r, int c) { const int st = (r >> 4) * 2 + (c >> 5), rr = r & 15, cc = c & 31, ob = rr * 64 + cc * 2; return st * 1024 + (ob ^ (((ob >> 9) & 1) << 5)); }
__host__ __device__ __forceinline__ void stage_rc(int b, int& R, int& C) { const int st = b / 1024, sb = b % 1024, swz = sb ^ (((sb >> 9) & 1) << 5); R = (st >> 1) * 16 + swz / 64; C = (st & 1) * 32 + (swz % 64) / 2; }
__host__ __device__ __forceinline__ int perm32(int rho) { const int n = rho >> 4, i = rho & 15; return 8 * (i >> 2) + 4 * n + (i & 3); }
__host__ __device__ __forceinline__ int permV(int rho) { const int n = rho >> 4, i = rho & 15; return 16 * (i >> 3) + 8 * n + (i & 7); }
template <int P> __host__ __device__ __forceinline__ int permf(int rho) { return P == 1 ? perm32(rho) : (P == 2 ? permV(rho) : rho); }

struct Unit { int pm, pn, e, rt; };
struct Gemm { const bf16_t* A; const bf16_t* Bt; int M, N, K; };

struct StaticOrder {
    int nM, nN, nwg, G, c;
    __device__ void init(int M, int N, int G_, int c_) { nM = M / BM; nN = N / BM; nwg = nM * nN; G = G_; c = c_; }
    __device__ bool next(int i, Unit& u) const {
        const long L = (long)i * G + c; if (L >= nwg) return false;
        int wgid = (int)L; { const int q = nwg / NXCD, r = nwg % NXCD, xcd = wgid % NXCD, off = wgid / NXCD; wgid = (xcd < r ? xcd * (q + 1) : r * (q + 1) + (xcd - r) * q) + off; }
        const int nig = WGM * nN, gid = wgid / nig, fm = gid * WGM, gsz = (nM - fm) < WGM ? (nM - fm) : WGM;
        u.pm = fm + ((wgid % nig) % gsz); u.pn = (wgid % nig) / gsz; u.e = 0; u.rt = 0; return true;
    }
    __device__ __forceinline__ size_t a_base(const Unit& u, size_t tstep) const { return (size_t)u.pm * tstep; }
    __device__ __forceinline__ unsigned row_off(const Unit&, int r, int K) const { return (unsigned)(r * K) * 2u; }
    __device__ __forceinline__ void a_ready(const Unit&, int) const {}
};

template <int NCT, bool GATHER> struct MoeOrder {
    const LAS int* tbl; const int* tok; int G, c, K;
    __device__ bool next(int i, Unit& u) const {
        const int L = i * G + c, total = __builtin_amdgcn_readfirstlane(tbl[16]) * NCT; if (L >= total) return false;
        const int g = L / NCT, ct = L % NCT; int e = 0;
#pragma unroll
        for (int k = 1; k < 16; ++k) e += (g >= tbl[k]) ? 1 : 0;
        e = __builtin_amdgcn_readfirstlane(e);
        u.pm = g; u.pn = e * NCT + ct; u.e = e; u.rt = __builtin_amdgcn_readfirstlane(g - tbl[e]); return true;
    }
    __device__ __forceinline__ size_t a_base(const Unit& u, size_t tstep) const { return GATHER ? 0 : (size_t)u.pm * tstep; }
    __device__ __forceinline__ unsigned row_off(const Unit& u, int r, int K_) const {
        if (!GATHER) return (unsigned)(r * K_) * 2u;
        const int pos = u.rt * 256 + r; const int n = __builtin_amdgcn_readfirstlane(tbl[17 + u.e]);
        const int t = pos < n ? tok[u.e * SEQ + pos] : 0;
        return (unsigned)(t * K_) * 2u;
    }
    __device__ __forceinline__ void a_ready(const Unit&, int) const {}
};

struct DownOrder {
    const LAS int* tbl; unsigned* cnt; unsigned* tmo; int G, c;
    __device__ bool next(int i, Unit& u) const {
        const int T = __builtin_amdgcn_readfirstlane(tbl[16]);
        const int U1 = 4 * T, nb2 = U1 > G ? U1 - G : 0, F = G - nb2;
        const int g1 = T < (G >> 2) ? T : (G >> 2), E = 8 * g1, Lt = 8 * (T - g1);
        int k = -1, late = 0;
        int ii = i;
        if (c >= nb2) { const int cf = c - nb2; const int nE = E > cf ? (E - cf + F - 1) / F : 0; if (ii < nE) k = cf + ii * F; else ii -= nE; }
        int g, ct;
        if (k >= 0) { g = k >> 3; ct = k & 7; }
        else {
            const int qE = E / F, rem = E - qE * F;
            int r;
            if (c >= nb2) { const int cf = c - nb2; r = cf >= rem ? cf - rem : (F - rem) + nb2 + cf; } else r = (F - rem) + c;
            const int kk = r + ii * G; if (kk >= Lt) return false; g = g1 + (kk >> 3); ct = kk & 7; late = 1; }
        (void)late;
        int e = 0;
#pragma unroll
        for (int q = 1; q < 16; ++q) e += (g >= tbl[q]) ? 1 : 0;
        e = __builtin_amdgcn_readfirstlane(e);
        u.pm = g; u.pn = e * 8 + ct; u.e = e; u.rt = __builtin_amdgcn_readfirstlane(g - tbl[e]); return true;
    }
    __device__ __forceinline__ size_t a_base(const Unit& u, size_t tstep) const { return (size_t)u.pm * tstep; }
    __device__ __forceinline__ unsigned row_off(const Unit&, int r, int K_) const { return (unsigned)(r * K_) * 2u; }
    __device__ __forceinline__ void a_ready(const Unit& u, int wid) const {
        if (wid == 0) {
            unsigned sp = 0;
            while ((unsigned)__builtin_amdgcn_readfirstlane((int)__hip_atomic_load(cnt + 64 * u.pm, __ATOMIC_RELAXED, __HIP_MEMORY_SCOPE_AGENT)) < 32u) {
                __builtin_amdgcn_s_sleep(2);
                if (++sp > (1u << 22)) { __hip_atomic_store(tmo, 1u, __ATOMIC_RELAXED, __HIP_MEMORY_SCOPE_AGENT); break; }
            }
            __builtin_amdgcn_fence(__ATOMIC_ACQUIRE, "agent");
            asm volatile("s_waitcnt vmcnt(0)" ::: "memory");
        }
        asm volatile("" ::: "memory"); __builtin_amdgcn_s_barrier(); asm volatile("" ::: "memory");
    }
};

template <class Epi, class Sched, bool SP2 = true>
__device__ __forceinline__ void gemm_phase(LAS unsigned char* lds, const Gemm g, const Sched& S, const Epi& E, int wv) {
    const int tid = otid(wv), wid = __builtin_amdgcn_readfirstlane(tid >> 6), lane = tid & 63, wr = wid >> 2, wc = wid & 3, fr = lane & 15, fq = lane >> 4;
    const int K = g.K, nt = K / BK;
    unsigned voffB[2]; int Rr[2], Cc[2];
#pragma unroll
    for (int i = 0; i < 2; ++i) { int R, C; stage_rc(tid * 16 + i * 8192, R, C); const int Rb = (R & ~31) + permf<Epi::PERM>(R & 31);
        Rr[i] = R; Cc[i] = C; voffB[i] = (unsigned)(Rb * K + C) * 2u; }
    const size_t kstep = (size_t)(BK * 2);
    const size_t hstep = (size_t)HALF * K * 2;
    const size_t tstep = 2 * hstep;
    const unsigned ldsw = (unsigned)wid * 1024u;
    const int aoff = lds_byte(wr * 64 + fr, fq * 8), boff = lds_byte(wc * 32 + fr, fq * 8);
#define PG8_SA(b, h) (((b) * 2 + (h)) * HTB)
#define PG8_SB(b, h) ((4 + (b) * 2 + (h)) * HTB)
#define PG8_STAGE(bufoff, gbase, voff) do { _Pragma("unroll") for (int _i = 0; _i < 2; ++_i) \
        __builtin_amdgcn_global_load_lds((const unsigned*)((const char*)(gbase) + (voff)[_i]), (LAS unsigned*)(lds + (bufoff) + ldsw + _i * 8192), 16, 0, 0); } while (0)
#define PG8_LDA(dst, b, h) do { _Pragma("unroll") for (int m = 0; m < 4; ++m) _Pragma("unroll") for (int k = 0; k < 2; ++k) dst[m][k] = *(const LAS bf16x8*)(lds + PG8_SA(b, h) + aoff + m * 2048 + k * 1024); } while (0)
#define PG8_LDB(dst, b, h) do { _Pragma("unroll") for (int n = 0; n < 2; ++n) _Pragma("unroll") for (int k = 0; k < 2; ++k) dst[n][k] = *(const LAS bf16x8*)(lds + PG8_SB(b, h) + boff + n * 2048 + k * 1024); } while (0)
#define PG8_MMA(ai, bj, At, Bt) do { __builtin_amdgcn_s_setprio(1); _Pragma("unroll") for (int m = 0; m < 4; ++m) _Pragma("unroll") for (int n = 0; n < 2; ++n) _Pragma("unroll") for (int k = 0; k < 2; ++k) \
        acc[ai][bj][m][n] = __builtin_amdgcn_mfma_f32_16x16x32_bf16(Bt[n][k], At[m][k], acc[ai][bj][m][n], 0, 0, 0); __builtin_amdgcn_s_setprio(0); } while (0)
#define PG8_WAIT_V(n) asm volatile("s_waitcnt vmcnt(" #n ")" ::: "memory")
#define PG8_WAIT_L(n) asm volatile("s_waitcnt lgkmcnt(" #n ")" ::: "memory")
#define PG8_BAR __builtin_amdgcn_s_barrier()
#define PG8_SCHED __builtin_amdgcn_sched_barrier(0)
    Unit cur, nxt; int ui = 0;
    if (!S.next(0, cur)) return;
    f32x4 acc[2][2][4][2];
    if constexpr (Epi::LOAD_INIT) E.init(acc, cur, wr, wc, fr, fq);
    else {
#pragma unroll
    for (int a = 0; a < 2; ++a)
#pragma unroll
        for (int b = 0; b < 2; ++b)
#pragma unroll
            for (int m = 0; m < 4; ++m)
#pragma unroll
                for (int n = 0; n < 2; ++n) acc[a][b][m][n] = (f32x4){0.f, 0.f, 0.f, 0.f};
    }
    bf16x8 At[4][2], B0[2][2], B1[2][2];
    unsigned oc[2][2], on[2][2];
#pragma unroll
    for (int h = 0; h < 2; ++h)
#pragma unroll
        for (int i = 0; i < 2; ++i) { oc[h][i] = S.row_off(cur, h * HALF + Rr[i], K) + (unsigned)Cc[i] * 2u; on[h][i] = oc[h][i]; }
    const char* cA = (const char*)g.A + S.a_base(cur, tstep); const char* cB = (const char*)g.Bt + (size_t)cur.pn * tstep;
    S.a_ready(cur, wid);
    if constexpr (SP2) {
        PG8_STAGE(PG8_SB(0, 0), cB, voffB); PG8_STAGE(PG8_SB(0, 1), cB + hstep, voffB); PG8_STAGE(PG8_SA(0, 0), cA, oc[0]); PG8_STAGE(PG8_SA(0, 1), cA, oc[1]);
        if (wr == 1) PG8_BAR;
        PG8_WAIT_V(2); PG8_BAR;
        PG8_STAGE(PG8_SB(1, 0), cB + kstep, voffB); PG8_STAGE(PG8_SA(1, 0), cA + kstep, oc[0]); PG8_STAGE(PG8_SB(1, 1), cB + hstep + kstep, voffB);
        PG8_WAIT_V(6); PG8_BAR;
    } else {
        PG8_STAGE(PG8_SB(0, 0), cB, voffB); PG8_STAGE(PG8_SA(0, 0), cA, oc[0]); PG8_STAGE(PG8_SB(0, 1), cB + hstep, voffB); PG8_STAGE(PG8_SA(0, 1), cA, oc[1]);
        if (wr == 1) PG8_BAR;
        PG8_WAIT_V(4); PG8_BAR;
        PG8_STAGE(PG8_SB(1, 0), cB + kstep, voffB); PG8_STAGE(PG8_SA(1, 0), cA + kstep, oc[0]); PG8_STAGE(PG8_SB(1, 1), cB + hstep + kstep, voffB);
        PG8_WAIT_V(6); PG8_BAR;
    }
    for (;;) {
        const bool has_next = S.next(ui + 1, nxt);
        const char* nA = has_next ? (const char*)g.A + S.a_base(nxt, tstep) : cA; const char* nB = has_next ? (const char*)g.Bt + (size_t)nxt.pn * tstep : cB;
        if (has_next) {
#pragma unroll
            for (int h = 0; h < 2; ++h)
#pragma unroll
                for (int i = 0; i < 2; ++i) on[h][i] = S.row_off(nxt, h * HALF + Rr[i], K) + (unsigned)Cc[i] * 2u;
        }
        for (int t = 0; t < nt; t += 2) {
            const bool last = (t == nt - 2);
            if (last && has_next) S.a_ready(nxt, wid);
            const char* a1 = cA + (size_t)(t + 1) * kstep;
            const char* a2 = last ? nA : cA + (size_t)(t + 2) * kstep; const char* b2 = last ? nB : cB + (size_t)(t + 2) * kstep;
            const char* a3 = a2 + kstep; const char* b3 = b2 + kstep;
            unsigned o2a[2], o2b[2];
            o2a[0] = last ? on[0][0] : oc[0][0]; o2a[1] = last ? on[0][1] : oc[0][1]; o2b[0] = last ? on[1][0] : oc[1][0]; o2b[1] = last ? on[1][1] : oc[1][1];
            if constexpr (SP2) {
            PG8_LDB(B0, 0, 0); PG8_LDB(B1, 0, 1); PG8_SCHED; PG8_LDA(At, 0, 0); PG8_STAGE(PG8_SA(1, 1), a1, oc[1]);
            PG8_WAIT_V(8); PG8_WAIT_L(0); PG8_BAR; PG8_MMA(0, 0, At, B0); PG8_MMA(0, 1, At, B1); PG8_BAR; PG8_SCHED;
            PG8_LDA(At, 0, 1); PG8_STAGE(PG8_SB(0, 0), b2, voffB); PG8_STAGE(PG8_SB(0, 1), b2 + hstep, voffB); PG8_STAGE(PG8_SA(0, 0), a2, o2a);
            PG8_WAIT_V(8); PG8_WAIT_L(0); PG8_BAR; PG8_MMA(1, 0, At, B0); PG8_MMA(1, 1, At, B1); PG8_BAR; PG8_SCHED;
            PG8_LDB(B0, 1, 0); PG8_LDB(B1, 1, 1); PG8_SCHED; PG8_LDA(At, 1, 0); PG8_STAGE(PG8_SA(0, 1), a2, o2b);
            PG8_WAIT_V(8); PG8_WAIT_L(0); PG8_BAR; PG8_MMA(0, 0, At, B0); PG8_MMA(0, 1, At, B1); PG8_BAR; PG8_SCHED;
            PG8_LDA(At, 1, 1); PG8_STAGE(PG8_SB(1, 0), b3, voffB); PG8_STAGE(PG8_SB(1, 1), b3 + hstep, voffB); PG8_STAGE(PG8_SA(1, 0), a3, o2a);
            PG8_WAIT_V(8); PG8_WAIT_L(0); PG8_BAR; PG8_MMA(1, 0, At, B0); PG8_MMA(1, 1, At, B1); PG8_BAR; PG8_SCHED;
            } else {
            PG8_LDB(B0, 0, 0); PG8_SCHED; PG8_LDA(At, 0, 0); PG8_STAGE(PG8_SA(1, 1), a1, oc[1]);
            PG8_WAIT_L(8); PG8_BAR; PG8_WAIT_L(0); PG8_MMA(0, 0, At, B0); PG8_BAR; PG8_SCHED;
            PG8_LDB(B1, 0, 1); PG8_STAGE(PG8_SB(0, 0), b2, voffB);
            PG8_BAR; PG8_WAIT_L(0); PG8_MMA(0, 1, At, B1); PG8_BAR;
            PG8_LDA(At, 0, 1); PG8_STAGE(PG8_SA(0, 0), a2, o2a);
            PG8_BAR; PG8_WAIT_L(0); PG8_MMA(1, 0, At, B0); PG8_BAR; PG8_SCHED;
            PG8_STAGE(PG8_SB(0, 1), b2 + hstep, voffB);
            PG8_WAIT_V(6); PG8_BAR; PG8_MMA(1, 1, At, B1); PG8_BAR;
            PG8_LDB(B0, 1, 0); PG8_SCHED; PG8_LDA(At, 1, 0); PG8_STAGE(PG8_SA(0, 1), a2, o2b);
            PG8_WAIT_L(8); PG8_BAR; PG8_WAIT_L(0); PG8_MMA(0, 0, At, B0); PG8_BAR; PG8_SCHED;
            PG8_LDB(B1, 1, 1); PG8_STAGE(PG8_SB(1, 0), b3, voffB);
            PG8_BAR; PG8_WAIT_L(0); PG8_MMA(0, 1, At, B1); PG8_BAR;
            PG8_LDA(At, 1, 1); PG8_STAGE(PG8_SA(1, 0), a3, o2a);
            PG8_BAR; PG8_WAIT_L(0); PG8_MMA(1, 0, At, B0); PG8_BAR; PG8_SCHED;
            PG8_STAGE(PG8_SB(1, 1), b3 + hstep, voffB);
            PG8_WAIT_V(6); PG8_BAR; PG8_MMA(1, 1, At, B1); PG8_BAR;
            }
        }
        if (wr == 0) PG8_BAR;
        { const int tz = otid(wv) & 63; E(acc, cur, wr, wc, tz & 15, tz >> 4); }
        if (!has_next) break;
#pragma unroll
        for (int a = 0; a < 2; ++a)
#pragma unroll
            for (int b = 0; b < 2; ++b)
#pragma unroll
                for (int m = 0; m < 4; ++m)
#pragma unroll
                    for (int n = 0; n < 2; ++n) acc[a][b][m][n] = (f32x4){0.f, 0.f, 0.f, 0.f};
        if constexpr (Epi::LOAD_INIT) { const int tz2 = otid(wv) & 63; E.init(acc, nxt, wr, wc, tz2 & 15, tz2 >> 4); }
        cur = nxt; cA = nA; cB = nB; ++ui;
#pragma unroll
        for (int h = 0; h < 2; ++h)
#pragma unroll
            for (int i = 0; i < 2; ++i) oc[h][i] = on[h][i];
        if (wr == 1) PG8_BAR;
    }
    PG8_WAIT_V(0);
    PG8_BAR;
#undef PG8_SA
#undef PG8_SB
#undef PG8_STAGE
#undef PG8_LDA
#undef PG8_LDB
#undef PG8_MMA
#undef PG8_WAIT_V
#undef PG8_WAIT_L
#undef PG8_BAR
#undef PG8_SCHED
}


struct EpiQK {
    static constexpr int PERM = 1; static constexpr bool LOAD_INIT = false;
    bf16_t* O; const float *gqd, *gkd, *gqf, *gkf; LAS float* tbl; const float* rstd;
    __device__ __forceinline__ void operator()(const f32x4 (&acc)[2][2][4][2], const Unit& u, int wr, int wc, int fr, int fq) const {
#pragma unroll
        for (int ai = 0; ai < 2; ++ai)
#pragma unroll
            for (int m = 0; m < 4; ++m)
#pragma unroll
                for (int bj = 0; bj < 2; ++bj) {
                    const f32x4 a = acc[ai][bj][m][0], b = acc[ai][bj][m][1];
                    float ss = (a[0] * a[0] + a[1] * a[1]) + (a[2] * a[2] + a[3] * a[3]) + (b[0] * b[0] + b[1] * b[1]) + (b[2] * b[2] + b[3] * b[3]);
                    ss += swz_xor<16>(ss); ss = sum_xor32(ss);
                    if (fq == 0) tbl[(bj * 256 + ai * 128 + wr * 64 + m * 16 + fr) * 4 + wc] = ss;
                }
        asm volatile("s_waitcnt lgkmcnt(0)" ::: "memory"); __builtin_amdgcn_s_barrier(); asm volatile("" ::: "memory");
        const int colh = wc * 32 + fq * 8;
#pragma unroll
        for (int bj = 0; bj < 2; ++bj) {
            const int hh = u.pn * 2 + bj;
            int mode; const float* gp; float extra;
            if (hh < 6) { mode = 0; gp = gqd + (colh & 63); extra = 0.125f * LOG2E; }
            else if (hh < 12) { mode = 0; gp = gkd + (colh & 63); extra = 1.f; }
            else if (hh < 17) { mode = 1; gp = gqf + colh; extra = 0.08838834764831845f * LOG2E; }
            else if (hh < 22) { mode = 1; gp = gkf + colh; extra = 1.f; }
            else if (hh < 27) { mode = 2; gp = gqd; extra = 0.08838834764831845f * LOG2E; }
            else { mode = 2; gp = gqd; extra = 1.f; }
            f32x4 g0 = (f32x4){1.f, 1.f, 1.f, 1.f}, g1 = g0;
            if (mode != 2) { g0 = *(const f32x4*)gp; g1 = *(const f32x4*)(gp + 4); }
            g0 = g0 * extra; g1 = g1 * extra;
#pragma unroll
            for (int ai = 0; ai < 2; ++ai)
#pragma unroll
                for (int m = 0; m < 4; ++m) {
                    const int rl = ai * 128 + wr * 64 + m * 16 + fr;
                    const float rr = rstd[u.pm * 256 + rl];
                    float rs = rr;
                    if (mode != 2) {
                        const f32x4 t = *(const LAS f32x4*)(tbl + (bj * 256 + rl) * 4);
                        const float tot = (mode == 0) ? ((wc < 2) ? (t[0] + t[1]) : (t[2] + t[3])) : ((t[0] + t[1]) + (t[2] + t[3]));
                        rs = rr * __builtin_amdgcn_rsqf(rr * rr * tot * (mode == 0 ? (1.f / 64.f) : (1.f / 128.f)) + EPS);
                    }
                    const f32x4 v0 = acc[ai][bj][m][0] * g0 * rs, v1 = acc[ai][bj][m][1] * g1 * rs;
                    u32x4 w; w.x = cvtpk(v0[0], v0[1]); w.y = cvtpk(v0[2], v0[3]); w.z = cvtpk(v1[0], v1[1]); w.w = cvtpk(v1[2], v1[3]);
                    *(u32x4*)(O + (size_t)(u.pm * 256 + rl) * NQK + u.pn * 256 + bj * 128 + colh) = w;
                }
        }
    }
};
struct EpiVT {
    static constexpr int PERM = 2; static constexpr bool LOAD_INIT = false;
    bf16_t* O; int ldc; const float* rstd;
    __device__ __forceinline__ void operator()(const f32x4 (&acc)[2][2][4][2], const Unit& u, int wr, int wc, int fr, int fq) const {
        f32x4 r0[2], r1[2];
#pragma unroll
        for (int bj = 0; bj < 2; ++bj) { const float* rp = rstd + u.pn * 256 + bj * 128 + wc * 32 + 16 * (fq >> 1) + 4 * (fq & 1);
            r0[bj] = *(const f32x4*)rp; r1[bj] = *(const f32x4*)(rp + 8); }
#pragma unroll
        for (int ai = 0; ai < 2; ++ai)
#pragma unroll
            for (int m = 0; m < 4; ++m)
#pragma unroll
                for (int bj = 0; bj < 2; ++bj) {
                    const f32x4 v0 = acc[ai][bj][m][0] * r0[bj], v1 = acc[ai][bj][m][1] * r1[bj];
                    u32x4 w; w.x = cvtpk(v0[0], v0[1]); w.y = cvtpk(v0[2], v0[3]); w.z = cvtpk(v1[0], v1[1]); w.w = cvtpk(v1[2], v1[3]);
                    *(u32x4*)(O + (size_t)(u.pm * 256 + ai * 128 + wr * 64 + m * 16 + fr) * ldc + u.pn * 256 + bj * 128 + wc * 32 + fq * 8) = w;
                }
    }
};
struct EpiResAdd {
    static constexpr int PERM = 1; static constexpr bool LOAD_INIT = true;
    bf16_t* X; float sc; unsigned* done;
    __device__ __forceinline__ void init(f32x4 (&acc)[2][2][4][2], const Unit& u, int wr, int wc, int fr, int fq) const {
#pragma unroll
        for (int ai = 0; ai < 2; ++ai)
#pragma unroll
            for (int m = 0; m < 4; ++m)
#pragma unroll
                for (int bj = 0; bj < 2; ++bj) {
                    const u32x4 w = *(const u32x4*)(X + (size_t)(u.pm * 256 + ai * 128 + wr * 64 + m * 16 + fr) * DM + u.pn * 256 + bj * 128 + wc * 32 + fq * 8);
                    acc[ai][bj][m][0] = (f32x4){bf_lo(w.x), bf_hi(w.x), bf_lo(w.y), bf_hi(w.y)};
                    acc[ai][bj][m][1] = (f32x4){bf_lo(w.z), bf_hi(w.z), bf_lo(w.w), bf_hi(w.w)};
                }
    }
    __device__ __forceinline__ void operator()(const f32x4 (&acc)[2][2][4][2], const Unit& u, int wr, int wc, int fr, int fq) const {
        const __amdgpu_buffer_rsrc_t rsrc = __builtin_amdgcn_make_buffer_rsrc((void*)X, 0, SEQ * DM * 2, 0x00020000);
#pragma unroll
        for (int ai = 0; ai < 2; ++ai)
#pragma unroll
            for (int m = 0; m < 4; ++m)
#pragma unroll
                for (int bj = 0; bj < 2; ++bj) {
                    const f32x4 v0 = acc[ai][bj][m][0], v1 = acc[ai][bj][m][1];
                    u32x4 w; w.x = cvtpk(v0[0], v0[1]); w.y = cvtpk(v0[2], v0[3]); w.z = cvtpk(v1[0], v1[1]); w.w = cvtpk(v1[2], v1[3]);
                    __builtin_amdgcn_raw_buffer_store_b128(w, rsrc, (int)(((u.pm * 256 + ai * 128 + wr * 64 + m * 16 + fr) * DM + u.pn * 256 + bj * 128 + wc * 32 + fq * 8) * 2), 0, 16);
                }
        asm volatile("s_waitcnt vmcnt(0)" ::: "memory");
        if (fr == 0 && fq == 0) __hip_atomic_fetch_add(done + 64 * u.pm, 1u, __ATOMIC_RELAXED, __HIP_MEMORY_SCOPE_AGENT);
    }
};
struct EpiGU {
    static constexpr int PERM = 1; static constexpr bool LOAD_INIT = false;
    bf16_t* ACT; const float* gate; const LAS int* tbl; unsigned* done;
    __device__ __forceinline__ void operator()(const f32x4 (&acc)[2][2][4][2], const Unit& u, int wr, int wc, int fr, int fq) const {
        const int ct = u.pn & 3, n_e = __builtin_amdgcn_readfirstlane(tbl[17 + u.e]);
        const __amdgpu_buffer_rsrc_t rsrc = __builtin_amdgcn_make_buffer_rsrc((void*)ACT, 0, MOE_ROWS * FEXP * 2, 0x00020000);
#pragma unroll
        for (int ai = 0; ai < 2; ++ai)
#pragma unroll
            for (int m = 0; m < 4; ++m) {
                const int rl = ai * 128 + wr * 64 + m * 16 + fr, pos = u.rt * 256 + rl;
                f32x2_t gr2 = {0.f, 0.f}; if (pos < n_e) gr2 = *(const f32x2_t*)(gate + 2 * (u.e * SEQ + pos));
                const float gt = gr2[0], rs = gr2[1];
                float o[8];
#pragma unroll
                for (int n = 0; n < 2; ++n)
#pragma unroll
                    for (int j = 0; j < 4; ++j) { const float gv = acc[ai][0][m][n][j] * rs, uv = acc[ai][1][m][n][j] * rs;
                        const float sg = gv * __builtin_amdgcn_rcpf(1.f + fexp2(-gv * LOG2E)); o[n * 4 + j] = sg * uv * gt; }
                u32x4 w; w.x = cvtpk(o[0], o[1]); w.y = cvtpk(o[2], o[3]); w.z = cvtpk(o[4], o[5]); w.w = cvtpk(o[6], o[7]);
                __builtin_amdgcn_raw_buffer_store_b128(w, rsrc, (int)(((u.pm * 256 + rl) * FEXP + ct * 128 + wc * 32 + fq * 8) * 2), 0, 16);
            }
        asm volatile("s_waitcnt vmcnt(0)" ::: "memory");
        if (fr == 0 && fq == 0) __hip_atomic_fetch_add(done + 64 * u.pm, 1u, __ATOMIC_RELAXED, __HIP_MEMORY_SCOPE_AGENT);
    }
};
struct EpiDown {
    static constexpr int PERM = 1; static constexpr bool LOAD_INIT = false;
    bf16_t* Y;
    __device__ __forceinline__ void operator()(const f32x4 (&acc)[2][2][4][2], const Unit& u, int wr, int wc, int fr, int fq) const {
        const int ct = u.pn & 7;
#pragma unroll
        for (int ai = 0; ai < 2; ++ai)
#pragma unroll
            for (int m = 0; m < 4; ++m)
#pragma unroll
                for (int bj = 0; bj < 2; ++bj) {
                    const f32x4 v0 = acc[ai][bj][m][0], v1 = acc[ai][bj][m][1];
                    u32x4 w; w.x = cvtpk(v0[0], v0[1]); w.y = cvtpk(v0[2], v0[3]); w.z = cvtpk(v1[0], v1[1]); w.w = cvtpk(v1[2], v1[3]);
                    *(u32x4*)(Y + (size_t)(u.pm * 256 + ai * 128 + wr * 64 + m * 16 + fr) * DM + ct * 256 + bj * 128 + wc * 32 + fq * 8) = w;
                }
    }
};
}

#define XB_TMO      128
#define XB_XCNT(j)  (256  + 64 * (j))
#define XB_XSUB(j)  (1280 + 64 * (j))
#define XB_XGEN(j)  (2304 + 64 * (j))
#define XB_TOP      3328
#define XB_TOPGEN   3392
#define XCD_BAR_WORDS 3456
#define XB_SPIN_CAP (1u << 18)

__device__ __forceinline__ unsigned xb_ld(unsigned* p)              { return __hip_atomic_load(p, __ATOMIC_RELAXED, __HIP_MEMORY_SCOPE_AGENT); }
__device__ __forceinline__ unsigned xb_add(unsigned* p, unsigned v) { return __hip_atomic_fetch_add(p, v, __ATOMIC_RELAXED, __HIP_MEMORY_SCOPE_AGENT); }
__device__ __forceinline__ unsigned xb_xcc_id() { return (unsigned)__builtin_amdgcn_s_getreg((3 << 11) | 20) & 0xFu; }
#define XB_SPIN(cond, bar) do { unsigned _sp = 0; while (cond) { __builtin_amdgcn_s_sleep(1); \
    if ((++_sp & 255u) == 0u) { if (xb_ld(&(bar)[XB_TMO])) break; if (_sp > XB_SPIN_CAP) { atomicAdd(&(bar)[XB_TMO], 1u); break; } } } } while (0)

struct XcdBarrier { unsigned* bar; unsigned x; volatile LAS unsigned* st; int wv; };

__device__ __forceinline__ XcdBarrier xcd_barrier_post(unsigned* bar, volatile LAS unsigned* st, int wv) {
    XcdBarrier b; b.bar = bar; b.x = xb_xcc_id(); b.st = st; b.wv = wv;
    if (otid(wv) == 0) (void)xb_add(&bar[XB_XCNT(b.x)], 1u);
    return b;
}
__device__ __forceinline__ void xcd_barrier_complete(unsigned* bar, unsigned x, unsigned& nloc, unsigned& nx) {
    const unsigned G = gridDim.x * gridDim.y * gridDim.z;
    unsigned sum, cnt, mine, sp = 0u;
    for (;;) {
        sum = 0u; cnt = 0u; mine = 0u;
#pragma unroll
        for (unsigned j = 0; j < 16; ++j) { const unsigned c = xb_ld(&bar[XB_XCNT(j)]); sum += c; cnt += (c > 0u) ? 1u : 0u; mine = (j == x) ? c : mine; }
        if (sum == G) break;
        __builtin_amdgcn_s_sleep(1);
        if ((++sp & 255u) == 0u) { if (xb_ld(&bar[XB_TMO])) break; if (sp > XB_SPIN_CAP) { atomicAdd(&bar[XB_TMO], 1u); break; } }
    }
    nloc = mine > 0u ? mine : 1u; nx = cnt > 0u ? cnt : 1u;
}
__device__ __attribute__((noinline)) void xcd_barrier_impl(unsigned* bar_, unsigned bx, volatile LAS unsigned* bst, int bwv) {
    XcdBarrier b; b.bar = bar_; b.x = bx; b.st = bst; b.wv = bwv;
    asm volatile("s_waitcnt vmcnt(0)" ::: "memory");
    __syncthreads();
    if (otid(b.wv) == 0) {
        unsigned* bar = b.bar;
        __builtin_amdgcn_s_waitcnt(0);
        unsigned nloc = b.st[0], nx = b.st[1];
        if (nloc == 0u) { xcd_barrier_complete(bar, b.x, nloc, nx); b.st[0] = nloc; b.st[1] = nx; }
        const unsigned old = xb_add(&bar[XB_XSUB(b.x)], 1u);
        const unsigned gen = old / nloc;
        if (old + 1u == (gen + 1u) * nloc) {
            __builtin_amdgcn_fence(__ATOMIC_RELEASE, "agent");
            asm volatile("s_waitcnt vmcnt(0)" ::: "memory");
            const unsigned og = xb_add(&bar[XB_TOP], 1u);
            const unsigned tg = og / nx;
            if (og + 1u == (tg + 1u) * nx) xb_add(&bar[XB_TOPGEN], 1u);
            else XB_SPIN(xb_ld(&bar[XB_TOPGEN]) == tg, bar);
            __builtin_amdgcn_fence(__ATOMIC_ACQUIRE, "agent");
            xb_add(&bar[XB_XGEN(b.x)], 1u);
            asm volatile("s_waitcnt vmcnt(0)" ::: "memory");
        } else {
            XB_SPIN(xb_ld(&bar[XB_XGEN(b.x)]) == gen, bar);
            __builtin_amdgcn_fence(__ATOMIC_ACQUIRE, "agent");
            asm volatile("s_waitcnt vmcnt(0)" ::: "memory");
        }
    }
    __syncthreads();
}

__device__ __forceinline__ void xcd_barrier(const XcdBarrier& b) { xcd_barrier_impl(b.bar, b.x, b.st, b.wv); }

struct Params {
    const float *x, *attn_norm, *w_in, *b_forget, *qnorm_diff, *knorm_diff, *lam_q1, *lam_k1, *lam_q2, *lam_k2, *subln_diff, *onorm_sb,
        *qnorm_fox, *knorm_fox, *onorm_fox, *w_out, *ffn_norm, *w_router, *router_bias, *w_gate, *w_up, *w_down;
    float* out; unsigned char* ws; int ph_lo, ph_hi;
};
typedef const __attribute__((address_space(4))) Params* KArgs;
__device__ __forceinline__ KArgs kparams() { KArgs k = (KArgs)__builtin_amdgcn_kernarg_segment_ptr(); asm volatile("" : "+s"(k)); return k; }

__device__ __forceinline__ void transpose_item(const float* W, int ldn, int k0, int n0, bf16_t* WT, int K, int drow, LAS float* scr, int lane, const float* kgain = nullptr) {
#pragma unroll 8
    for (int i = 0; i < 32; ++i) { const int kk = 2 * i + (lane >> 5); scr[kk * 33 + (lane & 31)] = W[(size_t)(k0 + kk) * ldn + n0 + (lane & 31)]; }
    asm volatile("s_waitcnt lgkmcnt(0)" ::: "memory");
    const int c = lane & 7;
    f32x4 ga = {1.f, 1.f, 1.f, 1.f}, gb = ga;
    if (kgain) { ga = *(const f32x4*)(kgain + k0 + 8 * c); gb = *(const f32x4*)(kgain + k0 + 8 * c + 4); }
#pragma unroll
    for (int j = 0; j < 4; ++j) { const int n = (lane >> 3) + 8 * j; const LAS float* s = scr + (8 * c) * 33 + n;
        u32x4 o; o.x = cvtpk(s[0 * 33] * ga[0], s[1 * 33] * ga[1]); o.y = cvtpk(s[2 * 33] * ga[2], s[3 * 33] * ga[3]); o.z = cvtpk(s[4 * 33] * gb[0], s[5 * 33] * gb[1]); o.w = cvtpk(s[6 * 33] * gb[2], s[7 * 33] * gb[3]);
        *(u32x4*)(WT + (size_t)(drow + n) * K + k0 + 8 * c) = o; }
    asm volatile("s_waitcnt lgkmcnt(0)" ::: "memory");
}
__device__ __forceinline__ int win_dest(int n0, int& sel) {
    if (n0 < 768) { sel = 0; return n0; }
    if (n0 < 1536) { sel = 0; return n0; }
    if (n0 < 2304) { sel = 1; return n0 - 1536; }
    if (n0 < 2944) { sel = 0; return 2816 + (n0 - 2304); }
    if (n0 < 3584) { sel = 0; return 3456 + (n0 - 2944); }
    if (n0 < 4224) { sel = 1; return 768 + (n0 - 3584); }
    if (n0 < 4864) { sel = 0; return 1536 + (n0 - 4224); }
    if (n0 < 5504) { sel = 0; return 2176 + (n0 - 4864); }
    sel = 1; return 1408 + (n0 - 5504);
}
__device__ __forceinline__ void phase_prologue(KArgs p, LAS unsigned char* lds, int wv) {
    const int tid = otid(wv), lane = tid & 63, wave = tid >> 6;
    LAS float* scr = (LAS float*)(lds + wave * 16384);
    const int gw = blockIdx.x * 8 + wave, NGW = gridDim.x * 8;
    constexpr int I_IN = 32 * 192, I_O = 32 * 64, I_G = 16 * 32 * 16, I_D = 16 * 8 * 64, I_L = I_IN + I_O + 2 * I_G + I_D;
    bf16_t* Wqk = (bf16_t*)(p->ws + WS_WQK); bf16_t* Wv = (bf16_t*)(p->ws + WS_WV); bf16_t* Wo = (bf16_t*)(p->ws + WS_WO);
    bf16_t* Wgu = (bf16_t*)(p->ws + WS_WGU); bf16_t* Wd = (bf16_t*)(p->ws + WS_WD);
    for (int it = gw; it < DEPTH * I_L; it += NGW) {
        const int l = it / I_L; int r = it % I_L;
        if (r < I_IN) { const int kb = r / 192, nb = r % 192; int sel; const int drow = win_dest(nb * 32, sel);
            transpose_item(p->w_in + (size_t)l * DM * NIN, NIN, kb * 64, nb * 32, sel ? Wv + (size_t)l * NV * DM : Wqk + (size_t)l * NQK * DM, DM, drow, scr, lane, p->attn_norm + (size_t)l * DM); continue; }
        r -= I_IN;
        if (r < I_O) { const int kb = r / 64, nb = r % 64;
            transpose_item(p->w_out + (size_t)l * DM * DM, DM, kb * 64, nb * 32, Wo + (size_t)l * DM * DM, DM, nb * 32, scr, lane); continue; }
        r -= I_O;
        if (r < 2 * I_G) { const int up = r / I_G; r %= I_G; const int e = r / 512, kb = (r % 512) / 16, nb = r % 16; const int n0 = nb * 32;
            const float* src = (up ? p->w_up : p->w_gate) + ((size_t)l * NEXP + e) * DM * FEXP;
            transpose_item(src, FEXP, kb * 64, n0, Wgu + ((size_t)l * NEXP + e) * 1024 * DM, DM, (n0 >> 7) * 256 + up * 128 + (n0 & 127), scr, lane, p->ffn_norm + (size_t)l * DM); continue; }
        r -= 2 * I_G;
        { const int e = r / 512, kb = (r % 512) / 64, nb = r % 64;
            transpose_item(p->w_down + ((size_t)l * NEXP + e) * FEXP * DM, DM, kb * 64, nb * 32, Wd + ((size_t)l * NEXP + e) * DM * FEXP, FEXP, nb * 32, scr, lane); }
    }
    { float* WRT = (float*)(p->ws + WS_WRT); for (int i = blockIdx.x * 512 + tid; i < 16 * DM; i += gridDim.x * 512) WRT[(i & 15) * DM + (i >> 4)] = p->w_router[i]; }
    float* WF = (float*)(p->ws + WS_WF);
    for (int i = blockIdx.x * 512 + tid; i < DEPTH * 5 * DM; i += gridDim.x * 512) { const int l = i / (5 * DM), h = (i / DM) % 5, d = i % DM;
        WF[i] = p->w_in[((size_t)l * DM + d) * NIN + 6144 + h]; }
    if (blockIdx.x == 1 && wave < DEPTH) {
        const int l = wave;
        float a = fabsf(p->qnorm_diff[l * 64 + lane]), b = fabsf(p->knorm_diff[l * 64 + lane]);
        float c2 = fmaxf(fabsf(p->qnorm_fox[l * 128 + lane]), fabsf(p->qnorm_fox[l * 128 + 64 + lane])), d2 = fmaxf(fabsf(p->knorm_fox[l * 128 + lane]), fabsf(p->knorm_fox[l * 128 + 64 + lane]));
#pragma unroll
        for (int o = 1; o < 32; o <<= 1) { a = fmaxf(a, __int_as_float(__builtin_amdgcn_ds_bpermute(((lane ^ o) << 2), __float_as_int(a)))); b = fmaxf(b, __int_as_float(__builtin_amdgcn_ds_bpermute(((lane ^ o) << 2), __float_as_int(b))));
            c2 = fmaxf(c2, __int_as_float(__builtin_amdgcn_ds_bpermute(((lane ^ o) << 2), __float_as_int(c2)))); d2 = fmaxf(d2, __int_as_float(__builtin_amdgcn_ds_bpermute(((lane ^ o) << 2), __float_as_int(d2)))); }
        a = fmaxf(a, __int_as_float(__builtin_amdgcn_ds_bpermute(((lane ^ 32) << 2), __float_as_int(a)))); b = fmaxf(b, __int_as_float(__builtin_amdgcn_ds_bpermute(((lane ^ 32) << 2), __float_as_int(b))));
        c2 = fmaxf(c2, __int_as_float(__builtin_amdgcn_ds_bpermute(((lane ^ 32) << 2), __float_as_int(c2)))); d2 = fmaxf(d2, __int_as_float(__builtin_amdgcn_ds_bpermute(((lane ^ 32) << 2), __float_as_int(d2))));
        if (lane == 0) { ((float*)(p->ws + WS_LAM))[8 + 2 * l] = a * b; ((float*)(p->ws + WS_LAM))[8 + 2 * l + 1] = c2 * d2; }
    }
    if (blockIdx.x == 0 && wave < DEPTH) {
        const int l = wave;
        float a = wave_sum(p->lam_q1[l * 64 + lane] * p->lam_k1[l * 64 + lane]), b = wave_sum(p->lam_q2[l * 64 + lane] * p->lam_k2[l * 64 + lane]);
        if (lane == 0) ((float*)(p->ws + WS_LAM))[l] = fexp2(a * LOG2E) - fexp2(b * LOG2E) + (0.8f - 0.6f * fexp2(-0.3f * LOG2E * (float)l));
    }
}

__device__ __forceinline__ float log_sigmoid(float x) { return fminf(x, 0.f) - 0.6931471805599453f * flog2(1.f + fexp2(-fabsf(x) * LOG2E)); }

__device__ __forceinline__ void phase_norm1(KArgs p, int l, LAS unsigned char* lds, int wv, bool probe2 = false) {
    const int tid = otid(wv), lane = tid & 63, wave = tid >> 6;
    LAS float* wf = (LAS float*)lds;
    LAS int* rbase = (LAS int*)(lds + 5 * DM * 4);
    if (l < DEPTH) { const float* WF = (const float*)(p->ws + WS_WF) + (size_t)l * 5 * DM; for (int i = tid; i < 5 * DM; i += 512) wf[i] = WF[i]; }
    if (l > 0 && tid == 0) { const unsigned* cnt = (const unsigned*)(p->ws + WS_CTL) + CW_CNT + (l - 1) * 16 * 64; int acc = 0;
        for (int e = 0; e < 16; ++e) { rbase[e] = acc * 256; acc += ((int)cnt[e * 64] + 255) >> 8; } }
    __syncthreads();
    const bf16_t* Y = (const bf16_t*)(p->ws + WS_Y); const i32x4* tsel = (const i32x4*)(p->ws + WS_TSEL);
    bf16_t* XN = (bf16_t*)(p->ws + WS_XN); float* LOGF = (float*)(p->ws + WS_LOGF);
    const int gw = blockIdx.x * 8 + wave, NGW = gridDim.x * 8;
    for (int t = gw; t < SEQ; t += NGW) {
        asm volatile("" ::: "memory");
        f32x4 v[8];
        if (l == 0 && !probe2) { const f32x4* xr = (const f32x4*)(p->x + (size_t)t * DM) + lane;
#pragma unroll
            for (int j = 0; j < 8; ++j) v[j] = xr[64 * j]; }
        else { const u32x2* xr = (const u32x2*)((const bf16_t*)(p->ws + WS_OUTB) + (size_t)t * DM) + lane;
#pragma unroll
            for (int j = 0; j < 8; ++j) { const u32x2 a = xr[64 * j]; v[j] = (f32x4){bf_lo(a[0]), bf_hi(a[0]), bf_lo(a[1]), bf_hi(a[1])}; } }
        if (l > 0) {
            const float ysc = probe2 ? 0.f : 1.f;
            const i32x4 ts = tsel[t];
            const u32x2* y1 = (const u32x2*)(Y + (size_t)(rbase[ts[0]] + ts[1]) * DM) + lane; const u32x2* y2 = (const u32x2*)(Y + (size_t)(rbase[ts[2]] + ts[3]) * DM) + lane;
#pragma unroll
            for (int j = 0; j < 8; ++j) { const u32x2 a = y1[64 * j], b = y2[64 * j];
                v[j][0] += ysc * (bf_lo(a[0]) + bf_lo(b[0])); v[j][1] += ysc * (bf_hi(a[0]) + bf_hi(b[0])); v[j][2] += ysc * (bf_lo(a[1]) + bf_lo(b[1])); v[j][3] += ysc * (bf_hi(a[1]) + bf_hi(b[1])); }
        }
        if (l == DEPTH) { f32x4* orow = (f32x4*)(p->out + (size_t)t * DM) + lane;
#pragma unroll
            for (int j = 0; j < 8; ++j) orow[64 * j] = v[j]; }
        else { u32x2* orow = (u32x2*)((bf16_t*)(p->ws + WS_OUTB) + (size_t)t * DM) + lane;
#pragma unroll
            for (int j = 0; j < 8; ++j) { u32x2 w; w[0] = cvtpk(v[j][0], v[j][1]); w[1] = cvtpk(v[j][2], v[j][3]); orow[64 * j] = w; } }
        if (l == DEPTH) continue;
        float ss = 0.f;
#pragma unroll
        for (int j = 0; j < 8; ++j) ss += (v[j][0] * v[j][0] + v[j][1] * v[j][1]) + (v[j][2] * v[j][2] + v[j][3] * v[j][3]);
        const float rstd = __builtin_amdgcn_rsqf(wave_sum(ss) * (1.f / DM) + EPS);
        const f32x4* gr = (const f32x4*)(p->attn_norm + (size_t)l * DM) + lane;
        float fc[5] = {0.f, 0.f, 0.f, 0.f, 0.f};
        if (lane == 0) ((float*)(p->ws + WS_RSTD))[t] = rstd;
#pragma unroll
        for (int j = 0; j < 8; ++j) { const f32x4 xn = v[j] * rstd * gr[64 * j];
#pragma unroll
            for (int h = 0; h < 5; ++h) { const f32x4 w4 = *(const LAS f32x4*)(wf + h * DM + 4 * lane + 256 * j); fc[h] += (xn[0] * w4[0] + xn[1] * w4[1]) + (xn[2] * w4[2] + xn[3] * w4[3]); } }
#pragma unroll
        for (int h = 0; h < 5; ++h) { const float s = wave_sum(fc[h]); if (lane == 0) LOGF[h * SEQ + t] = log_sigmoid(s + p->b_forget[l * 5 + h]); }
    }
}

__device__ __forceinline__ void scan_head(KArgs p, int h, int l, LAS unsigned char* lds, int wv) {
    const int tid = otid(wv), lane = tid & 63, wave = tid >> 6;
    const float* src = (const float*)(p->ws + WS_LOGF) + (size_t)h * SEQ + tid * 16; float* dst = (float*)(p->ws + WS_DC2) + (size_t)h * SEQ + tid * 16;
    LAS float* wt = (LAS float*)lds;
    float v[16]; float s = 0.f;
#pragma unroll
    for (int i = 0; i < 4; ++i) { const f32x4 a = ((const f32x4*)src)[i]; v[4 * i] = a[0]; v[4 * i + 1] = a[1]; v[4 * i + 2] = a[2]; v[4 * i + 3] = a[3]; }
#pragma unroll
    for (int i = 0; i < 16; ++i) { s += v[i]; v[i] = s; }
    float inc = s;
#pragma unroll
    for (int o = 1; o < 64; o <<= 1) { const float n = __int_as_float(__builtin_amdgcn_ds_bpermute(((lane - o) & 63) << 2, __float_as_int(inc))); if (lane >= o) inc += n; }
    if (lane == 63) wt[wave] = inc;
    __syncthreads();
    float base = inc - s;
    for (int w = 0; w < wave; ++w) base += wt[w];
#pragma unroll
    for (int i = 0; i < 4; ++i) ((f32x4*)dst)[i] = (f32x4){(v[4 * i] + base) * LOG2E, (v[4 * i + 1] + base) * LOG2E, (v[4 * i + 2] + base) * LOG2E, (v[4 * i + 3] + base) * LOG2E};
    LAS float* dl = (LAS float*)(lds + 64);
#pragma unroll
    for (int i = 0; i < 16; ++i) dl[tid * 16 + i] = (v[i] + base) * LOG2E;
    __syncthreads();
    { const float thr = 39.f + 2.f * 16.3221377f * ((const float*)(p->ws + WS_LAM))[8 + 2 * l + 1];
      const int qb = tid >> 4, part = tid & 15; const float dref = dl[256 * qb]; int cnt = 0;
      for (int i = part; i < 4 * qb; i += 16) cnt += (dref - dl[64 * i + 63] <= -thr) ? 1 : 0;
      float c = (float)cnt; c += swz_xor<1>(c); c += swz_xor<2>(c); c += swz_xor<4>(c); c += swz_xor<8>(c);
      if (part == 0) ((int*)(p->ws + WS_LAM))[64 + h * 32 + qb] = (int)c; }
    __syncthreads();
}

namespace att {
constexpr int KP = 272, VP = 144;
constexpr int KT_BYTES = 64 * KP, VT_BYTES = 128 * VP, KB_BYTES = 256;
constexpr int BUF_BYTES = KT_BYTES + VT_BYTES + KB_BYTES;
constexpr float THR = 8.f;
static_assert(2 * BUF_BYTES <= RING_BYTES && 4 * 128 * 32 * 4 <= RING_BYTES, "attention LDS");

struct Stg { u32x4 k0, k1, v0, v1; };
__device__ __forceinline__ void stage_load(Stg& s, const bf16_t* Kg, const bf16_t* Vg, int j, int tid) {
    const bf16_t* kp = Kg + (size_t)(64 * j + (tid >> 3)) * NQK + (tid & 7) * 8;
    s.k0 = *(const u32x4*)kp; s.k1 = *(const u32x4*)(kp + 64);
    const bf16_t* vp = Vg + (size_t)(tid >> 2) * SEQ + 64 * j + (tid & 3) * 8;
    s.v0 = *(const u32x4*)vp; s.v1 = *(const u32x4*)(vp + 32);
}
__device__ __forceinline__ void stage_write(const Stg& s, LAS unsigned char* buf, int tid) {
    LAS unsigned char* kd = buf + (tid >> 3) * KP + (tid & 7) * 16; *(LAS u32x4*)kd = s.k0; *(LAS u32x4*)(kd + 128) = s.k1;
    LAS unsigned char* vd = buf + KT_BYTES + (tid >> 2) * VP + (tid & 3) * 16; *(LAS u32x4*)vd = s.v0; *(LAS u32x4*)(vd + 64) = s.v1;
}
template <int NKS>
__device__ __forceinline__ void qk_tile(f32x16& p0, f32x16& p1, const LAS unsigned char* kb, const bf16x8* qr) {
    bf16x8 ka[NKS], kc[NKS];
#pragma unroll
    for (int ks = 0; ks < NKS; ++ks) { ka[ks] = *(const LAS bf16x8*)(kb + ks * 32); kc[ks] = *(const LAS bf16x8*)(kb + 32 * KP + ks * 32); }
    __builtin_amdgcn_sched_barrier(0);
#pragma unroll
    for (int ks = 0; ks < NKS; ++ks) {
        p0 = __builtin_amdgcn_mfma_f32_32x32x16_bf16(ka[ks], qr[ks], p0, 0, 0, 0);
        p1 = __builtin_amdgcn_mfma_f32_32x32x16_bf16(kc[ks], qr[ks], p1, 0, 0, 0);
    }
    __builtin_amdgcn_sched_barrier(0);
}
__device__ __forceinline__ bf16x8 pack8(const f32x16& p, int b) {
    u32x4 w = {cvtpk(p[b + 0], p[b + 1]), cvtpk(p[b + 2], p[b + 3]), cvtpk(p[b + 4], p[b + 5]), cvtpk(p[b + 6], p[b + 7])};
    return *reinterpret_cast<bf16x8*>(&w);
}
__device__ __forceinline__ void pv_tile(f32x16 (&o)[4], const LAS unsigned char* vb, const f32x16& p0, const f32x16& p1) {
    const bf16x8 pb0 = pack8(p0, 0), pb1 = pack8(p0, 8), pb2 = pack8(p1, 0), pb3 = pack8(p1, 8);
#pragma unroll
    for (int dh = 0; dh < 2; ++dh) {
        bf16x8 va[8];
#pragma unroll
        for (int i = 0; i < 8; ++i) va[i] = *(const LAS bf16x8*)(vb + (2 * dh + (i >> 2)) * 32 * VP + (i & 3) * 32);
        __builtin_amdgcn_sched_barrier(0);
#pragma unroll
        for (int i = 0; i < 8; ++i) { const int d0 = 2 * dh + (i >> 2), s4 = i & 3;
            o[d0] = __builtin_amdgcn_mfma_f32_32x32x16_bf16(va[i], s4 == 0 ? pb0 : (s4 == 1 ? pb1 : (s4 == 2 ? pb2 : pb3)), o[d0], 0, 0, 0); }
        __builtin_amdgcn_sched_barrier(0);
    }
}
template <int NKS>
__device__ __forceinline__ void tile_fixed(f32x16 (&o)[4], const LAS unsigned char* kb, const LAS unsigned char* vb, const bf16x8* qr, f32x16& y0, f32x16& y1, float& l) {
    bf16x8 ka[NKS], kc[NKS];
#pragma unroll
    for (int ks = 0; ks < NKS; ++ks) { ka[ks] = *(const LAS bf16x8*)(kb + ks * 32); kc[ks] = *(const LAS bf16x8*)(kb + 32 * KP + ks * 32); }
    __builtin_amdgcn_sched_barrier(0);
#pragma unroll
    for (int ks = 0; ks < NKS; ++ks) y0 = __builtin_amdgcn_mfma_f32_32x32x16_bf16(ka[ks], qr[ks], y0, 0, 0, 0);
    __builtin_amdgcn_sched_barrier(0);
    asm volatile("" : "+v"(y0));
#pragma unroll
    for (int ks = 0; ks < NKS; ++ks) y1 = __builtin_amdgcn_mfma_f32_32x32x16_bf16(kc[ks], qr[ks], y1, 0, 0, 0);
    float s = 0.f;
#pragma unroll
    for (int r = 0; r < 16; ++r) { y0[r] = fexp2(y0[r]); s += y0[r]; }
    const bf16x8 pb0 = pack8(y0, 0), pb1 = pack8(y0, 8);
#pragma unroll
    for (int q = 0; q < NKS; ++q) { __builtin_amdgcn_sched_group_barrier(0x008, 1, 0);
#pragma unroll
        for (int h = 0; h < 8 / NKS; ++h) { __builtin_amdgcn_sched_group_barrier(0x400, 2, 0); __builtin_amdgcn_sched_group_barrier(0x002, 3, 0); } }
    __builtin_amdgcn_sched_barrier(0);
    bf16x8 va[8];
#pragma unroll
    for (int i = 0; i < 8; ++i) va[i] = *(const LAS bf16x8*)(vb + (i >> 1) * 32 * VP + (i & 1) * 32);
    __builtin_amdgcn_sched_barrier(0);
    asm volatile("" : "+v"(y1));
#pragma unroll
    for (int i = 0; i < 8; ++i) o[i >> 1] = __builtin_amdgcn_mfma_f32_32x32x16_bf16(va[i], (i & 1) ? pb1 : pb0, o[i >> 1], 0, 0, 0);
    float s1 = 0.f;
#pragma unroll
    for (int r = 0; r < 16; ++r) { y1[r] = fexp2(y1[r]); s1 += y1[r]; }
    const bf16x8 pb2 = pack8(y1, 0), pb3 = pack8(y1, 8);
#pragma unroll
    for (int q = 0; q < 8; ++q) { __builtin_amdgcn_sched_group_barrier(0x008, 1, 0); __builtin_amdgcn_sched_group_barrier(0x400, 2, 0); __builtin_amdgcn_sched_group_barrier(0x002, 3, 0); }
    __builtin_amdgcn_sched_barrier(0);
    l += s + s1;
    bf16x8 vb2[8];
#pragma unroll
    for (int i = 0; i < 8; ++i) vb2[i] = *(const LAS bf16x8*)(vb + (i >> 1) * 32 * VP + 64 + (i & 1) * 32);
    __builtin_amdgcn_sched_barrier(0);
#pragma unroll
    for (int i = 0; i < 8; ++i) o[i >> 1] = __builtin_amdgcn_mfma_f32_32x32x16_bf16(vb2[i], (i & 1) ? pb3 : pb2, o[i >> 1], 0, 0, 0);
    __builtin_amdgcn_sched_barrier(0);
}
__device__ __forceinline__ float swap_max(float v) { auto rr = __builtin_amdgcn_permlane32_swap(__float_as_uint(v), __float_as_uint(v), false, false); return fmaxf(__uint_as_float(rr[0]), __uint_as_float(rr[1])); }
__device__ __forceinline__ float swap_sum(float v) { auto rr = __builtin_amdgcn_permlane32_swap(__float_as_uint(v), __float_as_uint(v), false, false); return __uint_as_float(rr[0]) + __uint_as_float(rr[1]); }
__device__ __forceinline__ void softmax_step(f32x16& y0, f32x16& y1, float A, float& m, float& l, f32x16 (&o)[4]) {
    float mx = y0[0];
#pragma unroll
    for (int r = 1; r < 16; ++r) mx = fmaxf(mx, y0[r]);
#pragma unroll
    for (int r = 0; r < 16; ++r) mx = fmaxf(mx, y1[r]);
    mx = swap_max(mx) + A;
    if (__any(mx > m + THR)) {
        const float mn = fmaxf(m, mx), al = fexp2(m - mn); m = mn; l *= al;
#pragma unroll
        for (int d0 = 0; d0 < 4; ++d0)
#pragma unroll
            for (int r = 0; r < 16; ++r) o[d0][r] *= al;
    }
    const float mA = m - A; float s = 0.f;
#pragma unroll
    for (int r = 0; r < 16; ++r) { y0[r] = fexp2(y0[r] - mA); s += y0[r]; }
#pragma unroll
    for (int r = 0; r < 16; ++r) { y1[r] = fexp2(y1[r] - mA); s += y1[r]; }
    l += s;
}
__device__ __forceinline__ void softmax_fixed(f32x16& y0, f32x16& y1, float c, float& l) {
    float s = 0.f;
#pragma unroll
    for (int r = 0; r < 16; ++r) { y0[r] = fexp2(y0[r] + c); s += y0[r]; }
#pragma unroll
    for (int r = 0; r < 16; ++r) { y1[r] = fexp2(y1[r] + c); s += y1[r]; }
    l += s;
}
#define KIDX(r) (((r) & 3) + 8 * ((r) >> 2))

template <int TY>
__device__ __forceinline__ void att_item(KArgs p, int l, int head, int qb, LAS unsigned char* lds, int wv, int part = 0) {
    const int tid = otid(wv), wid = __builtin_amdgcn_readfirstlane(tid >> 6), lane = tid & 63, r32 = lane & 31, hi = lane >> 5;
    constexpr int NKS = (TY == 0) ? 4 : 8;
    const int br = (TY == 0) ? (wid >> 2) : 0, rg = (TY == 0) ? (wid & 3) : wid;
    const int t0w = (TY == 0) ? (128 * qb + 32 * rg) : (256 * qb + 32 * wid);
    const int trow = t0w + r32;
    const int NT = (TY == 0) ? (2 * qb + 2) : (4 * qb + 4);
    const int qcol = (TY == 0) ? (128 * head + 64 * br) : (TY == 1 ? 2816 + 128 * head : 1536 + 128 * head);
    const int kcol = (TY == 0) ? (768 + 128 * head) : (TY == 1 ? 3456 + 128 * head : 2176 + 128 * head);
    const int hv = (TY == 0) ? head : (TY == 1 ? 6 + head : 11 + head);
    const bf16_t* QKB = (const bf16_t*)(p->ws + WS_QKB);
    const bf16_t* Kg = QKB + kcol; const bf16_t* Vg = (const bf16_t*)(p->ws + WS_VT) + (size_t)hv * HD * SEQ;
    const float* dc2 = (const float*)(p->ws + WS_DC2) + (size_t)head * SEQ;
    const float dcref = (TY == 2) ? dc2[256 * qb] : 0.f;
    const float slope2 = (TY == 0) ? fexp2(-8.0f * (float)(head + 1) / 6.0f) * LOG2E : 0.f;
    const float Bfix = (TY == 0) ? (11.5415603f * 1.01f * ((const float*)(p->ws + WS_LAM))[8 + 2 * l] + 0.25f) : (16.3221377f * 1.01f * ((const float*)(p->ws + WS_LAM))[8 + 2 * l + 1] + 0.25f);
    const float cfix = (TY == 2) ? (dc2[trow] - dcref - Bfix) : -Bfix;

    int j_lo = 0;
    if (TY == 0 && SKIP_A) {
        const float Bq = 11.5415603f * ((const float*)(p->ws + WS_LAM))[8 + 2 * l];
        const float x = ((float)(128 * qb - 63) - (39.f + 2.f * Bq) / slope2) * (1.f / 64.f);
        j_lo = x < 0.f ? 0 : (int)x + 1;
    } else if (TY == 2 && SKIP_C) {
        j_lo = ((const int*)(p->ws + WS_LAM))[64 + head * 32 + qb];
    }
    j_lo = __builtin_amdgcn_readfirstlane(j_lo);
    const int NTP = NT - j_lo;
    const bool elig = (TY == 2) ? (qb >= 8) : ((TY == 0) ? (head >= 4 && qb >= 16) : false);
    const bool split = elig && NTP > 32;
    if (part == 1 && !split) return;
    const int mid = j_lo + (NTP >> 1);
    const int jtop = (part == 1) ? mid - 1 : NT - 1;
    const int cntT = (part == 1) ? (mid - j_lo) : (split ? NT - mid : NTP);
    const int sidx = (TY == 2) ? (head * 32 + qb) : (160 + head * 64 + qb);
    unsigned long long* pay = (unsigned long long*)(p->ws + WS_PART) + ((size_t)sidx * 8 + wid) * 17 * 64 + lane;
    unsigned* aflag = (unsigned*)(p->ws + WS_CTL) + CW_AFLAG + (l * 544 + sidx) * 64;
    LAS unsigned char* buf0 = lds; LAS unsigned char* buf1 = lds + BUF_BYTES;
    LAS int* flags = (LAS int*)(lds + 2 * BUF_BYTES);
    if (TY == 1 && tid < 16) flags[tid] = 0;
    Stg st; float kbv = 0.f;
    stage_load(st, Kg, Vg, jtop, tid);
    if (TY == 2 && tid < 64) kbv = dcref - dc2[64 * jtop + tid];
    bf16x8 qr[NKS];
#pragma unroll
    for (int ks = 0; ks < NKS; ++ks) qr[ks] = *(const bf16x8*)(QKB + (size_t)trow * NQK + qcol + ks * 16 + hi * 8);
    stage_write(st, buf0, tid);
    if (TY == 2 && tid < 64) *(LAS float*)(buf0 + KT_BYTES + VT_BYTES + tid * 4) = kbv;
    if (cntT > 1) { stage_load(st, Kg, Vg, jtop - 1, tid); if (TY == 2 && tid < 64) kbv = dcref - dc2[64 * (jtop - 1) + tid]; }
    __syncthreads();

    f32x16 o[4];
#pragma unroll
    for (int d0 = 0; d0 < 4; ++d0)
#pragma unroll
        for (int r = 0; r < 16; ++r) o[d0][r] = 0.f;
    float m = 0.f, lsum = 0.f, R = 0.f;
    const int koff = r32 * KP + hi * 16 + ((TY == 0) ? br * 128 : 0), voff = KT_BYTES + r32 * VP + hi * 16;

    for (int it = 0; it < cntT; ++it) {
        if (TY == 1 && (SKIP_B & 1) && it > 0) { const i32x4 f0 = *(const LAS i32x4*)(flags + ((it - 1) & 1) * 8), f1 = *(const LAS i32x4*)(flags + ((it - 1) & 1) * 8 + 4);
            if (__builtin_amdgcn_readfirstlane((f0[0] & f0[1] & f0[2] & f0[3] & f1[0] & f1[1] & f1[2] & f1[3])) != 0) break; }
        const int j = jtop - it;
        LAS unsigned char* cur = (it & 1) ? buf1 : buf0; LAS unsigned char* oth = (it & 1) ? buf0 : buf1;
        const bool more = it + 1 < cntT;
        if (TY == 0) {
            const int cw = 2 * qb + (rg >> 1);
            if (j <= cw) {
                f32x16 y0, y1;
                const int trel = trow - 64 * j;
                if (j == cw) {
                    const float tq = (float)(trel - 4 * hi);
#pragma unroll
                    for (int r = 0; r < 16; ++r) { y0[r] = fmaf(-slope2, fabsf(tq - (float)KIDX(r)), cfix); y1[r] = fmaf(-slope2, fabsf(tq - (float)(KIDX(r) + 32)), cfix); }
                } else {
                    const float A = fmaf(-slope2, (float)(trel - 4 * hi), cfix);
#pragma unroll
                    for (int r = 0; r < 16; ++r) { y0[r] = fmaf(slope2, (float)KIDX(r), A); y1[r] = fmaf(slope2, (float)(KIDX(r) + 32), A); }
                }
                tile_fixed<NKS>(o, cur + koff, cur + voff, qr, y0, y1, lsum);
            }
        } else {
            const int jj = j - 4 * qb;
            if (jj <= (wid >> 1) && !(TY == 1 && (SKIP_B & 2) && __all(R <= -40.f))) {
                const bool partial = (jj == (wid >> 1));
                const int tin = 32 * (wid & 1) + r32 - 4 * hi;
                f32x16 y0, y1;
                if (TY == 2) {
                    const LAS f32x4* kbp = (const LAS f32x4*)(cur + KT_BYTES + VT_BYTES) + hi;
#pragma unroll
                    for (int g = 0; g < 4; ++g) { const f32x4 b0 = kbp[2 * g], b1 = kbp[2 * g + 8];
#pragma unroll
                        for (int i = 0; i < 4; ++i) { y0[4 * g + i] = b0[i] + cfix; y1[4 * g + i] = b1[i] + cfix; } }
                    if (partial) {
#pragma unroll
                        for (int r = 0; r < 16; ++r) { if (KIDX(r) > tin) y0[r] = -__builtin_inff(); if (KIDX(r) + 32 > tin) y1[r] = -__builtin_inff(); }
                    }
                    tile_fixed<NKS>(o, cur + koff, cur + voff, qr, y0, y1, lsum);
                } else {
#pragma unroll
                    for (int r = 0; r < 16; ++r) { y0[r] = 0.f; y1[r] = 0.f; }
                    qk_tile<NKS>(y0, y1, cur + koff, qr);
                    f32x16 lb0, lb1;
#pragma unroll
                    for (int r = 0; r < 16; ++r) {
                        { const float z = fminf(fmaxf(y0[r], -100.f), 100.f), b = -flog2(1.f + fexp2(-z)); float k = b - z, bb = b;
                          if (partial && KIDX(r) >= tin) { k = 0.f; bb = -__builtin_inff(); } lb0[r] = bb; y0[r] = k; }
                        { const float z = fminf(fmaxf(y1[r], -100.f), 100.f), b = -flog2(1.f + fexp2(-z)); float k = b - z, bb = b;
                          if (partial && KIDX(r) + 32 >= tin) { k = 0.f; bb = -__builtin_inff(); } lb1[r] = bb; y1[r] = k; }
                    }
                    float gs0[4], gs1[4];
#pragma unroll
                    for (int g = 0; g < 4; ++g) {
                        { const float e0 = y0[4 * g], e1 = y0[4 * g + 1], e2 = y0[4 * g + 2], e3 = y0[4 * g + 3]; const float s2 = e3, s1 = e3 + e2, s0 = s1 + e1;
                          y0[4 * g + 3] = 0.f; y0[4 * g + 2] = s2; y0[4 * g + 1] = s1; y0[4 * g] = s0; gs0[g] = s0 + e0; }
                        { const float e0 = y1[4 * g], e1 = y1[4 * g + 1], e2 = y1[4 * g + 2], e3 = y1[4 * g + 3]; const float s2 = e3, s1 = e3 + e2, s0 = s1 + e1;
                          y1[4 * g + 3] = 0.f; y1[4 * g + 2] = s2; y1[4 * g + 1] = s1; y1[4 * g] = s0; gs1[g] = s0 + e0; }
                    }
                    float run = R;
#pragma unroll
                    for (int half = 1; half >= 0; --half)
#pragma unroll
                        for (int g = 3; g >= 0; --g) {
                            const float mine = half ? gs1[g] : gs0[g];
                            auto rr = __builtin_amdgcn_permlane32_swap(__float_as_uint(mine), __float_as_uint(mine), false, false);
                            const float g_lo = __uint_as_float(rr[0]), g_hi = __uint_as_float(rr[1]);
                            const float off_hi = run; run += g_hi; const float off_lo = run; run += g_lo;
                            const float off = hi ? off_hi : off_lo;
#pragma unroll
                            for (int i = 0; i < 4; ++i) {
                                if (half) y1[4 * g + i] = fexp2(lb1[4 * g + i] + y1[4 * g + i] + off);
                                else y0[4 * g + i] = fexp2(lb0[4 * g + i] + y0[4 * g + i] + off);
                            }
                        }
                    R = run;
                    pv_tile(o, cur + voff, y0, y1);
                }
            }
        }
        if (TY == 1) { const int dn = __all(R <= -40.f) ? 1 : 0; if (lane == 0) flags[(it & 1) * 8 + wid] = dn; }
        if (more) { stage_write(st, oth, tid); if (TY == 2 && tid < 64) *(LAS float*)(oth + KT_BYTES + VT_BYTES + tid * 4) = kbv; }
        if (it + 2 < cntT) { stage_load(st, Kg, Vg, j - 2, tid); if (TY == 2 && tid < 64) kbv = dcref - dc2[64 * (j - 2) + tid]; }
        __syncthreads();
    }

    bf16_t* MIX = (bf16_t*)(p->ws + WS_MIX);
    float inv = 1.f;
    if (TY != 1) {
        float lt = swap_sum(lsum);
        if (part == 1) {
            __hip_atomic_store(pay, ((unsigned long long)__float_as_uint(lt) << 32) | __float_as_uint(m), __ATOMIC_RELAXED, __HIP_MEMORY_SCOPE_AGENT);
#pragma unroll
            for (int d0 = 0; d0 < 4; ++d0)
#pragma unroll
                for (int g = 0; g < 4; ++g)
                    __hip_atomic_store(pay + (1 + d0 * 4 + g) * 64, ((unsigned long long)cvtpk(o[d0][4 * g + 2], o[d0][4 * g + 3]) << 32) | cvtpk(o[d0][4 * g], o[d0][4 * g + 1]), __ATOMIC_RELAXED, __HIP_MEMORY_SCOPE_AGENT);
            asm volatile("s_waitcnt vmcnt(0)" ::: "memory");
            __syncthreads();
            if (tid == 0) __hip_atomic_store(aflag, 1u, __ATOMIC_RELAXED, __HIP_MEMORY_SCOPE_AGENT);
            __syncthreads();
            return;
        }
        if (split) {
            if (tid == 0) { unsigned sp = 0; while (__hip_atomic_load(aflag, __ATOMIC_RELAXED, __HIP_MEMORY_SCOPE_AGENT) == 0u && ++sp < (1u << 22)) __builtin_amdgcn_s_sleep(2);
                __builtin_amdgcn_fence(__ATOMIC_ACQUIRE, "agent"); asm volatile("s_waitcnt vmcnt(0)" ::: "memory"); }
            __syncthreads();
            const unsigned long long ml = __hip_atomic_load(pay, __ATOMIC_RELAXED, __HIP_MEMORY_SCOPE_AGENT);
            const float mf = __uint_as_float((unsigned)ml), lf = __uint_as_float((unsigned)(ml >> 32));
            const float mn = fmaxf(m, mf), a0 = fexp2(m - mn), a1 = fexp2(mf - mn);
            lt = a0 * lt + a1 * lf;
#pragma unroll
            for (int d0 = 0; d0 < 4; ++d0)
#pragma unroll
                for (int g = 0; g < 4; ++g) {
                    const unsigned long long w = __hip_atomic_load(pay + (1 + d0 * 4 + g) * 64, __ATOMIC_RELAXED, __HIP_MEMORY_SCOPE_AGENT);
                    const unsigned w0 = (unsigned)w, w1 = (unsigned)(w >> 32);
                    o[d0][4 * g] = a0 * o[d0][4 * g] + a1 * bf_lo(w0); o[d0][4 * g + 1] = a0 * o[d0][4 * g + 1] + a1 * bf_hi(w0);
                    o[d0][4 * g + 2] = a0 * o[d0][4 * g + 2] + a1 * bf_lo(w1); o[d0][4 * g + 3] = a0 * o[d0][4 * g + 3] + a1 * bf_hi(w1);
                }
        }
        inv = 1.f / lt;
    }
    float post = 1.f; const float* gain;
    if (TY == 0) {
        const float lam = ((const float*)(p->ws + WS_LAM))[l];
        LAS float* X = (LAS float*)lds + (size_t)rg * 128 * 32;
        if (br == 1) {
            const float sc = inv * lam;
#pragma unroll
            for (int d0 = 0; d0 < 4; ++d0)
#pragma unroll
                for (int r = 0; r < 16; ++r) X[(32 * d0 + KIDX(r) + 4 * hi) * 32 + r32] = o[d0][r] * sc;
        }
        __syncthreads();
        if (br == 0) {
#pragma unroll
            for (int d0 = 0; d0 < 4; ++d0)
#pragma unroll
                for (int r = 0; r < 16; ++r) o[d0][r] = o[d0][r] * inv - X[(32 * d0 + KIDX(r) + 4 * hi) * 32 + r32];
        }
        inv = 1.f;
        post = 1.f - (0.8f - 0.6f * fexp2(-0.3f * LOG2E * (float)l));
        gain = p->subln_diff + l * HD;
    } else if (TY == 1) gain = p->onorm_sb + l * HD;
    else gain = p->onorm_fox + l * HD;
    if (TY != 0 || br == 0) {
        float ss = 0.f;
#pragma unroll
        for (int d0 = 0; d0 < 4; ++d0)
#pragma unroll
            for (int r = 0; r < 16; ++r) { const float v = o[d0][r] * inv; ss += v * v; }
        ss = swap_sum(ss);
        const float sc = inv * post * __builtin_amdgcn_rsqf(ss * (1.f / HD) + EPS);
        bf16_t* orow = MIX + (size_t)trow * DM + hv * HD + 4 * hi;
#pragma unroll
        for (int d0 = 0; d0 < 4; ++d0)
#pragma unroll
            for (int g = 0; g < 4; ++g) {
                const f32x4 g4 = *(const f32x4*)(gain + 32 * d0 + 8 * g + 4 * hi);
                u32x2 w; w[0] = cvtpk(o[d0][4 * g] * sc * g4[0], o[d0][4 * g + 1] * sc * g4[1]); w[1] = cvtpk(o[d0][4 * g + 2] * sc * g4[2], o[d0][4 * g + 3] * sc * g4[3]);
                *(u32x2*)(orow + 32 * d0 + 8 * g) = w;
            }
    }
    __syncthreads();
}

constexpr int N_FAR = 5 * 24 + 2 * 48;
constexpr int N_ITEMS = N_FAR + 32 * 22;
__device__ __forceinline__ void attention_phase(KArgs p, int l, LAS unsigned char* lds, volatile LAS unsigned* itemw, int wv, int qi, int tmask = 7) {
    unsigned* q = (unsigned*)(p->ws + WS_CTL) + CW_ATTQ + qi * 64;
    for (;;) {
        if (otid(wv) == 0) *itemw = __hip_atomic_fetch_add(q, 1u, __ATOMIC_RELAXED, __HIP_MEMORY_SCOPE_AGENT);
        __syncthreads();
        int item = (int)*itemw;
        __syncthreads();
        if (item >= N_ITEMS) break;
        if (item < N_FAR) {
            if (item < 120) { if (tmask & 1) att_item<2>(p, l, item % 5, 31 - item / 5, lds, wv, 1); }
            else { const int i2 = item - 120; if (tmask & 2) att_item<0>(p, l, 5 - (i2 & 1), 63 - (i2 >> 1), lds, wv, 1); }
            continue;
        }
        item -= N_FAR;
        if (item < 288) { const int w = item % 9, pp = 31 - item / 9;
            if (w < 5) { if (tmask & 1) att_item<2>(p, l, w, pp, lds, wv); }
            else if (tmask & 2) att_item<0>(p, l, 5 - ((w - 5) >> 1), 2 * pp + 1 - ((w - 5) & 1), lds, wv); }
        else if (item < 544) { const int it2 = item - 288, w = it2 % 8, pp = 31 - it2 / 8;
            if (tmask & 2) att_item<0>(p, l, 3 - (w >> 1), 2 * pp + 1 - (w & 1), lds, wv); }
        else if (tmask & 4) { const int it3 = item - 544; att_item<1>(p, l, it3 % 5, 31 - it3 / 5, lds, wv); }
    }
}
}

__device__ __forceinline__ void phase_route(KArgs p, int l, LAS unsigned char* lds, int wv, int ci, bool waitp = true) {
    const int tid = otid(wv), lane = tid & 63, wave = tid >> 6;
    LAS float* wrt = (LAS float*)lds;
    LAS int* bsel = (LAS int*)(lds + 16 * DM * 4);
    LAS float* bsc = (LAS float*)(bsel + 64);
    LAS float* bgate = bsc + 64;
    LAS float* brs = bgate + 64;
    { const f32x4* src = (const f32x4*)(p->ws + WS_WRT); for (int i = tid; i < 16 * DM / 4; i += 512) ((LAS f32x4*)wrt)[i] = src[i]; }
    __syncthreads();
    bf16_t* XN = (bf16_t*)(p->ws + WS_XN);
    for (int blk = blockIdx.x; blk < SEQ / 32; blk += gridDim.x) {
        const int tid = otid(wv), lane = tid & 63, wave = tid >> 6;
        if (waitp) { if (wave == 0) {
            const unsigned* wc = (const unsigned*)(p->ws + WS_CTL) + CW_WOC + l * 32 * 64 + 64 * (blk >> 3);
            unsigned sp = 0;
            while ((unsigned)__builtin_amdgcn_readfirstlane((int)__hip_atomic_load(wc, __ATOMIC_RELAXED, __HIP_MEMORY_SCOPE_AGENT)) < 64u && ++sp < (1u << 22)) __builtin_amdgcn_s_sleep(2);
            __builtin_amdgcn_fence(__ATOMIC_ACQUIRE, "agent");
            asm volatile("s_waitcnt vmcnt(0)" ::: "memory");
            } __syncthreads(); }
        const int tb = blk * 32 + wave * 4;
        f32x4 hx[4][8];
#pragma unroll
        for (int i = 0; i < 4; ++i) { const u32x2* xr = (const u32x2*)((const bf16_t*)(p->ws + WS_OUTB) + (size_t)(tb + i) * DM) + lane;
#pragma unroll
            for (int j = 0; j < 8; ++j) { const u32x2 a = xr[64 * j]; hx[i][j] = (f32x4){bf_lo(a[0]), bf_hi(a[0]), bf_lo(a[1]), bf_hi(a[1])}; } }
#pragma unroll
        for (int i = 0; i < 4; ++i) {
            float ss = 0.f;
#pragma unroll
            for (int j = 0; j < 8; ++j) ss += (hx[i][j][0] * hx[i][j][0] + hx[i][j][1] * hx[i][j][1]) + (hx[i][j][2] * hx[i][j][2] + hx[i][j][3] * hx[i][j][3]);
            const float rstd = __builtin_amdgcn_rsqf(wave_sum(ss) * (1.f / DM) + EPS);
            if (lane == 0) brs[wave * 4 + i] = rstd;
            const f32x4* gr = (const f32x4*)(p->ffn_norm + (size_t)l * DM) + lane;
#pragma unroll
            for (int j = 0; j < 8; ++j) hx[i][j] = hx[i][j] * rstd * gr[64 * j];
        }
#pragma unroll
        for (int h2 = 0; h2 < 2; ++h2) {
            f32x4 (&hn)[2][8] = *reinterpret_cast<f32x4 (*)[2][8]>(&hx[2 * h2]);
            asm volatile("" ::: "memory"); __builtin_amdgcn_sched_barrier(0);
            float acc[32];
#pragma unroll
            for (int k = 0; k < 32; ++k) acc[k] = 0.f;
#pragma unroll
            for (int j = 0; j < 8; ++j)
#pragma unroll
                for (int eh = 0; eh < 2; ++eh) {
#pragma unroll
                    for (int e = 8 * eh; e < 8 * eh + 8; ++e) { const f32x4 w4 = *(const LAS f32x4*)(wrt + e * DM + 4 * lane + 256 * j);
#pragma unroll
                        for (int i = 0; i < 2; ++i) acc[i * 16 + e] += (hn[i][j][0] * w4[0] + hn[i][j][1] * w4[1]) + (hn[i][j][2] * w4[2] + hn[i][j][3] * w4[3]); }
                    __builtin_amdgcn_sched_barrier(0);
                }
#pragma unroll
            for (int k = 0; k < 32; ++k) acc[k] = sum_xor32(acc[k]);
#define RSTEP(H) { const bool up = (lane & H) != 0; _Pragma("unroll") for (int k = 0; k < H; ++k) { const float a = acc[k], b = acc[k + H]; const float give = up ? a : b, keep = up ? b : a; acc[k] = keep + swz_xor<H>(give); } }
            RSTEP(16) RSTEP(8) RSTEP(4) RSTEP(2) RSTEP(1)
#undef RSTEP
            const float logit = acc[0];
            const float score = __builtin_amdgcn_rcpf(1.f + fexp2(-logit * LOG2E));
            const float sel = score + p->router_bias[lane & 15];
            const float v1 = swz_xor<1>(sel), v2 = swz_xor<2>(sel), v3 = swz_xor<3>(sel);
            const float a = fmaxf(sel, v1), b = fminf(sel, v1), c = fmaxf(v2, v3), d = fminf(v2, v3);
            const float gs = fmaxf(a, c) + fmaxf(fminf(a, c), fmaxf(b, d));
            const float g1 = swz_xor<4>(gs), g2 = swz_xor<8>(gs), g3 = swz_xor<12>(gs);
            const int myg = (lane >> 2) & 3, k = lane & 3;
            const bool best = (gs > g1 || (gs == g1 && myg < (myg ^ 1))) && (gs > g2 || (gs == g2 && myg < (myg ^ 2))) && (gs > g3 || (gs == g3 && myg < (myg ^ 3)));
            const int rank = ((v1 > sel || (v1 == sel && (k ^ 1) < k)) ? 1 : 0) + ((v2 > sel || (v2 == sel && (k ^ 2) < k)) ? 1 : 0) + ((v3 > sel || (v3 == sel && (k ^ 3) < k)) ? 1 : 0);
            if (best && rank < 2 && lane < 32) { const int row = wave * 4 + h2 * 2 + (lane >> 4); bsel[row * 2 + rank] = lane & 15; bsc[row * 2 + rank] = score; }
        }
        asm volatile("s_waitcnt lgkmcnt(0)" ::: "memory");
        if (lane < 8) { const int idx = wave * 8 + lane; const float sm = bsc[idx], so = bsc[idx ^ 1]; bgate[idx] = sm / (sm + so); }
        __syncthreads();
        if (wave == 0) {
            unsigned* cnt = (unsigned*)(p->ws + WS_CTL) + CW_CNT + ci * 16 * 64;
            const int mye = bsel[lane]; int myrank = 0, n = 0;
            const unsigned long long below = (1ull << lane) - 1ull;
#pragma unroll
            for (int e = 0; e < 16; ++e) { const unsigned long long mk = __ballot(mye == e); if (mye == e) myrank = (int)__popcll(mk & below); if (lane == e) n = (int)__popcll(mk); }
            int base = 0;
            if (lane < 16 && n) base = (int)__hip_atomic_fetch_add(cnt + lane * 64, (unsigned)n, __ATOMIC_RELAXED, __HIP_MEMORY_SCOPE_AGENT);
            const int pos = __builtin_amdgcn_ds_bpermute(mye << 2, base) + myrank, tok = blk * 32 + (lane >> 1);
            ((int*)(p->ws + WS_TOK))[mye * SEQ + pos] = tok; ((f32x2_t*)(p->ws + WS_GATE))[mye * SEQ + pos] = (f32x2_t){bgate[lane], brs[lane >> 1]};
            int* ts = (int*)(p->ws + WS_TSEL) + tok * 4 + (lane & 1) * 2; ts[0] = mye; ts[1] = pos;
        }
        __syncthreads();
    }
}

__device__ __forceinline__ void moe_table(KArgs p, int l, LAS int* tbl, int wv) {
    if (otid(wv) == 0) { const unsigned* cnt = (const unsigned*)(p->ws + WS_CTL) + CW_CNT + l * 16 * 64; int acc = 0;
        for (int e = 0; e < 16; ++e) { const int n = (int)cnt[e * 64]; tbl[e] = acc; tbl[17 + e] = n; acc += (n + 255) >> 8; } tbl[16] = acc; }
    __syncthreads();
}

constexpr int N_PHASES = 2 + 7 * DEPTH;
__device__ __forceinline__ int opq(int v) { asm volatile("" : "+s"(v)); return v; }
__device__ __forceinline__ LAS unsigned char* opq(LAS unsigned char* v) { unsigned x = (unsigned)(uintptr_t)v; asm volatile("" : "+s"(x)); return (LAS unsigned char*)(uintptr_t)x; }
__global__ void __launch_bounds__(512, 2) trunk_fwd(Params pk) {
    extern __shared__ __attribute__((aligned(16))) unsigned char lds_raw[];
    LAS unsigned char* lds = (LAS unsigned char*)lds_raw;
    volatile LAS unsigned* MISC = (volatile LAS unsigned*)(lds + MISC_OFF);
    LAS int* mtbl = (LAS int*)(lds + MISC_OFF + 256);
#define p kparams()
    const int wv = __builtin_amdgcn_readfirstlane((int)threadIdx.x >> 6);
    for (int u = threadIdx.x; u < (LDS_BYTES - MISC_OFF) / 4; u += 512) ((LAS unsigned*)(lds + MISC_OFF))[u] = 0u;
    __syncthreads();
    unsigned* ctl = (unsigned*)(p->ws + WS_CTL);
    XcdBarrier bar; bar.bar = ctl + CW_BAR; bar.x = 0; bar.st = nullptr; bar.wv = wv;
    const bool multi = (p->ph_hi - p->ph_lo) > 1;
    if (multi) bar = xcd_barrier_post(ctl + CW_BAR, MISC + 8, wv);
    const int lo = p->ph_lo, hi = p->ph_hi;
#define IN(k) (lo <= (k) && (k) < hi)
#define SEAM(k) do { if (IN(k) && IN((k) + 1)) xcd_barrier(bar); } while (0)
    const int G0 = gridDim.x, c0 = blockIdx.x; LAS unsigned char* const lds0 = lds;
#define PHASE_LOCALS const int G = opq(G0), c = opq(c0); LAS unsigned char* const lds = opq(lds0); LAS int* const mtbl = (LAS int*)(lds + MISC_OFF + 256); volatile LAS unsigned* const MISC = (volatile LAS unsigned*)(lds + MISC_OFF); (void)G; (void)c; (void)mtbl; (void)MISC;

    if (PK(0) && IN(0)) { PHASE_LOCALS phase_prologue(p, lds, wv); if (DUP_PHASE == 0) { __syncthreads(); phase_prologue(p, lds, wv); } SEAM(0); }
    for (int l = 0; l < DEPTH; ++l) {
        const int pb = 1 + 7 * l;
        if (PK(1) && IN(pb + 0)) { PHASE_LOCALS phase_norm1(p, l, lds, wv); if (DUP_PHASE == 1) { xcd_barrier(bar); phase_norm1(p, l, lds, wv, true); } SEAM(pb + 0); }
        if (PK(2) && IN(pb + 1)) { PHASE_LOCALS
            if (c < H_FOX) scan_head(p, c, l, lds, wv);
            for (int rep = 0; rep < (DUP_PHASE == 2 ? 2 : 1); ++rep) {
            { pg8::Gemm g{(const bf16_t*)(p->ws + WS_OUTB), (const bf16_t*)(p->ws + WS_WQK) + (size_t)l * NQK * DM, SEQ, NQK, DM};
              pg8::StaticOrder S; S.init(SEQ, NQK, G, c);
              pg8::EpiQK E{(bf16_t*)(p->ws + WS_QKB), p->qnorm_diff + l * 64, p->knorm_diff + l * 64, p->qnorm_fox + l * 128, p->knorm_fox + l * 128, (LAS float*)(lds + TBL_OFF), (const float*)(p->ws + WS_RSTD)};
              pg8::gemm_phase<pg8::EpiQK, pg8::StaticOrder>(lds, g, S, E, wv); }
            { pg8::Gemm g{(const bf16_t*)(p->ws + WS_WV) + (size_t)l * NV * DM, (const bf16_t*)(p->ws + WS_OUTB), NV, SEQ, DM};
              pg8::StaticOrder S; S.init(NV, SEQ, G, c);
              pg8::EpiVT E{(bf16_t*)(p->ws + WS_VT), SEQ, (const float*)(p->ws + WS_RSTD)};
              pg8::gemm_phase<pg8::EpiVT, pg8::StaticOrder>(lds, g, S, E, wv); }
            }
            SEAM(pb + 1);
        }
        if (PK(3) && IN(pb + 2)) { PHASE_LOCALS att::attention_phase(p, l, lds, MISC + 16, wv, l); if (DUP_PHASE == 3) { __syncthreads(); att::attention_phase(p, l, lds, MISC + 16, wv, l + 4, ATT_MASK2); } SEAM(pb + 2); }
        if (PK(4) && IN(pb + 3)) { PHASE_LOCALS
            pg8::Gemm g{(const bf16_t*)(p->ws + WS_MIX), (const bf16_t*)(p->ws + WS_WO) + (size_t)l * DM * DM, SEQ, DM, DM};
            pg8::StaticOrder S; S.init(SEQ, DM, G, c);
            pg8::EpiResAdd E{(bf16_t*)(p->ws + WS_OUTB), 1.f, (unsigned*)(p->ws + WS_CTL) + CW_WOC + l * 32 * 64};
            pg8::gemm_phase<pg8::EpiResAdd, pg8::StaticOrder>(lds, g, S, E, wv);
        }
        if (PK(5) && IN(pb + 4)) { PHASE_LOCALS phase_route(p, l, lds, wv, l); if (DUP_PHASE == 5) { xcd_barrier(bar); phase_route(p, l, lds, wv, l + 4); } SEAM(pb + 4); }
        if (PK(6) && IN(pb + 5)) { PHASE_LOCALS
            moe_table(p, l, mtbl, wv);
            pg8::Gemm g{(const bf16_t*)(p->ws + WS_OUTB), (const bf16_t*)(p->ws + WS_WGU) + (size_t)l * NEXP * 1024 * DM, MOE_ROWS, NEXP * 1024, DM};
            pg8::MoeOrder<4, true> S{mtbl, (const int*)(p->ws + WS_TOK), G, c, DM};
            pg8::EpiGU E{(bf16_t*)(p->ws + WS_ACT), (const float*)(p->ws + WS_GATE), mtbl, (unsigned*)(p->ws + WS_CTL) + CW_GUC + l * 80 * 64};
            for (int rep = 0; rep < (DUP_PHASE == 6 ? 2 : 1); ++rep)
            pg8::gemm_phase<pg8::EpiGU, pg8::MoeOrder<4, true>>(lds, g, S, E, wv);
        }
        if (PK(7) && IN(pb + 6)) { PHASE_LOCALS
            moe_table(p, l, mtbl, wv);
            pg8::Gemm g{(const bf16_t*)(p->ws + WS_ACT), (const bf16_t*)(p->ws + WS_WD) + (size_t)l * NEXP * DM * FEXP, MOE_ROWS, NEXP * DM, FEXP};
            pg8::DownOrder S{mtbl, (unsigned*)(p->ws + WS_CTL) + CW_GUC + l * 80 * 64, (unsigned*)(p->ws + WS_CTL) + CW_BAR + XB_TMO, G, c};
            pg8::EpiDown E{(bf16_t*)(p->ws + WS_Y)};
            pg8::gemm_phase<pg8::EpiDown, pg8::DownOrder>(lds, g, S, E, wv);
            SEAM(pb + 6);
        }
    }
    if (PK(1) && IN(N_PHASES - 1)) { PHASE_LOCALS phase_norm1(p, DEPTH, lds, wv); }
#undef IN
#undef SEAM
#undef PHASE_LOCALS
#undef p
}

extern "C" void kernel_launch(void* const* d_in, const int* in_sizes, int n_in, void* d_out, int out_size, void* d_ws, size_t ws_size, hipStream_t stream) {
    static int grid = 0;
    if (grid == 0) {
        if (n_in != 22 || in_sizes[0] != SEQ * DM || out_size != SEQ * DM || ws_size < WS_END) {
            fprintf(stderr, "kernel_launch: unexpected shapes (n_in %d, in0 %d, out %d, ws %zu < %zu); nothing launched\n", n_in, n_in > 0 ? in_sizes[0] : -1, out_size, ws_size, (size_t)WS_END); grid = -1; return; }
        int dev = 0, cus = 0, per_cu = 0;
        if (hipGetDevice(&dev) != hipSuccess || hipDeviceGetAttribute(&cus, hipDeviceAttributeMultiprocessorCount, dev) != hipSuccess) { grid = -1; return; }
        if (hipFuncSetAttribute((const void*)trunk_fwd, hipFuncAttributeMaxDynamicSharedMemorySize, LDS_BYTES) != hipSuccess) { fprintf(stderr, "kernel_launch: hipFuncSetAttribute failed\n"); grid = -1; return; }
        if (hipOccupancyMaxActiveBlocksPerMultiprocessor(&per_cu, (const void*)trunk_fwd, 512, LDS_BYTES) != hipSuccess || per_cu < 1)
            fprintf(stderr, "kernel_launch: note: occupancy query reports %d workgroups per CU\n", per_cu);
        (void)hipGetLastError();
        grid = cus;
    }
    if (grid < 0) return;
    if (hipMemsetAsync((char*)d_ws + WS_CTL, 0, CTL_ZERO_BYTES, stream) != hipSuccess) { fprintf(stderr, "kernel_launch: memset failed\n"); return; }
    Params hp{};
    const float** pp = (const float**)&hp;
    for (int i = 0; i < 22; ++i) pp[i] = (const float*)d_in[i];
    hp.out = (float*)d_out; hp.ws = (unsigned char*)d_ws;
#if MK_ONE_LAUNCH
    hp.ph_lo = 0; hp.ph_hi = N_PHASES;
    hipLaunchKernelGGL(trunk_fwd, dim3(grid), dim3(512), LDS_BYTES, stream, hp);
#else
    for (int ph = 0; ph < N_PHASES; ++ph) { hp.ph_lo = ph; hp.ph_hi = ph + 1; hipLaunchKernelGGL(trunk_fwd, dim3(grid), dim3(512), LDS_BYTES, stream, hp); }
#endif
    const hipError_t le = hipPeekAtLastError();
    if (le != hipSuccess) fprintf(stderr, "kernel_launch: launch failed: %s\n", hipGetErrorName(le));
}
```

```cpp
#include <hip/hip_runtime.h>
#include <cstdio>
#include <cstdint>

#ifndef MK_ONE_LAUNCH
#define MK_ONE_LAUNCH 1
#endif
#ifndef PHASE_MASK
#define PHASE_MASK 0xff
#endif
#define PK(k) (((PHASE_MASK) >> (k)) & 1)
#ifndef DUP_PHASE
#define DUP_PHASE -1
#endif
#ifndef ATT_MASK2
#define ATT_MASK2 7
#endif
#ifndef SKIP_A
#define SKIP_A 1
#endif
#ifndef SKIP_B
#define SKIP_B 3
#endif
#ifndef SKIP_C
#define SKIP_C 1
#endif

#define GAS __attribute__((address_space(1)))
#define LAS __attribute__((address_space(3)))
typedef unsigned short bf16_t;
typedef short bf16x8 __attribute__((ext_vector_type(8)));
typedef float f32x4 __attribute__((ext_vector_type(4)));
typedef float f32x16 __attribute__((ext_vector_type(16)));
typedef unsigned u32x4 __attribute__((ext_vector_type(4)));
typedef unsigned u32x2 __attribute__((ext_vector_type(2)));
typedef int i32x4 __attribute__((ext_vector_type(4)));

constexpr int SEQ = 8192, DM = 2048, DEPTH = 4, NQK = 4096, NV = 2048, NEXP = 16, FEXP = 512, NIN = 6149;
constexpr int HD = 128, H_DIFF = 6, H_SB = 5, H_FOX = 5;
constexpr float EPS = 1e-6f;
constexpr float LOG2E = 1.4426950408889634f;
constexpr int MOE_ROWS = 16384 + 16 * 256;

constexpr size_t MiB = 1u << 20;
constexpr size_t WS_CTL = 0, CTL_ZERO_BYTES = 1 * MiB;
constexpr size_t WS_WF = 1 * MiB;
constexpr size_t WS_LAM = 1 * MiB + 512 * 1024;
constexpr size_t WS_LOGF = 2 * MiB;
constexpr size_t WS_DC2 = 3 * MiB;
constexpr size_t WS_TOK = 4 * MiB;
constexpr size_t WS_GATE = 5 * MiB;
constexpr size_t WS_TSEL = 6 * MiB;
constexpr size_t WS_WRT = 7 * MiB;
constexpr size_t WS_RSTD = 8 * MiB;
constexpr size_t WS_WQK = 16 * MiB;
constexpr size_t WS_WV = 80 * MiB;
constexpr size_t WS_WO = 112 * MiB;
constexpr size_t WS_WGU = 144 * MiB;
constexpr size_t WS_WD = 400 * MiB;
constexpr size_t WS_XN = 528 * MiB;
constexpr size_t WS_QKB = 560 * MiB;
constexpr size_t WS_VT = 624 * MiB;
constexpr size_t WS_MIX = 656 * MiB;
constexpr size_t WS_ACT = 688 * MiB;
constexpr size_t WS_Y = 708 * MiB;
constexpr size_t WS_PART = 788 * MiB;
constexpr size_t WS_OUTB = 828 * MiB;
constexpr size_t WS_OUTB8 = 862 * MiB;
constexpr size_t WS_END = 878 * MiB;
constexpr int CW_BAR = 4096;
constexpr int CW_ATTQ = 16384;
constexpr int CW_CNT = 32768;
constexpr int CW_AFLAG = 65536;
constexpr int CW_WOC = 233472;
constexpr int CW_GUC = 212992;

constexpr int RING_BYTES = 131072;
constexpr int TBL_OFF = RING_BYTES;
constexpr int MISC_OFF = RING_BYTES + 8192;
constexpr int LDS_BYTES = 147456;

typedef float f32x2_t __attribute__((ext_vector_type(2)));
typedef __bf16 bf16x2_t __attribute__((ext_vector_type(2)));
typedef int i32x8 __attribute__((ext_vector_type(8)));
__device__ __forceinline__ unsigned cvt4f8(float a, float b, float c, float d) {
    int w = 0; w = __builtin_amdgcn_cvt_pk_fp8_f32(a, b, w, false); w = __builtin_amdgcn_cvt_pk_fp8_f32(c, d, w, true); return (unsigned)w; }
constexpr float W8_SCALE = 256.f, ACT8_SCALE = 4.f;
__device__ __forceinline__ unsigned cvtpk(float lo, float hi) { const f32x2_t v = {lo, hi}; const bf16x2_t b = __builtin_convertvector(v, bf16x2_t); return __builtin_bit_cast(unsigned, b); }
__device__ __forceinline__ float bf_lo(unsigned u) { return __uint_as_float(u << 16); }
__device__ __forceinline__ float bf_hi(unsigned u) { return __uint_as_float(u & 0xffff0000u); }
__device__ __forceinline__ float fexp2(float x) { return __builtin_amdgcn_exp2f(x); }
__device__ __forceinline__ float flog2(float x) { return __builtin_amdgcn_logf(x); }
__device__ __forceinline__ int otid(int wv) { int t; asm volatile("v_mbcnt_lo_u32_b32 %0, -1, 0\n\tv_mbcnt_hi_u32_b32 %0, -1, %0" : "=v"(t)); return wv * 64 + t; }
template <int M> __device__ __forceinline__ float swz_xor(float v) { return __int_as_float(__builtin_amdgcn_ds_swizzle(__float_as_int(v), 0x1F | (M << 10))); }
__device__ __forceinline__ float sum_xor32(float v) { auto rr = __builtin_amdgcn_permlane32_swap(__float_as_uint(v), __float_as_uint(v), false, false); return __uint_as_float(rr[0]) + __uint_as_float(rr[1]); }
__device__ __forceinline__ float wave_sum(float v) {
    v += swz_xor<1>(v); v += swz_xor<2>(v); v += swz_xor<4>(v); v += swz_xor<8>(v); v += swz_xor<16>(v);
    return sum_xor32(v);
}

namespace pg8 {
constexpr int BM = 256, BK = 64, HALF = 128, HTB = HALF * BK * 2, STAGE_BYTES = 8 * HTB, NXCD = 8, WGM = 8;
__host__ __device__ __forceinline__ int lds_byte(int r, int c) { const int st = (r >> 4) * 2 + (c >> 5), rr = r & 15, cc = c & 31, ob = rr * 64 + cc * 2; return st * 1024 + (ob ^ (((ob >> 9) & 1) << 5)); }
__host__ __device__ __forceinline__ void stage_rc(int b, int& R, int& C) { const int st = b / 1024, sb = b % 1024, swz = sb ^ (((sb >> 9) & 1) << 5); R = (st >> 1) * 16 + swz / 64; C = (st & 1) * 32 + (swz % 64) / 2; }
__host__ __device__ __forceinline__ int perm32(int rho) { const int n = rho >> 4, i = rho & 15; return 8 * (i >> 2) + 4 * n + (i & 3); }
__host__ __device__ __forceinline__ int permV(int rho) { const int n = rho >> 4, i = rho & 15; return 16 * (i >> 3) + 8 * n + (i & 7); }
template <int P> __host__ __device__ __forceinline__ int permf(int rho) { return P == 1 ? perm32(rho) : (P == 2 ? permV(rho) : rho); }

struct Unit { int pm, pn, e, rt; };
struct Gemm { const bf16_t* A; const bf16_t* Bt; int M, N, K; };

struct StaticOrder {
    int nM, nN, nwg, G, c;
    __device__ void init(int M, int N, int G_, int c_) { nM = M / BM; nN = N / BM; nwg = nM * nN; G = G_; c = c_; }
    __device__ bool next(int i, Unit& u) const {
        const long L = (long)i * G + c; if (L >= nwg) return false;
        int wgid = (int)L; { const int q = nwg / NXCD, r = nwg % NXCD, xcd = wgid % NXCD, off = wgid / NXCD; wgid = (xcd < r ? xcd * (q + 1) : r * (q + 1) + (xcd - r) * q) + off; }
        const int nig = WGM * nN, gid = wgid / nig, fm = gid * WGM, gsz = (nM - fm) < WGM ? (nM - fm) : WGM;
        u.pm = fm + ((wgid % nig) % gsz); u.pn = (wgid % nig) / gsz; u.e = 0; u.rt = 0; return true;
    }
    __device__ __forceinline__ size_t a_base(const Unit& u, size_t tstep) const { return (size_t)u.pm * tstep; }
    __device__ __forceinline__ unsigned row_off(const Unit&, int r, int K) const { return (unsigned)(r * K) * 2u; }
    __device__ __forceinline__ void a_ready(const Unit&, int) const {}
};

template <int NCT, bool GATHER> struct MoeOrder {
    const LAS int* tbl; const int* tok; int G, c, K;
    __device__ bool next(int i, Unit& u) const {
        const int L = i * G + c, total = __builtin_amdgcn_readfirstlane(tbl[16]) * NCT; if (L >= total) return false;
        const int g = L / NCT, ct = L % NCT; int e = 0;
#pragma unroll
        for (int k = 1; k < 16; ++k) e += (g >= tbl[k]) ? 1 : 0;
        e = __builtin_amdgcn_readfirstlane(e);
        u.pm = g; u.pn = e * NCT + ct; u.e = e; u.rt = __builtin_amdgcn_readfirstlane(g - tbl[e]); return true;
    }
    __device__ __forceinline__ size_t a_base(const Unit& u, size_t tstep) const { return GATHER ? 0 : (size_t)u.pm * tstep; }
    __device__ __forceinline__ unsigned row_off(const Unit& u, int r, int K_) const {
        if (!GATHER) return (unsigned)(r * K_) * 2u;
        const int pos = u.rt * 256 + r; const int n = __builtin_amdgcn_readfirstlane(tbl[17 + u.e]);
        const int t = pos < n ? tok[u.e * SEQ + pos] : 0;
        return (unsigned)(t * K_) * 2u;
    }
    __device__ __forceinline__ void a_ready(const Unit&, int) const {}
};

struct DownOrder {
    const LAS int* tbl; unsigned* cnt; unsigned* tmo; int G, c;
    __device__ bool next(int i, Unit& u) const {
        const int T = __builtin_amdgcn_readfirstlane(tbl[16]);
        const int U1 = 4 * T, nb2 = U1 > G ? U1 - G : 0, F = G - nb2;
        const int g1 = T < (G >> 2) ? T : (G >> 2), E = 8 * g1, Lt = 8 * (T - g1);
        int k = -1, late = 0;
        int ii = i;
        if (c >= nb2) { const int cf = c - nb2; const int nE = E > cf ? (E - cf + F - 1) / F : 0; if (ii < nE) k = cf + ii * F; else ii -= nE; }
        int g, ct;
        if (k >= 0) { g = k >> 3; ct = k & 7; }
        else { const int k0 = (c - nb2 + G) % G; const int kk = k0 + ii * G; if (kk >= Lt) return false; g = g1 + (kk >> 3); ct = kk & 7; late = 1; }
        (void)late;
        int e = 0;
#pragma unroll
        for (int q = 1; q < 16; ++q) e += (g >= tbl[q]) ? 1 : 0;
        e = __builtin_amdgcn_readfirstlane(e);
        u.pm = g; u.pn = e * 8 + ct; u.e = e; u.rt = __builtin_amdgcn_readfirstlane(g - tbl[e]); return true;
    }
    __device__ __forceinline__ size_t a_base(const Unit& u, size_t tstep) const { return (size_t)u.pm * tstep; }
    __device__ __forceinline__ unsigned row_off(const Unit&, int r, int K_) const { return (unsigned)(r * K_) * 2u; }
    __device__ __forceinline__ void a_ready(const Unit& u, int wid) const {
        if (wid == 0) {
            unsigned sp = 0;
            while ((unsigned)__builtin_amdgcn_readfirstlane((int)__hip_atomic_load(cnt + 64 * u.pm, __ATOMIC_RELAXED, __HIP_MEMORY_SCOPE_AGENT)) < 32u) {
                __builtin_amdgcn_s_sleep(2);
                if (++sp > (1u << 22)) { __hip_atomic_store(tmo, 1u, __ATOMIC_RELAXED, __HIP_MEMORY_SCOPE_AGENT); break; }
            }
            __builtin_amdgcn_fence(__ATOMIC_ACQUIRE, "agent");
            asm volatile("s_waitcnt vmcnt(0)" ::: "memory");
        }
        asm volatile("" ::: "memory"); __builtin_amdgcn_s_barrier(); asm volatile("" ::: "memory");
    }
};

template <class Epi, class Sched, bool SP2 = true>
__device__ __forceinline__ void gemm_phase(LAS unsigned char* lds, const Gemm g, const Sched& S, const Epi& E, int wv) {
    const int tid = otid(wv), wid = __builtin_amdgcn_readfirstlane(tid >> 6), lane = tid & 63, wr = wid >> 2, wc = wid & 3, fr = lane & 15, fq = lane >> 4;
    const int K = g.K, nt = K / BK;
    unsigned voffB[2]; int Rr[2], Cc[2];
#pragma unroll
    for (int i = 0; i < 2; ++i) { int R, C; stage_rc(tid * 16 + i * 8192, R, C); const int Rb = (R & ~31) + permf<Epi::PERM>(R & 31);
        Rr[i] = R; Cc[i] = C; voffB[i] = (unsigned)(Rb * K + C) * 2u; }
    const size_t kstep = (size_t)(BK * 2);
    const size_t hstep = (size_t)HALF * K * 2;
    const size_t tstep = 2 * hstep;
    const unsigned ldsw = (unsigned)wid * 1024u;
    const int aoff = lds_byte(wr * 64 + fr, fq * 8), boff = lds_byte(wc * 32 + fr, fq * 8);
#define PG8_SA(b, h) (((b) * 2 + (h)) * HTB)
#define PG8_SB(b, h) ((4 + (b) * 2 + (h)) * HTB)
#define PG8_STAGE(bufoff, gbase, voff) do { _Pragma("unroll") for (int _i = 0; _i < 2; ++_i) \
        __builtin_amdgcn_global_load_lds((const unsigned*)((const char*)(gbase) + (voff)[_i]), (LAS unsigned*)(lds + (bufoff) + ldsw + _i * 8192), 16, 0, 0); } while (0)
#define PG8_LDA(dst, b, h) do { _Pragma("unroll") for (int m = 0; m < 4; ++m) _Pragma("unroll") for (int k = 0; k < 2; ++k) dst[m][k] = *(const LAS bf16x8*)(lds + PG8_SA(b, h) + aoff + m * 2048 + k * 1024); } while (0)
#define PG8_LDB(dst, b, h) do { _Pragma("unroll") for (int n = 0; n < 2; ++n) _Pragma("unroll") for (int k = 0; k < 2; ++k) dst[n][k] = *(const LAS bf16x8*)(lds + PG8_SB(b, h) + boff + n * 2048 + k * 1024); } while (0)
#define PG8_CAT(x) __builtin_shufflevector(__builtin_bit_cast(i32x4, (x)[0]), __builtin_bit_cast(i32x4, (x)[1]), 0, 1, 2, 3, 4, 5, 6, 7)
#define PG8_MMA(ai, bj, At, Bt) do { __builtin_amdgcn_s_setprio(1); \
        if constexpr (Epi::FP8) { _Pragma("unroll") for (int m = 0; m < 4; ++m) _Pragma("unroll") for (int n = 0; n < 2; ++n) \
            asm volatile("v_mfma_scale_f32_16x16x128_f8f6f4 %0, %1, %2, %0, %3, %3 op_sel_hi:[0,0,0]" : "+v"(acc[ai][bj][m][n]) : "v"(PG8_CAT(Bt[n])), "v"(PG8_CAT(At[m])), "v"(one8)); } \
        else { _Pragma("unroll") for (int m = 0; m < 4; ++m) _Pragma("unroll") for (int n = 0; n < 2; ++n) _Pragma("unroll") for (int k = 0; k < 2; ++k) \
            acc[ai][bj][m][n] = __builtin_amdgcn_mfma_f32_16x16x32_bf16(Bt[n][k], At[m][k], acc[ai][bj][m][n], 0, 0, 0); } \
        __builtin_amdgcn_s_setprio(0); } while (0)
#define PG8_WAIT_V(n) asm volatile("s_waitcnt vmcnt(" #n ")" ::: "memory")
#define PG8_WAIT_L(n) asm volatile("s_waitcnt lgkmcnt(" #n ")" ::: "memory")
#define PG8_BAR __builtin_amdgcn_s_barrier()
#define PG8_SCHED __builtin_amdgcn_sched_barrier(0)
    Unit cur, nxt; int ui = 0;
    if (!S.next(0, cur)) return;
    const unsigned one8 = 0x7F7F7F7Fu;
    (void)one8;
    f32x4 acc[2][2][4][2];
    if constexpr (Epi::LOAD_INIT) E.init(acc, cur, wr, wc, fr, fq);
    else {
#pragma unroll
    for (int a = 0; a < 2; ++a)
#pragma unroll
        for (int b = 0; b < 2; ++b)
#pragma unroll
            for (int m = 0; m < 4; ++m)
#pragma unroll
                for (int n = 0; n < 2; ++n) acc[a][b][m][n] = (f32x4){0.f, 0.f, 0.f, 0.f};
    }
    bf16x8 At[4][2], B0[2][2], B1[2][2];
    unsigned oc[2][2], on[2][2];
#pragma unroll
    for (int h = 0; h < 2; ++h)
#pragma unroll
        for (int i = 0; i < 2; ++i) { oc[h][i] = S.row_off(cur, h * HALF + Rr[i], K) + (unsigned)Cc[i] * 2u; on[h][i] = oc[h][i]; }
    const char* cA = (const char*)g.A + S.a_base(cur, tstep); const char* cB = (const char*)g.Bt + (size_t)cur.pn * tstep;
    S.a_ready(cur, wid);
    if constexpr (SP2) {
        PG8_STAGE(PG8_SB(0, 0), cB, voffB); PG8_STAGE(PG8_SB(0, 1), cB + hstep, voffB); PG8_STAGE(PG8_SA(0, 0), cA, oc[0]); PG8_STAGE(PG8_SA(0, 1), cA, oc[1]);
        if (wr == 1) PG8_BAR;
        PG8_WAIT_V(2); PG8_BAR;
        PG8_STAGE(PG8_SB(1, 0), cB + kstep, voffB); PG8_STAGE(PG8_SA(1, 0), cA + kstep, oc[0]); PG8_STAGE(PG8_SB(1, 1), cB + hstep + kstep, voffB);
        PG8_WAIT_V(6); PG8_BAR;
    } else {
        PG8_STAGE(PG8_SB(0, 0), cB, voffB); PG8_STAGE(PG8_SA(0, 0), cA, oc[0]); PG8_STAGE(PG8_SB(0, 1), cB + hstep, voffB); PG8_STAGE(PG8_SA(0, 1), cA, oc[1]);
        if (wr == 1) PG8_BAR;
        PG8_WAIT_V(4); PG8_BAR;
        PG8_STAGE(PG8_SB(1, 0), cB + kstep, voffB); PG8_STAGE(PG8_SA(1, 0), cA + kstep, oc[0]); PG8_STAGE(PG8_SB(1, 1), cB + hstep + kstep, voffB);
        PG8_WAIT_V(6); PG8_BAR;
    }
    for (;;) {
        const bool has_next = S.next(ui + 1, nxt);
        const char* nA = has_next ? (const char*)g.A + S.a_base(nxt, tstep) : cA; const char* nB = has_next ? (const char*)g.Bt + (size_t)nxt.pn * tstep : cB;
        if (has_next) {
#pragma unroll
            for (int h = 0; h < 2; ++h)
#pragma unroll
                for (int i = 0; i < 2; ++i) on[h][i] = S.row_off(nxt, h * HALF + Rr[i], K) + (unsigned)Cc[i] * 2u;
        }
        for (int t = 0; t < nt; t += 2) {
            const bool last = (t == nt - 2);
            if (last && has_next) S.a_ready(nxt, wid);
            const char* a1 = cA + (size_t)(t + 1) * kstep;
            const char* a2 = last ? nA : cA + (size_t)(t + 2) * kstep; const char* b2 = last ? nB : cB + (size_t)(t + 2) * kstep;
            const char* a3 = a2 + kstep; const char* b3 = b2 + kstep;
            unsigned o2a[2], o2b[2];
            o2a[0] = last ? on[0][0] : oc[0][0]; o2a[1] = last ? on[0][1] : oc[0][1]; o2b[0] = last ? on[1][0] : oc[1][0]; o2b[1] = last ? on[1][1] : oc[1][1];
            if constexpr (SP2) {
            PG8_LDB(B0, 0, 0); PG8_LDB(B1, 0, 1); PG8_SCHED; PG8_LDA(At, 0, 0); PG8_STAGE(PG8_SA(1, 1), a1, oc[1]);
            PG8_WAIT_V(8); PG8_WAIT_L(0); PG8_BAR; PG8_MMA(0, 0, At, B0); PG8_MMA(0, 1, At, B1); PG8_BAR; PG8_SCHED;
            PG8_LDA(At, 0, 1); PG8_STAGE(PG8_SB(0, 0), b2, voffB); PG8_STAGE(PG8_SB(0, 1), b2 + hstep, voffB); PG8_STAGE(PG8_SA(0, 0), a2, o2a);
            PG8_WAIT_V(8); PG8_WAIT_L(0); PG8_BAR; PG8_MMA(1, 0, At, B0); PG8_MMA(1, 1, At, B1); PG8_BAR; PG8_SCHED;
            PG8_LDB(B0, 1, 0); PG8_LDB(B1, 1, 1); PG8_SCHED; PG8_LDA(At, 1, 0); PG8_STAGE(PG8_SA(0, 1), a2, o2b);
            PG8_WAIT_V(8); PG8_WAIT_L(0); PG8_BAR; PG8_MMA(0, 0, At, B0); PG8_MMA(0, 1, At, B1); PG8_BAR; PG8_SCHED;
            PG8_LDA(At, 1, 1); PG8_STAGE(PG8_SB(1, 0), b3, voffB); PG8_STAGE(PG8_SB(1, 1), b3 + hstep, voffB); PG8_STAGE(PG8_SA(1, 0), a3, o2a);
            PG8_WAIT_V(8); PG8_WAIT_L(0); PG8_BAR; PG8_MMA(1, 0, At, B0); PG8_MMA(1, 1, At, B1); PG8_BAR; PG8_SCHED;
            } else {
            PG8_LDB(B0, 0, 0); PG8_SCHED; PG8_LDA(At, 0, 0); PG8_STAGE(PG8_SA(1, 1), a1, oc[1]);
            PG8_WAIT_L(8); PG8_BAR; PG8_WAIT_L(0); PG8_MMA(0, 0, At, B0); PG8_BAR; PG8_SCHED;
            PG8_LDB(B1, 0, 1); PG8_STAGE(PG8_SB(0, 0), b2, voffB);
            PG8_BAR; PG8_WAIT_L(0); PG8_MMA(0, 1, At, B1); PG8_BAR;
            PG8_LDA(At, 0, 1); PG8_STAGE(PG8_SA(0, 0), a2, o2a);
            PG8_BAR; PG8_WAIT_L(0); PG8_MMA(1, 0, At, B0); PG8_BAR; PG8_SCHED;
            PG8_STAGE(PG8_SB(0, 1), b2 + hstep, voffB);
            PG8_WAIT_V(6); PG8_BAR; PG8_MMA(1, 1, At, B1); PG8_BAR;
            PG8_LDB(B0, 1, 0); PG8_SCHED; PG8_LDA(At, 1, 0); PG8_STAGE(PG8_SA(0, 1), a2, o2b);
            PG8_WAIT_L(8); PG8_BAR; PG8_WAIT_L(0); PG8_MMA(0, 0, At, B0); PG8_BAR; PG8_SCHED;
            PG8_LDB(B1, 1, 1); PG8_STAGE(PG8_SB(1, 0), b3, voffB);
            PG8_BAR; PG8_WAIT_L(0); PG8_MMA(0, 1, At, B1); PG8_BAR;
            PG8_LDA(At, 1, 1); PG8_STAGE(PG8_SA(1, 0), a3, o2a);
            PG8_BAR; PG8_WAIT_L(0); PG8_MMA(1, 0, At, B0); PG8_BAR; PG8_SCHED;
            PG8_STAGE(PG8_SB(1, 1), b3 + hstep, voffB);
            PG8_WAIT_V(6); PG8_BAR; PG8_MMA(1, 1, At, B1); PG8_BAR;
            }
        }
        if (wr == 0) PG8_BAR;
        if constexpr (Epi::FP8) asm volatile("s_nop 15\n\ts_nop 15" ::: "memory");
        { const int tz = otid(wv) & 63; E(acc, cur, wr, wc, tz & 15, tz >> 4); }
        if (!has_next) break;
#pragma unroll
        for (int a = 0; a < 2; ++a)
#pragma unroll
            for (int b = 0; b < 2; ++b)
#pragma unroll
                for (int m = 0; m < 4; ++m)
#pragma unroll
                    for (int n = 0; n < 2; ++n) acc[a][b][m][n] = (f32x4){0.f, 0.f, 0.f, 0.f};
        if constexpr (Epi::LOAD_INIT) { const int tz2 = otid(wv) & 63; E.init(acc, nxt, wr, wc, tz2 & 15, tz2 >> 4); }
        cur = nxt; cA = nA; cB = nB; ++ui;
#pragma unroll
        for (int h = 0; h < 2; ++h)
#pragma unroll
            for (int i = 0; i < 2; ++i) oc[h][i] = on[h][i];
        if (wr == 1) PG8_BAR;
    }
    PG8_WAIT_V(0);
    PG8_BAR;
#undef PG8_SA
#undef PG8_SB
#undef PG8_STAGE
#undef PG8_LDA
#undef PG8_LDB
#undef PG8_MMA
#undef PG8_CAT
#undef PG8_WAIT_V
#undef PG8_WAIT_L
#undef PG8_BAR
#undef PG8_SCHED
}


struct EpiQK {
    static constexpr int PERM = 1; static constexpr bool LOAD_INIT = false; static constexpr bool FP8 = false;
    bf16_t* O; const float *gqd, *gkd, *gqf, *gkf; LAS float* tbl; const float* rstd;
    __device__ __forceinline__ void operator()(const f32x4 (&acc)[2][2][4][2], const Unit& u, int wr, int wc, int fr, int fq) const {
#pragma unroll
        for (int ai = 0; ai < 2; ++ai)
#pragma unroll
            for (int m = 0; m < 4; ++m)
#pragma unroll
                for (int bj = 0; bj < 2; ++bj) {
                    const f32x4 a = acc[ai][bj][m][0], b = acc[ai][bj][m][1];
                    float ss = (a[0] * a[0] + a[1] * a[1]) + (a[2] * a[2] + a[3] * a[3]) + (b[0] * b[0] + b[1] * b[1]) + (b[2] * b[2] + b[3] * b[3]);
                    ss += swz_xor<16>(ss); ss = sum_xor32(ss);
                    if (fq == 0) tbl[(bj * 256 + ai * 128 + wr * 64 + m * 16 + fr) * 4 + wc] = ss;
                }
        asm volatile("s_waitcnt lgkmcnt(0)" ::: "memory"); __builtin_amdgcn_s_barrier(); asm volatile("" ::: "memory");
        const int colh = wc * 32 + fq * 8;
#pragma unroll
        for (int bj = 0; bj < 2; ++bj) {
            const int hh = u.pn * 2 + bj;
            int mode; const float* gp; float extra;
            if (hh < 6) { mode = 0; gp = gqd + (colh & 63); extra = 0.125f * LOG2E; }
            else if (hh < 12) { mode = 0; gp = gkd + (colh & 63); extra = 1.f; }
            else if (hh < 17) { mode = 1; gp = gqf + colh; extra = 0.08838834764831845f * LOG2E; }
            else if (hh < 22) { mode = 1; gp = gkf + colh; extra = 1.f; }
            else if (hh < 27) { mode = 2; gp = gqd; extra = 0.08838834764831845f * LOG2E; }
            else { mode = 2; gp = gqd; extra = 1.f; }
            f32x4 g0 = (f32x4){1.f, 1.f, 1.f, 1.f}, g1 = g0;
            if (mode != 2) { g0 = *(const f32x4*)gp; g1 = *(const f32x4*)(gp + 4); }
            g0 = g0 * extra; g1 = g1 * extra;
#pragma unroll
            for (int ai = 0; ai < 2; ++ai)
#pragma unroll
                for (int m = 0; m < 4; ++m) {
                    const int rl = ai * 128 + wr * 64 + m * 16 + fr;
                    const float rr = rstd[u.pm * 256 + rl];
                    float rs = rr;
                    if (mode != 2) {
                        const f32x4 t = *(const LAS f32x4*)(tbl + (bj * 256 + rl) * 4);
                        const float tot = (mode == 0) ? ((wc < 2) ? (t[0] + t[1]) : (t[2] + t[3])) : ((t[0] + t[1]) + (t[2] + t[3]));
                        rs = rr * __builtin_amdgcn_rsqf(rr * rr * tot * (mode == 0 ? (1.f / 64.f) : (1.f / 128.f)) + EPS);
                    }
                    const f32x4 v0 = acc[ai][bj][m][0] * g0 * rs, v1 = acc[ai][bj][m][1] * g1 * rs;
                    u32x4 w; w.x = cvtpk(v0[0], v0[1]); w.y = cvtpk(v0[2], v0[3]); w.z = cvtpk(v1[0], v1[1]); w.w = cvtpk(v1[2], v1[3]);
                    *(u32x4*)(O + (size_t)(u.pm * 256 + rl) * NQK + u.pn * 256 + bj * 128 + colh) = w;
                }
        }
    }
};
struct EpiVT {
    static constexpr int PERM = 2; static constexpr bool LOAD_INIT = false; static constexpr bool FP8 = false;
    bf16_t* O; int ldc; const float* rstd;
    __device__ __forceinline__ void operator()(const f32x4 (&acc)[2][2][4][2], const Unit& u, int wr, int wc, int fr, int fq) const {
        f32x4 r0[2], r1[2];
#pragma unroll
        for (int bj = 0; bj < 2; ++bj) { const float* rp = rstd + u.pn * 256 + bj * 128 + wc * 32 + 16 * (fq >> 1) + 4 * (fq & 1);
            r0[bj] = *(const f32x4*)rp; r1[bj] = *(const f32x4*)(rp + 8); }
#pragma unroll
        for (int ai = 0; ai < 2; ++ai)
#pragma unroll
            for (int m = 0; m < 4; ++m)
#pragma unroll
                for (int bj = 0; bj < 2; ++bj) {
                    const f32x4 v0 = acc[ai][bj][m][0] * r0[bj], v1 = acc[ai][bj][m][1] * r1[bj];
                    u32x4 w; w.x = cvtpk(v0[0], v0[1]); w.y = cvtpk(v0[2], v0[3]); w.z = cvtpk(v1[0], v1[1]); w.w = cvtpk(v1[2], v1[3]);
                    *(u32x4*)(O + (size_t)(u.pm * 256 + ai * 128 + wr * 64 + m * 16 + fr) * ldc + u.pn * 256 + bj * 128 + wc * 32 + fq * 8) = w;
                }
    }
};
struct EpiResAdd {
    static constexpr int PERM = 1; static constexpr bool LOAD_INIT = true; static constexpr bool FP8 = false;
    bf16_t* X; float sc; unsigned* done; unsigned char* X8;
    __device__ __forceinline__ void init(f32x4 (&acc)[2][2][4][2], const Unit& u, int wr, int wc, int fr, int fq) const {
#pragma unroll
        for (int ai = 0; ai < 2; ++ai)
#pragma unroll
            for (int m = 0; m < 4; ++m)
#pragma unroll
                for (int bj = 0; bj < 2; ++bj) {
                    const u32x4 w = *(const u32x4*)(X + (size_t)(u.pm * 256 + ai * 128 + wr * 64 + m * 16 + fr) * DM + u.pn * 256 + bj * 128 + wc * 32 + fq * 8);
                    acc[ai][bj][m][0] = (f32x4){bf_lo(w.x), bf_hi(w.x), bf_lo(w.y), bf_hi(w.y)};
                    acc[ai][bj][m][1] = (f32x4){bf_lo(w.z), bf_hi(w.z), bf_lo(w.w), bf_hi(w.w)};
                }
    }
    __device__ __forceinline__ void operator()(const f32x4 (&acc)[2][2][4][2], const Unit& u, int wr, int wc, int fr, int fq) const {
        const __amdgpu_buffer_rsrc_t rsrc = __builtin_amdgcn_make_buffer_rsrc((void*)X, 0, SEQ * DM * 2, 0x00020000);
        const __amdgpu_buffer_rsrc_t rsrc8 = __builtin_amdgcn_make_buffer_rsrc((void*)X8, 0, SEQ * DM, 0x00020000);
#pragma unroll
        for (int ai = 0; ai < 2; ++ai)
#pragma unroll
            for (int m = 0; m < 4; ++m)
#pragma unroll
                for (int bj = 0; bj < 2; ++bj) {
                    const f32x4 v0 = acc[ai][bj][m][0], v1 = acc[ai][bj][m][1];
                    u32x4 w; w.x = cvtpk(v0[0], v0[1]); w.y = cvtpk(v0[2], v0[3]); w.z = cvtpk(v1[0], v1[1]); w.w = cvtpk(v1[2], v1[3]);
                    u32x2 w8; w8.x = cvt4f8(v0[0], v0[1], v0[2], v0[3]); w8.y = cvt4f8(v1[0], v1[1], v1[2], v1[3]);
                    __builtin_amdgcn_raw_buffer_store_b64(w8, rsrc8, (int)((u.pm * 256 + ai * 128 + wr * 64 + m * 16 + fr) * DM + u.pn * 256 + bj * 128 + wc * 32 + fq * 8), 0, 16);
                    __builtin_amdgcn_raw_buffer_store_b128(w, rsrc, (int)(((u.pm * 256 + ai * 128 + wr * 64 + m * 16 + fr) * DM + u.pn * 256 + bj * 128 + wc * 32 + fq * 8) * 2), 0, 16);
                }
        asm volatile("s_waitcnt vmcnt(0)" ::: "memory");
        if (fr == 0 && fq == 0) __hip_atomic_fetch_add(done + 64 * u.pm, 1u, __ATOMIC_RELAXED, __HIP_MEMORY_SCOPE_AGENT);
    }
};
struct EpiGU {
    static constexpr int PERM = 1; static constexpr bool LOAD_INIT = false; static constexpr bool FP8 = true;
    unsigned char* ACT; const float* gate; const LAS int* tbl; unsigned* done;
    __device__ __forceinline__ void operator()(const f32x4 (&acc)[2][2][4][2], const Unit& u, int wr, int wc, int fr, int fq) const {
        const int ct = u.pn & 3, n_e = __builtin_amdgcn_readfirstlane(tbl[17 + u.e]);
        const __amdgpu_buffer_rsrc_t rsrc = __builtin_amdgcn_make_buffer_rsrc((void*)ACT, 0, MOE_ROWS * FEXP, 0x00020000);
#pragma unroll
        for (int ai = 0; ai < 2; ++ai)
#pragma unroll
            for (int m = 0; m < 4; ++m) {
                const int rl = ai * 128 + wr * 64 + m * 16 + fr, pos = u.rt * 256 + rl;
                f32x2_t gr2 = {0.f, 0.f}; if (pos < n_e) gr2 = *(const f32x2_t*)(gate + 2 * (u.e * SEQ + pos));
                const float gt = gr2[0] * ACT8_SCALE, rs = gr2[1] * (1.f / W8_SCALE);
                float o[8];
#pragma unroll
                for (int n = 0; n < 2; ++n)
#pragma unroll
                    for (int j = 0; j < 4; ++j) { const float gv = acc[ai][0][m][n][j] * rs, uv = acc[ai][1][m][n][j] * rs;
                        const float sg = gv * __builtin_amdgcn_rcpf(1.f + fexp2(-gv * LOG2E)); o[n * 4 + j] = sg * uv * gt; }
                u32x2 w; w.x = cvt4f8(o[0], o[1], o[2], o[3]); w.y = cvt4f8(o[4], o[5], o[6], o[7]);
                __builtin_amdgcn_raw_buffer_store_b64(w, rsrc, (int)((u.pm * 256 + rl) * FEXP + ct * 128 + wc * 32 + fq * 8), 0, 16);
            }
        asm volatile("s_waitcnt vmcnt(0)" ::: "memory");
        if (fr == 0 && fq == 0) __hip_atomic_fetch_add(done + 64 * u.pm, 1u, __ATOMIC_RELAXED, __HIP_MEMORY_SCOPE_AGENT);
    }
};
struct EpiDown {
    static constexpr int PERM = 1; static constexpr bool LOAD_INIT = false; static constexpr bool FP8 = true;
    bf16_t* Y;
    __device__ __forceinline__ void operator()(const f32x4 (&acc)[2][2][4][2], const Unit& u, int wr, int wc, int fr, int fq) const {
        const int ct = u.pn & 7;
#pragma unroll
        for (int ai = 0; ai < 2; ++ai)
#pragma unroll
            for (int m = 0; m < 4; ++m)
#pragma unroll
                for (int bj = 0; bj < 2; ++bj) {
                    const f32x4 v0 = acc[ai][bj][m][0] * (1.f / (W8_SCALE * ACT8_SCALE)), v1 = acc[ai][bj][m][1] * (1.f / (W8_SCALE * ACT8_SCALE));
                    u32x4 w; w.x = cvtpk(v0[0], v0[1]); w.y = cvtpk(v0[2], v0[3]); w.z = cvtpk(v1[0], v1[1]); w.w = cvtpk(v1[2], v1[3]);
                    *(u32x4*)(Y + (size_t)(u.pm * 256 + ai * 128 + wr * 64 + m * 16 + fr) * DM + ct * 256 + bj * 128 + wc * 32 + fq * 8) = w;
                }
    }
};
}

#define XB_TMO      128
#define XB_XCNT(j)  (256  + 64 * (j))
#define XB_XSUB(j)  (1280 + 64 * (j))
#define XB_XGEN(j)  (2304 + 64 * (j))
#define XB_TOP      3328
#define XB_TOPGEN   3392
#define XCD_BAR_WORDS 3456
#define XB_SPIN_CAP (1u << 18)

__device__ __forceinline__ unsigned xb_ld(unsigned* p)              { return __hip_atomic_load(p, __ATOMIC_RELAXED, __HIP_MEMORY_SCOPE_AGENT); }
__device__ __forceinline__ unsigned xb_add(unsigned* p, unsigned v) { return __hip_atomic_fetch_add(p, v, __ATOMIC_RELAXED, __HIP_MEMORY_SCOPE_AGENT); }
__device__ __forceinline__ unsigned xb_xcc_id() { return (unsigned)__builtin_amdgcn_s_getreg((3 << 11) | 20) & 0xFu; }
#define XB_SPIN(cond, bar) do { unsigned _sp = 0; while (cond) { __builtin_amdgcn_s_sleep(1); \
    if ((++_sp & 255u) == 0u) { if (xb_ld(&(bar)[XB_TMO])) break; if (_sp > XB_SPIN_CAP) { atomicAdd(&(bar)[XB_TMO], 1u); break; } } } } while (0)

struct XcdBarrier { unsigned* bar; unsigned x; volatile LAS unsigned* st; int wv; };

__device__ __forceinline__ XcdBarrier xcd_barrier_post(unsigned* bar, volatile LAS unsigned* st, int wv) {
    XcdBarrier b; b.bar = bar; b.x = xb_xcc_id(); b.st = st; b.wv = wv;
    if (otid(wv) == 0) (void)xb_add(&bar[XB_XCNT(b.x)], 1u);
    return b;
}
__device__ __forceinline__ void xcd_barrier_complete(unsigned* bar, unsigned x, unsigned& nloc, unsigned& nx) {
    const unsigned G = gridDim.x * gridDim.y * gridDim.z;
    unsigned sum, cnt, mine, sp = 0u;
    for (;;) {
        sum = 0u; cnt = 0u; mine = 0u;
#pragma unroll
        for (unsigned j = 0; j < 16; ++j) { const unsigned c = xb_ld(&bar[XB_XCNT(j)]); sum += c; cnt += (c > 0u) ? 1u : 0u; mine = (j == x) ? c : mine; }
        if (sum == G) break;
        __builtin_amdgcn_s_sleep(1);
        if ((++sp & 255u) == 0u) { if (xb_ld(&bar[XB_TMO])) break; if (sp > XB_SPIN_CAP) { atomicAdd(&bar[XB_TMO], 1u); break; } }
    }
    nloc = mine > 0u ? mine : 1u; nx = cnt > 0u ? cnt : 1u;
}
__device__ __attribute__((noinline)) void xcd_barrier_impl(unsigned* bar_, unsigned bx, volatile LAS unsigned* bst, int bwv) {
    XcdBarrier b; b.bar = bar_; b.x = bx; b.st = bst; b.wv = bwv;
    asm volatile("s_waitcnt vmcnt(0)" ::: "memory");
    __syncthreads();
    if (otid(b.wv) == 0) {
        unsigned* bar = b.bar;
        __builtin_amdgcn_s_waitcnt(0);
        unsigned nloc = b.st[0], nx = b.st[1];
        if (nloc == 0u) { xcd_barrier_complete(bar, b.x, nloc, nx); b.st[0] = nloc; b.st[1] = nx; }
        const unsigned old = xb_add(&bar[XB_XSUB(b.x)], 1u);
        const unsigned gen = old / nloc;
        if (old + 1u == (gen + 1u) * nloc) {
            __builtin_amdgcn_fence(__ATOMIC_RELEASE, "agent");
            asm volatile("s_waitcnt vmcnt(0)" ::: "memory");
            const unsigned og = xb_add(&bar[XB_TOP], 1u);
            const unsigned tg = og / nx;
            if (og + 1u == (tg + 1u) * nx) xb_add(&bar[XB_TOPGEN], 1u);
            else XB_SPIN(xb_ld(&bar[XB_TOPGEN]) == tg, bar);
            __builtin_amdgcn_fence(__ATOMIC_ACQUIRE, "agent");
            xb_add(&bar[XB_XGEN(b.x)], 1u);
            asm volatile("s_waitcnt vmcnt(0)" ::: "memory");
        } else {
            XB_SPIN(xb_ld(&bar[XB_XGEN(b.x)]) == gen, bar);
            __builtin_amdgcn_fence(__ATOMIC_ACQUIRE, "agent");
            asm volatile("s_waitcnt vmcnt(0)" ::: "memory");
        }
    }
    __syncthreads();
}

__device__ __forceinline__ void xcd_barrier(const XcdBarrier& b) { xcd_barrier_impl(b.bar, b.x, b.st, b.wv); }

struct Params {
    const float *x, *attn_norm, *w_in, *b_forget, *qnorm_diff, *knorm_diff, *lam_q1, *lam_k1, *lam_q2, *lam_k2, *subln_diff, *onorm_sb,
        *qnorm_fox, *knorm_fox, *onorm_fox, *w_out, *ffn_norm, *w_router, *router_bias, *w_gate, *w_up, *w_down;
    float* out; unsigned char* ws; int ph_lo, ph_hi;
};
typedef const __attribute__((address_space(4))) Params* KArgs;
__device__ __forceinline__ KArgs kparams() { KArgs k = (KArgs)__builtin_amdgcn_kernarg_segment_ptr(); asm volatile("" : "+s"(k)); return k; }

__device__ __forceinline__ void transpose_item(const float* W, int ldn, int k0, int n0, bf16_t* WT, int K, int drow, LAS float* scr, int lane, const float* kgain = nullptr, bool f8 = false) {
#pragma unroll 8
    for (int i = 0; i < 32; ++i) { const int kk = 2 * i + (lane >> 5); scr[kk * 33 + (lane & 31)] = W[(size_t)(k0 + kk) * ldn + n0 + (lane & 31)]; }
    asm volatile("s_waitcnt lgkmcnt(0)" ::: "memory");
    const int c = lane & 7;
    f32x4 ga = {1.f, 1.f, 1.f, 1.f}, gb = ga;
    if (kgain) { ga = *(const f32x4*)(kgain + k0 + 8 * c); gb = *(const f32x4*)(kgain + k0 + 8 * c + 4); }
#pragma unroll
    for (int j = 0; j < 4; ++j) { const int n = (lane >> 3) + 8 * j; const LAS float* s = scr + (8 * c) * 33 + n;
        if (f8) { u32x2 o8; o8.x = cvt4f8(s[0 * 33] * ga[0] * W8_SCALE, s[1 * 33] * ga[1] * W8_SCALE, s[2 * 33] * ga[2] * W8_SCALE, s[3 * 33] * ga[3] * W8_SCALE);
            o8.y = cvt4f8(s[4 * 33] * gb[0] * W8_SCALE, s[5 * 33] * gb[1] * W8_SCALE, s[6 * 33] * gb[2] * W8_SCALE, s[7 * 33] * gb[3] * W8_SCALE);
            *(u32x2*)((unsigned char*)WT + (size_t)(drow + n) * K + k0 + 8 * c) = o8; continue; }
        u32x4 o; o.x = cvtpk(s[0 * 33] * ga[0], s[1 * 33] * ga[1]); o.y = cvtpk(s[2 * 33] * ga[2], s[3 * 33] * ga[3]); o.z = cvtpk(s[4 * 33] * gb[0], s[5 * 33] * gb[1]); o.w = cvtpk(s[6 * 33] * gb[2], s[7 * 33] * gb[3]);
        *(u32x4*)(WT + (size_t)(drow + n) * K + k0 + 8 * c) = o; }
    asm volatile("s_waitcnt lgkmcnt(0)" ::: "memory");
}
__device__ __forceinline__ int win_dest(int n0, int& sel) {
    if (n0 < 768) { sel = 0; return n0; }
    if (n0 < 1536) { sel = 0; return n0; }
    if (n0 < 2304) { sel = 1; return n0 - 1536; }
    if (n0 < 2944) { sel = 0; return 2816 + (n0 - 2304); }
    if (n0 < 3584) { sel = 0; return 3456 + (n0 - 2944); }
    if (n0 < 4224) { sel = 1; return 768 + (n0 - 3584); }
    if (n0 < 4864) { sel = 0; return 1536 + (n0 - 4224); }
    if (n0 < 5504) { sel = 0; return 2176 + (n0 - 4864); }
    sel = 1; return 1408 + (n0 - 5504);
}
__device__ __forceinline__ void phase_prologue(KArgs p, LAS unsigned char* lds, int wv) {
    const int tid = otid(wv), lane = tid & 63, wave = tid >> 6;
    LAS float* scr = (LAS float*)(lds + wave * 16384);
    const int gw = blockIdx.x * 8 + wave, NGW = gridDim.x * 8;
    constexpr int I_IN = 32 * 192, I_O = 32 * 64, I_G = 16 * 32 * 16, I_D = 16 * 8 * 64, I_L = I_IN + I_O + 2 * I_G + I_D;
    bf16_t* Wqk = (bf16_t*)(p->ws + WS_WQK); bf16_t* Wv = (bf16_t*)(p->ws + WS_WV); bf16_t* Wo = (bf16_t*)(p->ws + WS_WO);
    bf16_t* Wgu = (bf16_t*)(p->ws + WS_WGU); bf16_t* Wd = (bf16_t*)(p->ws + WS_WD);
    for (int it = gw; it < DEPTH * I_L; it += NGW) {
        const int l = it / I_L; int r = it % I_L;
        if (r < I_IN) { const int kb = r / 192, nb = r % 192; int sel; const int drow = win_dest(nb * 32, sel);
            transpose_item(p->w_in + (size_t)l * DM * NIN, NIN, kb * 64, nb * 32, sel ? Wv + (size_t)l * NV * DM : Wqk + (size_t)l * NQK * DM, DM, drow, scr, lane, p->attn_norm + (size_t)l * DM); continue; }
        r -= I_IN;
        if (r < I_O) { const int kb = r / 64, nb = r % 64;
            transpose_item(p->w_out + (size_t)l * DM * DM, DM, kb * 64, nb * 32, Wo + (size_t)l * DM * DM, DM, nb * 32, scr, lane); continue; }
        r -= I_O;
        if (r < 2 * I_G) { const int up = r / I_G; r %= I_G; const int e = r / 512, kb = (r % 512) / 16, nb = r % 16; const int n0 = nb * 32;
            const float* src = (up ? p->w_up : p->w_gate) + ((size_t)l * NEXP + e) * DM * FEXP;
            transpose_item(src, FEXP, kb * 64, n0, (bf16_t*)((unsigned char*)Wgu + ((size_t)l * NEXP + e) * 1024 * DM), DM, (n0 >> 7) * 256 + up * 128 + (n0 & 127), scr, lane, p->ffn_norm + (size_t)l * DM, true); continue; }
        r -= 2 * I_G;
        { const int e = r / 512, kb = (r % 512) / 64, nb = r % 64;
            transpose_item(p->w_down + ((size_t)l * NEXP + e) * FEXP * DM, DM, kb * 64, nb * 32, (bf16_t*)((unsigned char*)Wd + ((size_t)l * NEXP + e) * DM * FEXP), FEXP, nb * 32, scr, lane, nullptr, true); }
    }
    { float* WRT = (float*)(p->ws + WS_WRT); for (int i = blockIdx.x * 512 + tid; i < 16 * DM; i += gridDim.x * 512) WRT[(i & 15) * DM + (i >> 4)] = p->w_router[i]; }
    float* WF = (float*)(p->ws + WS_WF);
    for (int i = blockIdx.x * 512 + tid; i < DEPTH * 5 * DM; i += gridDim.x * 512) { const int l = i / (5 * DM), h = (i / DM) % 5, d = i % DM;
        WF[i] = p->w_in[((size_t)l * DM + d) * NIN + 6144 + h]; }
    if (blockIdx.x == 1 && wave < DEPTH) {
        const int l = wave;
        float a = fabsf(p->qnorm_diff[l * 64 + lane]), b = fabsf(p->knorm_diff[l * 64 + lane]);
        float c2 = fmaxf(fabsf(p->qnorm_fox[l * 128 + lane]), fabsf(p->qnorm_fox[l * 128 + 64 + lane])), d2 = fmaxf(fabsf(p->knorm_fox[l * 128 + lane]), fabsf(p->knorm_fox[l * 128 + 64 + lane]));
#pragma unroll
        for (int o = 1; o < 32; o <<= 1) { a = fmaxf(a, __int_as_float(__builtin_amdgcn_ds_bpermute(((lane ^ o) << 2), __float_as_int(a)))); b = fmaxf(b, __int_as_float(__builtin_amdgcn_ds_bpermute(((lane ^ o) << 2), __float_as_int(b))));
            c2 = fmaxf(c2, __int_as_float(__builtin_amdgcn_ds_bpermute(((lane ^ o) << 2), __float_as_int(c2)))); d2 = fmaxf(d2, __int_as_float(__builtin_amdgcn_ds_bpermute(((lane ^ o) << 2), __float_as_int(d2)))); }
        a = fmaxf(a, __int_as_float(__builtin_amdgcn_ds_bpermute(((lane ^ 32) << 2), __float_as_int(a)))); b = fmaxf(b, __int_as_float(__builtin_amdgcn_ds_bpermute(((lane ^ 32) << 2), __float_as_int(b))));
        c2 = fmaxf(c2, __int_as_float(__builtin_amdgcn_ds_bpermute(((lane ^ 32) << 2), __float_as_int(c2)))); d2 = fmaxf(d2, __int_as_float(__builtin_amdgcn_ds_bpermute(((lane ^ 32) << 2), __float_as_int(d2))));
        if (lane == 0) { ((float*)(p->ws + WS_LAM))[8 + 2 * l] = a * b; ((float*)(p->ws + WS_LAM))[8 + 2 * l + 1] = c2 * d2; }
    }
    if (blockIdx.x == 0 && wave < DEPTH) {
        const int l = wave;
        float a = wave_sum(p->lam_q1[l * 64 + lane] * p->lam_k1[l * 64 + lane]), b = wave_sum(p->lam_q2[l * 64 + lane] * p->lam_k2[l * 64 + lane]);
        if (lane == 0) ((float*)(p->ws + WS_LAM))[l] = fexp2(a * LOG2E) - fexp2(b * LOG2E) + (0.8f - 0.6f * fexp2(-0.3f * LOG2E * (float)l));
    }
}

__device__ __forceinline__ float log_sigmoid(float x) { return fminf(x, 0.f) - 0.6931471805599453f * flog2(1.f + fexp2(-fabsf(x) * LOG2E)); }

__device__ __forceinline__ void phase_norm1(KArgs p, int l, LAS unsigned char* lds, int wv, bool probe2 = false) {
    const int tid = otid(wv), lane = tid & 63, wave = tid >> 6;
    LAS float* wf = (LAS float*)lds;
    LAS int* rbase = (LAS int*)(lds + 5 * DM * 4);
    if (l < DEPTH) { const float* WF = (const float*)(p->ws + WS_WF) + (size_t)l * 5 * DM; for (int i = tid; i < 5 * DM; i += 512) wf[i] = WF[i]; }
    if (l > 0 && tid == 0) { const unsigned* cnt = (const unsigned*)(p->ws + WS_CTL) + CW_CNT + (l - 1) * 16 * 64; int acc = 0;
        for (int e = 0; e < 16; ++e) { rbase[e] = acc * 256; acc += ((int)cnt[e * 64] + 255) >> 8; } }
    __syncthreads();
    const bf16_t* Y = (const bf16_t*)(p->ws + WS_Y); const i32x4* tsel = (const i32x4*)(p->ws + WS_TSEL);
    bf16_t* XN = (bf16_t*)(p->ws + WS_XN); float* LOGF = (float*)(p->ws + WS_LOGF);
    const int gw = blockIdx.x * 8 + wave, NGW = gridDim.x * 8;
    for (int t = gw; t < SEQ; t += NGW) {
        asm volatile("" ::: "memory");
        f32x4 v[8];
        if (l == 0 && !probe2) { const f32x4* xr = (const f32x4*)(p->x + (size_t)t * DM) + lane;
#pragma unroll
            for (int j = 0; j < 8; ++j) v[j] = xr[64 * j]; }
        else { const u32x2* xr = (const u32x2*)((const bf16_t*)(p->ws + WS_OUTB) + (size_t)t * DM) + lane;
#pragma unroll
            for (int j = 0; j < 8; ++j) { const u32x2 a = xr[64 * j]; v[j] = (f32x4){bf_lo(a[0]), bf_hi(a[0]), bf_lo(a[1]), bf_hi(a[1])}; } }
        if (l > 0) {
            const float ysc = probe2 ? 0.f : 1.f;
            const i32x4 ts = tsel[t];
            const u32x2* y1 = (const u32x2*)(Y + (size_t)(rbase[ts[0]] + ts[1]) * DM) + lane; const u32x2* y2 = (const u32x2*)(Y + (size_t)(rbase[ts[2]] + ts[3]) * DM) + lane;
#pragma unroll
            for (int j = 0; j < 8; ++j) { const u32x2 a = y1[64 * j], b = y2[64 * j];
                v[j][0] += ysc * (bf_lo(a[0]) + bf_lo(b[0])); v[j][1] += ysc * (bf_hi(a[0]) + bf_hi(b[0])); v[j][2] += ysc * (bf_lo(a[1]) + bf_lo(b[1])); v[j][3] += ysc * (bf_hi(a[1]) + bf_hi(b[1])); }
        }
        if (l == DEPTH) { f32x4* orow = (f32x4*)(p->out + (size_t)t * DM) + lane;
#pragma unroll
            for (int j = 0; j < 8; ++j) orow[64 * j] = v[j]; }
        else { u32x2* orow = (u32x2*)((bf16_t*)(p->ws + WS_OUTB) + (size_t)t * DM) + lane;
#pragma unroll
            for (int j = 0; j < 8; ++j) { u32x2 w; w[0] = cvtpk(v[j][0], v[j][1]); w[1] = cvtpk(v[j][2], v[j][3]); orow[64 * j] = w; } }
        if (l == DEPTH) continue;
        float ss = 0.f;
#pragma unroll
        for (int j = 0; j < 8; ++j) ss += (v[j][0] * v[j][0] + v[j][1] * v[j][1]) + (v[j][2] * v[j][2] + v[j][3] * v[j][3]);
        const float rstd = __builtin_amdgcn_rsqf(wave_sum(ss) * (1.f / DM) + EPS);
        const f32x4* gr = (const f32x4*)(p->attn_norm + (size_t)l * DM) + lane;
        float fc[5] = {0.f, 0.f, 0.f, 0.f, 0.f};
        if (lane == 0) ((float*)(p->ws + WS_RSTD))[t] = rstd;
#pragma unroll
        for (int j = 0; j < 8; ++j) { const f32x4 xn = v[j] * rstd * gr[64 * j];
#pragma unroll
            for (int h = 0; h < 5; ++h) { const f32x4 w4 = *(const LAS f32x4*)(wf + h * DM + 4 * lane + 256 * j); fc[h] += (xn[0] * w4[0] + xn[1] * w4[1]) + (xn[2] * w4[2] + xn[3] * w4[3]); } }
#pragma unroll
        for (int h = 0; h < 5; ++h) { const float s = wave_sum(fc[h]); if (lane == 0) LOGF[h * SEQ + t] = log_sigmoid(s + p->b_forget[l * 5 + h]); }
    }
}

__device__ __forceinline__ void scan_head(KArgs p, int h, int l, LAS unsigned char* lds, int wv) {
    const int tid = otid(wv), lane = tid & 63, wave = tid >> 6;
    const float* src = (const float*)(p->ws + WS_LOGF) + (size_t)h * SEQ + tid * 16; float* dst = (float*)(p->ws + WS_DC2) + (size_t)h * SEQ + tid * 16;
    LAS float* wt = (LAS float*)lds;
    float v[16]; float s = 0.f;
#pragma unroll
    for (int i = 0; i < 4; ++i) { const f32x4 a = ((const f32x4*)src)[i]; v[4 * i] = a[0]; v[4 * i + 1] = a[1]; v[4 * i + 2] = a[2]; v[4 * i + 3] = a[3]; }
#pragma unroll
    for (int i = 0; i < 16; ++i) { s += v[i]; v[i] = s; }
    float inc = s;
#pragma unroll
    for (int o = 1; o < 64; o <<= 1) { const float n = __int_as_float(__builtin_amdgcn_ds_bpermute(((lane - o) & 63) << 2, __float_as_int(inc))); if (lane >= o) inc += n; }
    if (lane == 63) wt[wave] = inc;
    __syncthreads();
    float base = inc - s;
    for (int w = 0; w < wave; ++w) base += wt[w];
#pragma unroll
    for (int i = 0; i < 4; ++i) ((f32x4*)dst)[i] = (f32x4){(v[4 * i] + base) * LOG2E, (v[4 * i + 1] + base) * LOG2E, (v[4 * i + 2] + base) * LOG2E, (v[4 * i + 3] + base) * LOG2E};
    LAS float* dl = (LAS float*)(lds + 64);
#pragma unroll
    for (int i = 0; i < 16; ++i) dl[tid * 16 + i] = (v[i] + base) * LOG2E;
    __syncthreads();
    { const float thr = 39.f + 2.f * 16.3221377f * ((const float*)(p->ws + WS_LAM))[8 + 2 * l + 1];
      const int qb = tid >> 4, part = tid & 15; const float dref = dl[256 * qb]; int cnt = 0;
      for (int i = part; i < 4 * qb; i += 16) cnt += (dref - dl[64 * i + 63] <= -thr) ? 1 : 0;
      float c = (float)cnt; c += swz_xor<1>(c); c += swz_xor<2>(c); c += swz_xor<4>(c); c += swz_xor<8>(c);
      if (part == 0) ((int*)(p->ws + WS_LAM))[64 + h * 32 + qb] = (int)c; }
    __syncthreads();
}

namespace att {
constexpr int KP = 272, VP = 144;
constexpr int KT_BYTES = 64 * KP, VT_BYTES = 128 * VP, KB_BYTES = 256;
constexpr int BUF_BYTES = KT_BYTES + VT_BYTES + KB_BYTES;
constexpr float THR = 8.f;
static_assert(2 * BUF_BYTES <= RING_BYTES && 4 * 128 * 32 * 4 <= RING_BYTES, "attention LDS");

struct Stg { u32x4 k0, k1, v0, v1; };
__device__ __forceinline__ void stage_load(Stg& s, const bf16_t* Kg, const bf16_t* Vg, int j, int tid) {
    const bf16_t* kp = Kg + (size_t)(64 * j + (tid >> 3)) * NQK + (tid & 7) * 8;
    s.k0 = *(const u32x4*)kp; s.k1 = *(const u32x4*)(kp + 64);
    const bf16_t* vp = Vg + (size_t)(tid >> 2) * SEQ + 64 * j + (tid & 3) * 8;
    s.v0 = *(const u32x4*)vp; s.v1 = *(const u32x4*)(vp + 32);
}
__device__ __forceinline__ void stage_write(const Stg& s, LAS unsigned char* buf, int tid) {
    LAS unsigned char* kd = buf + (tid >> 3) * KP + (tid & 7) * 16; *(LAS u32x4*)kd = s.k0; *(LAS u32x4*)(kd + 128) = s.k1;
    LAS unsigned char* vd = buf + KT_BYTES + (tid >> 2) * VP + (tid & 3) * 16; *(LAS u32x4*)vd = s.v0; *(LAS u32x4*)(vd + 64) = s.v1;
}
template <int NKS>
__device__ __forceinline__ void qk_tile(f32x16& p0, f32x16& p1, const LAS unsigned char* kb, const bf16x8* qr) {
    bf16x8 ka[NKS], kc[NKS];
#pragma unroll
    for (int ks = 0; ks < NKS; ++ks) { ka[ks] = *(const LAS bf16x8*)(kb + ks * 32); kc[ks] = *(const LAS bf16x8*)(kb + 32 * KP + ks * 32); }
    __builtin_amdgcn_sched_barrier(0);
#pragma unroll
    for (int ks = 0; ks < NKS; ++ks) {
        p0 = __builtin_amdgcn_mfma_f32_32x32x16_bf16(ka[ks], qr[ks], p0, 0, 0, 0);
        p1 = __builtin_amdgcn_mfma_f32_32x32x16_bf16(kc[ks], qr[ks], p1, 0, 0, 0);
    }
    __builtin_amdgcn_sched_barrier(0);
}
__device__ __forceinline__ bf16x8 pack8(const f32x16& p, int b) {
    u32x4 w = {cvtpk(p[b + 0], p[b + 1]), cvtpk(p[b + 2], p[b + 3]), cvtpk(p[b + 4], p[b + 5]), cvtpk(p[b + 6], p[b + 7])};
    return *reinterpret_cast<bf16x8*>(&w);
}
__device__ __forceinline__ void pv_tile(f32x16 (&o)[4], const LAS unsigned char* vb, const f32x16& p0, const f32x16& p1) {
    const bf16x8 pb0 = pack8(p0, 0), pb1 = pack8(p0, 8), pb2 = pack8(p1, 0), pb3 = pack8(p1, 8);
#pragma unroll
    for (int dh = 0; dh < 2; ++dh) {
        bf16x8 va[8];
#pragma unroll
        for (int i = 0; i < 8; ++i) va[i] = *(const LAS bf16x8*)(vb + (2 * dh + (i >> 2)) * 32 * VP + (i & 3) * 32);
        __builtin_amdgcn_sched_barrier(0);
#pragma unroll
        for (int i = 0; i < 8; ++i) { const int d0 = 2 * dh + (i >> 2), s4 = i & 3;
            o[d0] = __builtin_amdgcn_mfma_f32_32x32x16_bf16(va[i], s4 == 0 ? pb0 : (s4 == 1 ? pb1 : (s4 == 2 ? pb2 : pb3)), o[d0], 0, 0, 0); }
        __builtin_amdgcn_sched_barrier(0);
    }
}
template <int NKS>
__device__ __forceinline__ void tile_fixed(f32x16 (&o)[4], const LAS unsigned char* kb, const LAS unsigned char* vb, const bf16x8* qr, f32x16& y0, f32x16& y1, float& l) {
    bf16x8 ka[NKS], kc[NKS];
#pragma unroll
    for (int ks = 0; ks < NKS; ++ks) { ka[ks] = *(const LAS bf16x8*)(kb + ks * 32); kc[ks] = *(const LAS bf16x8*)(kb + 32 * KP + ks * 32); }
    __builtin_amdgcn_sched_barrier(0);
#pragma unroll
    for (int ks = 0; ks < NKS; ++ks) y0 = __builtin_amdgcn_mfma_f32_32x32x16_bf16(ka[ks], qr[ks], y0, 0, 0, 0);
    __builtin_amdgcn_sched_barrier(0);
    asm volatile("" : "+v"(y0));
#pragma unroll
    for (int ks = 0; ks < NKS; ++ks) y1 = __builtin_amdgcn_mfma_f32_32x32x16_bf16(kc[ks], qr[ks], y1, 0, 0, 0);
    float s = 0.f;
#pragma unroll
    for (int r = 0; r < 16; ++r) { y0[r] = fexp2(y0[r]); s += y0[r]; }
    const bf16x8 pb0 = pack8(y0, 0), pb1 = pack8(y0, 8);
#pragma unroll
    for (int q = 0; q < NKS; ++q) { __builtin_amdgcn_sched_group_barrier(0x008, 1, 0);
#pragma unroll
        for (int h = 0; h < 8 / NKS; ++h) { __builtin_amdgcn_sched_group_barrier(0x400, 2, 0); __builtin_amdgcn_sched_group_barrier(0x002, 3, 0); } }
    __builtin_amdgcn_sched_barrier(0);
    bf16x8 va[8];
#pragma unroll
    for (int i = 0; i < 8; ++i) va[i] = *(const LAS bf16x8*)(vb + (i >> 1) * 32 * VP + (i & 1) * 32);
    __builtin_amdgcn_sched_barrier(0);
    asm volatile("" : "+v"(y1));
#pragma unroll
    for (int i = 0; i < 8; ++i) o[i >> 1] = __builtin_amdgcn_mfma_f32_32x32x16_bf16(va[i], (i & 1) ? pb1 : pb0, o[i >> 1], 0, 0, 0);
    float s1 = 0.f;
#pragma unroll
    for (int r = 0; r < 16; ++r) { y1[r] = fexp2(y1[r]); s1 += y1[r]; }
    const bf16x8 pb2 = pack8(y1, 0), pb3 = pack8(y1, 8);
#pragma unroll
    for (int q = 0; q < 8; ++q) { __builtin_amdgcn_sched_group_barrier(0x008, 1, 0); __builtin_amdgcn_sched_group_barrier(0x400, 2, 0); __builtin_amdgcn_sched_group_barrier(0x002, 3, 0); }
    __builtin_amdgcn_sched_barrier(0);
    l += s + s1;
    bf16x8 vb2[8];
#pragma unroll
    for (int i = 0; i < 8; ++i) vb2[i] = *(const LAS bf16x8*)(vb + (i >> 1) * 32 * VP + 64 + (i & 1) * 32);
    __builtin_amdgcn_sched_barrier(0);
#pragma unroll
    for (int i = 0; i < 8; ++i) o[i >> 1] = __builtin_amdgcn_mfma_f32_32x32x16_bf16(vb2[i], (i & 1) ? pb3 : pb2, o[i >> 1], 0, 0, 0);
    __builtin_amdgcn_sched_barrier(0);
}
__device__ __forceinline__ float swap_max(float v) { auto rr = __builtin_amdgcn_permlane32_swap(__float_as_uint(v), __float_as_uint(v), false, false); return fmaxf(__uint_as_float(rr[0]), __uint_as_float(rr[1])); }
__device__ __forceinline__ float swap_sum(float v) { auto rr = __builtin_amdgcn_permlane32_swap(__float_as_uint(v), __float_as_uint(v), false, false); return __uint_as_float(rr[0]) + __uint_as_float(rr[1]); }
__device__ __forceinline__ void softmax_step(f32x16& y0, f32x16& y1, float A, float& m, float& l, f32x16 (&o)[4]) {
    float mx = y0[0];
#pragma unroll
    for (int r = 1; r < 16; ++r) mx = fmaxf(mx, y0[r]);
#pragma unroll
    for (int r = 0; r < 16; ++r) mx = fmaxf(mx, y1[r]);
    mx = swap_max(mx) + A;
    if (__any(mx > m + THR)) {
        const float mn = fmaxf(m, mx), al = fexp2(m - mn); m = mn; l *= al;
#pragma unroll
        for (int d0 = 0; d0 < 4; ++d0)
#pragma unroll
            for (int r = 0; r < 16; ++r) o[d0][r] *= al;
    }
    const float mA = m - A; float s = 0.f;
#pragma unroll
    for (int r = 0; r < 16; ++r) { y0[r] = fexp2(y0[r] - mA); s += y0[r]; }
#pragma unroll
    for (int r = 0; r < 16; ++r) { y1[r] = fexp2(y1[r] - mA); s += y1[r]; }
    l += s;
}
__device__ __forceinline__ void softmax_fixed(f32x16& y0, f32x16& y1, float c, float& l) {
    float s = 0.f;
#pragma unroll
    for (int r = 0; r < 16; ++r) { y0[r] = fexp2(y0[r] + c); s += y0[r]; }
#pragma unroll
    for (int r = 0; r < 16; ++r) { y1[r] = fexp2(y1[r] + c); s += y1[r]; }
    l += s;
}
#define KIDX(r) (((r) & 3) + 8 * ((r) >> 2))

template <int TY>
__device__ __forceinline__ void att_item(KArgs p, int l, int head, int qb, LAS unsigned char* lds, int wv, int part = 0) {
    const int tid = otid(wv), wid = __builtin_amdgcn_readfirstlane(tid >> 6), lane = tid & 63, r32 = lane & 31, hi = lane >> 5;
    constexpr int NKS = (TY == 0) ? 4 : 8;
    const int br = (TY == 0) ? (wid >> 2) : 0, rg = (TY == 0) ? (wid & 3) : wid;
    const int t0w = (TY == 0) ? (128 * qb + 32 * rg) : (256 * qb + 32 * wid);
    const int trow = t0w + r32;
    const int NT = (TY == 0) ? (2 * qb + 2) : (4 * qb + 4);
    const int qcol = (TY == 0) ? (128 * head + 64 * br) : (TY == 1 ? 2816 + 128 * head : 1536 + 128 * head);
    const int kcol = (TY == 0) ? (768 + 128 * head) : (TY == 1 ? 3456 + 128 * head : 2176 + 128 * head);
    const int hv = (TY == 0) ? head : (TY == 1 ? 6 + head : 11 + head);
    const bf16_t* QKB = (const bf16_t*)(p->ws + WS_QKB);
    const bf16_t* Kg = QKB + kcol; const bf16_t* Vg = (const bf16_t*)(p->ws + WS_VT) + (size_t)hv * HD * SEQ;
    const float* dc2 = (const float*)(p->ws + WS_DC2) + (size_t)head * SEQ;
    const float dcref = (TY == 2) ? dc2[256 * qb] : 0.f;
    const float slope2 = (TY == 0) ? fexp2(-8.0f * (float)(head + 1) / 6.0f) * LOG2E : 0.f;
    const float Bfix = (TY == 0) ? (11.5415603f * 1.01f * ((const float*)(p->ws + WS_LAM))[8 + 2 * l] + 0.25f) : (16.3221377f * 1.01f * ((const float*)(p->ws + WS_LAM))[8 + 2 * l + 1] + 0.25f);
    const float cfix = (TY == 2) ? (dc2[trow] - dcref - Bfix) : -Bfix;

    int j_lo = 0;
    if (TY == 0 && SKIP_A) {
        const float Bq = 11.5415603f * ((const float*)(p->ws + WS_LAM))[8 + 2 * l];
        const float x = ((float)(128 * qb - 63) - (39.f + 2.f * Bq) / slope2) * (1.f / 64.f);
        j_lo = x < 0.f ? 0 : (int)x + 1;
    } else if (TY == 2 && SKIP_C) {
        j_lo = ((const int*)(p->ws + WS_LAM))[64 + head * 32 + qb];
    }
    j_lo = __builtin_amdgcn_readfirstlane(j_lo);
    const int NTP = NT - j_lo;
    const bool elig = (TY == 2) ? (qb >= 8) : ((TY == 0) ? (head >= 4 && qb >= 16) : false);
    const bool split = elig && NTP > 32;
    if (part == 1 && !split) return;
    const int mid = j_lo + (NTP >> 1);
    const int jtop = (part == 1) ? mid - 1 : NT - 1;
    const int cntT = (part == 1) ? (mid - j_lo) : (split ? NT - mid : NTP);
    const int sidx = (TY == 2) ? (head * 32 + qb) : (160 + head * 64 + qb);
    unsigned long long* pay = (unsigned long long*)(p->ws + WS_PART) + ((size_t)sidx * 8 + wid) * 17 * 64 + lane;
    unsigned* aflag = (unsigned*)(p->ws + WS_CTL) + CW_AFLAG + (l * 544 + sidx) * 64;
    LAS unsigned char* buf0 = lds; LAS unsigned char* buf1 = lds + BUF_BYTES;
    LAS int* flags = (LAS int*)(lds + 2 * BUF_BYTES);
    if (TY == 1 && tid < 16) flags[tid] = 0;
    Stg st; float kbv = 0.f;
    stage_load(st, Kg, Vg, jtop, tid);
    if (TY == 2 && tid < 64) kbv = dcref - dc2[64 * jtop + tid];
    bf16x8 qr[NKS];
#pragma unroll
    for (int ks = 0; ks < NKS; ++ks) qr[ks] = *(const bf16x8*)(QKB + (size_t)trow * NQK + qcol + ks * 16 + hi * 8);
    stage_write(st, buf0, tid);
    if (TY == 2 && tid < 64) *(LAS float*)(buf0 + KT_BYTES + VT_BYTES + tid * 4) = kbv;
    if (cntT > 1) { stage_load(st, Kg, Vg, jtop - 1, tid); if (TY == 2 && tid < 64) kbv = dcref - dc2[64 * (jtop - 1) + tid]; }
    __syncthreads();

    f32x16 o[4];
#pragma unroll
    for (int d0 = 0; d0 < 4; ++d0)
#pragma unroll
        for (int r = 0; r < 16; ++r) o[d0][r] = 0.f;
    float m = 0.f, lsum = 0.f, R = 0.f;
    const int koff = r32 * KP + hi * 16 + ((TY == 0) ? br * 128 : 0), voff = KT_BYTES + r32 * VP + hi * 16;

    for (int it = 0; it < cntT; ++it) {
        if (TY == 1 && (SKIP_B & 1) && it > 0) { const i32x4 f0 = *(const LAS i32x4*)(flags + ((it - 1) & 1) * 8), f1 = *(const LAS i32x4*)(flags + ((it - 1) & 1) * 8 + 4);
            if (__builtin_amdgcn_readfirstlane((f0[0] & f0[1] & f0[2] & f0[3] & f1[0] & f1[1] & f1[2] & f1[3])) != 0) break; }
        const int j = jtop - it;
        LAS unsigned char* cur = (it & 1) ? buf1 : buf0; LAS unsigned char* oth = (it & 1) ? buf0 : buf1;
        const bool more = it + 1 < cntT;
        if (TY == 0) {
            const int cw = 2 * qb + (rg >> 1);
            if (j <= cw) {
                f32x16 y0, y1;
                const int trel = trow - 64 * j;
                if (j == cw) {
                    const float tq = (float)(trel - 4 * hi);
#pragma unroll
                    for (int r = 0; r < 16; ++r) { y0[r] = fmaf(-slope2, fabsf(tq - (float)KIDX(r)), cfix); y1[r] = fmaf(-slope2, fabsf(tq - (float)(KIDX(r) + 32)), cfix); }
                } else {
                    const float A = fmaf(-slope2, (float)(trel - 4 * hi), cfix);
#pragma unroll
                    for (int r = 0; r < 16; ++r) { y0[r] = fmaf(slope2, (float)KIDX(r), A); y1[r] = fmaf(slope2, (float)(KIDX(r) + 32), A); }
                }
                tile_fixed<NKS>(o, cur + koff, cur + voff, qr, y0, y1, lsum);
            }
        } else {
            const int jj = j - 4 * qb;
            if (jj <= (wid >> 1) && !(TY == 1 && (SKIP_B & 2) && __all(R <= -40.f))) {
                const bool partial = (jj == (wid >> 1));
                const int tin = 32 * (wid & 1) + r32 - 4 * hi;
                f32x16 y0, y1;
                if (TY == 2) {
                    const LAS f32x4* kbp = (const LAS f32x4*)(cur + KT_BYTES + VT_BYTES) + hi;
#pragma unroll
                    for (int g = 0; g < 4; ++g) { const f32x4 b0 = kbp[2 * g], b1 = kbp[2 * g + 8];
#pragma unroll
                        for (int i = 0; i < 4; ++i) { y0[4 * g + i] = b0[i] + cfix; y1[4 * g + i] = b1[i] + cfix; } }
                    if (partial) {
#pragma unroll
                        for (int r = 0; r < 16; ++r) { if (KIDX(r) > tin) y0[r] = -__builtin_inff(); if (KIDX(r) + 32 > tin) y1[r] = -__builtin_inff(); }
                    }
                    tile_fixed<NKS>(o, cur + koff, cur + voff, qr, y0, y1, lsum);
                } else {
#pragma unroll
                    for (int r = 0; r < 16; ++r) { y0[r] = 0.f; y1[r] = 0.f; }
                    qk_tile<NKS>(y0, y1, cur + koff, qr);
                    f32x16 lb0, lb1;
#pragma unroll
                    for (int r = 0; r < 16; ++r) {
                        { const float z = fminf(fmaxf(y0[r], -100.f), 100.f), b = -flog2(1.f + fexp2(-z)); float k = b - z, bb = b;
                          if (partial && KIDX(r) >= tin) { k = 0.f; bb = -__builtin_inff(); } lb0[r] = bb; y0[r] = k; }
                        { const float z = fminf(fmaxf(y1[r], -100.f), 100.f), b = -flog2(1.f + fexp2(-z)); float k = b - z, bb = b;
                          if (partial && KIDX(r) + 32 >= tin) { k = 0.f; bb = -__builtin_inff(); } lb1[r] = bb; y1[r] = k; }
                    }
                    float gs0[4], gs1[4];
#pragma unroll
                    for (int g = 0; g < 4; ++g) {
                        { const float e0 = y0[4 * g], e1 = y0[4 * g + 1], e2 = y0[4 * g + 2], e3 = y0[4 * g + 3]; const float s2 = e3, s1 = e3 + e2, s0 = s1 + e1;
                          y0[4 * g + 3] = 0.f; y0[4 * g + 2] = s2; y0[4 * g + 1] = s1; y0[4 * g] = s0; gs0[g] = s0 + e0; }
                        { const float e0 = y1[4 * g], e1 = y1[4 * g + 1], e2 = y1[4 * g + 2], e3 = y1[4 * g + 3]; const float s2 = e3, s1 = e3 + e2, s0 = s1 + e1;
                          y1[4 * g + 3] = 0.f; y1[4 * g + 2] = s2; y1[4 * g + 1] = s1; y1[4 * g] = s0; gs1[g] = s0 + e0; }
                    }
                    float run = R;
#pragma unroll
                    for (int half = 1; half >= 0; --half)
#pragma unroll
                        for (int g = 3; g >= 0; --g) {
                            const float mine = half ? gs1[g] : gs0[g];
                            auto rr = __builtin_amdgcn_permlane32_swap(__float_as_uint(mine), __float_as_uint(mine), false, false);
                            const float g_lo = __uint_as_float(rr[0]), g_hi = __uint_as_float(rr[1]);
                            const float off_hi = run; run += g_hi; const float off_lo = run; run += g_lo;
                            const float off = hi ? off_hi : off_lo;
#pragma unroll
                            for (int i = 0; i < 4; ++i) {
                                if (half) y1[4 * g + i] = fexp2(lb1[4 * g + i] + y1[4 * g + i] + off);
                                else y0[4 * g + i] = fexp2(lb0[4 * g + i] + y0[4 * g + i] + off);
                            }
                        }
                    R = run;
                    pv_tile(o, cur + voff, y0, y1);
                }
            }
        }
        if (TY == 1) { const int dn = __all(R <= -40.f) ? 1 : 0; if (lane == 0) flags[(it & 1) * 8 + wid] = dn; }
        if (more) { stage_write(st, oth, tid); if (TY == 2 && tid < 64) *(LAS float*)(oth + KT_BYTES + VT_BYTES + tid * 4) = kbv; }
        if (it + 2 < cntT) { stage_load(st, Kg, Vg, j - 2, tid); if (TY == 2 && tid < 64) kbv = dcref - dc2[64 * (j - 2) + tid]; }
        __syncthreads();
    }

    bf16_t* MIX = (bf16_t*)(p->ws + WS_MIX);
    float inv = 1.f;
    if (TY != 1) {
        float lt = swap_sum(lsum);
        if (part == 1) {
            __hip_atomic_store(pay, ((unsigned long long)__float_as_uint(lt) << 32) | __float_as_uint(m), __ATOMIC_RELAXED, __HIP_MEMORY_SCOPE_AGENT);
#pragma unroll
            for (int d0 = 0; d0 < 4; ++d0)
#pragma unroll
                for (int g = 0; g < 4; ++g)
                    __hip_atomic_store(pay + (1 + d0 * 4 + g) * 64, ((unsigned long long)cvtpk(o[d0][4 * g + 2], o[d0][4 * g + 3]) << 32) | cvtpk(o[d0][4 * g], o[d0][4 * g + 1]), __ATOMIC_RELAXED, __HIP_MEMORY_SCOPE_AGENT);
            asm volatile("s_waitcnt vmcnt(0)" ::: "memory");
            __syncthreads();
            if (tid == 0) __hip_atomic_store(aflag, 1u, __ATOMIC_RELAXED, __HIP_MEMORY_SCOPE_AGENT);
            __syncthreads();
            return;
        }
        if (split) {
            if (tid == 0) { unsigned sp = 0; while (__hip_atomic_load(aflag, __ATOMIC_RELAXED, __HIP_MEMORY_SCOPE_AGENT) == 0u && ++sp < (1u << 22)) __builtin_amdgcn_s_sleep(2);
                __builtin_amdgcn_fence(__ATOMIC_ACQUIRE, "agent"); asm volatile("s_waitcnt vmcnt(0)" ::: "memory"); }
            __syncthreads();
            const unsigned long long ml = __hip_atomic_load(pay, __ATOMIC_RELAXED, __HIP_MEMORY_SCOPE_AGENT);
            const float mf = __uint_as_float((unsigned)ml), lf = __uint_as_float((unsigned)(ml >> 32));
            const float mn = fmaxf(m, mf), a0 = fexp2(m - mn), a1 = fexp2(mf - mn);
            lt = a0 * lt + a1 * lf;
#pragma unroll
            for (int d0 = 0; d0 < 4; ++d0)
#pragma unroll
                for (int g = 0; g < 4; ++g) {
                    const unsigned long long w = __hip_atomic_load(pay + (1 + d0 * 4 + g) * 64, __ATOMIC_RELAXED, __HIP_MEMORY_SCOPE_AGENT);
                    const unsigned w0 = (unsigned)w, w1 = (unsigned)(w >> 32);
                    o[d0][4 * g] = a0 * o[d0][4 * g] + a1 * bf_lo(w0); o[d0][4 * g + 1] = a0 * o[d0][4 * g + 1] + a1 * bf_hi(w0);
                    o[d0][4 * g + 2] = a0 * o[d0][4 * g + 2] + a1 * bf_lo(w1); o[d0][4 * g + 3] = a0 * o[d0][4 * g + 3] + a1 * bf_hi(w1);
                }
        }
        inv = 1.f / lt;
    }
    float post = 1.f; const float* gain;
    if (TY == 0) {
        const float lam = ((const float*)(p->ws + WS_LAM))[l];
        LAS float* X = (LAS float*)lds + (size_t)rg * 128 * 32;
        if (br == 1) {
            const float sc = inv * lam;
#pragma unroll
            for (int d0 = 0; d0 < 4; ++d0)
#pragma unroll
                for (int r = 0; r < 16; ++r) X[(32 * d0 + KIDX(r) + 4 * hi) * 32 + r32] = o[d0][r] * sc;
        }
        __syncthreads();
        if (br == 0) {
#pragma unroll
            for (int d0 = 0; d0 < 4; ++d0)
#pragma unroll
                for (int r = 0; r < 16; ++r) o[d0][r] = o[d0][r] * inv - X[(32 * d0 + KIDX(r) + 4 * hi) * 32 + r32];
        }
        inv = 1.f;
        post = 1.f - (0.8f - 0.6f * fexp2(-0.3f * LOG2E * (float)l));
        gain = p->subln_diff + l * HD;
    } else if (TY == 1) gain = p->onorm_sb + l * HD;
    else gain = p->onorm_fox + l * HD;
    if (TY != 0 || br == 0) {
        float ss = 0.f;
#pragma unroll
        for (int d0 = 0; d0 < 4; ++d0)
#pragma unroll
            for (int r = 0; r < 16; ++r) { const float v = o[d0][r] * inv; ss += v * v; }
        ss = swap_sum(ss);
        const float sc = inv * post * __builtin_amdgcn_rsqf(ss * (1.f / HD) + EPS);
        bf16_t* orow = MIX + (size_t)trow * DM + hv * HD + 4 * hi;
#pragma unroll
        for (int d0 = 0; d0 < 4; ++d0)
#pragma unroll
            for (int g = 0; g < 4; ++g) {
                const f32x4 g4 = *(const f32x4*)(gain + 32 * d0 + 8 * g + 4 * hi);
                u32x2 w; w[0] = cvtpk(o[d0][4 * g] * sc * g4[0], o[d0][4 * g + 1] * sc * g4[1]); w[1] = cvtpk(o[d0][4 * g + 2] * sc * g4[2], o[d0][4 * g + 3] * sc * g4[3]);
                *(u32x2*)(orow + 32 * d0 + 8 * g) = w;
            }
    }
    __syncthreads();
}

constexpr int N_FAR = 5 * 24 + 2 * 48;
constexpr int N_ITEMS = N_FAR + 32 * 22;
__device__ __forceinline__ void attention_phase(KArgs p, int l, LAS unsigned char* lds, volatile LAS unsigned* itemw, int wv, int qi, int tmask = 7) {
    unsigned* q = (unsigned*)(p->ws + WS_CTL) + CW_ATTQ + qi * 64;
    for (;;) {
        if (otid(wv) == 0) *itemw = __hip_atomic_fetch_add(q, 1u, __ATOMIC_RELAXED, __HIP_MEMORY_SCOPE_AGENT);
        __syncthreads();
        int item = (int)*itemw;
        __syncthreads();
        if (item >= N_ITEMS) break;
        if (item < N_FAR) {
            if (item < 120) { if (tmask & 1) att_item<2>(p, l, item % 5, 31 - item / 5, lds, wv, 1); }
            else { const int i2 = item - 120; if (tmask & 2) att_item<0>(p, l, 5 - (i2 & 1), 63 - (i2 >> 1), lds, wv, 1); }
            continue;
        }
        item -= N_FAR;
        if (item < 288) { const int w = item % 9, pp = 31 - item / 9;
            if (w < 5) { if (tmask & 1) att_item<2>(p, l, w, pp, lds, wv); }
            else if (tmask & 2) att_item<0>(p, l, 5 - ((w - 5) >> 1), 2 * pp + 1 - ((w - 5) & 1), lds, wv); }
        else if (item < 544) { const int it2 = item - 288, w = it2 % 8, pp = 31 - it2 / 8;
            if (tmask & 2) att_item<0>(p, l, 3 - (w >> 1), 2 * pp + 1 - (w & 1), lds, wv); }
        else if (tmask & 4) { const int it3 = item - 544; att_item<1>(p, l, it3 % 5, 31 - it3 / 5, lds, wv); }
    }
}
}

__device__ __forceinline__ void phase_route(KArgs p, int l, LAS unsigned char* lds, int wv, int ci, bool waitp = true) {
    const int tid = otid(wv), lane = tid & 63, wave = tid >> 6;
    LAS float* wrt = (LAS float*)lds;
    LAS int* bsel = (LAS int*)(lds + 16 * DM * 4);
    LAS float* bsc = (LAS float*)(bsel + 64);
    LAS float* bgate = bsc + 64;
    LAS float* brs = bgate + 64;
    { const f32x4* src = (const f32x4*)(p->ws + WS_WRT); for (int i = tid; i < 16 * DM / 4; i += 512) ((LAS f32x4*)wrt)[i] = src[i]; }
    __syncthreads();
    bf16_t* XN = (bf16_t*)(p->ws + WS_XN);
    for (int blk = blockIdx.x; blk < SEQ / 32; blk += gridDim.x) {
        const int tid = otid(wv), lane = tid & 63, wave = tid >> 6;
        if (waitp) { if (wave == 0) {
            const unsigned* wc = (const unsigned*)(p->ws + WS_CTL) + CW_WOC + l * 32 * 64 + 64 * (blk >> 3);
            unsigned sp = 0;
            while ((unsigned)__builtin_amdgcn_readfirstlane((int)__hip_atomic_load(wc, __ATOMIC_RELAXED, __HIP_MEMORY_SCOPE_AGENT)) < 64u && ++sp < (1u << 22)) __builtin_amdgcn_s_sleep(2);
            __builtin_amdgcn_fence(__ATOMIC_ACQUIRE, "agent");
            asm volatile("s_waitcnt vmcnt(0)" ::: "memory");
            } __syncthreads(); }
        const int tb = blk * 32 + wave * 4;
        f32x4 hx[4][8];
#pragma unroll
        for (int i = 0; i < 4; ++i) { const u32x2* xr = (const u32x2*)((const bf16_t*)(p->ws + WS_OUTB) + (size_t)(tb + i) * DM) + lane;
#pragma unroll
            for (int j = 0; j < 8; ++j) { const u32x2 a = xr[64 * j]; hx[i][j] = (f32x4){bf_lo(a[0]), bf_hi(a[0]), bf_lo(a[1]), bf_hi(a[1])}; } }
#pragma unroll
        for (int i = 0; i < 4; ++i) {
            float ss = 0.f;
#pragma unroll
            for (int j = 0; j < 8; ++j) ss += (hx[i][j][0] * hx[i][j][0] + hx[i][j][1] * hx[i][j][1]) + (hx[i][j][2] * hx[i][j][2] + hx[i][j][3] * hx[i][j][3]);
            const float rstd = __builtin_amdgcn_rsqf(wave_sum(ss) * (1.f / DM) + EPS);
            if (lane == 0) brs[wave * 4 + i] = rstd;
            const f32x4* gr = (const f32x4*)(p->ffn_norm + (size_t)l * DM) + lane;
#pragma unroll
            for (int j = 0; j < 8; ++j) hx[i][j] = hx[i][j] * rstd * gr[64 * j];
        }
#pragma unroll
        for (int h2 = 0; h2 < 2; ++h2) {
            f32x4 (&hn)[2][8] = *reinterpret_cast<f32x4 (*)[2][8]>(&hx[2 * h2]);
            asm volatile("" ::: "memory"); __builtin_amdgcn_sched_barrier(0);
            float acc[32];
#pragma unroll
            for (int k = 0; k < 32; ++k) acc[k] = 0.f;
#pragma unroll
            for (int j = 0; j < 8; ++j)
#pragma unroll
                for (int eh = 0; eh < 2; ++eh) {
#pragma unroll
                    for (int e = 8 * eh; e < 8 * eh + 8; ++e) { const f32x4 w4 = *(const LAS f32x4*)(wrt + e * DM + 4 * lane + 256 * j);
#pragma unroll
                        for (int i = 0; i < 2; ++i) acc[i * 16 + e] += (hn[i][j][0] * w4[0] + hn[i][j][1] * w4[1]) + (hn[i][j][2] * w4[2] + hn[i][j][3] * w4[3]); }
                    __builtin_amdgcn_sched_barrier(0);
                }
#pragma unroll
            for (int k = 0; k < 32; ++k) acc[k] = sum_xor32(acc[k]);
#define RSTEP(H) { const bool up = (lane & H) != 0; _Pragma("unroll") for (int k = 0; k < H; ++k) { const float a = acc[k], b = acc[k + H]; const float give = up ? a : b, keep = up ? b : a; acc[k] = keep + swz_xor<H>(give); } }
            RSTEP(16) RSTEP(8) RSTEP(4) RSTEP(2) RSTEP(1)
#undef RSTEP
            const float logit = acc[0];
            const float score = __builtin_amdgcn_rcpf(1.f + fexp2(-logit * LOG2E));
            const float sel = score + p->router_bias[lane & 15];
            const float v1 = swz_xor<1>(sel), v2 = swz_xor<2>(sel), v3 = swz_xor<3>(sel);
            const float a = fmaxf(sel, v1), b = fminf(sel, v1), c = fmaxf(v2, v3), d = fminf(v2, v3);
            const float gs = fmaxf(a, c) + fmaxf(fminf(a, c), fmaxf(b, d));
            const float g1 = swz_xor<4>(gs), g2 = swz_xor<8>(gs), g3 = swz_xor<12>(gs);
            const int myg = (lane >> 2) & 3, k = lane & 3;
            const bool best = (gs > g1 || (gs == g1 && myg < (myg ^ 1))) && (gs > g2 || (gs == g2 && myg < (myg ^ 2))) && (gs > g3 || (gs == g3 && myg < (myg ^ 3)));
            const int rank = ((v1 > sel || (v1 == sel && (k ^ 1) < k)) ? 1 : 0) + ((v2 > sel || (v2 == sel && (k ^ 2) < k)) ? 1 : 0) + ((v3 > sel || (v3 == sel && (k ^ 3) < k)) ? 1 : 0);
            if (best && rank < 2 && lane < 32) { const int row = wave * 4 + h2 * 2 + (lane >> 4); bsel[row * 2 + rank] = lane & 15; bsc[row * 2 + rank] = score; }
        }
        asm volatile("s_waitcnt lgkmcnt(0)" ::: "memory");
        if (lane < 8) { const int idx = wave * 8 + lane; const float sm = bsc[idx], so = bsc[idx ^ 1]; bgate[idx] = sm / (sm + so); }
        __syncthreads();
        if (wave == 0) {
            unsigned* cnt = (unsigned*)(p->ws + WS_CTL) + CW_CNT + ci * 16 * 64;
            const int mye = bsel[lane]; int myrank = 0, n = 0;
            const unsigned long long below = (1ull << lane) - 1ull;
#pragma unroll
            for (int e = 0; e < 16; ++e) { const unsigned long long mk = __ballot(mye == e); if (mye == e) myrank = (int)__popcll(mk & below); if (lane == e) n = (int)__popcll(mk); }
            int base = 0;
            if (lane < 16 && n) base = (int)__hip_atomic_fetch_add(cnt + lane * 64, (unsigned)n, __ATOMIC_RELAXED, __HIP_MEMORY_SCOPE_AGENT);
            const int pos = __builtin_amdgcn_ds_bpermute(mye << 2, base) + myrank, tok = blk * 32 + (lane >> 1);
            ((int*)(p->ws + WS_TOK))[mye * SEQ + pos] = tok; ((f32x2_t*)(p->ws + WS_GATE))[mye * SEQ + pos] = (f32x2_t){bgate[lane], brs[lane >> 1]};
            int* ts = (int*)(p->ws + WS_TSEL) + tok * 4 + (lane & 1) * 2; ts[0] = mye; ts[1] = pos;
        }
        __syncthreads();
    }
}

__device__ __forceinline__ void moe_table(KArgs p, int l, LAS int* tbl, int wv) {
    if (otid(wv) == 0) { const unsigned* cnt = (const unsigned*)(p->ws + WS_CTL) + CW_CNT + l * 16 * 64; int acc = 0;
        for (int e = 0; e < 16; ++e) { const int n = (int)cnt[e * 64]; tbl[e] = acc; tbl[17 + e] = n; acc += (n + 255) >> 8; } tbl[16] = acc; }
    __syncthreads();
}

constexpr int N_PHASES = 2 + 7 * DEPTH;
__device__ __forceinline__ int opq(int v) { asm volatile("" : "+s"(v)); return v; }
__device__ __forceinline__ LAS unsigned char* opq(LAS unsigned char* v) { unsigned x = (unsigned)(uintptr_t)v; asm volatile("" : "+s"(x)); return (LAS unsigned char*)(uintptr_t)x; }
__global__ void __launch_bounds__(512, 2) trunk_fwd(Params pk) {
    extern __shared__ __attribute__((aligned(16))) unsigned char lds_raw[];
    LAS unsigned char* lds = (LAS unsigned char*)lds_raw;
    volatile LAS unsigned* MISC = (volatile LAS unsigned*)(lds + MISC_OFF);
    LAS int* mtbl = (LAS int*)(lds + MISC_OFF + 256);
#define p kparams()
    const int wv = __builtin_amdgcn_readfirstlane((int)threadIdx.x >> 6);
    for (int u = threadIdx.x; u < (LDS_BYTES - MISC_OFF) / 4; u += 512) ((LAS unsigned*)(lds + MISC_OFF))[u] = 0u;
    __syncthreads();
    unsigned* ctl = (unsigned*)(p->ws + WS_CTL);
    XcdBarrier bar; bar.bar = ctl + CW_BAR; bar.x = 0; bar.st = nullptr; bar.wv = wv;
    const bool multi = (p->ph_hi - p->ph_lo) > 1;
    if (multi) bar = xcd_barrier_post(ctl + CW_BAR, MISC + 8, wv);
    const int lo = p->ph_lo, hi = p->ph_hi;
#define IN(k) (lo <= (k) && (k) < hi)
#define SEAM(k) do { if (IN(k) && IN((k) + 1)) xcd_barrier(bar); } while (0)
    const int G0 = gridDim.x, c0 = blockIdx.x; LAS unsigned char* const lds0 = lds;
#define PHASE_LOCALS const int G = opq(G0), c = opq(c0); LAS unsigned char* const lds = opq(lds0); LAS int* const mtbl = (LAS int*)(lds + MISC_OFF + 256); volatile LAS unsigned* const MISC = (volatile LAS unsigned*)(lds + MISC_OFF); (void)G; (void)c; (void)mtbl; (void)MISC;

    if (PK(0) && IN(0)) { PHASE_LOCALS phase_prologue(p, lds, wv); if (DUP_PHASE == 0) { __syncthreads(); phase_prologue(p, lds, wv); } SEAM(0); }
    for (int l = 0; l < DEPTH; ++l) {
        const int pb = 1 + 7 * l;
        if (PK(1) && IN(pb + 0)) { PHASE_LOCALS phase_norm1(p, l, lds, wv); if (DUP_PHASE == 1) { xcd_barrier(bar); phase_norm1(p, l, lds, wv, true); } SEAM(pb + 0); }
        if (PK(2) && IN(pb + 1)) { PHASE_LOCALS
            if (c < H_FOX) scan_head(p, c, l, lds, wv);
            for (int rep = 0; rep < (DUP_PHASE == 2 ? 2 : 1); ++rep) {
            { pg8::Gemm g{(const bf16_t*)(p->ws + WS_OUTB), (const bf16_t*)(p->ws + WS_WQK) + (size_t)l * NQK * DM, SEQ, NQK, DM};
              pg8::StaticOrder S; S.init(SEQ, NQK, G, c);
              pg8::EpiQK E{(bf16_t*)(p->ws + WS_QKB), p->qnorm_diff + l * 64, p->knorm_diff + l * 64, p->qnorm_fox + l * 128, p->knorm_fox + l * 128, (LAS float*)(lds + TBL_OFF), (const float*)(p->ws + WS_RSTD)};
              pg8::gemm_phase<pg8::EpiQK, pg8::StaticOrder>(lds, g, S, E, wv); }
            { pg8::Gemm g{(const bf16_t*)(p->ws + WS_WV) + (size_t)l * NV * DM, (const bf16_t*)(p->ws + WS_OUTB), NV, SEQ, DM};
              pg8::StaticOrder S; S.init(NV, SEQ, G, c);
              pg8::EpiVT E{(bf16_t*)(p->ws + WS_VT), SEQ, (const float*)(p->ws + WS_RSTD)};
              pg8::gemm_phase<pg8::EpiVT, pg8::StaticOrder>(lds, g, S, E, wv); }
            }
            SEAM(pb + 1);
        }
        if (PK(3) && IN(pb + 2)) { PHASE_LOCALS att::attention_phase(p, l, lds, MISC + 16, wv, l); if (DUP_PHASE == 3) { __syncthreads(); att::attention_phase(p, l, lds, MISC + 16, wv, l + 4, ATT_MASK2); } SEAM(pb + 2); }
        if (PK(4) && IN(pb + 3)) { PHASE_LOCALS
            pg8::Gemm g{(const bf16_t*)(p->ws + WS_MIX), (const bf16_t*)(p->ws + WS_WO) + (size_t)l * DM * DM, SEQ, DM, DM};
            pg8::StaticOrder S; S.init(SEQ, DM, G, c);
            pg8::EpiResAdd E{(bf16_t*)(p->ws + WS_OUTB), 1.f, (unsigned*)(p->ws + WS_CTL) + CW_WOC + l * 32 * 64, p->ws + WS_OUTB8};
            pg8::gemm_phase<pg8::EpiResAdd, pg8::StaticOrder>(lds, g, S, E, wv);
        }
        if (PK(5) && IN(pb + 4)) { PHASE_LOCALS phase_route(p, l, lds, wv, l); if (DUP_PHASE == 5) { xcd_barrier(bar); phase_route(p, l, lds, wv, l + 4); } SEAM(pb + 4); }
        if (PK(6) && IN(pb + 5)) { PHASE_LOCALS
            moe_table(p, l, mtbl, wv);
            pg8::Gemm g{(const bf16_t*)(p->ws + WS_OUTB8), (const bf16_t*)(p->ws + WS_WGU + (size_t)l * NEXP * 1024 * DM), MOE_ROWS, NEXP * 1024, DM / 2};
            pg8::MoeOrder<4, true> S{mtbl, (const int*)(p->ws + WS_TOK), G, c, DM / 2};
            pg8::EpiGU E{p->ws + WS_ACT, (const float*)(p->ws + WS_GATE), mtbl, (unsigned*)(p->ws + WS_CTL) + CW_GUC + l * 80 * 64};
            for (int rep = 0; rep < (DUP_PHASE == 6 ? 2 : 1); ++rep)
            pg8::gemm_phase<pg8::EpiGU, pg8::MoeOrder<4, true>>(lds, g, S, E, wv);
        }
        if (PK(7) && IN(pb + 6)) { PHASE_LOCALS
            moe_table(p, l, mtbl, wv);
            pg8::Gemm g{(const bf16_t*)(p->ws + WS_ACT), (const bf16_t*)(p->ws + WS_WD + (size_t)l * NEXP * DM * FEXP), MOE_ROWS, NEXP * DM, FEXP / 2};
            pg8::DownOrder S{mtbl, (unsigned*)(p->ws + WS_CTL) + CW_GUC + l * 80 * 64, (unsigned*)(p->ws + WS_CTL) + CW_BAR + XB_TMO, G, c};
            pg8::EpiDown E{(bf16_t*)(p->ws + WS_Y)};
            pg8::gemm_phase<pg8::EpiDown, pg8::DownOrder>(lds, g, S, E, wv);
            SEAM(pb + 6);
        }
    }
    if (PK(1) && IN(N_PHASES - 1)) { PHASE_LOCALS phase_norm1(p, DEPTH, lds, wv); }
#undef IN
#undef SEAM
#undef PHASE_LOCALS
#undef p
}

extern "C" void kernel_launch(void* const* d_in, const int* in_sizes, int n_in, void* d_out, int out_size, void* d_ws, size_t ws_size, hipStream_t stream) {
    static int grid = 0;
    if (grid == 0) {
        if (n_in != 22 || in_sizes[0] != SEQ * DM || out_size != SEQ * DM || ws_size < WS_END) {
            fprintf(stderr, "kernel_launch: unexpected shapes (n_in %d, in0 %d, out %d, ws %zu < %zu); nothing launched\n", n_in, n_in > 0 ? in_sizes[0] : -1, out_size, ws_size, (size_t)WS_END); grid = -1; return; }
        int dev = 0, cus = 0, per_cu = 0;
        if (hipGetDevice(&dev) != hipSuccess || hipDeviceGetAttribute(&cus, hipDeviceAttributeMultiprocessorCount, dev) != hipSuccess) { grid = -1; return; }
        if (hipFuncSetAttribute((const void*)trunk_fwd, hipFuncAttributeMaxDynamicSharedMemorySize, LDS_BYTES) != hipSuccess) { fprintf(stderr, "kernel_launch: hipFuncSetAttribute failed\n"); grid = -1; return; }
        if (hipOccupancyMaxActiveBlocksPerMultiprocessor(&per_cu, (const void*)trunk_fwd, 512, LDS_BYTES) != hipSuccess || per_cu < 1)
            fprintf(stderr, "kernel_launch: note: occupancy query reports %d workgroups per CU\n", per_cu);
        (void)hipGetLastError();
        grid = cus;
    }
    if (grid < 0) return;
    if (hipMemsetAsync((char*)d_ws + WS_CTL, 0, CTL_ZERO_BYTES, stream) != hipSuccess) { fprintf(stderr, "kernel_launch: memset failed\n"); return; }
    Params hp{};
    const float** pp = (const float**)&hp;
    for (int i = 0; i < 22; ++i) pp[i] = (const float*)d_in[i];
    hp.out = (float*)d_out; hp.ws = (unsigned char*)d_ws;
#if MK_ONE_LAUNCH
    hp.ph_lo = 0; hp.ph_hi = N_PHASES;
    hipLaunchKernelGGL(trunk_fwd, dim3(grid), dim3(512), LDS_BYTES, stream, hp);
#else
    for (int ph = 0; ph < N_PHASES; ++ph) { hp.ph_lo = ph; hp.ph_hi = ph + 1; hipLaunchKernelGGL(trunk_fwd, dim3(grid), dim3(512), LDS_BYTES, stream, hp); }
#endif
    const hipError_t le = hipPeekAtLastError();
    if (le != hipSuccess) fprintf(stderr, "kernel_launch: launch failed: %s\n", hipGetErrorName(le));
}
```

```cpp
#include <hip/hip_runtime.h>
#include <cstdio>
#include <cstdint>

#ifndef MK_ONE_LAUNCH
#define MK_ONE_LAUNCH 1
#endif
#ifndef PHASE_MASK
#define PHASE_MASK 0xff
#endif
#define PK(k) (((PHASE_MASK) >> (k)) & 1)
#ifndef FP8_PROJ
#define FP8_PROJ 1
#endif
#ifndef DUP_PHASE
#define DUP_PHASE -1
#endif
#ifndef ATT_MASK2
#define ATT_MASK2 7
#endif
#ifndef SKIP_A
#define SKIP_A 1
#endif
#ifndef SKIP_B
#define SKIP_B 3
#endif
#ifndef SKIP_C
#define SKIP_C 1
#endif

#define GAS __attribute__((address_space(1)))
#define LAS __attribute__((address_space(3)))
typedef unsigned short bf16_t;
typedef short bf16x8 __attribute__((ext_vector_type(8)));
typedef float f32x4 __attribute__((ext_vector_type(4)));
typedef float f32x16 __attribute__((ext_vector_type(16)));
typedef unsigned u32x4 __attribute__((ext_vector_type(4)));
typedef unsigned u32x2 __attribute__((ext_vector_type(2)));
typedef int i32x4 __attribute__((ext_vector_type(4)));

constexpr int SEQ = 8192, DM = 2048, DEPTH = 4, NQK = 4096, NV = 2048, NEXP = 16, FEXP = 512, NIN = 6149;
constexpr int HD = 128, H_DIFF = 6, H_SB = 5, H_FOX = 5;
constexpr float EPS = 1e-6f;
constexpr float LOG2E = 1.4426950408889634f;
constexpr int MOE_ROWS = 16384 + 16 * 256;

constexpr size_t MiB = 1u << 20;
constexpr size_t WS_CTL = 0, CTL_ZERO_BYTES = 1 * MiB;
constexpr size_t WS_WF = 1 * MiB;
constexpr size_t WS_LAM = 1 * MiB + 512 * 1024;
constexpr size_t WS_LOGF = 2 * MiB;
constexpr size_t WS_DC2 = 3 * MiB;
constexpr size_t WS_TOK = 4 * MiB;
constexpr size_t WS_GATE = 5 * MiB;
constexpr size_t WS_TSEL = 6 * MiB;
constexpr size_t WS_WRT = 7 * MiB;
constexpr size_t WS_RSTD = 8 * MiB;
constexpr size_t WS_WQK = 16 * MiB;
constexpr size_t WS_WV = 80 * MiB;
constexpr size_t WS_WO = 112 * MiB;
constexpr size_t WS_WGU = 144 * MiB;
constexpr size_t WS_WD = 400 * MiB;
constexpr size_t WS_XN = 528 * MiB;
constexpr size_t WS_QKB = 560 * MiB;
constexpr size_t WS_VT = 624 * MiB;
constexpr size_t WS_MIX = 656 * MiB;
constexpr size_t WS_ACT = 688 * MiB;
constexpr size_t WS_Y = 708 * MiB;
constexpr size_t WS_PART = 788 * MiB;
constexpr size_t WS_OUTB = 828 * MiB;
constexpr size_t WS_OUTB8 = 862 * MiB;
constexpr size_t WS_END = 878 * MiB;
constexpr int CW_BAR = 4096;
constexpr int CW_ATTQ = 16384;
constexpr int CW_CNT = 32768;
constexpr int CW_AFLAG = 65536;
constexpr int CW_WOC = 233472;
constexpr int CW_GUC = 212992;

constexpr int RING_BYTES = 131072;
constexpr int TBL_OFF = RING_BYTES;
constexpr int MISC_OFF = RING_BYTES + 8192;
constexpr int LDS_BYTES = 147456;

typedef float f32x2_t __attribute__((ext_vector_type(2)));
typedef __bf16 bf16x2_t __attribute__((ext_vector_type(2)));
typedef int i32x8 __attribute__((ext_vector_type(8)));
__device__ __forceinline__ unsigned cvt4f8(float a, float b, float c, float d) {
    int w = 0; w = __builtin_amdgcn_cvt_pk_fp8_f32(a, b, w, false); w = __builtin_amdgcn_cvt_pk_fp8_f32(c, d, w, true); return (unsigned)w; }
constexpr float W8_SCALE = 256.f, ACT8_SCALE = 4.f;
__device__ __forceinline__ unsigned cvtpk(float lo, float hi) { const f32x2_t v = {lo, hi}; const bf16x2_t b = __builtin_convertvector(v, bf16x2_t); return __builtin_bit_cast(unsigned, b); }
__device__ __forceinline__ float bf_lo(unsigned u) { return __uint_as_float(u << 16); }
__device__ __forceinline__ float bf_hi(unsigned u) { return __uint_as_float(u & 0xffff0000u); }
__device__ __forceinline__ float fexp2(float x) { return __builtin_amdgcn_exp2f(x); }
__device__ __forceinline__ float flog2(float x) { return __builtin_amdgcn_logf(x); }
__device__ __forceinline__ int otid(int wv) { int t; asm volatile("v_mbcnt_lo_u32_b32 %0, -1, 0\n\tv_mbcnt_hi_u32_b32 %0, -1, %0" : "=v"(t)); return wv * 64 + t; }
template <int M> __device__ __forceinline__ float swz_xor(float v) { return __int_as_float(__builtin_amdgcn_ds_swizzle(__float_as_int(v), 0x1F | (M << 10))); }
__device__ __forceinline__ float sum_xor32(float v) { auto rr = __builtin_amdgcn_permlane32_swap(__float_as_uint(v), __float_as_uint(v), false, false); return __uint_as_float(rr[0]) + __uint_as_float(rr[1]); }
__device__ __forceinline__ float wave_sum(float v) {
    v += swz_xor<1>(v); v += swz_xor<2>(v); v += swz_xor<4>(v); v += swz_xor<8>(v); v += swz_xor<16>(v);
    return sum_xor32(v);
}

namespace pg8 {
constexpr int BM = 256, BK = 64, HALF = 128, HTB = HALF * BK * 2, STAGE_BYTES = 8 * HTB, NXCD = 8, WGM = 8;
__host__ __device__ __forceinline__ int lds_byte(int r, int c) { const int st = (r >> 4) * 2 + (c >> 5), rr = r & 15, cc = c & 31, ob = rr * 64 + cc * 2; return st * 1024 + (ob ^ (((ob >> 9) & 1) << 5)); }
__host__ __device__ __forceinline__ void stage_rc(int b, int& R, int& C) { const int st = b / 1024, sb = b % 1024, swz = sb ^ (((sb >> 9) & 1) << 5); R = (st >> 1) * 16 + swz / 64; C = (st & 1) * 32 + (swz % 64) / 2; }
__host__ __device__ __forceinline__ int perm32(int rho) { const int n = rho >> 4, i = rho & 15; return 8 * (i >> 2) + 4 * n + (i & 3); }
__host__ __device__ __forceinline__ int permV(int rho) { const int n = rho >> 4, i = rho & 15; return 16 * (i >> 3) + 8 * n + (i & 7); }
template <int P> __host__ __device__ __forceinline__ int permf(int rho) { return P == 1 ? perm32(rho) : (P == 2 ? permV(rho) : rho); }

struct Unit { int pm, pn, e, rt; };
struct Gemm { const bf16_t* A; const bf16_t* Bt; int M, N, K; };

struct StaticOrder {
    int nM, nN, nwg, G, c;
    __device__ void init(int M, int N, int G_, int c_) { nM = M / BM; nN = N / BM; nwg = nM * nN; G = G_; c = c_; }
    __device__ bool next(int i, Unit& u) const {
        const long L = (long)i * G + c; if (L >= nwg) return false;
        int wgid = (int)L; { const int q = nwg / NXCD, r = nwg % NXCD, xcd = wgid % NXCD, off = wgid / NXCD; wgid = (xcd < r ? xcd * (q + 1) : r * (q + 1) + (xcd - r) * q) + off; }
        const int nig = WGM * nN, gid = wgid / nig, fm = gid * WGM, gsz = (nM - fm) < WGM ? (nM - fm) : WGM;
        u.pm = fm + ((wgid % nig) % gsz); u.pn = (wgid % nig) / gsz; u.e = 0; u.rt = 0; return true;
    }
    __device__ __forceinline__ size_t a_base(const Unit& u, size_t tstep) const { return (size_t)u.pm * tstep; }
    __device__ __forceinline__ unsigned row_off(const Unit&, int r, int K) const { return (unsigned)(r * K) * 2u; }
    __device__ __forceinline__ void a_ready(const Unit&, int) const {}
};

template <int NCT, bool GATHER> struct MoeOrder {
    const LAS int* tbl; const int* tok; int G, c, K;
    __device__ bool next(int i, Unit& u) const {
        const int L = i * G + c, total = __builtin_amdgcn_readfirstlane(tbl[16]) * NCT; if (L >= total) return false;
        const int g = L / NCT, ct = L % NCT; int e = 0;
#pragma unroll
        for (int k = 1; k < 16; ++k) e += (g >= tbl[k]) ? 1 : 0;
        e = __builtin_amdgcn_readfirstlane(e);
        u.pm = g; u.pn = e * NCT + ct; u.e = e; u.rt = __builtin_amdgcn_readfirstlane(g - tbl[e]); return true;
    }
    __device__ __forceinline__ size_t a_base(const Unit& u, size_t tstep) const { return GATHER ? 0 : (size_t)u.pm * tstep; }
    __device__ __forceinline__ unsigned row_off(const Unit& u, int r, int K_) const {
        if (!GATHER) return (unsigned)(r * K_) * 2u;
        const int pos = u.rt * 256 + r; const int n = __builtin_amdgcn_readfirstlane(tbl[17 + u.e]);
        const int t = pos < n ? tok[u.e * SEQ + pos] : 0;
        return (unsigned)(t * K_) * 2u;
    }
    __device__ __forceinline__ void a_ready(const Unit&, int) const {}
};

struct DownOrder {
    const LAS int* tbl; unsigned* cnt; unsigned* tmo; int G, c;
    __device__ bool next(int i, Unit& u) const {
        const int T = __builtin_amdgcn_readfirstlane(tbl[16]);
        const int U1 = 4 * T, nb2 = U1 > G ? U1 - G : 0, F = G - nb2;
        const int g1 = T < (G >> 2) ? T : (G >> 2), E = 8 * g1, Lt = 8 * (T - g1);
        int k = -1, late = 0;
        int ii = i;
        if (c >= nb2) { const int cf = c - nb2; const int nE = E > cf ? (E - cf + F - 1) / F : 0; if (ii < nE) k = cf + ii * F; else ii -= nE; }
        int g, ct;
        if (k >= 0) { g = k >> 3; ct = k & 7; }
        else { const int k0 = (c - nb2 + G) % G; const int kk = k0 + ii * G; if (kk >= Lt) return false; g = g1 + (kk >> 3); ct = kk & 7; late = 1; }
        (void)late;
        int e = 0;
#pragma unroll
        for (int q = 1; q < 16; ++q) e += (g >= tbl[q]) ? 1 : 0;
        e = __builtin_amdgcn_readfirstlane(e);
        u.pm = g; u.pn = e * 8 + ct; u.e = e; u.rt = __builtin_amdgcn_readfirstlane(g - tbl[e]); return true;
    }
    __device__ __forceinline__ size_t a_base(const Unit& u, size_t tstep) const { return (size_t)u.pm * tstep; }
    __device__ __forceinline__ unsigned row_off(const Unit&, int r, int K_) const { return (unsigned)(r * K_) * 2u; }
    __device__ __forceinline__ void a_ready(const Unit& u, int wid) const {
        if (wid == 0) {
            unsigned sp = 0;
            while ((unsigned)__builtin_amdgcn_readfirstlane((int)__hip_atomic_load(cnt + 64 * u.pm, __ATOMIC_RELAXED, __HIP_MEMORY_SCOPE_AGENT)) < 32u) {
                __builtin_amdgcn_s_sleep(2);
                if (++sp > (1u << 22)) { __hip_atomic_store(tmo, 1u, __ATOMIC_RELAXED, __HIP_MEMORY_SCOPE_AGENT); break; }
            }
            __builtin_amdgcn_fence(__ATOMIC_ACQUIRE, "agent");
            asm volatile("s_waitcnt vmcnt(0)" ::: "memory");
        }
        asm volatile("" ::: "memory"); __builtin_amdgcn_s_barrier(); asm volatile("" ::: "memory");
    }
};

template <class Epi, class Sched, bool SP2 = true>
__device__ __forceinline__ void gemm_phase(LAS unsigned char* lds, const Gemm g, const Sched& S, const Epi& E, int wv) {
    const int tid = otid(wv), wid = __builtin_amdgcn_readfirstlane(tid >> 6), lane = tid & 63, wr = wid >> 2, wc = wid & 3, fr = lane & 15, fq = lane >> 4;
    const int K = g.K, nt = K / BK;
    unsigned voffB[2]; int Rr[2], Cc[2];
#pragma unroll
    for (int i = 0; i < 2; ++i) { int R, C; stage_rc(tid * 16 + i * 8192, R, C); const int Rb = (R & ~31) + permf<Epi::PERM>(R & 31);
        Rr[i] = R; Cc[i] = C; voffB[i] = (unsigned)(Rb * K + C) * 2u; }
    const size_t kstep = (size_t)(BK * 2);
    const size_t hstep = (size_t)HALF * K * 2;
    const size_t tstep = 2 * hstep;
    const unsigned ldsw = (unsigned)wid * 1024u;
    const int aoff = lds_byte(wr * 64 + fr, fq * 8), boff = lds_byte(wc * 32 + fr, fq * 8);
#define PG8_SA(b, h) (((b) * 2 + (h)) * HTB)
#define PG8_SB(b, h) ((4 + (b) * 2 + (h)) * HTB)
#define PG8_STAGE(bufoff, gbase, voff) do { _Pragma("unroll") for (int _i = 0; _i < 2; ++_i) \
        __builtin_amdgcn_global_load_lds((const unsigned*)((const char*)(gbase) + (voff)[_i]), (LAS unsigned*)(lds + (bufoff) + ldsw + _i * 8192), 16, 0, 0); } while (0)
#define PG8_LDA(dst, b, h) do { _Pragma("unroll") for (int m = 0; m < 4; ++m) _Pragma("unroll") for (int k = 0; k < 2; ++k) dst[m][k] = *(const LAS bf16x8*)(lds + PG8_SA(b, h) + aoff + m * 2048 + k * 1024); } while (0)
#define PG8_LDB(dst, b, h) do { _Pragma("unroll") for (int n = 0; n < 2; ++n) _Pragma("unroll") for (int k = 0; k < 2; ++k) dst[n][k] = *(const LAS bf16x8*)(lds + PG8_SB(b, h) + boff + n * 2048 + k * 1024); } while (0)
#define PG8_CAT(x) __builtin_shufflevector(__builtin_bit_cast(i32x4, (x)[0]), __builtin_bit_cast(i32x4, (x)[1]), 0, 1, 2, 3, 4, 5, 6, 7)
#define PG8_MMA(ai, bj, At, Bt) do { __builtin_amdgcn_s_setprio(1); \
        if constexpr (Epi::FP8) { _Pragma("unroll") for (int m = 0; m < 4; ++m) _Pragma("unroll") for (int n = 0; n < 2; ++n) \
            asm volatile("v_mfma_scale_f32_16x16x128_f8f6f4 %0, %1, %2, %0, %3, %3 op_sel_hi:[0,0,0]" : "+v"(acc[ai][bj][m][n]) : "v"(PG8_CAT(Bt[n])), "v"(PG8_CAT(At[m])), "v"(one8)); } \
        else { _Pragma("unroll") for (int m = 0; m < 4; ++m) _Pragma("unroll") for (int n = 0; n < 2; ++n) _Pragma("unroll") for (int k = 0; k < 2; ++k) \
            acc[ai][bj][m][n] = __builtin_amdgcn_mfma_f32_16x16x32_bf16(Bt[n][k], At[m][k], acc[ai][bj][m][n], 0, 0, 0); } \
        __builtin_amdgcn_s_setprio(0); } while (0)
#define PG8_WAIT_V(n) asm volatile("s_waitcnt vmcnt(" #n ")" ::: "memory")
#define PG8_WAIT_L(n) asm volatile("s_waitcnt lgkmcnt(" #n ")" ::: "memory")
#define PG8_BAR __builtin_amdgcn_s_barrier()
#define PG8_SCHED __builtin_amdgcn_sched_barrier(0)
    Unit cur, nxt; int ui = 0;
    if (!S.next(0, cur)) return;
    const unsigned one8 = 0x7F7F7F7Fu;
    (void)one8;
    f32x4 acc[2][2][4][2];
    if constexpr (Epi::LOAD_INIT) E.init(acc, cur, wr, wc, fr, fq);
    else {
#pragma unroll
    for (int a = 0; a < 2; ++a)
#pragma unroll
        for (int b = 0; b < 2; ++b)
#pragma unroll
            for (int m = 0; m < 4; ++m)
#pragma unroll
                for (int n = 0; n < 2; ++n) acc[a][b][m][n] = (f32x4){0.f, 0.f, 0.f, 0.f};
    }
    bf16x8 At[4][2], B0[2][2], B1[2][2];
    unsigned oc[2][2], on[2][2];
#pragma unroll
    for (int h = 0; h < 2; ++h)
#pragma unroll
        for (int i = 0; i < 2; ++i) { oc[h][i] = S.row_off(cur, h * HALF + Rr[i], K) + (unsigned)Cc[i] * 2u; on[h][i] = oc[h][i]; }
    const char* cA = (const char*)g.A + S.a_base(cur, tstep); const char* cB = (const char*)g.Bt + (size_t)cur.pn * tstep;
    S.a_ready(cur, wid);
    if constexpr (SP2) {
        PG8_STAGE(PG8_SB(0, 0), cB, voffB); PG8_STAGE(PG8_SB(0, 1), cB + hstep, voffB); PG8_STAGE(PG8_SA(0, 0), cA, oc[0]); PG8_STAGE(PG8_SA(0, 1), cA, oc[1]);
        if (wr == 1) PG8_BAR;
        PG8_WAIT_V(2); PG8_BAR;
        PG8_STAGE(PG8_SB(1, 0), cB + kstep, voffB); PG8_STAGE(PG8_SA(1, 0), cA + kstep, oc[0]); PG8_STAGE(PG8_SB(1, 1), cB + hstep + kstep, voffB);
        PG8_WAIT_V(6); PG8_BAR;
    } else {
        PG8_STAGE(PG8_SB(0, 0), cB, voffB); PG8_STAGE(PG8_SA(0, 0), cA, oc[0]); PG8_STAGE(PG8_SB(0, 1), cB + hstep, voffB); PG8_STAGE(PG8_SA(0, 1), cA, oc[1]);
        if (wr == 1) PG8_BAR;
        PG8_WAIT_V(4); PG8_BAR;
        PG8_STAGE(PG8_SB(1, 0), cB + kstep, voffB); PG8_STAGE(PG8_SA(1, 0), cA + kstep, oc[0]); PG8_STAGE(PG8_SB(1, 1), cB + hstep + kstep, voffB);
        PG8_WAIT_V(6); PG8_BAR;
    }
    for (;;) {
        const bool has_next = S.next(ui + 1, nxt);
        const char* nA = has_next ? (const char*)g.A + S.a_base(nxt, tstep) : cA; const char* nB = has_next ? (const char*)g.Bt + (size_t)nxt.pn * tstep : cB;
        if (has_next) {
#pragma unroll
            for (int h = 0; h < 2; ++h)
#pragma unroll
                for (int i = 0; i < 2; ++i) on[h][i] = S.row_off(nxt, h * HALF + Rr[i], K) + (unsigned)Cc[i] * 2u;
        }
        for (int t = 0; t < nt; t += 2) {
            const bool last = (t == nt - 2);
            if (last && has_next) S.a_ready(nxt, wid);
            const char* a1 = cA + (size_t)(t + 1) * kstep;
            const char* a2 = last ? nA : cA + (size_t)(t + 2) * kstep; const char* b2 = last ? nB : cB + (size_t)(t + 2) * kstep;
            const char* a3 = a2 + kstep; const char* b3 = b2 + kstep;
            unsigned o2a[2], o2b[2];
            o2a[0] = last ? on[0][0] : oc[0][0]; o2a[1] = last ? on[0][1] : oc[0][1]; o2b[0] = last ? on[1][0] : oc[1][0]; o2b[1] = last ? on[1][1] : oc[1][1];
            if constexpr (SP2) {
            PG8_LDB(B0, 0, 0); PG8_LDB(B1, 0, 1); PG8_SCHED; PG8_LDA(At, 0, 0); PG8_STAGE(PG8_SA(1, 1), a1, oc[1]);
            PG8_WAIT_V(8); PG8_WAIT_L(0); PG8_BAR; PG8_MMA(0, 0, At, B0); PG8_MMA(0, 1, At, B1); PG8_BAR; PG8_SCHED;
            PG8_LDA(At, 0, 1); PG8_STAGE(PG8_SB(0, 0), b2, voffB); PG8_STAGE(PG8_SB(0, 1), b2 + hstep, voffB); PG8_STAGE(PG8_SA(0, 0), a2, o2a);
            PG8_WAIT_V(8); PG8_WAIT_L(0); PG8_BAR; PG8_MMA(1, 0, At, B0); PG8_MMA(1, 1, At, B1); PG8_BAR; PG8_SCHED;
            PG8_LDB(B0, 1, 0); PG8_LDB(B1, 1, 1); PG8_SCHED; PG8_LDA(At, 1, 0); PG8_STAGE(PG8_SA(0, 1), a2, o2b);
            PG8_WAIT_V(8); PG8_WAIT_L(0); PG8_BAR; PG8_MMA(0, 0, At, B0); PG8_MMA(0, 1, At, B1); PG8_BAR; PG8_SCHED;
            PG8_LDA(At, 1, 1); PG8_STAGE(PG8_SB(1, 0), b3, voffB); PG8_STAGE(PG8_SB(1, 1), b3 + hstep, voffB); PG8_STAGE(PG8_SA(1, 0), a3, o2a);
            PG8_WAIT_V(8); PG8_WAIT_L(0); PG8_BAR; PG8_MMA(1, 0, At, B0); PG8_MMA(1, 1, At, B1); PG8_BAR; PG8_SCHED;
            } else {
            PG8_LDB(B0, 0, 0); PG8_SCHED; PG8_LDA(At, 0, 0); PG8_STAGE(PG8_SA(1, 1), a1, oc[1]);
            PG8_WAIT_L(8); PG8_BAR; PG8_WAIT_L(0); PG8_MMA(0, 0, At, B0); PG8_BAR; PG8_SCHED;
            PG8_LDB(B1, 0, 1); PG8_STAGE(PG8_SB(0, 0), b2, voffB);
            PG8_BAR; PG8_WAIT_L(0); PG8_MMA(0, 1, At, B1); PG8_BAR;
            PG8_LDA(At, 0, 1); PG8_STAGE(PG8_SA(0, 0), a2, o2a);
            PG8_BAR; PG8_WAIT_L(0); PG8_MMA(1, 0, At, B0); PG8_BAR; PG8_SCHED;
            PG8_STAGE(PG8_SB(0, 1), b2 + hstep, voffB);
            PG8_WAIT_V(6); PG8_BAR; PG8_MMA(1, 1, At, B1); PG8_BAR;
            PG8_LDB(B0, 1, 0); PG8_SCHED; PG8_LDA(At, 1, 0); PG8_STAGE(PG8_SA(0, 1), a2, o2b);
            PG8_WAIT_L(8); PG8_BAR; PG8_WAIT_L(0); PG8_MMA(0, 0, At, B0); PG8_BAR; PG8_SCHED;
            PG8_LDB(B1, 1, 1); PG8_STAGE(PG8_SB(1, 0), b3, voffB);
            PG8_BAR; PG8_WAIT_L(0); PG8_MMA(0, 1, At, B1); PG8_BAR;
            PG8_LDA(At, 1, 1); PG8_STAGE(PG8_SA(1, 0), a3, o2a);
            PG8_BAR; PG8_WAIT_L(0); PG8_MMA(1, 0, At, B0); PG8_BAR; PG8_SCHED;
            PG8_STAGE(PG8_SB(1, 1), b3 + hstep, voffB);
            PG8_WAIT_V(6); PG8_BAR; PG8_MMA(1, 1, At, B1); PG8_BAR;
            }
        }
        if (wr == 0) PG8_BAR;
        if constexpr (Epi::FP8) asm volatile("s_nop 15\n\ts_nop 15" ::: "memory");
        { const int tz = otid(wv) & 63; E(acc, cur, wr, wc, tz & 15, tz >> 4); }
        if (!has_next) break;
#pragma unroll
        for (int a = 0; a < 2; ++a)
#pragma unroll
            for (int b = 0; b < 2; ++b)
#pragma unroll
                for (int m = 0; m < 4; ++m)
#pragma unroll
                    for (int n = 0; n < 2; ++n) acc[a][b][m][n] = (f32x4){0.f, 0.f, 0.f, 0.f};
        if constexpr (Epi::LOAD_INIT) { const int tz2 = otid(wv) & 63; E.init(acc, nxt, wr, wc, tz2 & 15, tz2 >> 4); }
        cur = nxt; cA = nA; cB = nB; ++ui;
#pragma unroll
        for (int h = 0; h < 2; ++h)
#pragma unroll
            for (int i = 0; i < 2; ++i) oc[h][i] = on[h][i];
        if (wr == 1) PG8_BAR;
    }
    PG8_WAIT_V(0);
    PG8_BAR;
#undef PG8_SA
#undef PG8_SB
#undef PG8_STAGE
#undef PG8_LDA
#undef PG8_LDB
#undef PG8_MMA
#undef PG8_CAT
#undef PG8_WAIT_V
#undef PG8_WAIT_L
#undef PG8_BAR
#undef PG8_SCHED
}


struct EpiQK {
    static constexpr int PERM = 1; static constexpr bool LOAD_INIT = false; static constexpr bool FP8 = (FP8_PROJ != 0);
    bf16_t* O; const float *gqd, *gkd, *gqf, *gkf; LAS float* tbl; const float* rstd;
    __device__ __forceinline__ void operator()(const f32x4 (&acc)[2][2][4][2], const Unit& u, int wr, int wc, int fr, int fq) const {
#pragma unroll
        for (int ai = 0; ai < 2; ++ai)
#pragma unroll
            for (int m = 0; m < 4; ++m)
#pragma unroll
                for (int bj = 0; bj < 2; ++bj) {
                    const f32x4 a = acc[ai][bj][m][0], b = acc[ai][bj][m][1];
                    float ss = (a[0] * a[0] + a[1] * a[1]) + (a[2] * a[2] + a[3] * a[3]) + (b[0] * b[0] + b[1] * b[1]) + (b[2] * b[2] + b[3] * b[3]);
                    ss += swz_xor<16>(ss); ss = sum_xor32(ss);
                    if (fq == 0) tbl[(bj * 256 + ai * 128 + wr * 64 + m * 16 + fr) * 4 + wc] = FP8 ? ss * (1.f / (W8_SCALE * W8_SCALE)) : ss;
                }
        asm volatile("s_waitcnt lgkmcnt(0)" ::: "memory"); __builtin_amdgcn_s_barrier(); asm volatile("" ::: "memory");
        const int colh = wc * 32 + fq * 8;
#pragma unroll
        for (int bj = 0; bj < 2; ++bj) {
            const int hh = u.pn * 2 + bj;
            int mode; const float* gp; float extra;
            if (hh < 6) { mode = 0; gp = gqd + (colh & 63); extra = 0.125f * LOG2E; }
            else if (hh < 12) { mode = 0; gp = gkd + (colh & 63); extra = 1.f; }
            else if (hh < 17) { mode = 1; gp = gqf + colh; extra = 0.08838834764831845f * LOG2E; }
            else if (hh < 22) { mode = 1; gp = gkf + colh; extra = 1.f; }
            else if (hh < 27) { mode = 2; gp = gqd; extra = 0.08838834764831845f * LOG2E; }
            else { mode = 2; gp = gqd; extra = 1.f; }
            f32x4 g0 = (f32x4){1.f, 1.f, 1.f, 1.f}, g1 = g0;
            if (mode != 2) { g0 = *(const f32x4*)gp; g1 = *(const f32x4*)(gp + 4); }
            g0 = g0 * (FP8 ? extra * (1.f / W8_SCALE) : extra); g1 = g1 * (FP8 ? extra * (1.f / W8_SCALE) : extra);
#pragma unroll
            for (int ai = 0; ai < 2; ++ai)
#pragma unroll
                for (int m = 0; m < 4; ++m) {
                    const int rl = ai * 128 + wr * 64 + m * 16 + fr;
                    const float rr = rstd[u.pm * 256 + rl];
                    float rs = rr;
                    if (mode != 2) {
                        const f32x4 t = *(const LAS f32x4*)(tbl + (bj * 256 + rl) * 4);
                        const float tot = (mode == 0) ? ((wc < 2) ? (t[0] + t[1]) : (t[2] + t[3])) : ((t[0] + t[1]) + (t[2] + t[3]));
                        rs = rr * __builtin_amdgcn_rsqf(rr * rr * tot * (mode == 0 ? (1.f / 64.f) : (1.f / 128.f)) + EPS);
                    }
                    const f32x4 v0 = acc[ai][bj][m][0] * g0 * rs, v1 = acc[ai][bj][m][1] * g1 * rs;
                    u32x4 w; w.x = cvtpk(v0[0], v0[1]); w.y = cvtpk(v0[2], v0[3]); w.z = cvtpk(v1[0], v1[1]); w.w = cvtpk(v1[2], v1[3]);
                    *(u32x4*)(O + (size_t)(u.pm * 256 + rl) * NQK + u.pn * 256 + bj * 128 + colh) = w;
                }
        }
    }
};
struct EpiVT {
    static constexpr int PERM = 2; static constexpr bool LOAD_INIT = false; static constexpr bool FP8 = (FP8_PROJ != 0);
    bf16_t* O; int ldc; const float* rstd;
    __device__ __forceinline__ void operator()(const f32x4 (&acc)[2][2][4][2], const Unit& u, int wr, int wc, int fr, int fq) const {
        f32x4 r0[2], r1[2];
#pragma unroll
        for (int bj = 0; bj < 2; ++bj) { const float* rp = rstd + u.pn * 256 + bj * 128 + wc * 32 + 16 * (fq >> 1) + 4 * (fq & 1);
            r0[bj] = *(const f32x4*)rp; r1[bj] = *(const f32x4*)(rp + 8); if (FP8) { r0[bj] = r0[bj] * (1.f / W8_SCALE); r1[bj] = r1[bj] * (1.f / W8_SCALE); } }
#pragma unroll
        for (int ai = 0; ai < 2; ++ai)
#pragma unroll
            for (int m = 0; m < 4; ++m)
#pragma unroll
                for (int bj = 0; bj < 2; ++bj) {
                    const f32x4 v0 = acc[ai][bj][m][0] * r0[bj], v1 = acc[ai][bj][m][1] * r1[bj];
                    u32x4 w; w.x = cvtpk(v0[0], v0[1]); w.y = cvtpk(v0[2], v0[3]); w.z = cvtpk(v1[0], v1[1]); w.w = cvtpk(v1[2], v1[3]);
                    *(u32x4*)(O + (size_t)(u.pm * 256 + ai * 128 + wr * 64 + m * 16 + fr) * ldc + u.pn * 256 + bj * 128 + wc * 32 + fq * 8) = w;
                }
    }
};
struct EpiResAdd {
    static constexpr int PERM = 1; static constexpr bool LOAD_INIT = true; static constexpr bool FP8 = false;
    bf16_t* X; float sc; unsigned* done; unsigned char* X8;
    __device__ __forceinline__ void init(f32x4 (&acc)[2][2][4][2], const Unit& u, int wr, int wc, int fr, int fq) const {
#pragma unroll
        for (int ai = 0; ai < 2; ++ai)
#pragma unroll
            for (int m = 0; m < 4; ++m)
#pragma unroll
                for (int bj = 0; bj < 2; ++bj) {
                    const u32x4 w = *(const u32x4*)(X + (size_t)(u.pm * 256 + ai * 128 + wr * 64 + m * 16 + fr) * DM + u.pn * 256 + bj * 128 + wc * 32 + fq * 8);
                    acc[ai][bj][m][0] = (f32x4){bf_lo(w.x), bf_hi(w.x), bf_lo(w.y), bf_hi(w.y)};
                    acc[ai][bj][m][1] = (f32x4){bf_lo(w.z), bf_hi(w.z), bf_lo(w.w), bf_hi(w.w)};
                }
    }
    __device__ __forceinline__ void operator()(const f32x4 (&acc)[2][2][4][2], const Unit& u, int wr, int wc, int fr, int fq) const {
        const __amdgpu_buffer_rsrc_t rsrc = __builtin_amdgcn_make_buffer_rsrc((void*)X, 0, SEQ * DM * 2, 0x00020000);
        const __amdgpu_buffer_rsrc_t rsrc8 = __builtin_amdgcn_make_buffer_rsrc((void*)X8, 0, SEQ * DM, 0x00020000);
#pragma unroll
        for (int ai = 0; ai < 2; ++ai)
#pragma unroll
            for (int m = 0; m < 4; ++m)
#pragma unroll
                for (int bj = 0; bj < 2; ++bj) {
                    const f32x4 v0 = acc[ai][bj][m][0], v1 = acc[ai][bj][m][1];
                    u32x4 w; w.x = cvtpk(v0[0], v0[1]); w.y = cvtpk(v0[2], v0[3]); w.z = cvtpk(v1[0], v1[1]); w.w = cvtpk(v1[2], v1[3]);
                    u32x2 w8; w8.x = cvt4f8(v0[0], v0[1], v0[2], v0[3]); w8.y = cvt4f8(v1[0], v1[1], v1[2], v1[3]);
                    __builtin_amdgcn_raw_buffer_store_b64(w8, rsrc8, (int)((u.pm * 256 + ai * 128 + wr * 64 + m * 16 + fr) * DM + u.pn * 256 + bj * 128 + wc * 32 + fq * 8), 0, 16);
                    __builtin_amdgcn_raw_buffer_store_b128(w, rsrc, (int)(((u.pm * 256 + ai * 128 + wr * 64 + m * 16 + fr) * DM + u.pn * 256 + bj * 128 + wc * 32 + fq * 8) * 2), 0, 16);
                }
        asm volatile("s_waitcnt vmcnt(0)" ::: "memory");
        if (fr == 0 && fq == 0) __hip_atomic_fetch_add(done + 64 * u.pm, 1u, __ATOMIC_RELAXED, __HIP_MEMORY_SCOPE_AGENT);
    }
};
struct EpiGU {
    static constexpr int PERM = 1; static constexpr bool LOAD_INIT = false; static constexpr bool FP8 = true;
    unsigned char* ACT; const float* gate; const LAS int* tbl; unsigned* done;
    __device__ __forceinline__ void operator()(const f32x4 (&acc)[2][2][4][2], const Unit& u, int wr, int wc, int fr, int fq) const {
        const int ct = u.pn & 3, n_e = __builtin_amdgcn_readfirstlane(tbl[17 + u.e]);
        const __amdgpu_buffer_rsrc_t rsrc = __builtin_amdgcn_make_buffer_rsrc((void*)ACT, 0, MOE_ROWS * FEXP, 0x00020000);
#pragma unroll
        for (int ai = 0; ai < 2; ++ai)
#pragma unroll
            for (int m = 0; m < 4; ++m) {
                const int rl = ai * 128 + wr * 64 + m * 16 + fr, pos = u.rt * 256 + rl;
                f32x2_t gr2 = {0.f, 0.f}; if (pos < n_e) gr2 = *(const f32x2_t*)(gate + 2 * (u.e * SEQ + pos));
                const float gt = gr2[0] * ACT8_SCALE, rs = gr2[1] * (1.f / W8_SCALE);
                float o[8];
#pragma unroll
                for (int n = 0; n < 2; ++n)
#pragma unroll
                    for (int j = 0; j < 4; ++j) { const float gv = acc[ai][0][m][n][j] * rs, uv = acc[ai][1][m][n][j] * rs;
                        const float sg = gv * __builtin_amdgcn_rcpf(1.f + fexp2(-gv * LOG2E)); o[n * 4 + j] = sg * uv * gt; }
                u32x2 w; w.x = cvt4f8(o[0], o[1], o[2], o[3]); w.y = cvt4f8(o[4], o[5], o[6], o[7]);
                __builtin_amdgcn_raw_buffer_store_b64(w, rsrc, (int)((u.pm * 256 + rl) * FEXP + ct * 128 + wc * 32 + fq * 8), 0, 16);
            }
        asm volatile("s_waitcnt vmcnt(0)" ::: "memory");
        if (fr == 0 && fq == 0) __hip_atomic_fetch_add(done + 64 * u.pm, 1u, __ATOMIC_RELAXED, __HIP_MEMORY_SCOPE_AGENT);
    }
};
struct EpiDown {
    static constexpr int PERM = 1; static constexpr bool LOAD_INIT = false; static constexpr bool FP8 = true;
    bf16_t* Y;
    __device__ __forceinline__ void operator()(const f32x4 (&acc)[2][2][4][2], const Unit& u, int wr, int wc, int fr, int fq) const {
        const int ct = u.pn & 7;
#pragma unroll
        for (int ai = 0; ai < 2; ++ai)
#pragma unroll
            for (int m = 0; m < 4; ++m)
#pragma unroll
                for (int bj = 0; bj < 2; ++bj) {
                    const f32x4 v0 = acc[ai][bj][m][0] * (1.f / (W8_SCALE * ACT8_SCALE)), v1 = acc[ai][bj][m][1] * (1.f / (W8_SCALE * ACT8_SCALE));
                    u32x4 w; w.x = cvtpk(v0[0], v0[1]); w.y = cvtpk(v0[2], v0[3]); w.z = cvtpk(v1[0], v1[1]); w.w = cvtpk(v1[2], v1[3]);
                    *(u32x4*)(Y + (size_t)(u.pm * 256 + ai * 128 + wr * 64 + m * 16 + fr) * DM + ct * 256 + bj * 128 + wc * 32 + fq * 8) = w;
                }
    }
};
}

#define XB_TMO      128
#define XB_XCNT(j)  (256  + 64 * (j))
#define XB_XSUB(j)  (1280 + 64 * (j))
#define XB_XGEN(j)  (2304 + 64 * (j))
#define XB_TOP      3328
#define XB_TOPGEN   3392
#define XCD_BAR_WORDS 3456
#define XB_SPIN_CAP (1u << 18)

__device__ __forceinline__ unsigned xb_ld(unsigned* p)              { return __hip_atomic_load(p, __ATOMIC_RELAXED, __HIP_MEMORY_SCOPE_AGENT); }
__device__ __forceinline__ unsigned xb_add(unsigned* p, unsigned v) { return __hip_atomic_fetch_add(p, v, __ATOMIC_RELAXED, __HIP_MEMORY_SCOPE_AGENT); }
__device__ __forceinline__ unsigned xb_xcc_id() { return (unsigned)__builtin_amdgcn_s_getreg((3 << 11) | 20) & 0xFu; }
#define XB_SPIN(cond, bar) do { unsigned _sp = 0; while (cond) { __builtin_amdgcn_s_sleep(1); \
    if ((++_sp & 255u) == 0u) { if (xb_ld(&(bar)[XB_TMO])) break; if (_sp > XB_SPIN_CAP) { atomicAdd(&(bar)[XB_TMO], 1u); break; } } } } while (0)

struct XcdBarrier { unsigned* bar; unsigned x; volatile LAS unsigned* st; int wv; };

__device__ __forceinline__ XcdBarrier xcd_barrier_post(unsigned* bar, volatile LAS unsigned* st, int wv) {
    XcdBarrier b; b.bar = bar; b.x = xb_xcc_id(); b.st = st; b.wv = wv;
    if (otid(wv) == 0) (void)xb_add(&bar[XB_XCNT(b.x)], 1u);
    return b;
}
__device__ __forceinline__ void xcd_barrier_complete(unsigned* bar, unsigned x, unsigned& nloc, unsigned& nx) {
    const unsigned G = gridDim.x * gridDim.y * gridDim.z;
    unsigned sum, cnt, mine, sp = 0u;
    for (;;) {
        sum = 0u; cnt = 0u; mine = 0u;
#pragma unroll
        for (unsigned j = 0; j < 16; ++j) { const unsigned c = xb_ld(&bar[XB_XCNT(j)]); sum += c; cnt += (c > 0u) ? 1u : 0u; mine = (j == x) ? c : mine; }
        if (sum == G) break;
        __builtin_amdgcn_s_sleep(1);
        if ((++sp & 255u) == 0u) { if (xb_ld(&bar[XB_TMO])) break; if (sp > XB_SPIN_CAP) { atomicAdd(&bar[XB_TMO], 1u); break; } }
    }
    nloc = mine > 0u ? mine : 1u; nx = cnt > 0u ? cnt : 1u;
}
__device__ __attribute__((noinline)) void xcd_barrier_impl(unsigned* bar_, unsigned bx, volatile LAS unsigned* bst, int bwv) {
    XcdBarrier b; b.bar = bar_; b.x = bx; b.st = bst; b.wv = bwv;
    asm volatile("s_waitcnt vmcnt(0)" ::: "memory");
    __syncthreads();
    if (otid(b.wv) == 0) {
        unsigned* bar = b.bar;
        __builtin_amdgcn_s_waitcnt(0);
        unsigned nloc = b.st[0], nx = b.st[1];
        if (nloc == 0u) { xcd_barrier_complete(bar, b.x, nloc, nx); b.st[0] = nloc; b.st[1] = nx; }
        const unsigned old = xb_add(&bar[XB_XSUB(b.x)], 1u);
        const unsigned gen = old / nloc;
        if (old + 1u == (gen + 1u) * nloc) {
            __builtin_amdgcn_fence(__ATOMIC_RELEASE, "agent");
            asm volatile("s_waitcnt vmcnt(0)" ::: "memory");
            const unsigned og = xb_add(&bar[XB_TOP], 1u);
            const unsigned tg = og / nx;
            if (og + 1u == (tg + 1u) * nx) xb_add(&bar[XB_TOPGEN], 1u);
            else XB_SPIN(xb_ld(&bar[XB_TOPGEN]) == tg, bar);
            __builtin_amdgcn_fence(__ATOMIC_ACQUIRE, "agent");
            xb_add(&bar[XB_XGEN(b.x)], 1u);
            asm volatile("s_waitcnt vmcnt(0)" ::: "memory");
        } else {
            XB_SPIN(xb_ld(&bar[XB_XGEN(b.x)]) == gen, bar);
            __builtin_amdgcn_fence(__ATOMIC_ACQUIRE, "agent");
            asm volatile("s_waitcnt vmcnt(0)" ::: "memory");
        }
    }
    __syncthreads();
}

__device__ __forceinline__ void xcd_barrier(const XcdBarrier& b) { xcd_barrier_impl(b.bar, b.x, b.st, b.wv); }

struct Params {
    const float *x, *attn_norm, *w_in, *b_forget, *qnorm_diff, *knorm_diff, *lam_q1, *lam_k1, *lam_q2, *lam_k2, *subln_diff, *onorm_sb,
        *qnorm_fox, *knorm_fox, *onorm_fox, *w_out, *ffn_norm, *w_router, *router_bias, *w_gate, *w_up, *w_down;
    float* out; unsigned char* ws; int ph_lo, ph_hi;
};
typedef const __attribute__((address_space(4))) Params* KArgs;
__device__ __forceinline__ KArgs kparams() { KArgs k = (KArgs)__builtin_amdgcn_kernarg_segment_ptr(); asm volatile("" : "+s"(k)); return k; }

__device__ __forceinline__ void transpose_item(const float* W, int ldn, int k0, int n0, bf16_t* WT, int K, int drow, LAS float* scr, int lane, const float* kgain = nullptr, bool f8 = false) {
#pragma unroll 8
    for (int i = 0; i < 32; ++i) { const int kk = 2 * i + (lane >> 5); scr[kk * 33 + (lane & 31)] = W[(size_t)(k0 + kk) * ldn + n0 + (lane & 31)]; }
    asm volatile("s_waitcnt lgkmcnt(0)" ::: "memory");
    const int c = lane & 7;
    f32x4 ga = {1.f, 1.f, 1.f, 1.f}, gb = ga;
    if (kgain) { ga = *(const f32x4*)(kgain + k0 + 8 * c); gb = *(const f32x4*)(kgain + k0 + 8 * c + 4); }
#pragma unroll
    for (int j = 0; j < 4; ++j) { const int n = (lane >> 3) + 8 * j; const LAS float* s = scr + (8 * c) * 33 + n;
        if (f8) { u32x2 o8; o8.x = cvt4f8(s[0 * 33] * ga[0] * W8_SCALE, s[1 * 33] * ga[1] * W8_SCALE, s[2 * 33] * ga[2] * W8_SCALE, s[3 * 33] * ga[3] * W8_SCALE);
            o8.y = cvt4f8(s[4 * 33] * gb[0] * W8_SCALE, s[5 * 33] * gb[1] * W8_SCALE, s[6 * 33] * gb[2] * W8_SCALE, s[7 * 33] * gb[3] * W8_SCALE);
            *(u32x2*)((unsigned char*)WT + (size_t)(drow + n) * K + k0 + 8 * c) = o8; continue; }
        u32x4 o; o.x = cvtpk(s[0 * 33] * ga[0], s[1 * 33] * ga[1]); o.y = cvtpk(s[2 * 33] * ga[2], s[3 * 33] * ga[3]); o.z = cvtpk(s[4 * 33] * gb[0], s[5 * 33] * gb[1]); o.w = cvtpk(s[6 * 33] * gb[2], s[7 * 33] * gb[3]);
        *(u32x4*)(WT + (size_t)(drow + n) * K + k0 + 8 * c) = o; }
    asm volatile("s_waitcnt lgkmcnt(0)" ::: "memory");
}
__device__ __forceinline__ int win_dest(int n0, int& sel) {
    if (n0 < 768) { sel = 0; return n0; }
    if (n0 < 1536) { sel = 0; return n0; }
    if (n0 < 2304) { sel = 1; return n0 - 1536; }
    if (n0 < 2944) { sel = 0; return 2816 + (n0 - 2304); }
    if (n0 < 3584) { sel = 0; return 3456 + (n0 - 2944); }
    if (n0 < 4224) { sel = 1; return 768 + (n0 - 3584); }
    if (n0 < 4864) { sel = 0; return 1536 + (n0 - 4224); }
    if (n0 < 5504) { sel = 0; return 2176 + (n0 - 4864); }
    sel = 1; return 1408 + (n0 - 5504);
}
__device__ __forceinline__ void phase_prologue(KArgs p, LAS unsigned char* lds, int wv) {
    const int tid = otid(wv), lane = tid & 63, wave = tid >> 6;
    LAS float* scr = (LAS float*)(lds + wave * 16384);
    const int gw = blockIdx.x * 8 + wave, NGW = gridDim.x * 8;
    constexpr int I_IN = 32 * 192, I_O = 32 * 64, I_G = 16 * 32 * 16, I_D = 16 * 8 * 64, I_L = I_IN + I_O + 2 * I_G + I_D;
    bf16_t* Wqk = (bf16_t*)(p->ws + WS_WQK); bf16_t* Wv = (bf16_t*)(p->ws + WS_WV); bf16_t* Wo = (bf16_t*)(p->ws + WS_WO);
    bf16_t* Wgu = (bf16_t*)(p->ws + WS_WGU); bf16_t* Wd = (bf16_t*)(p->ws + WS_WD);
    for (int it = gw; it < DEPTH * I_L; it += NGW) {
        const int l = it / I_L; int r = it % I_L;
        if (r < I_IN) { const int kb = r / 192, nb = r % 192; int sel; const int drow = win_dest(nb * 32, sel);
            if (FP8_PROJ) transpose_item(p->w_in + (size_t)l * DM * NIN, NIN, kb * 64, nb * 32, (bf16_t*)(sel ? (unsigned char*)Wv + (size_t)l * NV * DM : (unsigned char*)Wqk + (size_t)l * NQK * DM), DM, drow, scr, lane, p->attn_norm + (size_t)l * DM, true);
            else transpose_item(p->w_in + (size_t)l * DM * NIN, NIN, kb * 64, nb * 32, sel ? Wv + (size_t)l * NV * DM : Wqk + (size_t)l * NQK * DM, DM, drow, scr, lane, p->attn_norm + (size_t)l * DM); continue; }
        r -= I_IN;
        if (r < I_O) { const int kb = r / 64, nb = r % 64;
            transpose_item(p->w_out + (size_t)l * DM * DM, DM, kb * 64, nb * 32, Wo + (size_t)l * DM * DM, DM, nb * 32, scr, lane); continue; }
        r -= I_O;
        if (r < 2 * I_G) { const int up = r / I_G; r %= I_G; const int e = r / 512, kb = (r % 512) / 16, nb = r % 16; const int n0 = nb * 32;
            const float* src = (up ? p->w_up : p->w_gate) + ((size_t)l * NEXP + e) * DM * FEXP;
            transpose_item(src, FEXP, kb * 64, n0, (bf16_t*)((unsigned char*)Wgu + ((size_t)l * NEXP + e) * 1024 * DM), DM, (n0 >> 7) * 256 + up * 128 + (n0 & 127), scr, lane, p->ffn_norm + (size_t)l * DM, true); continue; }
        r -= 2 * I_G;
        { const int e = r / 512, kb = (r % 512) / 64, nb = r % 64;
            transpose_item(p->w_down + ((size_t)l * NEXP + e) * FEXP * DM, DM, kb * 64, nb * 32, (bf16_t*)((unsigned char*)Wd + ((size_t)l * NEXP + e) * DM * FEXP), FEXP, nb * 32, scr, lane, nullptr, true); }
    }
    { float* WRT = (float*)(p->ws + WS_WRT); for (int i = blockIdx.x * 512 + tid; i < 16 * DM; i += gridDim.x * 512) WRT[(i & 15) * DM + (i >> 4)] = p->w_router[i]; }
    float* WF = (float*)(p->ws + WS_WF);
    for (int i = blockIdx.x * 512 + tid; i < DEPTH * 5 * DM; i += gridDim.x * 512) { const int l = i / (5 * DM), h = (i / DM) % 5, d = i % DM;
        WF[i] = p->w_in[((size_t)l * DM + d) * NIN + 6144 + h]; }
    if (blockIdx.x == 1 && wave < DEPTH) {
        const int l = wave;
        float a = fabsf(p->qnorm_diff[l * 64 + lane]), b = fabsf(p->knorm_diff[l * 64 + lane]);
        float c2 = fmaxf(fabsf(p->qnorm_fox[l * 128 + lane]), fabsf(p->qnorm_fox[l * 128 + 64 + lane])), d2 = fmaxf(fabsf(p->knorm_fox[l * 128 + lane]), fabsf(p->knorm_fox[l * 128 + 64 + lane]));
#pragma unroll
        for (int o = 1; o < 32; o <<= 1) { a = fmaxf(a, __int_as_float(__builtin_amdgcn_ds_bpermute(((lane ^ o) << 2), __float_as_int(a)))); b = fmaxf(b, __int_as_float(__builtin_amdgcn_ds_bpermute(((lane ^ o) << 2), __float_as_int(b))));
            c2 = fmaxf(c2, __int_as_float(__builtin_amdgcn_ds_bpermute(((lane ^ o) << 2), __float_as_int(c2)))); d2 = fmaxf(d2, __int_as_float(__builtin_amdgcn_ds_bpermute(((lane ^ o) << 2), __float_as_int(d2)))); }
        a = fmaxf(a, __int_as_float(__builtin_amdgcn_ds_bpermute(((lane ^ 32) << 2), __float_as_int(a)))); b = fmaxf(b, __int_as_float(__builtin_amdgcn_ds_bpermute(((lane ^ 32) << 2), __float_as_int(b))));
        c2 = fmaxf(c2, __int_as_float(__builtin_amdgcn_ds_bpermute(((lane ^ 32) << 2), __float_as_int(c2)))); d2 = fmaxf(d2, __int_as_float(__builtin_amdgcn_ds_bpermute(((lane ^ 32) << 2), __float_as_int(d2))));
        if (lane == 0) { ((float*)(p->ws + WS_LAM))[8 + 2 * l] = a * b; ((float*)(p->ws + WS_LAM))[8 + 2 * l + 1] = c2 * d2; }
    }
    if (blockIdx.x == 0 && wave < DEPTH) {
        const int l = wave;
        float a = wave_sum(p->lam_q1[l * 64 + lane] * p->lam_k1[l * 64 + lane]), b = wave_sum(p->lam_q2[l * 64 + lane] * p->lam_k2[l * 64 + lane]);
        if (lane == 0) ((float*)(p->ws + WS_LAM))[l] = fexp2(a * LOG2E) - fexp2(b * LOG2E) + (0.8f - 0.6f * fexp2(-0.3f * LOG2E * (float)l));
    }
}

__device__ __forceinline__ float log_sigmoid(float x) { return fminf(x, 0.f) - 0.6931471805599453f * flog2(1.f + fexp2(-fabsf(x) * LOG2E)); }

__device__ __forceinline__ void phase_norm1(KArgs p, int l, LAS unsigned char* lds, int wv, bool probe2 = false) {
    const int tid = otid(wv), lane = tid & 63, wave = tid >> 6;
    LAS float* wf = (LAS float*)lds;
    LAS int* rbase = (LAS int*)(lds + 5 * DM * 4);
    if (l < DEPTH) { const float* WF = (const float*)(p->ws + WS_WF) + (size_t)l * 5 * DM; for (int i = tid; i < 5 * DM; i += 512) wf[i] = WF[i]; }
    if (l > 0 && tid == 0) { const unsigned* cnt = (const unsigned*)(p->ws + WS_CTL) + CW_CNT + (l - 1) * 16 * 64; int acc = 0;
        for (int e = 0; e < 16; ++e) { rbase[e] = acc * 256; acc += ((int)cnt[e * 64] + 255) >> 8; } }
    __syncthreads();
    const bf16_t* Y = (const bf16_t*)(p->ws + WS_Y); const i32x4* tsel = (const i32x4*)(p->ws + WS_TSEL);
    bf16_t* XN = (bf16_t*)(p->ws + WS_XN); float* LOGF = (float*)(p->ws + WS_LOGF);
    const int gw = blockIdx.x * 8 + wave, NGW = gridDim.x * 8;
    for (int t = gw; t < SEQ; t += NGW) {
        asm volatile("" ::: "memory");
        f32x4 v[8];
        if (l == 0 && !probe2) { const f32x4* xr = (const f32x4*)(p->x + (size_t)t * DM) + lane;
#pragma unroll
            for (int j = 0; j < 8; ++j) v[j] = xr[64 * j]; }
        else { const u32x2* xr = (const u32x2*)((const bf16_t*)(p->ws + WS_OUTB) + (size_t)t * DM) + lane;
#pragma unroll
            for (int j = 0; j < 8; ++j) { const u32x2 a = xr[64 * j]; v[j] = (f32x4){bf_lo(a[0]), bf_hi(a[0]), bf_lo(a[1]), bf_hi(a[1])}; } }
        if (l > 0) {
            const float ysc = probe2 ? 0.f : 1.f;
            const i32x4 ts = tsel[t];
            const u32x2* y1 = (const u32x2*)(Y + (size_t)(rbase[ts[0]] + ts[1]) * DM) + lane; const u32x2* y2 = (const u32x2*)(Y + (size_t)(rbase[ts[2]] + ts[3]) * DM) + lane;
#pragma unroll
            for (int j = 0; j < 8; ++j) { const u32x2 a = y1[64 * j], b = y2[64 * j];
                v[j][0] += ysc * (bf_lo(a[0]) + bf_lo(b[0])); v[j][1] += ysc * (bf_hi(a[0]) + bf_hi(b[0])); v[j][2] += ysc * (bf_lo(a[1]) + bf_lo(b[1])); v[j][3] += ysc * (bf_hi(a[1]) + bf_hi(b[1])); }
        }
        if (l == DEPTH) { f32x4* orow = (f32x4*)(p->out + (size_t)t * DM) + lane;
#pragma unroll
            for (int j = 0; j < 8; ++j) orow[64 * j] = v[j]; }
        else { u32x2* orow = (u32x2*)((bf16_t*)(p->ws + WS_OUTB) + (size_t)t * DM) + lane;
#pragma unroll
            for (int j = 0; j < 8; ++j) { u32x2 w; w[0] = cvtpk(v[j][0], v[j][1]); w[1] = cvtpk(v[j][2], v[j][3]); orow[64 * j] = w; }
            if (FP8_PROJ) { unsigned* orow8 = (unsigned*)(p->ws + WS_OUTB8 + (size_t)t * DM) + lane;
#pragma unroll
                for (int j = 0; j < 8; ++j) orow8[64 * j] = cvt4f8(v[j][0], v[j][1], v[j][2], v[j][3]); } }
        if (l == DEPTH) continue;
        float ss = 0.f;
#pragma unroll
        for (int j = 0; j < 8; ++j) ss += (v[j][0] * v[j][0] + v[j][1] * v[j][1]) + (v[j][2] * v[j][2] + v[j][3] * v[j][3]);
        const float rstd = __builtin_amdgcn_rsqf(wave_sum(ss) * (1.f / DM) + EPS);
        const f32x4* gr = (const f32x4*)(p->attn_norm + (size_t)l * DM) + lane;
        float fc[5] = {0.f, 0.f, 0.f, 0.f, 0.f};
        if (lane == 0) ((float*)(p->ws + WS_RSTD))[t] = rstd;
#pragma unroll
        for (int j = 0; j < 8; ++j) { const f32x4 xn = v[j] * rstd * gr[64 * j];
#pragma unroll
            for (int h = 0; h < 5; ++h) { const f32x4 w4 = *(const LAS f32x4*)(wf + h * DM + 4 * lane + 256 * j); fc[h] += (xn[0] * w4[0] + xn[1] * w4[1]) + (xn[2] * w4[2] + xn[3] * w4[3]); } }
#pragma unroll
        for (int h = 0; h < 5; ++h) { const float s = wave_sum(fc[h]); if (lane == 0) LOGF[h * SEQ + t] = log_sigmoid(s + p->b_forget[l * 5 + h]); }
    }
}

__device__ __forceinline__ void scan_head(KArgs p, int h, int l, LAS unsigned char* lds, int wv) {
    const int tid = otid(wv), lane = tid & 63, wave = tid >> 6;
    const float* src = (const float*)(p->ws + WS_LOGF) + (size_t)h * SEQ + tid * 16; float* dst = (float*)(p->ws + WS_DC2) + (size_t)h * SEQ + tid * 16;
    LAS float* wt = (LAS float*)lds;
    float v[16]; float s = 0.f;
#pragma unroll
    for (int i = 0; i < 4; ++i) { const f32x4 a = ((const f32x4*)src)[i]; v[4 * i] = a[0]; v[4 * i + 1] = a[1]; v[4 * i + 2] = a[2]; v[4 * i + 3] = a[3]; }
#pragma unroll
    for (int i = 0; i < 16; ++i) { s += v[i]; v[i] = s; }
    float inc = s;
#pragma unroll
    for (int o = 1; o < 64; o <<= 1) { const float n = __int_as_float(__builtin_amdgcn_ds_bpermute(((lane - o) & 63) << 2, __float_as_int(inc))); if (lane >= o) inc += n; }
    if (lane == 63) wt[wave] = inc;
    __syncthreads();
    float base = inc - s;
    for (int w = 0; w < wave; ++w) base += wt[w];
#pragma unroll
    for (int i = 0; i < 4; ++i) ((f32x4*)dst)[i] = (f32x4){(v[4 * i] + base) * LOG2E, (v[4 * i + 1] + base) * LOG2E, (v[4 * i + 2] + base) * LOG2E, (v[4 * i + 3] + base) * LOG2E};
    LAS float* dl = (LAS float*)(lds + 64);
#pragma unroll
    for (int i = 0; i < 16; ++i) dl[tid * 16 + i] = (v[i] + base) * LOG2E;
    __syncthreads();
    { const float thr = 39.f + 2.f * 16.3221377f * ((const float*)(p->ws + WS_LAM))[8 + 2 * l + 1];
      const int qb = tid >> 4, part = tid & 15; const float dref = dl[256 * qb]; int cnt = 0;
      for (int i = part; i < 4 * qb; i += 16) cnt += (dref - dl[64 * i + 63] <= -thr) ? 1 : 0;
      float c = (float)cnt; c += swz_xor<1>(c); c += swz_xor<2>(c); c += swz_xor<4>(c); c += swz_xor<8>(c);
      if (part == 0) ((int*)(p->ws + WS_LAM))[64 + h * 32 + qb] = (int)c; }
    __syncthreads();
}

namespace att {
constexpr int KP = 272, VP = 144;
constexpr int KT_BYTES = 64 * KP, VT_BYTES = 128 * VP, KB_BYTES = 256;
constexpr int BUF_BYTES = KT_BYTES + VT_BYTES + KB_BYTES;
constexpr float THR = 8.f;
static_assert(2 * BUF_BYTES <= RING_BYTES && 4 * 128 * 32 * 4 <= RING_BYTES, "attention LDS");

struct Stg { u32x4 k0, k1, v0, v1; };
__device__ __forceinline__ void stage_load(Stg& s, const bf16_t* Kg, const bf16_t* Vg, int j, int tid) {
    const bf16_t* kp = Kg + (size_t)(64 * j + (tid >> 3)) * NQK + (tid & 7) * 8;
    s.k0 = *(const u32x4*)kp; s.k1 = *(const u32x4*)(kp + 64);
    const bf16_t* vp = Vg + (size_t)(tid >> 2) * SEQ + 64 * j + (tid & 3) * 8;
    s.v0 = *(const u32x4*)vp; s.v1 = *(const u32x4*)(vp + 32);
}
__device__ __forceinline__ void stage_write(const Stg& s, LAS unsigned char* buf, int tid) {
    LAS unsigned char* kd = buf + (tid >> 3) * KP + (tid & 7) * 16; *(LAS u32x4*)kd = s.k0; *(LAS u32x4*)(kd + 128) = s.k1;
    LAS unsigned char* vd = buf + KT_BYTES + (tid >> 2) * VP + (tid & 3) * 16; *(LAS u32x4*)vd = s.v0; *(LAS u32x4*)(vd + 64) = s.v1;
}
template <int NKS>
__device__ __forceinline__ void qk_tile(f32x16& p0, f32x16& p1, const LAS unsigned char* kb, const bf16x8* qr) {
    bf16x8 ka[NKS], kc[NKS];
#pragma unroll
    for (int ks = 0; ks < NKS; ++ks) { ka[ks] = *(const LAS bf16x8*)(kb + ks * 32); kc[ks] = *(const LAS bf16x8*)(kb + 32 * KP + ks * 32); }
    __builtin_amdgcn_sched_barrier(0);
#pragma unroll
    for (int ks = 0; ks < NKS; ++ks) {
        p0 = __builtin_amdgcn_mfma_f32_32x32x16_bf16(ka[ks], qr[ks], p0, 0, 0, 0);
        p1 = __builtin_amdgcn_mfma_f32_32x32x16_bf16(kc[ks], qr[ks], p1, 0, 0, 0);
    }
    __builtin_amdgcn_sched_barrier(0);
}
__device__ __forceinline__ bf16x8 pack8(const f32x16& p, int b) {
    u32x4 w = {cvtpk(p[b + 0], p[b + 1]), cvtpk(p[b + 2], p[b + 3]), cvtpk(p[b + 4], p[b + 5]), cvtpk(p[b + 6], p[b + 7])};
    return *reinterpret_cast<bf16x8*>(&w);
}
__device__ __forceinline__ void pv_tile(f32x16 (&o)[4], const LAS unsigned char* vb, const f32x16& p0, const f32x16& p1) {
    const bf16x8 pb0 = pack8(p0, 0), pb1 = pack8(p0, 8), pb2 = pack8(p1, 0), pb3 = pack8(p1, 8);
#pragma unroll
    for (int dh = 0; dh < 2; ++dh) {
        bf16x8 va[8];
#pragma unroll
        for (int i = 0; i < 8; ++i) va[i] = *(const LAS bf16x8*)(vb + (2 * dh + (i >> 2)) * 32 * VP + (i & 3) * 32);
        __builtin_amdgcn_sched_barrier(0);
#pragma unroll
        for (int i = 0; i < 8; ++i) { const int d0 = 2 * dh + (i >> 2), s4 = i & 3;
            o[d0] = __builtin_amdgcn_mfma_f32_32x32x16_bf16(va[i], s4 == 0 ? pb0 : (s4 == 1 ? pb1 : (s4 == 2 ? pb2 : pb3)), o[d0], 0, 0, 0); }
        __builtin_amdgcn_sched_barrier(0);
    }
}
template <int NKS>
__device__ __forceinline__ void tile_fixed(f32x16 (&o)[4], const LAS unsigned char* kb, const LAS unsigned char* vb, const bf16x8* qr, f32x16& y0, f32x16& y1, float& l) {
    bf16x8 ka[NKS], kc[NKS];
#pragma unroll
    for (int ks = 0; ks < NKS; ++ks) { ka[ks] = *(const LAS bf16x8*)(kb + ks * 32); kc[ks] = *(const LAS bf16x8*)(kb + 32 * KP + ks * 32); }
    __builtin_amdgcn_sched_barrier(0);
#pragma unroll
    for (int ks = 0; ks < NKS; ++ks) y0 = __builtin_amdgcn_mfma_f32_32x32x16_bf16(ka[ks], qr[ks], y0, 0, 0, 0);
    __builtin_amdgcn_sched_barrier(0);
    asm volatile("" : "+v"(y0));
#pragma unroll
    for (int ks = 0; ks < NKS; ++ks) y1 = __builtin_amdgcn_mfma_f32_32x32x16_bf16(kc[ks], qr[ks], y1, 0, 0, 0);
    float s = 0.f;
#pragma unroll
    for (int r = 0; r < 16; ++r) { y0[r] = fexp2(y0[r]); s += y0[r]; }
    const bf16x8 pb0 = pack8(y0, 0), pb1 = pack8(y0, 8);
#pragma unroll
    for (int q = 0; q < NKS; ++q) { __builtin_amdgcn_sched_group_barrier(0x008, 1, 0);
#pragma unroll
        for (int h = 0; h < 8 / NKS; ++h) { __builtin_amdgcn_sched_group_barrier(0x400, 2, 0); __builtin_amdgcn_sched_group_barrier(0x002, 3, 0); } }
    __builtin_amdgcn_sched_barrier(0);
    bf16x8 va[8];
#pragma unroll
    for (int i = 0; i < 8; ++i) va[i] = *(const LAS bf16x8*)(vb + (i >> 1) * 32 * VP + (i & 1) * 32);
    __builtin_amdgcn_sched_barrier(0);
    asm volatile("" : "+v"(y1));
#pragma unroll
    for (int i = 0; i < 8; ++i) o[i >> 1] = __builtin_amdgcn_mfma_f32_32x32x16_bf16(va[i], (i & 1) ? pb1 : pb0, o[i >> 1], 0, 0, 0);
    float s1 = 0.f;
#pragma unroll
    for (int r = 0; r < 16; ++r) { y1[r] = fexp2(y1[r]); s1 += y1[r]; }
    const bf16x8 pb2 = pack8(y1, 0), pb3 = pack8(y1, 8);
#pragma unroll
    for (int q = 0; q < 8; ++q) { __builtin_amdgcn_sched_group_barrier(0x008, 1, 0); __builtin_amdgcn_sched_group_barrier(0x400, 2, 0); __builtin_amdgcn_sched_group_barrier(0x002, 3, 0); }
    __builtin_amdgcn_sched_barrier(0);
    l += s + s1;
    bf16x8 vb2[8];
#pragma unroll
    for (int i = 0; i < 8; ++i) vb2[i] = *(const LAS bf16x8*)(vb + (i >> 1) * 32 * VP + 64 + (i & 1) * 32);
    __builtin_amdgcn_sched_barrier(0);
#pragma unroll
    for (int i = 0; i < 8; ++i) o[i >> 1] = __builtin_amdgcn_mfma_f32_32x32x16_bf16(vb2[i], (i & 1) ? pb3 : pb2, o[i >> 1], 0, 0, 0);
    __builtin_amdgcn_sched_barrier(0);
}
__device__ __forceinline__ float swap_max(float v) { auto rr = __builtin_amdgcn_permlane32_swap(__float_as_uint(v), __float_as_uint(v), false, false); return fmaxf(__uint_as_float(rr[0]), __uint_as_float(rr[1])); }
__device__ __forceinline__ float swap_sum(float v) { auto rr = __builtin_amdgcn_permlane32_swap(__float_as_uint(v), __float_as_uint(v), false, false); return __uint_as_float(rr[0]) + __uint_as_float(rr[1]); }
__device__ __forceinline__ void softmax_step(f32x16& y0, f32x16& y1, float A, float& m, float& l, f32x16 (&o)[4]) {
    float mx = y0[0];
#pragma unroll
    for (int r = 1; r < 16; ++r) mx = fmaxf(mx, y0[r]);
#pragma unroll
    for (int r = 0; r < 16; ++r) mx = fmaxf(mx, y1[r]);
    mx = swap_max(mx) + A;
    if (__any(mx > m + THR)) {
        const float mn = fmaxf(m, mx), al = fexp2(m - mn); m = mn; l *= al;
#pragma unroll
        for (int d0 = 0; d0 < 4; ++d0)
#pragma unroll
            for (int r = 0; r < 16; ++r) o[d0][r] *= al;
    }
    const float mA = m - A; float s = 0.f;
#pragma unroll
    for (int r = 0; r < 16; ++r) { y0[r] = fexp2(y0[r] - mA); s += y0[r]; }
#pragma unroll
    for (int r = 0; r < 16; ++r) { y1[r] = fexp2(y1[r] - mA); s += y1[r]; }
    l += s;
}
__device__ __forceinline__ void softmax_fixed(f32x16& y0, f32x16& y1, float c, float& l) {
    float s = 0.f;
#pragma unroll
    for (int r = 0; r < 16; ++r) { y0[r] = fexp2(y0[r] + c); s += y0[r]; }
#pragma unroll
    for (int r = 0; r < 16; ++r) { y1[r] = fexp2(y1[r] + c); s += y1[r]; }
    l += s;
}
#define KIDX(r) (((r) & 3) + 8 * ((r) >> 2))

template <int TY>
__device__ __forceinline__ void att_item(KArgs p, int l, int head, int qb, LAS unsigned char* lds, int wv, int part = 0) {
    const int tid = otid(wv), wid = __builtin_amdgcn_readfirstlane(tid >> 6), lane = tid & 63, r32 = lane & 31, hi = lane >> 5;
    constexpr int NKS = (TY == 0) ? 4 : 8;
    const int br = (TY == 0) ? (wid >> 2) : 0, rg = (TY == 0) ? (wid & 3) : wid;
    const int t0w = (TY == 0) ? (128 * qb + 32 * rg) : (256 * qb + 32 * wid);
    const int trow = t0w + r32;
    const int NT = (TY == 0) ? (2 * qb + 2) : (4 * qb + 4);
    const int qcol = (TY == 0) ? (128 * head + 64 * br) : (TY == 1 ? 2816 + 128 * head : 1536 + 128 * head);
    const int kcol = (TY == 0) ? (768 + 128 * head) : (TY == 1 ? 3456 + 128 * head : 2176 + 128 * head);
    const int hv = (TY == 0) ? head : (TY == 1 ? 6 + head : 11 + head);
    const bf16_t* QKB = (const bf16_t*)(p->ws + WS_QKB);
    const bf16_t* Kg = QKB + kcol; const bf16_t* Vg = (const bf16_t*)(p->ws + WS_VT) + (size_t)hv * HD * SEQ;
    const float* dc2 = (const float*)(p->ws + WS_DC2) + (size_t)head * SEQ;
    const float dcref = (TY == 2) ? dc2[256 * qb] : 0.f;
    const float slope2 = (TY == 0) ? fexp2(-8.0f * (float)(head + 1) / 6.0f) * LOG2E : 0.f;
    const float Bfix = (TY == 0) ? (11.5415603f * 1.01f * ((const float*)(p->ws + WS_LAM))[8 + 2 * l] + 0.25f) : (16.3221377f * 1.01f * ((const float*)(p->ws + WS_LAM))[8 + 2 * l + 1] + 0.25f);
    const float cfix = (TY == 2) ? (dc2[trow] - dcref - Bfix) : -Bfix;

    int j_lo = 0;
    if (TY == 0 && SKIP_A) {
        const float Bq = 11.5415603f * ((const float*)(p->ws + WS_LAM))[8 + 2 * l];
        const float x = ((float)(128 * qb - 63) - (39.f + 2.f * Bq) / slope2) * (1.f / 64.f);
        j_lo = x < 0.f ? 0 : (int)x + 1;
    } else if (TY == 2 && SKIP_C) {
        j_lo = ((const int*)(p->ws + WS_LAM))[64 + head * 32 + qb];
    }
    j_lo = __builtin_amdgcn_readfirstlane(j_lo);
    const int NTP = NT - j_lo;
    const bool elig = (TY == 2) ? (qb >= 8) : ((TY == 0) ? (head >= 4 && qb >= 16) : false);
    const bool split = elig && NTP > 32;
    if (part == 1 && !split) return;
    const int mid = j_lo + (NTP >> 1);
    const int jtop = (part == 1) ? mid - 1 : NT - 1;
    const int cntT = (part == 1) ? (mid - j_lo) : (split ? NT - mid : NTP);
    const int sidx = (TY == 2) ? (head * 32 + qb) : (160 + head * 64 + qb);
    unsigned long long* pay = (unsigned long long*)(p->ws + WS_PART) + ((size_t)sidx * 8 + wid) * 17 * 64 + lane;
    unsigned* aflag = (unsigned*)(p->ws + WS_CTL) + CW_AFLAG + (l * 544 + sidx) * 64;
    LAS unsigned char* buf0 = lds; LAS unsigned char* buf1 = lds + BUF_BYTES;
    LAS int* flags = (LAS int*)(lds + 2 * BUF_BYTES);
    if (TY == 1 && tid < 16) flags[tid] = 0;
    Stg st; float kbv = 0.f;
    stage_load(st, Kg, Vg, jtop, tid);
    if (TY == 2 && tid < 64) kbv = dcref - dc2[64 * jtop + tid];
    bf16x8 qr[NKS];
#pragma unroll
    for (int ks = 0; ks < NKS; ++ks) qr[ks] = *(const bf16x8*)(QKB + (size_t)trow * NQK + qcol + ks * 16 + hi * 8);
    stage_write(st, buf0, tid);
    if (TY == 2 && tid < 64) *(LAS float*)(buf0 + KT_BYTES + VT_BYTES + tid * 4) = kbv;
    if (cntT > 1) { stage_load(st, Kg, Vg, jtop - 1, tid); if (TY == 2 && tid < 64) kbv = dcref - dc2[64 * (jtop - 1) + tid]; }
    __syncthreads();

    f32x16 o[4];
#pragma unroll
    for (int d0 = 0; d0 < 4; ++d0)
#pragma unroll
        for (int r = 0; r < 16; ++r) o[d0][r] = 0.f;
    float m = 0.f, lsum = 0.f, R = 0.f;
    const int koff = r32 * KP + hi * 16 + ((TY == 0) ? br * 128 : 0), voff = KT_BYTES + r32 * VP + hi * 16;

    for (int it = 0; it < cntT; ++it) {
        if (TY == 1 && (SKIP_B & 1) && it > 0) { const i32x4 f0 = *(const LAS i32x4*)(flags + ((it - 1) & 1) * 8), f1 = *(const LAS i32x4*)(flags + ((it - 1) & 1) * 8 + 4);
            if (__builtin_amdgcn_readfirstlane((f0[0] & f0[1] & f0[2] & f0[3] & f1[0] & f1[1] & f1[2] & f1[3])) != 0) break; }
        const int j = jtop - it;
        LAS unsigned char* cur = (it & 1) ? buf1 : buf0; LAS unsigned char* oth = (it & 1) ? buf0 : buf1;
        const bool more = it + 1 < cntT;
        if (TY == 0) {
            const int cw = 2 * qb + (rg >> 1);
            if (j <= cw) {
                f32x16 y0, y1;
                const int trel = trow - 64 * j;
                if (j == cw) {
                    const float tq = (float)(trel - 4 * hi);
#pragma unroll
                    for (int r = 0; r < 16; ++r) { y0[r] = fmaf(-slope2, fabsf(tq - (float)KIDX(r)), cfix); y1[r] = fmaf(-slope2, fabsf(tq - (float)(KIDX(r) + 32)), cfix); }
                } else {
                    const float A = fmaf(-slope2, (float)(trel - 4 * hi), cfix);
#pragma unroll
                    for (int r = 0; r < 16; ++r) { y0[r] = fmaf(slope2, (float)KIDX(r), A); y1[r] = fmaf(slope2, (float)(KIDX(r) + 32), A); }
                }
                tile_fixed<NKS>(o, cur + koff, cur + voff, qr, y0, y1, lsum);
            }
        } else {
            const int jj = j - 4 * qb;
            if (jj <= (wid >> 1) && !(TY == 1 && (SKIP_B & 2) && __all(R <= -40.f))) {
                const bool partial = (jj == (wid >> 1));
                const int tin = 32 * (wid & 1) + r32 - 4 * hi;
                f32x16 y0, y1;
                if (TY == 2) {
                    const LAS f32x4* kbp = (const LAS f32x4*)(cur + KT_BYTES + VT_BYTES) + hi;
#pragma unroll
                    for (int g = 0; g < 4; ++g) { const f32x4 b0 = kbp[2 * g], b1 = kbp[2 * g + 8];
#pragma unroll
                        for (int i = 0; i < 4; ++i) { y0[4 * g + i] = b0[i] + cfix; y1[4 * g + i] = b1[i] + cfix; } }
                    if (partial) {
#pragma unroll
                        for (int r = 0; r < 16; ++r) { if (KIDX(r) > tin) y0[r] = -__builtin_inff(); if (KIDX(r) + 32 > tin) y1[r] = -__builtin_inff(); }
                    }
                    tile_fixed<NKS>(o, cur + koff, cur + voff, qr, y0, y1, lsum);
                } else {
#pragma unroll
                    for (int r = 0; r < 16; ++r) { y0[r] = 0.f; y1[r] = 0.f; }
                    qk_tile<NKS>(y0, y1, cur + koff, qr);
                    f32x16 lb0, lb1;
#pragma unroll
                    for (int r = 0; r < 16; ++r) {
                        { const float z = fminf(fmaxf(y0[r], -100.f), 100.f), b = -flog2(1.f + fexp2(-z)); float k = b - z, bb = b;
                          if (partial && KIDX(r) >= tin) { k = 0.f; bb = -__builtin_inff(); } lb0[r] = bb; y0[r] = k; }
                        { const float z = fminf(fmaxf(y1[r], -100.f), 100.f), b = -flog2(1.f + fexp2(-z)); float k = b - z, bb = b;
                          if (partial && KIDX(r) + 32 >= tin) { k = 0.f; bb = -__builtin_inff(); } lb1[r] = bb; y1[r] = k; }
                    }
                    float gs0[4], gs1[4];
#pragma unroll
                    for (int g = 0; g < 4; ++g) {
                        { const float e0 = y0[4 * g], e1 = y0[4 * g + 1], e2 = y0[4 * g + 2], e3 = y0[4 * g + 3]; const float s2 = e3, s1 = e3 + e2, s0 = s1 + e1;
                          y0[4 * g + 3] = 0.f; y0[4 * g + 2] = s2; y0[4 * g + 1] = s1; y0[4 * g] = s0; gs0[g] = s0 + e0; }
                        { const float e0 = y1[4 * g], e1 = y1[4 * g + 1], e2 = y1[4 * g + 2], e3 = y1[4 * g + 3]; const float s2 = e3, s1 = e3 + e2, s0 = s1 + e1;
                          y1[4 * g + 3] = 0.f; y1[4 * g + 2] = s2; y1[4 * g + 1] = s1; y1[4 * g] = s0; gs1[g] = s0 + e0; }
                    }
                    float run = R;
#pragma unroll
                    for (int half = 1; half >= 0; --half)
#pragma unroll
                        for (int g = 3; g >= 0; --g) {
                            const float mine = half ? gs1[g] : gs0[g];
                            auto rr = __builtin_amdgcn_permlane32_swap(__float_as_uint(mine), __float_as_uint(mine), false, false);
                            const float g_lo = __uint_as_float(rr[0]), g_hi = __uint_as_float(rr[1]);
                            const float off_hi = run; run += g_hi; const float off_lo = run; run += g_lo;
                            const float off = hi ? off_hi : off_lo;
#pragma unroll
                            for (int i = 0; i < 4; ++i) {
                                if (half) y1[4 * g + i] = fexp2(lb1[4 * g + i] + y1[4 * g + i] + off);
                                else y0[4 * g + i] = fexp2(lb0[4 * g + i] + y0[4 * g + i] + off);
                            }
                        }
                    R = run;
                    pv_tile(o, cur + voff, y0, y1);
                }
            }
        }
        if (TY == 1) { const int dn = __all(R <= -40.f) ? 1 : 0; if (lane == 0) flags[(it & 1) * 8 + wid] = dn; }
        if (more) { stage_write(st, oth, tid); if (TY == 2 && tid < 64) *(LAS float*)(oth + KT_BYTES + VT_BYTES + tid * 4) = kbv; }
        if (it + 2 < cntT) { stage_load(st, Kg, Vg, j - 2, tid); if (TY == 2 && tid < 64) kbv = dcref - dc2[64 * (j - 2) + tid]; }
        __syncthreads();
    }

    bf16_t* MIX = (bf16_t*)(p->ws + WS_MIX);
    float inv = 1.f;
    if (TY != 1) {
        float lt = swap_sum(lsum);
        if (part == 1) {
            __hip_atomic_store(pay, ((unsigned long long)__float_as_uint(lt) << 32) | __float_as_uint(m), __ATOMIC_RELAXED, __HIP_MEMORY_SCOPE_AGENT);
#pragma unroll
            for (int d0 = 0; d0 < 4; ++d0)
#pragma unroll
                for (int g = 0; g < 4; ++g)
                    __hip_atomic_store(pay + (1 + d0 * 4 + g) * 64, ((unsigned long long)cvtpk(o[d0][4 * g + 2], o[d0][4 * g + 3]) << 32) | cvtpk(o[d0][4 * g], o[d0][4 * g + 1]), __ATOMIC_RELAXED, __HIP_MEMORY_SCOPE_AGENT);
            asm volatile("s_waitcnt vmcnt(0)" ::: "memory");
            __syncthreads();
            if (tid == 0) __hip_atomic_store(aflag, 1u, __ATOMIC_RELAXED, __HIP_MEMORY_SCOPE_AGENT);
            __syncthreads();
            return;
        }
        if (split) {
            if (tid == 0) { unsigned sp = 0; while (__hip_atomic_load(aflag, __ATOMIC_RELAXED, __HIP_MEMORY_SCOPE_AGENT) == 0u && ++sp < (1u << 22)) __builtin_amdgcn_s_sleep(2);
                __builtin_amdgcn_fence(__ATOMIC_ACQUIRE, "agent"); asm volatile("s_waitcnt vmcnt(0)" ::: "memory"); }
            __syncthreads();
            const unsigned long long ml = __hip_atomic_load(pay, __ATOMIC_RELAXED, __HIP_MEMORY_SCOPE_AGENT);
            const float mf = __uint_as_float((unsigned)ml), lf = __uint_as_float((unsigned)(ml >> 32));
            const float mn = fmaxf(m, mf), a0 = fexp2(m - mn), a1 = fexp2(mf - mn);
            lt = a0 * lt + a1 * lf;
#pragma unroll
            for (int d0 = 0; d0 < 4; ++d0)
#pragma unroll
                for (int g = 0; g < 4; ++g) {
                    const unsigned long long w = __hip_atomic_load(pay + (1 + d0 * 4 + g) * 64, __ATOMIC_RELAXED, __HIP_MEMORY_SCOPE_AGENT);
                    const unsigned w0 = (unsigned)w, w1 = (unsigned)(w >> 32);
                    o[d0][4 * g] = a0 * o[d0][4 * g] + a1 * bf_lo(w0); o[d0][4 * g + 1] = a0 * o[d0][4 * g + 1] + a1 * bf_hi(w0);
                    o[d0][4 * g + 2] = a0 * o[d0][4 * g + 2] + a1 * bf_lo(w1); o[d0][4 * g + 3] = a0 * o[d0][4 * g + 3] + a1 * bf_hi(w1);
                }
        }
        inv = 1.f / lt;
    }
    float post = 1.f; const float* gain;
    if (TY == 0) {
        const float lam = ((const float*)(p->ws + WS_LAM))[l];
        LAS float* X = (LAS float*)lds + (size_t)rg * 128 * 32;
        if (br == 1) {
            const float sc = inv * lam;
#pragma unroll
            for (int d0 = 0; d0 < 4; ++d0)
#pragma unroll
                for (int r = 0; r < 16; ++r) X[(32 * d0 + KIDX(r) + 4 * hi) * 32 + r32] = o[d0][r] * sc;
        }
        __syncthreads();
        if (br == 0) {
#pragma unroll
            for (int d0 = 0; d0 < 4; ++d0)
#pragma unroll
                for (int r = 0; r < 16; ++r) o[d0][r] = o[d0][r] * inv - X[(32 * d0 + KIDX(r) + 4 * hi) * 32 + r32];
        }
        inv = 1.f;
        post = 1.f - (0.8f - 0.6f * fexp2(-0.3f * LOG2E * (float)l));
        gain = p->subln_diff + l * HD;
    } else if (TY == 1) gain = p->onorm_sb + l * HD;
    else gain = p->onorm_fox + l * HD;
    if (TY != 0 || br == 0) {
        float ss = 0.f;
#pragma unroll
        for (int d0 = 0; d0 < 4; ++d0)
#pragma unroll
            for (int r = 0; r < 16; ++r) { const float v = o[d0][r] * inv; ss += v * v; }
        ss = swap_sum(ss);
        const float sc = inv * post * __builtin_amdgcn_rsqf(ss * (1.f / HD) + EPS);
        bf16_t* orow = MIX + (size_t)trow * DM + hv * HD + 4 * hi;
#pragma unroll
        for (int d0 = 0; d0 < 4; ++d0)
#pragma unroll
            for (int g = 0; g < 4; ++g) {
                const f32x4 g4 = *(const f32x4*)(gain + 32 * d0 + 8 * g + 4 * hi);
                u32x2 w; w[0] = cvtpk(o[d0][4 * g] * sc * g4[0], o[d0][4 * g + 1] * sc * g4[1]); w[1] = cvtpk(o[d0][4 * g + 2] * sc * g4[2], o[d0][4 * g + 3] * sc * g4[3]);
                *(u32x2*)(orow + 32 * d0 + 8 * g) = w;
            }
    }
    __syncthreads();
}

constexpr int N_FAR = 5 * 24 + 2 * 48;
constexpr int N_ITEMS = N_FAR + 32 * 22;
__device__ __forceinline__ void attention_phase(KArgs p, int l, LAS unsigned char* lds, volatile LAS unsigned* itemw, int wv, int qi, int tmask = 7) {
    unsigned* q = (unsigned*)(p->ws + WS_CTL) + CW_ATTQ + qi * 64;
    for (;;) {
        if (otid(wv) == 0) *itemw = __hip_atomic_fetch_add(q, 1u, __ATOMIC_RELAXED, __HIP_MEMORY_SCOPE_AGENT);
        __syncthreads();
        int item = (int)*itemw;
        __syncthreads();
        if (item >= N_ITEMS) break;
        if (item < N_FAR) {
            if (item < 120) { if (tmask & 1) att_item<2>(p, l, item % 5, 31 - item / 5, lds, wv, 1); }
            else { const int i2 = item - 120; if (tmask & 2) att_item<0>(p, l, 5 - (i2 & 1), 63 - (i2 >> 1), lds, wv, 1); }
            continue;
        }
        item -= N_FAR;
        if (item < 288) { const int w = item % 9, pp = 31 - item / 9;
            if (w < 5) { if (tmask & 1) att_item<2>(p, l, w, pp, lds, wv); }
            else if (tmask & 2) att_item<0>(p, l, 5 - ((w - 5) >> 1), 2 * pp + 1 - ((w - 5) & 1), lds, wv); }
        else if (item < 544) { const int it2 = item - 288, w = it2 % 8, pp = 31 - it2 / 8;
            if (tmask & 2) att_item<0>(p, l, 3 - (w >> 1), 2 * pp + 1 - (w & 1), lds, wv); }
        else if (tmask & 4) { const int it3 = item - 544; att_item<1>(p, l, it3 % 5, 31 - it3 / 5, lds, wv); }
    }
}
}

__device__ __forceinline__ void phase_route(KArgs p, int l, LAS unsigned char* lds, int wv, int ci, bool waitp = true) {
    const int tid = otid(wv), lane = tid & 63, wave = tid >> 6;
    LAS float* wrt = (LAS float*)lds;
    LAS int* bsel = (LAS int*)(lds + 16 * DM * 4);
    LAS float* bsc = (LAS float*)(bsel + 64);
    LAS float* bgate = bsc + 64;
    LAS float* brs = bgate + 64;
    { const f32x4* src = (const f32x4*)(p->ws + WS_WRT); for (int i = tid; i < 16 * DM / 4; i += 512) ((LAS f32x4*)wrt)[i] = src[i]; }
    __syncthreads();
    bf16_t* XN = (bf16_t*)(p->ws + WS_XN);
    for (int blk = blockIdx.x; blk < SEQ / 32; blk += gridDim.x) {
        const int tid = otid(wv), lane = tid & 63, wave = tid >> 6;
        if (waitp) { if (wave == 0) {
            const unsigned* wc = (const unsigned*)(p->ws + WS_CTL) + CW_WOC + l * 32 * 64 + 64 * (blk >> 3);
            unsigned sp = 0;
            while ((unsigned)__builtin_amdgcn_readfirstlane((int)__hip_atomic_load(wc, __ATOMIC_RELAXED, __HIP_MEMORY_SCOPE_AGENT)) < 64u && ++sp < (1u << 22)) __builtin_amdgcn_s_sleep(2);
            __builtin_amdgcn_fence(__ATOMIC_ACQUIRE, "agent");
            asm volatile("s_waitcnt vmcnt(0)" ::: "memory");
            } __syncthreads(); }
        const int tb = blk * 32 + wave * 4;
        f32x4 hx[4][8];
#pragma unroll
        for (int i = 0; i < 4; ++i) { const u32x2* xr = (const u32x2*)((const bf16_t*)(p->ws + WS_OUTB) + (size_t)(tb + i) * DM) + lane;
#pragma unroll
            for (int j = 0; j < 8; ++j) { const u32x2 a = xr[64 * j]; hx[i][j] = (f32x4){bf_lo(a[0]), bf_hi(a[0]), bf_lo(a[1]), bf_hi(a[1])}; } }
#pragma unroll
        for (int i = 0; i < 4; ++i) {
            float ss = 0.f;
#pragma unroll
            for (int j = 0; j < 8; ++j) ss += (hx[i][j][0] * hx[i][j][0] + hx[i][j][1] * hx[i][j][1]) + (hx[i][j][2] * hx[i][j][2] + hx[i][j][3] * hx[i][j][3]);
            const float rstd = __builtin_amdgcn_rsqf(wave_sum(ss) * (1.f / DM) + EPS);
            if (lane == 0) brs[wave * 4 + i] = rstd;
            const f32x4* gr = (const f32x4*)(p->ffn_norm + (size_t)l * DM) + lane;
#pragma unroll
            for (int j = 0; j < 8; ++j) hx[i][j] = hx[i][j] * rstd * gr[64 * j];
        }
#pragma unroll
        for (int h2 = 0; h2 < 2; ++h2) {
            f32x4 (&hn)[2][8] = *reinterpret_cast<f32x4 (*)[2][8]>(&hx[2 * h2]);
            asm volatile("" ::: "memory"); __builtin_amdgcn_sched_barrier(0);
            float acc[32];
#pragma unroll
            for (int k = 0; k < 32; ++k) acc[k] = 0.f;
#pragma unroll
            for (int j = 0; j < 8; ++j)
#pragma unroll
                for (int eh = 0; eh < 2; ++eh) {
#pragma unroll
                    for (int e = 8 * eh; e < 8 * eh + 8; ++e) { const f32x4 w4 = *(const LAS f32x4*)(wrt + e * DM + 4 * lane + 256 * j);
#pragma unroll
                        for (int i = 0; i < 2; ++i) acc[i * 16 + e] += (hn[i][j][0] * w4[0] + hn[i][j][1] * w4[1]) + (hn[i][j][2] * w4[2] + hn[i][j][3] * w4[3]); }
                    __builtin_amdgcn_sched_barrier(0);
                }
#pragma unroll
            for (int k = 0; k < 32; ++k) acc[k] = sum_xor32(acc[k]);
#define RSTEP(H) { const bool up = (lane & H) != 0; _Pragma("unroll") for (int k = 0; k < H; ++k) { const float a = acc[k], b = acc[k + H]; const float give = up ? a : b, keep = up ? b : a; acc[k] = keep + swz_xor<H>(give); } }
            RSTEP(16) RSTEP(8) RSTEP(4) RSTEP(2) RSTEP(1)
#undef RSTEP
            const float logit = acc[0];
            const float score = __builtin_amdgcn_rcpf(1.f + fexp2(-logit * LOG2E));
            const float sel = score + p->router_bias[lane & 15];
            const float v1 = swz_xor<1>(sel), v2 = swz_xor<2>(sel), v3 = swz_xor<3>(sel);
            const float a = fmaxf(sel, v1), b = fminf(sel, v1), c = fmaxf(v2, v3), d = fminf(v2, v3);
            const float gs = fmaxf(a, c) + fmaxf(fminf(a, c), fmaxf(b, d));
            const float g1 = swz_xor<4>(gs), g2 = swz_xor<8>(gs), g3 = swz_xor<12>(gs);
            const int myg = (lane >> 2) & 3, k = lane & 3;
            const bool best = (gs > g1 || (gs == g1 && myg < (myg ^ 1))) && (gs > g2 || (gs == g2 && myg < (myg ^ 2))) && (gs > g3 || (gs == g3 && myg < (myg ^ 3)));
            const int rank = ((v1 > sel || (v1 == sel && (k ^ 1) < k)) ? 1 : 0) + ((v2 > sel || (v2 == sel && (k ^ 2) < k)) ? 1 : 0) + ((v3 > sel || (v3 == sel && (k ^ 3) < k)) ? 1 : 0);
            if (best && rank < 2 && lane < 32) { const int row = wave * 4 + h2 * 2 + (lane >> 4); bsel[row * 2 + rank] = lane & 15; bsc[row * 2 + rank] = score; }
        }
        asm volatile("s_waitcnt lgkmcnt(0)" ::: "memory");
        if (lane < 8) { const int idx = wave * 8 + lane; const float sm = bsc[idx], so = bsc[idx ^ 1]; bgate[idx] = sm / (sm + so); }
        __syncthreads();
        if (wave == 0) {
            unsigned* cnt = (unsigned*)(p->ws + WS_CTL) + CW_CNT + ci * 16 * 64;
            const int mye = bsel[lane]; int myrank = 0, n = 0;
            const unsigned long long below = (1ull << lane) - 1ull;
#pragma unroll
            for (int e = 0; e < 16; ++e) { const unsigned long long mk = __ballot(mye == e); if (mye == e) myrank = (int)__popcll(mk & below); if (lane == e) n = (int)__popcll(mk); }
            int base = 0;
            if (lane < 16 && n) base = (int)__hip_atomic_fetch_add(cnt + lane * 64, (unsigned)n, __ATOMIC_RELAXED, __HIP_MEMORY_SCOPE_AGENT);
            const int pos = __builtin_amdgcn_ds_bpermute(mye << 2, base) + myrank, tok = blk * 32 + (lane >> 1);
            ((int*)(p->ws + WS_TOK))[mye * SEQ + pos] = tok; ((f32x2_t*)(p->ws + WS_GATE))[mye * SEQ + pos] = (f32x2_t){bgate[lane], brs[lane >> 1]};
            int* ts = (int*)(p->ws + WS_TSEL) + tok * 4 + (lane & 1) * 2; ts[0] = mye; ts[1] = pos;
        }
        __syncthreads();
    }
}

__device__ __forceinline__ void moe_table(KArgs p, int l, LAS int* tbl, int wv) {
    if (otid(wv) == 0) { const unsigned* cnt = (const unsigned*)(p->ws + WS_CTL) + CW_CNT + l * 16 * 64; int acc = 0;
        for (int e = 0; e < 16; ++e) { const int n = (int)cnt[e * 64]; tbl[e] = acc; tbl[17 + e] = n; acc += (n + 255) >> 8; } tbl[16] = acc; }
    __syncthreads();
}

constexpr int N_PHASES = 2 + 7 * DEPTH;
__device__ __forceinline__ int opq(int v) { asm volatile("" : "+s"(v)); return v; }
__device__ __forceinline__ LAS unsigned char* opq(LAS unsigned char* v) { unsigned x = (unsigned)(uintptr_t)v; asm volatile("" : "+s"(x)); return (LAS unsigned char*)(uintptr_t)x; }
__global__ void __launch_bounds__(512, 2) trunk_fwd(Params pk) {
    extern __shared__ __attribute__((aligned(16))) unsigned char lds_raw[];
    LAS unsigned char* lds = (LAS unsigned char*)lds_raw;
    volatile LAS unsigned* MISC = (volatile LAS unsigned*)(lds + MISC_OFF);
    LAS int* mtbl = (LAS int*)(lds + MISC_OFF + 256);
#define p kparams()
    const int wv = __builtin_amdgcn_readfirstlane((int)threadIdx.x >> 6);
    for (int u = threadIdx.x; u < (LDS_BYTES - MISC_OFF) / 4; u += 512) ((LAS unsigned*)(lds + MISC_OFF))[u] = 0u;
    __syncthreads();
    unsigned* ctl = (unsigned*)(p->ws + WS_CTL);
    XcdBarrier bar; bar.bar = ctl + CW_BAR; bar.x = 0; bar.st = nullptr; bar.wv = wv;
    const bool multi = (p->ph_hi - p->ph_lo) > 1;
    if (multi) bar = xcd_barrier_post(ctl + CW_BAR, MISC + 8, wv);
    const int lo = p->ph_lo, hi = p->ph_hi;
#define IN(k) (lo <= (k) && (k) < hi)
#define SEAM(k) do { if (IN(k) && IN((k) + 1)) xcd_barrier(bar); } while (0)
    const int G0 = gridDim.x, c0 = blockIdx.x; LAS unsigned char* const lds0 = lds;
#define PHASE_LOCALS const int G = opq(G0), c = opq(c0); LAS unsigned char* const lds = opq(lds0); LAS int* const mtbl = (LAS int*)(lds + MISC_OFF + 256); volatile LAS unsigned* const MISC = (volatile LAS unsigned*)(lds + MISC_OFF); (void)G; (void)c; (void)mtbl; (void)MISC;

    if (PK(0) && IN(0)) { PHASE_LOCALS phase_prologue(p, lds, wv); if (DUP_PHASE == 0) { __syncthreads(); phase_prologue(p, lds, wv); } SEAM(0); }
    for (int l = 0; l < DEPTH; ++l) {
        const int pb = 1 + 7 * l;
        if (PK(1) && IN(pb + 0)) { PHASE_LOCALS phase_norm1(p, l, lds, wv); if (DUP_PHASE == 1) { xcd_barrier(bar); phase_norm1(p, l, lds, wv, true); } SEAM(pb + 0); }
        if (PK(2) && IN(pb + 1)) { PHASE_LOCALS
            if (c < H_FOX) scan_head(p, c, l, lds, wv);
            for (int rep = 0; rep < (DUP_PHASE == 2 ? 2 : 1); ++rep) {
            { pg8::Gemm g{(const bf16_t*)(p->ws + (FP8_PROJ ? WS_OUTB8 : WS_OUTB)), (const bf16_t*)(p->ws + WS_WQK + (size_t)l * NQK * DM * (FP8_PROJ ? 1 : 2)), SEQ, NQK, FP8_PROJ ? DM / 2 : DM};
              pg8::StaticOrder S; S.init(SEQ, NQK, G, c);
              pg8::EpiQK E{(bf16_t*)(p->ws + WS_QKB), p->qnorm_diff + l * 64, p->knorm_diff + l * 64, p->qnorm_fox + l * 128, p->knorm_fox + l * 128, (LAS float*)(lds + TBL_OFF), (const float*)(p->ws + WS_RSTD)};
              pg8::gemm_phase<pg8::EpiQK, pg8::StaticOrder>(lds, g, S, E, wv); }
            { pg8::Gemm g{(const bf16_t*)(p->ws + WS_WV + (size_t)l * NV * DM * (FP8_PROJ ? 1 : 2)), (const bf16_t*)(p->ws + (FP8_PROJ ? WS_OUTB8 : WS_OUTB)), NV, SEQ, FP8_PROJ ? DM / 2 : DM};
              pg8::StaticOrder S; S.init(NV, SEQ, G, c);
              pg8::EpiVT E{(bf16_t*)(p->ws + WS_VT), SEQ, (const float*)(p->ws + WS_RSTD)};
              pg8::gemm_phase<pg8::EpiVT, pg8::StaticOrder>(lds, g, S, E, wv); }
            }
            SEAM(pb + 1);
        }
        if (PK(3) && IN(pb + 2)) { PHASE_LOCALS att::attention_phase(p, l, lds, MISC + 16, wv, l); if (DUP_PHASE == 3) { __syncthreads(); att::attention_phase(p, l, lds, MISC + 16, wv, l + 4, ATT_MASK2); } SEAM(pb + 2); }
        if (PK(4) && IN(pb + 3)) { PHASE_LOCALS
            pg8::Gemm g{(const bf16_t*)(p->ws + WS_MIX), (const bf16_t*)(p->ws + WS_WO) + (size_t)l * DM * DM, SEQ, DM, DM};
            pg8::StaticOrder S; S.init(SEQ, DM, G, c);
            pg8::EpiResAdd E{(bf16_t*)(p->ws + WS_OUTB), 1.f, (unsigned*)(p->ws + WS_CTL) + CW_WOC + l * 32 * 64, p->ws + WS_OUTB8};
            pg8::gemm_phase<pg8::EpiResAdd, pg8::StaticOrder>(lds, g, S, E, wv);
        }
        if (PK(5) && IN(pb + 4)) { PHASE_LOCALS phase_route(p, l, lds, wv, l); if (DUP_PHASE == 5) { xcd_barrier(bar); phase_route(p, l, lds, wv, l + 4); } SEAM(pb + 4); }
        if (PK(6) && IN(pb + 5)) { PHASE_LOCALS
            moe_table(p, l, mtbl, wv);
            pg8::Gemm g{(const bf16_t*)(p->ws + WS_OUTB8), (const bf16_t*)(p->ws + WS_WGU + (size_t)l * NEXP * 1024 * DM), MOE_ROWS, NEXP * 1024, DM / 2};
            pg8::MoeOrder<4, true> S{mtbl, (const int*)(p->ws + WS_TOK), G, c, DM / 2};
            pg8::EpiGU E{p->ws + WS_ACT, (const float*)(p->ws + WS_GATE), mtbl, (unsigned*)(p->ws + WS_CTL) + CW_GUC + l * 80 * 64};
            for (int rep = 0; rep < (DUP_PHASE == 6 ? 2 : 1); ++rep)
            pg8::gemm_phase<pg8::EpiGU, pg8::MoeOrder<4, true>>(lds, g, S, E, wv);
        }
        if (PK(7) && IN(pb + 6)) { PHASE_LOCALS
            moe_table(p, l, mtbl, wv);
            pg8::Gemm g{(const bf16_t*)(p->ws + WS_ACT), (const bf16_t*)(p->ws + WS_WD + (size_t)l * NEXP * DM * FEXP), MOE_ROWS, NEXP * DM, FEXP / 2};
            pg8::DownOrder S{mtbl, (unsigned*)(p->ws + WS_CTL) + CW_GUC + l * 80 * 64, (unsigned*)(p->ws + WS_CTL) + CW_BAR + XB_TMO, G, c};
            pg8::EpiDown E{(bf16_t*)(p->ws + WS_Y)};
            pg8::gemm_phase<pg8::EpiDown, pg8::DownOrder>(lds, g, S, E, wv);
            SEAM(pb + 6);
        }
    }
    if (PK(1) && IN(N_PHASES - 1)) { PHASE_LOCALS phase_norm1(p, DEPTH, lds, wv); }
#undef IN
#undef SEAM
#undef PHASE_LOCALS
#undef p
}

extern "C" void kernel_launch(void* const* d_in, const int* in_sizes, int n_in, void* d_out, int out_size, void* d_ws, size_t ws_size, hipStream_t stream) {
    static int grid = 0;
    if (grid == 0) {
        if (n_in != 22 || in_sizes[0] != SEQ * DM || out_size != SEQ * DM || ws_size < WS_END) {
            fprintf(stderr, "kernel_launch: unexpected shapes (n_in %d, in0 %d, out %d, ws %zu < %zu); nothing launched\n", n_in, n_in > 0 ? in_sizes[0] : -1, out_size, ws_size, (size_t)WS_END); grid = -1; return; }
        int dev = 0, cus = 0, per_cu = 0;
        if (hipGetDevice(&dev) != hipSuccess || hipDeviceGetAttribute(&cus, hipDeviceAttributeMultiprocessorCount, dev) != hipSuccess) { grid = -1; return; }
        if (hipFuncSetAttribute((const void*)trunk_fwd, hipFuncAttributeMaxDynamicSharedMemorySize, LDS_BYTES) != hipSuccess) { fprintf(stderr, "kernel_launch: hipFuncSetAttribute failed\n"); grid = -1; return; }
        if (hipOccupancyMaxActiveBlocksPerMultiprocessor(&per_cu, (const void*)trunk_fwd, 512, LDS_BYTES) != hipSuccess || per_cu < 1)
            fprintf(stderr, "kernel_launch: note: occupancy query reports %d workgroups per CU\n", per_cu);
        (void)hipGetLastError();
        grid = cus;
    }
    if (grid < 0) return;
    if (hipMemsetAsync((char*)d_ws + WS_CTL, 0, CTL_ZERO_BYTES, stream) != hipSuccess) { fprintf(stderr, "kernel_launch: memset failed\n"); return; }
    Params hp{};
    const float** pp = (const float**)&hp;
    for (int i = 0; i < 22; ++i) pp[i] = (const float*)d_in[i];
    hp.out = (float*)d_out; hp.ws = (unsigned char*)d_ws;
#if MK_ONE_LAUNCH
    hp.ph_lo = 0; hp.ph_hi = N_PHASES;
    hipLaunchKernelGGL(trunk_fwd, dim3(grid), dim3(512), LDS_BYTES, stream, hp);
#else
    for (int ph = 0; ph < N_PHASES; ++ph) { hp.ph_lo = ph; hp.ph_hi = ph + 1; hipLaunchKernelGGL(trunk_fwd, dim3(grid), dim3(512), LDS_BYTES, stream, hp); }
#endif
    const hipError_t le = hipPeekAtLastError();
    if (le != hipSuccess) fprintf(stderr, "kernel_launch: launch failed: %s\n", hipGetErrorName(le));
}
```

```cpp
#include <hip/hip_runtime.h>
#include <cstdio>
#include <cstdint>

#ifndef MK_ONE_LAUNCH
#define MK_ONE_LAUNCH 1
#endif
#ifndef PHASE_MASK
#define PHASE_MASK 0xff
#endif
#define PK(k) (((PHASE_MASK) >> (k)) & 1)
#ifndef FP8_PROJ
#define FP8_PROJ 1
#endif
#ifndef FP8_WOUT
#define FP8_WOUT 1
#endif
#ifndef DUP_PHASE
#define DUP_PHASE -1
#endif
#ifndef ATT_MASK2
#define ATT_MASK2 7
#endif
#ifndef SKIP_A
#define SKIP_A 1
#endif
#ifndef SKIP_B
#define SKIP_B 3
#endif
#ifndef SKIP_C
#define SKIP_C 1
#endif

#define GAS __attribute__((address_space(1)))
#define LAS __attribute__((address_space(3)))
typedef unsigned short bf16_t;
typedef short bf16x8 __attribute__((ext_vector_type(8)));
typedef float f32x4 __attribute__((ext_vector_type(4)));
typedef float f32x16 __attribute__((ext_vector_type(16)));
typedef unsigned u32x4 __attribute__((ext_vector_type(4)));
typedef unsigned u32x2 __attribute__((ext_vector_type(2)));
typedef int i32x4 __attribute__((ext_vector_type(4)));

constexpr int SEQ = 8192, DM = 2048, DEPTH = 4, NQK = 4096, NV = 2048, NEXP = 16, FEXP = 512, NIN = 6149;
constexpr int HD = 128, H_DIFF = 6, H_SB = 5, H_FOX = 5;
constexpr float EPS = 1e-6f;
constexpr float LOG2E = 1.4426950408889634f;
constexpr int MOE_ROWS = 16384 + 16 * 256;

constexpr size_t MiB = 1u << 20;
constexpr size_t WS_CTL = 0, CTL_ZERO_BYTES = 1 * MiB;
constexpr size_t WS_WF = 1 * MiB;
constexpr size_t WS_LAM = 1 * MiB + 512 * 1024;
constexpr size_t WS_LOGF = 2 * MiB;
constexpr size_t WS_DC2 = 3 * MiB;
constexpr size_t WS_TOK = 4 * MiB;
constexpr size_t WS_GATE = 5 * MiB;
constexpr size_t WS_TSEL = 6 * MiB;
constexpr size_t WS_WRT = 7 * MiB;
constexpr size_t WS_RSTD = 8 * MiB;
constexpr size_t WS_WQK = 16 * MiB;
constexpr size_t WS_WV = 80 * MiB;
constexpr size_t WS_WO = 112 * MiB;
constexpr size_t WS_WGU = 144 * MiB;
constexpr size_t WS_WD = 400 * MiB;
constexpr size_t WS_XN = 528 * MiB;
constexpr size_t WS_QKB = 560 * MiB;
constexpr size_t WS_VT = 624 * MiB;
constexpr size_t WS_MIX = 656 * MiB;
constexpr size_t WS_ACT = 688 * MiB;
constexpr size_t WS_Y = 708 * MiB;
constexpr size_t WS_PART = 788 * MiB;
constexpr size_t WS_OUTB = 828 * MiB;
constexpr size_t WS_OUTB8 = 862 * MiB;
constexpr size_t WS_END = 878 * MiB;
constexpr int CW_BAR = 4096;
constexpr int CW_ATTQ = 16384;
constexpr int CW_CNT = 32768;
constexpr int CW_AFLAG = 65536;
constexpr int CW_WOC = 233472;
constexpr int CW_GUC = 212992;

constexpr int RING_BYTES = 131072;
constexpr int TBL_OFF = RING_BYTES;
constexpr int MISC_OFF = RING_BYTES + 8192;
constexpr int LDS_BYTES = 147456;

typedef float f32x2_t __attribute__((ext_vector_type(2)));
typedef __bf16 bf16x2_t __attribute__((ext_vector_type(2)));
typedef int i32x8 __attribute__((ext_vector_type(8)));
__device__ __forceinline__ unsigned cvt4f8(float a, float b, float c, float d) {
    int w = 0; w = __builtin_amdgcn_cvt_pk_fp8_f32(a, b, w, false); w = __builtin_amdgcn_cvt_pk_fp8_f32(c, d, w, true); return (unsigned)w; }
constexpr float W8_SCALE = 256.f, ACT8_SCALE = 4.f;
__device__ __forceinline__ unsigned cvtpk(float lo, float hi) { const f32x2_t v = {lo, hi}; const bf16x2_t b = __builtin_convertvector(v, bf16x2_t); return __builtin_bit_cast(unsigned, b); }
__device__ __forceinline__ float bf_lo(unsigned u) { return __uint_as_float(u << 16); }
__device__ __forceinline__ float bf_hi(unsigned u) { return __uint_as_float(u & 0xffff0000u); }
__device__ __forceinline__ float fexp2(float x) { return __builtin_amdgcn_exp2f(x); }
__device__ __forceinline__ float flog2(float x) { return __builtin_amdgcn_logf(x); }
__device__ __forceinline__ int otid(int wv) { int t; asm volatile("v_mbcnt_lo_u32_b32 %0, -1, 0\n\tv_mbcnt_hi_u32_b32 %0, -1, %0" : "=v"(t)); return wv * 64 + t; }
template <int M> __device__ __forceinline__ float swz_xor(float v) { return __int_as_float(__builtin_amdgcn_ds_swizzle(__float_as_int(v), 0x1F | (M << 10))); }
__device__ __forceinline__ float sum_xor32(float v) { auto rr = __builtin_amdgcn_permlane32_swap(__float_as_uint(v), __float_as_uint(v), false, false); return __uint_as_float(rr[0]) + __uint_as_float(rr[1]); }
__device__ __forceinline__ float wave_sum(float v) {
    v += swz_xor<1>(v); v += swz_xor<2>(v); v += swz_xor<4>(v); v += swz_xor<8>(v); v += swz_xor<16>(v);
    return sum_xor32(v);
}

namespace pg8 {
constexpr int BM = 256, BK = 64, HALF = 128, HTB = HALF * BK * 2, STAGE_BYTES = 8 * HTB, NXCD = 8, WGM = 8;
__host__ __device__ __forceinline__ int lds_byte(int r, int c) { const int st = (r >> 4) * 2 + (c >> 5), rr = r & 15, cc = c & 31, ob = rr * 64 + cc * 2; return st * 1024 + (ob ^ (((ob >> 9) & 1) << 5)); }
__host__ __device__ __forceinline__ void stage_rc(int b, int& R, int& C) { const int st = b / 1024, sb = b % 1024, swz = sb ^ (((sb >> 9) & 1) << 5); R = (st >> 1) * 16 + swz / 64; C = (st & 1) * 32 + (swz % 64) / 2; }
__host__ __device__ __forceinline__ int perm32(int rho) { const int n = rho >> 4, i = rho & 15; return 8 * (i >> 2) + 4 * n + (i & 3); }
__host__ __device__ __forceinline__ int permV(int rho) { const int n = rho >> 4, i = rho & 15; return 16 * (i >> 3) + 8 * n + (i & 7); }
template <int P> __host__ __device__ __forceinline__ int permf(int rho) { return P == 1 ? perm32(rho) : (P == 2 ? permV(rho) : rho); }

struct Unit { int pm, pn, e, rt; };
struct Gemm { const bf16_t* A; const bf16_t* Bt; int M, N, K; };

struct StaticOrder {
    int nM, nN, nwg, G, c;
    __device__ void init(int M, int N, int G_, int c_) { nM = M / BM; nN = N / BM; nwg = nM * nN; G = G_; c = c_; }
    __device__ bool next(int i, Unit& u) const {
        const long L = (long)i * G + c; if (L >= nwg) return false;
        int wgid = (int)L; { const int q = nwg / NXCD, r = nwg % NXCD, xcd = wgid % NXCD, off = wgid / NXCD; wgid = (xcd < r ? xcd * (q + 1) : r * (q + 1) + (xcd - r) * q) + off; }
        const int nig = WGM * nN, gid = wgid / nig, fm = gid * WGM, gsz = (nM - fm) < WGM ? (nM - fm) : WGM;
        u.pm = fm + ((wgid % nig) % gsz); u.pn = (wgid % nig) / gsz; u.e = 0; u.rt = 0; return true;
    }
    __device__ __forceinline__ size_t a_base(const Unit& u, size_t tstep) const { return (size_t)u.pm * tstep; }
    __device__ __forceinline__ unsigned row_off(const Unit&, int r, int K) const { return (unsigned)(r * K) * 2u; }
    __device__ __forceinline__ void a_ready(const Unit&, int) const {}
};

template <int NCT, bool GATHER> struct MoeOrder {
    const LAS int* tbl; const int* tok; int G, c, K;
    __device__ bool next(int i, Unit& u) const {
        const int L = i * G + c, total = __builtin_amdgcn_readfirstlane(tbl[16]) * NCT; if (L >= total) return false;
        const int g = L / NCT, ct = L % NCT; int e = 0;
#pragma unroll
        for (int k = 1; k < 16; ++k) e += (g >= tbl[k]) ? 1 : 0;
        e = __builtin_amdgcn_readfirstlane(e);
        u.pm = g; u.pn = e * NCT + ct; u.e = e; u.rt = __builtin_amdgcn_readfirstlane(g - tbl[e]); return true;
    }
    __device__ __forceinline__ size_t a_base(const Unit& u, size_t tstep) const { return GATHER ? 0 : (size_t)u.pm * tstep; }
    __device__ __forceinline__ unsigned row_off(const Unit& u, int r, int K_) const {
        if (!GATHER) return (unsigned)(r * K_) * 2u;
        const int pos = u.rt * 256 + r; const int n = __builtin_amdgcn_readfirstlane(tbl[17 + u.e]);
        const int t = pos < n ? tok[u.e * SEQ + pos] : 0;
        return (unsigned)(t * K_) * 2u;
    }
    __device__ __forceinline__ void a_ready(const Unit&, int) const {}
};

struct DownOrder {
    const LAS int* tbl; unsigned* cnt; unsigned* tmo; int G, c;
    __device__ bool next(int i, Unit& u) const {
        const int T = __builtin_amdgcn_readfirstlane(tbl[16]);
        const int U1 = 4 * T, nb2 = U1 > G ? U1 - G : 0, F = G - nb2;
        const int g1 = T < (G >> 2) ? T : (G >> 2), E = 8 * g1, Lt = 8 * (T - g1);
        int k = -1, late = 0;
        int ii = i;
        if (c >= nb2) { const int cf = c - nb2; const int nE = E > cf ? (E - cf + F - 1) / F : 0; if (ii < nE) k = cf + ii * F; else ii -= nE; }
        int g, ct;
        if (k >= 0) { g = k >> 3; ct = k & 7; }
        else { const int k0 = (c - nb2 + G) % G; const int kk = k0 + ii * G; if (kk >= Lt) return false; g = g1 + (kk >> 3); ct = kk & 7; late = 1; }
        (void)late;
        int e = 0;
#pragma unroll
        for (int q = 1; q < 16; ++q) e += (g >= tbl[q]) ? 1 : 0;
        e = __builtin_amdgcn_readfirstlane(e);
        u.pm = g; u.pn = e * 8 + ct; u.e = e; u.rt = __builtin_amdgcn_readfirstlane(g - tbl[e]); return true;
    }
    __device__ __forceinline__ size_t a_base(const Unit& u, size_t tstep) const { return (size_t)u.pm * tstep; }
    __device__ __forceinline__ unsigned row_off(const Unit&, int r, int K_) const { return (unsigned)(r * K_) * 2u; }
    __device__ __forceinline__ void a_ready(const Unit& u, int wid) const {
        if (wid == 0) {
            unsigned sp = 0;
            while ((unsigned)__builtin_amdgcn_readfirstlane((int)__hip_atomic_load(cnt + 64 * u.pm, __ATOMIC_RELAXED, __HIP_MEMORY_SCOPE_AGENT)) < 32u) {
                __builtin_amdgcn_s_sleep(2);
                if (++sp > (1u << 22)) { __hip_atomic_store(tmo, 1u, __ATOMIC_RELAXED, __HIP_MEMORY_SCOPE_AGENT); break; }
            }
            __builtin_amdgcn_fence(__ATOMIC_ACQUIRE, "agent");
            asm volatile("s_waitcnt vmcnt(0)" ::: "memory");
        }
        asm volatile("" ::: "memory"); __builtin_amdgcn_s_barrier(); asm volatile("" ::: "memory");
    }
};

template <class Epi, class Sched, bool SP2 = true>
__device__ __forceinline__ void gemm_phase(LAS unsigned char* lds, const Gemm g, const Sched& S, const Epi& E, int wv) {
    const int tid = otid(wv), wid = __builtin_amdgcn_readfirstlane(tid >> 6), lane = tid & 63, wr = wid >> 2, wc = wid & 3, fr = lane & 15, fq = lane >> 4;
    const int K = g.K, nt = K / BK;
    unsigned voffB[2]; int Rr[2], Cc[2];
#pragma unroll
    for (int i = 0; i < 2; ++i) { int R, C; stage_rc(tid * 16 + i * 8192, R, C); const int Rb = (R & ~31) + permf<Epi::PERM>(R & 31);
        Rr[i] = R; Cc[i] = C; voffB[i] = (unsigned)(Rb * K + C) * 2u; }
    const size_t kstep = (size_t)(BK * 2);
    const size_t hstep = (size_t)HALF * K * 2;
    const size_t tstep = 2 * hstep;
    const unsigned ldsw = (unsigned)wid * 1024u;
    const int aoff = lds_byte(wr * 64 + fr, fq * 8), boff = lds_byte(wc * 32 + fr, fq * 8);
#define PG8_SA(b, h) (((b) * 2 + (h)) * HTB)
#define PG8_SB(b, h) ((4 + (b) * 2 + (h)) * HTB)
#define PG8_STAGE(bufoff, gbase, voff) do { _Pragma("unroll") for (int _i = 0; _i < 2; ++_i) \
        __builtin_amdgcn_global_load_lds((const unsigned*)((const char*)(gbase) + (voff)[_i]), (LAS unsigned*)(lds + (bufoff) + ldsw + _i * 8192), 16, 0, 0); } while (0)
#define PG8_LDA(dst, b, h) do { _Pragma("unroll") for (int m = 0; m < 4; ++m) _Pragma("unroll") for (int k = 0; k < 2; ++k) dst[m][k] = *(const LAS bf16x8*)(lds + PG8_SA(b, h) + aoff + m * 2048 + k * 1024); } while (0)
#define PG8_LDB(dst, b, h) do { _Pragma("unroll") for (int n = 0; n < 2; ++n) _Pragma("unroll") for (int k = 0; k < 2; ++k) dst[n][k] = *(const LAS bf16x8*)(lds + PG8_SB(b, h) + boff + n * 2048 + k * 1024); } while (0)
#define PG8_CAT(x) __builtin_shufflevector(__builtin_bit_cast(i32x4, (x)[0]), __builtin_bit_cast(i32x4, (x)[1]), 0, 1, 2, 3, 4, 5, 6, 7)
#define PG8_MMA(ai, bj, At, Bt) do { __builtin_amdgcn_s_setprio(1); \
        if constexpr (Epi::FP8) { _Pragma("unroll") for (int m = 0; m < 4; ++m) _Pragma("unroll") for (int n = 0; n < 2; ++n) \
            asm volatile("v_mfma_scale_f32_16x16x128_f8f6f4 %0, %1, %2, %0, %3, %3 op_sel_hi:[0,0,0]" : "+v"(acc[ai][bj][m][n]) : "v"(PG8_CAT(Bt[n])), "v"(PG8_CAT(At[m])), "v"(one8)); } \
        else { _Pragma("unroll") for (int m = 0; m < 4; ++m) _Pragma("unroll") for (int n = 0; n < 2; ++n) _Pragma("unroll") for (int k = 0; k < 2; ++k) \
            acc[ai][bj][m][n] = __builtin_amdgcn_mfma_f32_16x16x32_bf16(Bt[n][k], At[m][k], acc[ai][bj][m][n], 0, 0, 0); } \
        __builtin_amdgcn_s_setprio(0); } while (0)
#define PG8_WAIT_V(n) asm volatile("s_waitcnt vmcnt(" #n ")" ::: "memory")
#define PG8_WAIT_L(n) asm volatile("s_waitcnt lgkmcnt(" #n ")" ::: "memory")
#define PG8_BAR __builtin_amdgcn_s_barrier()
#define PG8_SCHED __builtin_amdgcn_sched_barrier(0)
    Unit cur, nxt; int ui = 0;
    if (!S.next(0, cur)) return;
    const unsigned one8 = 0x7F7F7F7Fu;
    (void)one8;
    f32x4 acc[2][2][4][2];
    if constexpr (Epi::LOAD_INIT) E.init(acc, cur, wr, wc, fr, fq);
    else {
#pragma unroll
    for (int a = 0; a < 2; ++a)
#pragma unroll
        for (int b = 0; b < 2; ++b)
#pragma unroll
            for (int m = 0; m < 4; ++m)
#pragma unroll
                for (int n = 0; n < 2; ++n) acc[a][b][m][n] = (f32x4){0.f, 0.f, 0.f, 0.f};
    }
    bf16x8 At[4][2], B0[2][2], B1[2][2];
    unsigned oc[2][2], on[2][2];
#pragma unroll
    for (int h = 0; h < 2; ++h)
#pragma unroll
        for (int i = 0; i < 2; ++i) { oc[h][i] = S.row_off(cur, h * HALF + Rr[i], K) + (unsigned)Cc[i] * 2u; on[h][i] = oc[h][i]; }
    const char* cA = (const char*)g.A + S.a_base(cur, tstep); const char* cB = (const char*)g.Bt + (size_t)cur.pn * tstep;
    S.a_ready(cur, wid);
    if constexpr (SP2) {
        PG8_STAGE(PG8_SB(0, 0), cB, voffB); PG8_STAGE(PG8_SB(0, 1), cB + hstep, voffB); PG8_STAGE(PG8_SA(0, 0), cA, oc[0]); PG8_STAGE(PG8_SA(0, 1), cA, oc[1]);
        if (wr == 1) PG8_BAR;
        PG8_WAIT_V(2); PG8_BAR;
        PG8_STAGE(PG8_SB(1, 0), cB + kstep, voffB); PG8_STAGE(PG8_SA(1, 0), cA + kstep, oc[0]); PG8_STAGE(PG8_SB(1, 1), cB + hstep + kstep, voffB);
        PG8_WAIT_V(6); PG8_BAR;
    } else {
        PG8_STAGE(PG8_SB(0, 0), cB, voffB); PG8_STAGE(PG8_SA(0, 0), cA, oc[0]); PG8_STAGE(PG8_SB(0, 1), cB + hstep, voffB); PG8_STAGE(PG8_SA(0, 1), cA, oc[1]);
        if (wr == 1) PG8_BAR;
        PG8_WAIT_V(4); PG8_BAR;
        PG8_STAGE(PG8_SB(1, 0), cB + kstep, voffB); PG8_STAGE(PG8_SA(1, 0), cA + kstep, oc[0]); PG8_STAGE(PG8_SB(1, 1), cB + hstep + kstep, voffB);
        PG8_WAIT_V(6); PG8_BAR;
    }
    for (;;) {
        const bool has_next = S.next(ui + 1, nxt);
        const char* nA = has_next ? (const char*)g.A + S.a_base(nxt, tstep) : cA; const char* nB = has_next ? (const char*)g.Bt + (size_t)nxt.pn * tstep : cB;
        if (has_next) {
#pragma unroll
            for (int h = 0; h < 2; ++h)
#pragma unroll
                for (int i = 0; i < 2; ++i) on[h][i] = S.row_off(nxt, h * HALF + Rr[i], K) + (unsigned)Cc[i] * 2u;
        }
        for (int t = 0; t < nt; t += 2) {
            const bool last = (t == nt - 2);
            if (last && has_next) S.a_ready(nxt, wid);
            const char* a1 = cA + (size_t)(t + 1) * kstep;
            const char* a2 = last ? nA : cA + (size_t)(t + 2) * kstep; const char* b2 = last ? nB : cB + (size_t)(t + 2) * kstep;
            const char* a3 = a2 + kstep; const char* b3 = b2 + kstep;
            unsigned o2a[2], o2b[2];
            o2a[0] = last ? on[0][0] : oc[0][0]; o2a[1] = last ? on[0][1] : oc[0][1]; o2b[0] = last ? on[1][0] : oc[1][0]; o2b[1] = last ? on[1][1] : oc[1][1];
            if constexpr (SP2) {
            PG8_LDB(B0, 0, 0); PG8_LDB(B1, 0, 1); PG8_SCHED; PG8_LDA(At, 0, 0); PG8_STAGE(PG8_SA(1, 1), a1, oc[1]);
            PG8_WAIT_V(8); PG8_WAIT_L(0); PG8_BAR; PG8_MMA(0, 0, At, B0); PG8_MMA(0, 1, At, B1); PG8_BAR; PG8_SCHED;
            PG8_LDA(At, 0, 1); PG8_STAGE(PG8_SB(0, 0), b2, voffB); PG8_STAGE(PG8_SB(0, 1), b2 + hstep, voffB); PG8_STAGE(PG8_SA(0, 0), a2, o2a);
            PG8_WAIT_V(8); PG8_WAIT_L(0); PG8_BAR; PG8_MMA(1, 0, At, B0); PG8_MMA(1, 1, At, B1); PG8_BAR; PG8_SCHED;
            PG8_LDB(B0, 1, 0); PG8_LDB(B1, 1, 1); PG8_SCHED; PG8_LDA(At, 1, 0); PG8_STAGE(PG8_SA(0, 1), a2, o2b);
            PG8_WAIT_V(8); PG8_WAIT_L(0); PG8_BAR; PG8_MMA(0, 0, At, B0); PG8_MMA(0, 1, At, B1); PG8_BAR; PG8_SCHED;
            PG8_LDA(At, 1, 1); PG8_STAGE(PG8_SB(1, 0), b3, voffB); PG8_STAGE(PG8_SB(1, 1), b3 + hstep, voffB); PG8_STAGE(PG8_SA(1, 0), a3, o2a);
            PG8_WAIT_V(8); PG8_WAIT_L(0); PG8_BAR; PG8_MMA(1, 0, At, B0); PG8_MMA(1, 1, At, B1); PG8_BAR; PG8_SCHED;
            } else {
            PG8_LDB(B0, 0, 0); PG8_SCHED; PG8_LDA(At, 0, 0); PG8_STAGE(PG8_SA(1, 1), a1, oc[1]);
            PG8_WAIT_L(8); PG8_BAR; PG8_WAIT_L(0); PG8_MMA(0, 0, At, B0); PG8_BAR; PG8_SCHED;
            PG8_LDB(B1, 0, 1); PG8_STAGE(PG8_SB(0, 0), b2, voffB);
            PG8_BAR; PG8_WAIT_L(0); PG8_MMA(0, 1, At, B1); PG8_BAR;
            PG8_LDA(At, 0, 1); PG8_STAGE(PG8_SA(0, 0), a2, o2a);
            PG8_BAR; PG8_WAIT_L(0); PG8_MMA(1, 0, At, B0); PG8_BAR; PG8_SCHED;
            PG8_STAGE(PG8_SB(0, 1), b2 + hstep, voffB);
            PG8_WAIT_V(6); PG8_BAR; PG8_MMA(1, 1, At, B1); PG8_BAR;
            PG8_LDB(B0, 1, 0); PG8_SCHED; PG8_LDA(At, 1, 0); PG8_STAGE(PG8_SA(0, 1), a2, o2b);
            PG8_WAIT_L(8); PG8_BAR; PG8_WAIT_L(0); PG8_MMA(0, 0, At, B0); PG8_BAR; PG8_SCHED;
            PG8_LDB(B1, 1, 1); PG8_STAGE(PG8_SB(1, 0), b3, voffB);
            PG8_BAR; PG8_WAIT_L(0); PG8_MMA(0, 1, At, B1); PG8_BAR;
            PG8_LDA(At, 1, 1); PG8_STAGE(PG8_SA(1, 0), a3, o2a);
            PG8_BAR; PG8_WAIT_L(0); PG8_MMA(1, 0, At, B0); PG8_BAR; PG8_SCHED;
            PG8_STAGE(PG8_SB(1, 1), b3 + hstep, voffB);
            PG8_WAIT_V(6); PG8_BAR; PG8_MMA(1, 1, At, B1); PG8_BAR;
            }
        }
        if (wr == 0) PG8_BAR;
        if constexpr (Epi::FP8) asm volatile("s_nop 15\n\ts_nop 15" ::: "memory");
        { const int tz = otid(wv) & 63; E(acc, cur, wr, wc, tz & 15, tz >> 4); }
        if (!has_next) break;
#pragma unroll
        for (int a = 0; a < 2; ++a)
#pragma unroll
            for (int b = 0; b < 2; ++b)
#pragma unroll
                for (int m = 0; m < 4; ++m)
#pragma unroll
                    for (int n = 0; n < 2; ++n) acc[a][b][m][n] = (f32x4){0.f, 0.f, 0.f, 0.f};
        if constexpr (Epi::LOAD_INIT) { const int tz2 = otid(wv) & 63; E.init(acc, nxt, wr, wc, tz2 & 15, tz2 >> 4); }
        cur = nxt; cA = nA; cB = nB; ++ui;
#pragma unroll
        for (int h = 0; h < 2; ++h)
#pragma unroll
            for (int i = 0; i < 2; ++i) oc[h][i] = on[h][i];
        if (wr == 1) PG8_BAR;
    }
    PG8_WAIT_V(0);
    PG8_BAR;
#undef PG8_SA
#undef PG8_SB
#undef PG8_STAGE
#undef PG8_LDA
#undef PG8_LDB
#undef PG8_MMA
#undef PG8_CAT
#undef PG8_WAIT_V
#undef PG8_WAIT_L
#undef PG8_BAR
#undef PG8_SCHED
}


struct EpiQK {
    static constexpr int PERM = 1; static constexpr bool LOAD_INIT = false; static constexpr bool FP8 = (FP8_PROJ != 0);
    bf16_t* O; const float *gqd, *gkd, *gqf, *gkf; LAS float* tbl; const float* rstd;
    __device__ __forceinline__ void operator()(const f32x4 (&acc)[2][2][4][2], const Unit& u, int wr, int wc, int fr, int fq) const {
#pragma unroll
        for (int ai = 0; ai < 2; ++ai)
#pragma unroll
            for (int m = 0; m < 4; ++m)
#pragma unroll
                for (int bj = 0; bj < 2; ++bj) {
                    const f32x4 a = acc[ai][bj][m][0], b = acc[ai][bj][m][1];
                    float ss = (a[0] * a[0] + a[1] * a[1]) + (a[2] * a[2] + a[3] * a[3]) + (b[0] * b[0] + b[1] * b[1]) + (b[2] * b[2] + b[3] * b[3]);
                    ss += swz_xor<16>(ss); ss = sum_xor32(ss);
                    if (fq == 0) tbl[(bj * 256 + ai * 128 + wr * 64 + m * 16 + fr) * 4 + wc] = FP8 ? ss * (1.f / (W8_SCALE * W8_SCALE)) : ss;
                }
        asm volatile("s_waitcnt lgkmcnt(0)" ::: "memory"); __builtin_amdgcn_s_barrier(); asm volatile("" ::: "memory");
        const int colh = wc * 32 + fq * 8;
#pragma unroll
        for (int bj = 0; bj < 2; ++bj) {
            const int hh = u.pn * 2 + bj;
            int mode; const float* gp; float extra;
            if (hh < 6) { mode = 0; gp = gqd + (colh & 63); extra = 0.125f * LOG2E; }
            else if (hh < 12) { mode = 0; gp = gkd + (colh & 63); extra = 1.f; }
            else if (hh < 17) { mode = 1; gp = gqf + colh; extra = 0.08838834764831845f * LOG2E; }
            else if (hh < 22) { mode = 1; gp = gkf + colh; extra = 1.f; }
            else if (hh < 27) { mode = 2; gp = gqd; extra = 0.08838834764831845f * LOG2E; }
            else { mode = 2; gp = gqd; extra = 1.f; }
            f32x4 g0 = (f32x4){1.f, 1.f, 1.f, 1.f}, g1 = g0;
            if (mode != 2) { g0 = *(const f32x4*)gp; g1 = *(const f32x4*)(gp + 4); }
            g0 = g0 * (FP8 ? extra * (1.f / W8_SCALE) : extra); g1 = g1 * (FP8 ? extra * (1.f / W8_SCALE) : extra);
#pragma unroll
            for (int ai = 0; ai < 2; ++ai)
#pragma unroll
                for (int m = 0; m < 4; ++m) {
                    const int rl = ai * 128 + wr * 64 + m * 16 + fr;
                    const float rr = rstd[u.pm * 256 + rl];
                    float rs = rr;
                    if (mode != 2) {
                        const f32x4 t = *(const LAS f32x4*)(tbl + (bj * 256 + rl) * 4);
                        const float tot = (mode == 0) ? ((wc < 2) ? (t[0] + t[1]) : (t[2] + t[3])) : ((t[0] + t[1]) + (t[2] + t[3]));
                        rs = rr * __builtin_amdgcn_rsqf(rr * rr * tot * (mode == 0 ? (1.f / 64.f) : (1.f / 128.f)) + EPS);
                    }
                    const f32x4 v0 = acc[ai][bj][m][0] * g0 * rs, v1 = acc[ai][bj][m][1] * g1 * rs;
                    u32x4 w; w.x = cvtpk(v0[0], v0[1]); w.y = cvtpk(v0[2], v0[3]); w.z = cvtpk(v1[0], v1[1]); w.w = cvtpk(v1[2], v1[3]);
                    *(u32x4*)(O + (size_t)(u.pm * 256 + rl) * NQK + u.pn * 256 + bj * 128 + colh) = w;
                }
        }
    }
};
struct EpiVT {
    static constexpr int PERM = 2; static constexpr bool LOAD_INIT = false; static constexpr bool FP8 = (FP8_PROJ != 0);
    bf16_t* O; int ldc; const float* rstd;
    __device__ __forceinline__ void operator()(const f32x4 (&acc)[2][2][4][2], const Unit& u, int wr, int wc, int fr, int fq) const {
        f32x4 r0[2], r1[2];
#pragma unroll
        for (int bj = 0; bj < 2; ++bj) { const float* rp = rstd + u.pn * 256 + bj * 128 + wc * 32 + 16 * (fq >> 1) + 4 * (fq & 1);
            r0[bj] = *(const f32x4*)rp; r1[bj] = *(const f32x4*)(rp + 8); if (FP8) { r0[bj] = r0[bj] * (1.f / W8_SCALE); r1[bj] = r1[bj] * (1.f / W8_SCALE); } }
#pragma unroll
        for (int ai = 0; ai < 2; ++ai)
#pragma unroll
            for (int m = 0; m < 4; ++m)
#pragma unroll
                for (int bj = 0; bj < 2; ++bj) {
                    const f32x4 v0 = acc[ai][bj][m][0] * r0[bj], v1 = acc[ai][bj][m][1] * r1[bj];
                    u32x4 w; w.x = cvtpk(v0[0], v0[1]); w.y = cvtpk(v0[2], v0[3]); w.z = cvtpk(v1[0], v1[1]); w.w = cvtpk(v1[2], v1[3]);
                    *(u32x4*)(O + (size_t)(u.pm * 256 + ai * 128 + wr * 64 + m * 16 + fr) * ldc + u.pn * 256 + bj * 128 + wc * 32 + fq * 8) = w;
                }
    }
};
struct EpiResAdd {
    static constexpr int PERM = 1; static constexpr bool LOAD_INIT = true; static constexpr bool FP8 = (FP8_WOUT != 0);
    bf16_t* X; float sc; unsigned* done; unsigned char* X8;
    __device__ __forceinline__ void init(f32x4 (&acc)[2][2][4][2], const Unit& u, int wr, int wc, int fr, int fq) const {
#pragma unroll
        for (int ai = 0; ai < 2; ++ai)
#pragma unroll
            for (int m = 0; m < 4; ++m)
#pragma unroll
                for (int bj = 0; bj < 2; ++bj) {
                    const u32x4 w = *(const u32x4*)(X + (size_t)(u.pm * 256 + ai * 128 + wr * 64 + m * 16 + fr) * DM + u.pn * 256 + bj * 128 + wc * 32 + fq * 8);
                    acc[ai][bj][m][0] = (f32x4){bf_lo(w.x), bf_hi(w.x), bf_lo(w.y), bf_hi(w.y)};
                    acc[ai][bj][m][1] = (f32x4){bf_lo(w.z), bf_hi(w.z), bf_lo(w.w), bf_hi(w.w)};
                    if (FP8) { acc[ai][bj][m][0] = acc[ai][bj][m][0] * W8_SCALE; acc[ai][bj][m][1] = acc[ai][bj][m][1] * W8_SCALE; }
                }
    }
    __device__ __forceinline__ void operator()(const f32x4 (&acc)[2][2][4][2], const Unit& u, int wr, int wc, int fr, int fq) const {
        const __amdgpu_buffer_rsrc_t rsrc = __builtin_amdgcn_make_buffer_rsrc((void*)X, 0, SEQ * DM * 2, 0x00020000);
        const __amdgpu_buffer_rsrc_t rsrc8 = __builtin_amdgcn_make_buffer_rsrc((void*)X8, 0, SEQ * DM, 0x00020000);
#pragma unroll
        for (int ai = 0; ai < 2; ++ai)
#pragma unroll
            for (int m = 0; m < 4; ++m)
#pragma unroll
                for (int bj = 0; bj < 2; ++bj) {
                    const f32x4 v0 = FP8 ? acc[ai][bj][m][0] * (1.f / W8_SCALE) : acc[ai][bj][m][0], v1 = FP8 ? acc[ai][bj][m][1] * (1.f / W8_SCALE) : acc[ai][bj][m][1];
                    u32x4 w; w.x = cvtpk(v0[0], v0[1]); w.y = cvtpk(v0[2], v0[3]); w.z = cvtpk(v1[0], v1[1]); w.w = cvtpk(v1[2], v1[3]);
                    u32x2 w8; w8.x = cvt4f8(v0[0], v0[1], v0[2], v0[3]); w8.y = cvt4f8(v1[0], v1[1], v1[2], v1[3]);
                    __builtin_amdgcn_raw_buffer_store_b64(w8, rsrc8, (int)((u.pm * 256 + ai * 128 + wr * 64 + m * 16 + fr) * DM + u.pn * 256 + bj * 128 + wc * 32 + fq * 8), 0, 16);
                    __builtin_amdgcn_raw_buffer_store_b128(w, rsrc, (int)(((u.pm * 256 + ai * 128 + wr * 64 + m * 16 + fr) * DM + u.pn * 256 + bj * 128 + wc * 32 + fq * 8) * 2), 0, 16);
                }
        asm volatile("s_waitcnt vmcnt(0)" ::: "memory");
        if (fr == 0 && fq == 0) __hip_atomic_fetch_add(done + 64 * u.pm, 1u, __ATOMIC_RELAXED, __HIP_MEMORY_SCOPE_AGENT);
    }
};
struct EpiGU {
    static constexpr int PERM = 1; static constexpr bool LOAD_INIT = false; static constexpr bool FP8 = true;
    unsigned char* ACT; const float* gate; const LAS int* tbl; unsigned* done;
    __device__ __forceinline__ void operator()(const f32x4 (&acc)[2][2][4][2], const Unit& u, int wr, int wc, int fr, int fq) const {
        const int ct = u.pn & 3, n_e = __builtin_amdgcn_readfirstlane(tbl[17 + u.e]);
        const __amdgpu_buffer_rsrc_t rsrc = __builtin_amdgcn_make_buffer_rsrc((void*)ACT, 0, MOE_ROWS * FEXP, 0x00020000);
#pragma unroll
        for (int ai = 0; ai < 2; ++ai)
#pragma unroll
            for (int m = 0; m < 4; ++m) {
                const int rl = ai * 128 + wr * 64 + m * 16 + fr, pos = u.rt * 256 + rl;
                f32x2_t gr2 = {0.f, 0.f}; if (pos < n_e) gr2 = *(const f32x2_t*)(gate + 2 * (u.e * SEQ + pos));
                const float gt = gr2[0] * ACT8_SCALE, rs = gr2[1] * (1.f / W8_SCALE);
                float o[8];
#pragma unroll
                for (int n = 0; n < 2; ++n)
#pragma unroll
                    for (int j = 0; j < 4; ++j) { const float gv = acc[ai][0][m][n][j] * rs, uv = acc[ai][1][m][n][j] * rs;
                        const float sg = gv * __builtin_amdgcn_rcpf(1.f + fexp2(-gv * LOG2E)); o[n * 4 + j] = sg * uv * gt; }
                u32x2 w; w.x = cvt4f8(o[0], o[1], o[2], o[3]); w.y = cvt4f8(o[4], o[5], o[6], o[7]);
                __builtin_amdgcn_raw_buffer_store_b64(w, rsrc, (int)((u.pm * 256 + rl) * FEXP + ct * 128 + wc * 32 + fq * 8), 0, 16);
            }
        asm volatile("s_waitcnt vmcnt(0)" ::: "memory");
        if (fr == 0 && fq == 0) __hip_atomic_fetch_add(done + 64 * u.pm, 1u, __ATOMIC_RELAXED, __HIP_MEMORY_SCOPE_AGENT);
    }
};
struct EpiDown {
    static constexpr int PERM = 1; static constexpr bool LOAD_INIT = false; static constexpr bool FP8 = true;
    bf16_t* Y;
    __device__ __forceinline__ void operator()(const f32x4 (&acc)[2][2][4][2], const Unit& u, int wr, int wc, int fr, int fq) const {
        const int ct = u.pn & 7;
#pragma unroll
        for (int ai = 0; ai < 2; ++ai)
#pragma unroll
            for (int m = 0; m < 4; ++m)
#pragma unroll
                for (int bj = 0; bj < 2; ++bj) {
                    const f32x4 v0 = acc[ai][bj][m][0] * (1.f / (W8_SCALE * ACT8_SCALE)), v1 = acc[ai][bj][m][1] * (1.f / (W8_SCALE * ACT8_SCALE));
                    u32x4 w; w.x = cvtpk(v0[0], v0[1]); w.y = cvtpk(v0[2], v0[3]); w.z = cvtpk(v1[0], v1[1]); w.w = cvtpk(v1[2], v1[3]);
                    *(u32x4*)(Y + (size_t)(u.pm * 256 + ai * 128 + wr * 64 + m * 16 + fr) * DM + ct * 256 + bj * 128 + wc * 32 + fq * 8) = w;
                }
    }
};
}

#define XB_TMO      128
#define XB_XCNT(j)  (256  + 64 * (j))
#define XB_XSUB(j)  (1280 + 64 * (j))
#define XB_XGEN(j)  (2304 + 64 * (j))
#define XB_TOP      3328
#define XB_TOPGEN   3392
#define XCD_BAR_WORDS 3456
#define XB_SPIN_CAP (1u << 18)

__device__ __forceinline__ unsigned xb_ld(unsigned* p)              { return __hip_atomic_load(p, __ATOMIC_RELAXED, __HIP_MEMORY_SCOPE_AGENT); }
__device__ __forceinline__ unsigned xb_add(unsigned* p, unsigned v) { return __hip_atomic_fetch_add(p, v, __ATOMIC_RELAXED, __HIP_MEMORY_SCOPE_AGENT); }
__device__ __forceinline__ unsigned xb_xcc_id() { return (unsigned)__builtin_amdgcn_s_getreg((3 << 11) | 20) & 0xFu; }
#define XB_SPIN(cond, bar) do { unsigned _sp = 0; while (cond) { __builtin_amdgcn_s_sleep(1); \
    if ((++_sp & 255u) == 0u) { if (xb_ld(&(bar)[XB_TMO])) break; if (_sp > XB_SPIN_CAP) { atomicAdd(&(bar)[XB_TMO], 1u); break; } } } } while (0)

struct XcdBarrier { unsigned* bar; unsigned x; volatile LAS unsigned* st; int wv; };

__device__ __forceinline__ XcdBarrier xcd_barrier_post(unsigned* bar, volatile LAS unsigned* st, int wv) {
    XcdBarrier b; b.bar = bar; b.x = xb_xcc_id(); b.st = st; b.wv = wv;
    if (otid(wv) == 0) (void)xb_add(&bar[XB_XCNT(b.x)], 1u);
    return b;
}
__device__ __forceinline__ void xcd_barrier_complete(unsigned* bar, unsigned x, unsigned& nloc, unsigned& nx) {
    const unsigned G = gridDim.x * gridDim.y * gridDim.z;
    unsigned sum, cnt, mine, sp = 0u;
    for (;;) {
        sum = 0u; cnt = 0u; mine = 0u;
#pragma unroll
        for (unsigned j = 0; j < 16; ++j) { const unsigned c = xb_ld(&bar[XB_XCNT(j)]); sum += c; cnt += (c > 0u) ? 1u : 0u; mine = (j == x) ? c : mine; }
        if (sum == G) break;
        __builtin_amdgcn_s_sleep(1);
        if ((++sp & 255u) == 0u) { if (xb_ld(&bar[XB_TMO])) break; if (sp > XB_SPIN_CAP) { atomicAdd(&bar[XB_TMO], 1u); break; } }
    }
    nloc = mine > 0u ? mine : 1u; nx = cnt > 0u ? cnt : 1u;
}
__device__ __attribute__((noinline)) void xcd_barrier_impl(unsigned* bar_, unsigned bx, volatile LAS unsigned* bst, int bwv) {
    XcdBarrier b; b.bar = bar_; b.x = bx; b.st = bst; b.wv = bwv;
    asm volatile("s_waitcnt vmcnt(0)" ::: "memory");
    __syncthreads();
    if (otid(b.wv) == 0) {
        unsigned* bar = b.bar;
        __builtin_amdgcn_s_waitcnt(0);
        unsigned nloc = b.st[0], nx = b.st[1];
        if (nloc == 0u) { xcd_barrier_complete(bar, b.x, nloc, nx); b.st[0] = nloc; b.st[1] = nx; }
        const unsigned old = xb_add(&bar[XB_XSUB(b.x)], 1u);
        const unsigned gen = old / nloc;
        if (old + 1u == (gen + 1u) * nloc) {
            __builtin_amdgcn_fence(__ATOMIC_RELEASE, "agent");
            asm volatile("s_waitcnt vmcnt(0)" ::: "memory");
            const unsigned og = xb_add(&bar[XB_TOP], 1u);
            const unsigned tg = og / nx;
            if (og + 1u == (tg + 1u) * nx) xb_add(&bar[XB_TOPGEN], 1u);
            else XB_SPIN(xb_ld(&bar[XB_TOPGEN]) == tg, bar);
            __builtin_amdgcn_fence(__ATOMIC_ACQUIRE, "agent");
            xb_add(&bar[XB_XGEN(b.x)], 1u);
            asm volatile("s_waitcnt vmcnt(0)" ::: "memory");
        } else {
            XB_SPIN(xb_ld(&bar[XB_XGEN(b.x)]) == gen, bar);
            __builtin_amdgcn_fence(__ATOMIC_ACQUIRE, "agent");
            asm volatile("s_waitcnt vmcnt(0)" ::: "memory");
        }
    }
    __syncthreads();
}

__device__ __forceinline__ void xcd_barrier(const XcdBarrier& b) { xcd_barrier_impl(b.bar, b.x, b.st, b.wv); }

struct Params {
    const float *x, *attn_norm, *w_in, *b_forget, *qnorm_diff, *knorm_diff, *lam_q1, *lam_k1, *lam_q2, *lam_k2, *subln_diff, *onorm_sb,
        *qnorm_fox, *knorm_fox, *onorm_fox, *w_out, *ffn_norm, *w_router, *router_bias, *w_gate, *w_up, *w_down;
    float* out; unsigned char* ws; int ph_lo, ph_hi;
};
typedef const __attribute__((address_space(4))) Params* KArgs;
__device__ __forceinline__ KArgs kparams() { KArgs k = (KArgs)__builtin_amdgcn_kernarg_segment_ptr(); asm volatile("" : "+s"(k)); return k; }

__device__ __forceinline__ void transpose_item(const float* W, int ldn, int k0, int n0, bf16_t* WT, int K, int drow, LAS float* scr, int lane, const float* kgain = nullptr, bool f8 = false) {
#pragma unroll 8
    for (int i = 0; i < 32; ++i) { const int kk = 2 * i + (lane >> 5); scr[kk * 33 + (lane & 31)] = W[(size_t)(k0 + kk) * ldn + n0 + (lane & 31)]; }
    asm volatile("s_waitcnt lgkmcnt(0)" ::: "memory");
    const int c = lane & 7;
    f32x4 ga = {1.f, 1.f, 1.f, 1.f}, gb = ga;
    if (kgain) { ga = *(const f32x4*)(kgain + k0 + 8 * c); gb = *(const f32x4*)(kgain + k0 + 8 * c + 4); }
#pragma unroll
    for (int j = 0; j < 4; ++j) { const int n = (lane >> 3) + 8 * j; const LAS float* s = scr + (8 * c) * 33 + n;
        if (f8) { u32x2 o8; o8.x = cvt4f8(s[0 * 33] * ga[0] * W8_SCALE, s[1 * 33] * ga[1] * W8_SCALE, s[2 * 33] * ga[2] * W8_SCALE, s[3 * 33] * ga[3] * W8_SCALE);
            o8.y = cvt4f8(s[4 * 33] * gb[0] * W8_SCALE, s[5 * 33] * gb[1] * W8_SCALE, s[6 * 33] * gb[2] * W8_SCALE, s[7 * 33] * gb[3] * W8_SCALE);
            *(u32x2*)((unsigned char*)WT + (size_t)(drow + n) * K + k0 + 8 * c) = o8; continue; }
        u32x4 o; o.x = cvtpk(s[0 * 33] * ga[0], s[1 * 33] * ga[1]); o.y = cvtpk(s[2 * 33] * ga[2], s[3 * 33] * ga[3]); o.z = cvtpk(s[4 * 33] * gb[0], s[5 * 33] * gb[1]); o.w = cvtpk(s[6 * 33] * gb[2], s[7 * 33] * gb[3]);
        *(u32x4*)(WT + (size_t)(drow + n) * K + k0 + 8 * c) = o; }
    asm volatile("s_waitcnt lgkmcnt(0)" ::: "memory");
}
__device__ __forceinline__ int win_dest(int n0, int& sel) {
    if (n0 < 768) { sel = 0; return n0; }
    if (n0 < 1536) { sel = 0; return n0; }
    if (n0 < 2304) { sel = 1; return n0 - 1536; }
    if (n0 < 2944) { sel = 0; return 2816 + (n0 - 2304); }
    if (n0 < 3584) { sel = 0; return 3456 + (n0 - 2944); }
    if (n0 < 4224) { sel = 1; return 768 + (n0 - 3584); }
    if (n0 < 4864) { sel = 0; return 1536 + (n0 - 4224); }
    if (n0 < 5504) { sel = 0; return 2176 + (n0 - 4864); }
    sel = 1; return 1408 + (n0 - 5504);
}
__device__ __forceinline__ void phase_prologue(KArgs p, LAS unsigned char* lds, int wv) {
    const int tid = otid(wv), lane = tid & 63, wave = tid >> 6;
    LAS float* scr = (LAS float*)(lds + wave * 16384);
    const int gw = blockIdx.x * 8 + wave, NGW = gridDim.x * 8;
    constexpr int I_IN = 32 * 192, I_O = 32 * 64, I_G = 16 * 32 * 16, I_D = 16 * 8 * 64, I_L = I_IN + I_O + 2 * I_G + I_D;
    bf16_t* Wqk = (bf16_t*)(p->ws + WS_WQK); bf16_t* Wv = (bf16_t*)(p->ws + WS_WV); bf16_t* Wo = (bf16_t*)(p->ws + WS_WO);
    bf16_t* Wgu = (bf16_t*)(p->ws + WS_WGU); bf16_t* Wd = (bf16_t*)(p->ws + WS_WD);
    for (int it = gw; it < DEPTH * I_L; it += NGW) {
        const int l = it / I_L; int r = it % I_L;
        if (r < I_IN) { const int kb = r / 192, nb = r % 192; int sel; const int drow = win_dest(nb * 32, sel);
            if (FP8_PROJ) transpose_item(p->w_in + (size_t)l * DM * NIN, NIN, kb * 64, nb * 32, (bf16_t*)(sel ? (unsigned char*)Wv + (size_t)l * NV * DM : (unsigned char*)Wqk + (size_t)l * NQK * DM), DM, drow, scr, lane, p->attn_norm + (size_t)l * DM, true);
            else transpose_item(p->w_in + (size_t)l * DM * NIN, NIN, kb * 64, nb * 32, sel ? Wv + (size_t)l * NV * DM : Wqk + (size_t)l * NQK * DM, DM, drow, scr, lane, p->attn_norm + (size_t)l * DM); continue; }
        r -= I_IN;
        if (r < I_O) { const int kb = r / 64, nb = r % 64;
            if (FP8_WOUT) transpose_item(p->w_out + (size_t)l * DM * DM, DM, kb * 64, nb * 32, (bf16_t*)((unsigned char*)Wo + (size_t)l * DM * DM), DM, nb * 32, scr, lane, nullptr, true);
            else transpose_item(p->w_out + (size_t)l * DM * DM, DM, kb * 64, nb * 32, Wo + (size_t)l * DM * DM, DM, nb * 32, scr, lane); continue; }
        r -= I_O;
        if (r < 2 * I_G) { const int up = r / I_G; r %= I_G; const int e = r / 512, kb = (r % 512) / 16, nb = r % 16; const int n0 = nb * 32;
            const float* src = (up ? p->w_up : p->w_gate) + ((size_t)l * NEXP + e) * DM * FEXP;
            transpose_item(src, FEXP, kb * 64, n0, (bf16_t*)((unsigned char*)Wgu + ((size_t)l * NEXP + e) * 1024 * DM), DM, (n0 >> 7) * 256 + up * 128 + (n0 & 127), scr, lane, p->ffn_norm + (size_t)l * DM, true); continue; }
        r -= 2 * I_G;
        { const int e = r / 512, kb = (r % 512) / 64, nb = r % 64;
            transpose_item(p->w_down + ((size_t)l * NEXP + e) * FEXP * DM, DM, kb * 64, nb * 32, (bf16_t*)((unsigned char*)Wd + ((size_t)l * NEXP + e) * DM * FEXP), FEXP, nb * 32, scr, lane, nullptr, true); }
    }
    { float* WRT = (float*)(p->ws + WS_WRT); for (int i = blockIdx.x * 512 + tid; i < 16 * DM; i += gridDim.x * 512) WRT[(i & 15) * DM + (i >> 4)] = p->w_router[i]; }
    float* WF = (float*)(p->ws + WS_WF);
    for (int i = blockIdx.x * 512 + tid; i < DEPTH * 5 * DM; i += gridDim.x * 512) { const int l = i / (5 * DM), h = (i / DM) % 5, d = i % DM;
        WF[i] = p->w_in[((size_t)l * DM + d) * NIN + 6144 + h]; }
    if (blockIdx.x == 1 && wave < DEPTH) {
        const int l = wave;
        float a = fabsf(p->qnorm_diff[l * 64 + lane]), b = fabsf(p->knorm_diff[l * 64 + lane]);
        float c2 = fmaxf(fabsf(p->qnorm_fox[l * 128 + lane]), fabsf(p->qnorm_fox[l * 128 + 64 + lane])), d2 = fmaxf(fabsf(p->knorm_fox[l * 128 + lane]), fabsf(p->knorm_fox[l * 128 + 64 + lane]));
#pragma unroll
        for (int o = 1; o < 32; o <<= 1) { a = fmaxf(a, __int_as_float(__builtin_amdgcn_ds_bpermute(((lane ^ o) << 2), __float_as_int(a)))); b = fmaxf(b, __int_as_float(__builtin_amdgcn_ds_bpermute(((lane ^ o) << 2), __float_as_int(b))));
            c2 = fmaxf(c2, __int_as_float(__builtin_amdgcn_ds_bpermute(((lane ^ o) << 2), __float_as_int(c2)))); d2 = fmaxf(d2, __int_as_float(__builtin_amdgcn_ds_bpermute(((lane ^ o) << 2), __float_as_int(d2)))); }
        a = fmaxf(a, __int_as_float(__builtin_amdgcn_ds_bpermute(((lane ^ 32) << 2), __float_as_int(a)))); b = fmaxf(b, __int_as_float(__builtin_amdgcn_ds_bpermute(((lane ^ 32) << 2), __float_as_int(b))));
        c2 = fmaxf(c2, __int_as_float(__builtin_amdgcn_ds_bpermute(((lane ^ 32) << 2), __float_as_int(c2)))); d2 = fmaxf(d2, __int_as_float(__builtin_amdgcn_ds_bpermute(((lane ^ 32) << 2), __float_as_int(d2))));
        if (lane == 0) { ((float*)(p->ws + WS_LAM))[8 + 2 * l] = a * b; ((float*)(p->ws + WS_LAM))[8 + 2 * l + 1] = c2 * d2; }
    }
    if (blockIdx.x == 0 && wave < DEPTH) {
        const int l = wave;
        float a = wave_sum(p->lam_q1[l * 64 + lane] * p->lam_k1[l * 64 + lane]), b = wave_sum(p->lam_q2[l * 64 + lane] * p->lam_k2[l * 64 + lane]);
        if (lane == 0) ((float*)(p->ws + WS_LAM))[l] = fexp2(a * LOG2E) - fexp2(b * LOG2E) + (0.8f - 0.6f * fexp2(-0.3f * LOG2E * (float)l));
    }
}

__device__ __forceinline__ float log_sigmoid(float x) { return fminf(x, 0.f) - 0.6931471805599453f * flog2(1.f + fexp2(-fabsf(x) * LOG2E)); }

__device__ __forceinline__ void phase_norm1(KArgs p, int l, LAS unsigned char* lds, int wv, bool probe2 = false) {
    const int tid = otid(wv), lane = tid & 63, wave = tid >> 6;
    LAS float* wf = (LAS float*)lds;
    LAS int* rbase = (LAS int*)(lds + 5 * DM * 4);
    if (l < DEPTH) { const float* WF = (const float*)(p->ws + WS_WF) + (size_t)l * 5 * DM; for (int i = tid; i < 5 * DM; i += 512) wf[i] = WF[i]; }
    if (l > 0 && tid == 0) { const unsigned* cnt = (const unsigned*)(p->ws + WS_CTL) + CW_CNT + (l - 1) * 16 * 64; int acc = 0;
        for (int e = 0; e < 16; ++e) { rbase[e] = acc * 256; acc += ((int)cnt[e * 64] + 255) >> 8; } }
    __syncthreads();
    const bf16_t* Y = (const bf16_t*)(p->ws + WS_Y); const i32x4* tsel = (const i32x4*)(p->ws + WS_TSEL);
    bf16_t* XN = (bf16_t*)(p->ws + WS_XN); float* LOGF = (float*)(p->ws + WS_LOGF);
    const int gw = blockIdx.x * 8 + wave, NGW = gridDim.x * 8;
    for (int t = gw; t < SEQ; t += NGW) {
        asm volatile("" ::: "memory");
        f32x4 v[8];
        if (l == 0 && !probe2) { const f32x4* xr = (const f32x4*)(p->x + (size_t)t * DM) + lane;
#pragma unroll
            for (int j = 0; j < 8; ++j) v[j] = xr[64 * j]; }
        else { const u32x2* xr = (const u32x2*)((const bf16_t*)(p->ws + WS_OUTB) + (size_t)t * DM) + lane;
#pragma unroll
            for (int j = 0; j < 8; ++j) { const u32x2 a = xr[64 * j]; v[j] = (f32x4){bf_lo(a[0]), bf_hi(a[0]), bf_lo(a[1]), bf_hi(a[1])}; } }
        if (l > 0) {
            const float ysc = probe2 ? 0.f : 1.f;
            const i32x4 ts = tsel[t];
            const u32x2* y1 = (const u32x2*)(Y + (size_t)(rbase[ts[0]] + ts[1]) * DM) + lane; const u32x2* y2 = (const u32x2*)(Y + (size_t)(rbase[ts[2]] + ts[3]) * DM) + lane;
#pragma unroll
            for (int j = 0; j < 8; ++j) { const u32x2 a = y1[64 * j], b = y2[64 * j];
                v[j][0] += ysc * (bf_lo(a[0]) + bf_lo(b[0])); v[j][1] += ysc * (bf_hi(a[0]) + bf_hi(b[0])); v[j][2] += ysc * (bf_lo(a[1]) + bf_lo(b[1])); v[j][3] += ysc * (bf_hi(a[1]) + bf_hi(b[1])); }
        }
        if (l == DEPTH) { f32x4* orow = (f32x4*)(p->out + (size_t)t * DM) + lane;
#pragma unroll
            for (int j = 0; j < 8; ++j) orow[64 * j] = v[j]; }
        else { u32x2* orow = (u32x2*)((bf16_t*)(p->ws + WS_OUTB) + (size_t)t * DM) + lane;
#pragma unroll
            for (int j = 0; j < 8; ++j) { u32x2 w; w[0] = cvtpk(v[j][0], v[j][1]); w[1] = cvtpk(v[j][2], v[j][3]); orow[64 * j] = w; }
            if (FP8_PROJ) { unsigned* orow8 = (unsigned*)(p->ws + WS_OUTB8 + (size_t)t * DM) + lane;
#pragma unroll
                for (int j = 0; j < 8; ++j) orow8[64 * j] = cvt4f8(v[j][0], v[j][1], v[j][2], v[j][3]); } }
        if (l == DEPTH) continue;
        float ss = 0.f;
#pragma unroll
        for (int j = 0; j < 8; ++j) ss += (v[j][0] * v[j][0] + v[j][1] * v[j][1]) + (v[j][2] * v[j][2] + v[j][3] * v[j][3]);
        const float rstd = __builtin_amdgcn_rsqf(wave_sum(ss) * (1.f / DM) + EPS);
        const f32x4* gr = (const f32x4*)(p->attn_norm + (size_t)l * DM) + lane;
        float fc[5] = {0.f, 0.f, 0.f, 0.f, 0.f};
        if (lane == 0) ((float*)(p->ws + WS_RSTD))[t] = rstd;
#pragma unroll
        for (int j = 0; j < 8; ++j) { const f32x4 xn = v[j] * rstd * gr[64 * j];
#pragma unroll
            for (int h = 0; h < 5; ++h) { const f32x4 w4 = *(const LAS f32x4*)(wf + h * DM + 4 * lane + 256 * j); fc[h] += (xn[0] * w4[0] + xn[1] * w4[1]) + (xn[2] * w4[2] + xn[3] * w4[3]); } }
#pragma unroll
        for (int h = 0; h < 5; ++h) { const float s = wave_sum(fc[h]); if (lane == 0) LOGF[h * SEQ + t] = log_sigmoid(s + p->b_forget[l * 5 + h]); }
    }
}

__device__ __forceinline__ void scan_head(KArgs p, int h, int l, LAS unsigned char* lds, int wv) {
    const int tid = otid(wv), lane = tid & 63, wave = tid >> 6;
    const float* src = (const float*)(p->ws + WS_LOGF) + (size_t)h * SEQ + tid * 16; float* dst = (float*)(p->ws + WS_DC2) + (size_t)h * SEQ + tid * 16;
    LAS float* wt = (LAS float*)lds;
    float v[16]; float s = 0.f;
#pragma unroll
    for (int i = 0; i < 4; ++i) { const f32x4 a = ((const f32x4*)src)[i]; v[4 * i] = a[0]; v[4 * i + 1] = a[1]; v[4 * i + 2] = a[2]; v[4 * i + 3] = a[3]; }
#pragma unroll
    for (int i = 0; i < 16; ++i) { s += v[i]; v[i] = s; }
    float inc = s;
#pragma unroll
    for (int o = 1; o < 64; o <<= 1) { const float n = __int_as_float(__builtin_amdgcn_ds_bpermute(((lane - o) & 63) << 2, __float_as_int(inc))); if (lane >= o) inc += n; }
    if (lane == 63) wt[wave] = inc;
    __syncthreads();
    float base = inc - s;
    for (int w = 0; w < wave; ++w) base += wt[w];
#pragma unroll
    for (int i = 0; i < 4; ++i) ((f32x4*)dst)[i] = (f32x4){(v[4 * i] + base) * LOG2E, (v[4 * i + 1] + base) * LOG2E, (v[4 * i + 2] + base) * LOG2E, (v[4 * i + 3] + base) * LOG2E};
    LAS float* dl = (LAS float*)(lds + 64);
#pragma unroll
    for (int i = 0; i < 16; ++i) dl[tid * 16 + i] = (v[i] + base) * LOG2E;
    __syncthreads();
    { const float thr = 39.f + 2.f * 16.3221377f * ((const float*)(p->ws + WS_LAM))[8 + 2 * l + 1];
      const int qb = tid >> 4, part = tid & 15; const float dref = dl[256 * qb]; int cnt = 0;
      for (int i = part; i < 4 * qb; i += 16) cnt += (dref - dl[64 * i + 63] <= -thr) ? 1 : 0;
      float c = (float)cnt; c += swz_xor<1>(c); c += swz_xor<2>(c); c += swz_xor<4>(c); c += swz_xor<8>(c);
      if (part == 0) ((int*)(p->ws + WS_LAM))[64 + h * 32 + qb] = (int)c; }
    __syncthreads();
}

namespace att {
constexpr int KP = 272, VP = 144;
constexpr int KT_BYTES = 64 * KP, VT_BYTES = 128 * VP, KB_BYTES = 256;
constexpr int BUF_BYTES = KT_BYTES + VT_BYTES + KB_BYTES;
constexpr float THR = 8.f;
static_assert(2 * BUF_BYTES <= RING_BYTES && 4 * 128 * 32 * 4 <= RING_BYTES, "attention LDS");

struct Stg { u32x4 k0, k1, v0, v1; };
__device__ __forceinline__ void stage_load(Stg& s, const bf16_t* Kg, const bf16_t* Vg, int j, int tid) {
    const bf16_t* kp = Kg + (size_t)(64 * j + (tid >> 3)) * NQK + (tid & 7) * 8;
    s.k0 = *(const u32x4*)kp; s.k1 = *(const u32x4*)(kp + 64);
    const bf16_t* vp = Vg + (size_t)(tid >> 2) * SEQ + 64 * j + (tid & 3) * 8;
    s.v0 = *(const u32x4*)vp; s.v1 = *(const u32x4*)(vp + 32);
}
__device__ __forceinline__ void stage_write(const Stg& s, LAS unsigned char* buf, int tid) {
    LAS unsigned char* kd = buf + (tid >> 3) * KP + (tid & 7) * 16; *(LAS u32x4*)kd = s.k0; *(LAS u32x4*)(kd + 128) = s.k1;
    LAS unsigned char* vd = buf + KT_BYTES + (tid >> 2) * VP + (tid & 3) * 16; *(LAS u32x4*)vd = s.v0; *(LAS u32x4*)(vd + 64) = s.v1;
}
template <int NKS>
__device__ __forceinline__ void qk_tile(f32x16& p0, f32x16& p1, const LAS unsigned char* kb, const bf16x8* qr) {
    bf16x8 ka[NKS], kc[NKS];
#pragma unroll
    for (int ks = 0; ks < NKS; ++ks) { ka[ks] = *(const LAS bf16x8*)(kb + ks * 32); kc[ks] = *(const LAS bf16x8*)(kb + 32 * KP + ks * 32); }
    __builtin_amdgcn_sched_barrier(0);
#pragma unroll
    for (int ks = 0; ks < NKS; ++ks) {
        p0 = __builtin_amdgcn_mfma_f32_32x32x16_bf16(ka[ks], qr[ks], p0, 0, 0, 0);
        p1 = __builtin_amdgcn_mfma_f32_32x32x16_bf16(kc[ks], qr[ks], p1, 0, 0, 0);
    }
    __builtin_amdgcn_sched_barrier(0);
}
__device__ __forceinline__ bf16x8 pack8(const f32x16& p, int b) {
    u32x4 w = {cvtpk(p[b + 0], p[b + 1]), cvtpk(p[b + 2], p[b + 3]), cvtpk(p[b + 4], p[b + 5]), cvtpk(p[b + 6], p[b + 7])};
    return *reinterpret_cast<bf16x8*>(&w);
}
__device__ __forceinline__ void pv_tile(f32x16 (&o)[4], const LAS unsigned char* vb, const f32x16& p0, const f32x16& p1) {
    const bf16x8 pb0 = pack8(p0, 0), pb1 = pack8(p0, 8), pb2 = pack8(p1, 0), pb3 = pack8(p1, 8);
#pragma unroll
    for (int dh = 0; dh < 2; ++dh) {
        bf16x8 va[8];
#pragma unroll
        for (int i = 0; i < 8; ++i) va[i] = *(const LAS bf16x8*)(vb + (2 * dh + (i >> 2)) * 32 * VP + (i & 3) * 32);
        __builtin_amdgcn_sched_barrier(0);
#pragma unroll
        for (int i = 0; i < 8; ++i) { const int d0 = 2 * dh + (i >> 2), s4 = i & 3;
            o[d0] = __builtin_amdgcn_mfma_f32_32x32x16_bf16(va[i], s4 == 0 ? pb0 : (s4 == 1 ? pb1 : (s4 == 2 ? pb2 : pb3)), o[d0], 0, 0, 0); }
        __builtin_amdgcn_sched_barrier(0);
    }
}
template <int NKS>
__device__ __forceinline__ void tile_fixed(f32x16 (&o)[4], const LAS unsigned char* kb, const LAS unsigned char* vb, const bf16x8* qr, f32x16& y0, f32x16& y1, float& l) {
    bf16x8 ka[NKS], kc[NKS];
#pragma unroll
    for (int ks = 0; ks < NKS; ++ks) { ka[ks] = *(const LAS bf16x8*)(kb + ks * 32); kc[ks] = *(const LAS bf16x8*)(kb + 32 * KP + ks * 32); }
    __builtin_amdgcn_sched_barrier(0);
#pragma unroll
    for (int ks = 0; ks < NKS; ++ks) y0 = __builtin_amdgcn_mfma_f32_32x32x16_bf16(ka[ks], qr[ks], y0, 0, 0, 0);
    __builtin_amdgcn_sched_barrier(0);
    asm volatile("" : "+v"(y0));
#pragma unroll
    for (int ks = 0; ks < NKS; ++ks) y1 = __builtin_amdgcn_mfma_f32_32x32x16_bf16(kc[ks], qr[ks], y1, 0, 0, 0);
    float s = 0.f;
#pragma unroll
    for (int r = 0; r < 16; ++r) { y0[r] = fexp2(y0[r]); s += y0[r]; }
    const bf16x8 pb0 = pack8(y0, 0), pb1 = pack8(y0, 8);
#pragma unroll
    for (int q = 0; q < NKS; ++q) { __builtin_amdgcn_sched_group_barrier(0x008, 1, 0);
#pragma unroll
        for (int h = 0; h < 8 / NKS; ++h) { __builtin_amdgcn_sched_group_barrier(0x400, 2, 0); __builtin_amdgcn_sched_group_barrier(0x002, 3, 0); } }
    __builtin_amdgcn_sched_barrier(0);
    bf16x8 va[8];
#pragma unroll
    for (int i = 0; i < 8; ++i) va[i] = *(const LAS bf16x8*)(vb + (i >> 1) * 32 * VP + (i & 1) * 32);
    __builtin_amdgcn_sched_barrier(0);
    asm volatile("" : "+v"(y1));
#pragma unroll
    for (int i = 0; i < 8; ++i) o[i >> 1] = __builtin_amdgcn_mfma_f32_32x32x16_bf16(va[i], (i & 1) ? pb1 : pb0, o[i >> 1], 0, 0, 0);
    float s1 = 0.f;
#pragma unroll
    for (int r = 0; r < 16; ++r) { y1[r] = fexp2(y1[r]); s1 += y1[r]; }
    const bf16x8 pb2 = pack8(y1, 0), pb3 = pack8(y1, 8);
#pragma unroll
    for (int q = 0; q < 8; ++q) { __builtin_amdgcn_sched_group_barrier(0x008, 1, 0); __builtin_amdgcn_sched_group_barrier(0x400, 2, 0); __builtin_amdgcn_sched_group_barrier(0x002, 3, 0); }
    __builtin_amdgcn_sched_barrier(0);
    l += s + s1;
    bf16x8 vb2[8];
#pragma unroll
    for (int i = 0; i < 8; ++i) vb2[i] = *(const LAS bf16x8*)(vb + (i >> 1) * 32 * VP + 64 + (i & 1) * 32);
    __builtin_amdgcn_sched_barrier(0);
#pragma unroll
    for (int i = 0; i < 8; ++i) o[i >> 1] = __builtin_amdgcn_mfma_f32_32x32x16_bf16(vb2[i], (i & 1) ? pb3 : pb2, o[i >> 1], 0, 0, 0);
    __builtin_amdgcn_sched_barrier(0);
}
__device__ __forceinline__ float swap_max(float v) { auto rr = __builtin_amdgcn_permlane32_swap(__float_as_uint(v), __float_as_uint(v), false, false); return fmaxf(__uint_as_float(rr[0]), __uint_as_float(rr[1])); }
__device__ __forceinline__ float swap_sum(float v) { auto rr = __builtin_amdgcn_permlane32_swap(__float_as_uint(v), __float_as_uint(v), false, false); return __uint_as_float(rr[0]) + __uint_as_float(rr[1]); }
__device__ __forceinline__ void softmax_step(f32x16& y0, f32x16& y1, float A, float& m, float& l, f32x16 (&o)[4]) {
    float mx = y0[0];
#pragma unroll
    for (int r = 1; r < 16; ++r) mx = fmaxf(mx, y0[r]);
#pragma unroll
    for (int r = 0; r < 16; ++r) mx = fmaxf(mx, y1[r]);
    mx = swap_max(mx) + A;
    if (__any(mx > m + THR)) {
        const float mn = fmaxf(m, mx), al = fexp2(m - mn); m = mn; l *= al;
#pragma unroll
        for (int d0 = 0; d0 < 4; ++d0)
#pragma unroll
            for (int r = 0; r < 16; ++r) o[d0][r] *= al;
    }
    const float mA = m - A; float s = 0.f;
#pragma unroll
    for (int r = 0; r < 16; ++r) { y0[r] = fexp2(y0[r] - mA); s += y0[r]; }
#pragma unroll
    for (int r = 0; r < 16; ++r) { y1[r] = fexp2(y1[r] - mA); s += y1[r]; }
    l += s;
}
__device__ __forceinline__ void softmax_fixed(f32x16& y0, f32x16& y1, float c, float& l) {
    float s = 0.f;
#pragma unroll
    for (int r = 0; r < 16; ++r) { y0[r] = fexp2(y0[r] + c); s += y0[r]; }
#pragma unroll
    for (int r = 0; r < 16; ++r) { y1[r] = fexp2(y1[r] + c); s += y1[r]; }
    l += s;
}
#define KIDX(r) (((r) & 3) + 8 * ((r) >> 2))

template <int TY>
__device__ __forceinline__ void att_item(KArgs p, int l, int head, int qb, LAS unsigned char* lds, int wv, int part = 0) {
    const int tid = otid(wv), wid = __builtin_amdgcn_readfirstlane(tid >> 6), lane = tid & 63, r32 = lane & 31, hi = lane >> 5;
    constexpr int NKS = (TY == 0) ? 4 : 8;
    const int br = (TY == 0) ? (wid >> 2) : 0, rg = (TY == 0) ? (wid & 3) : wid;
    const int t0w = (TY == 0) ? (128 * qb + 32 * rg) : (256 * qb + 32 * wid);
    const int trow = t0w + r32;
    const int NT = (TY == 0) ? (2 * qb + 2) : (4 * qb + 4);
    const int qcol = (TY == 0) ? (128 * head + 64 * br) : (TY == 1 ? 2816 + 128 * head : 1536 + 128 * head);
    const int kcol = (TY == 0) ? (768 + 128 * head) : (TY == 1 ? 3456 + 128 * head : 2176 + 128 * head);
    const int hv = (TY == 0) ? head : (TY == 1 ? 6 + head : 11 + head);
    const bf16_t* QKB = (const bf16_t*)(p->ws + WS_QKB);
    const bf16_t* Kg = QKB + kcol; const bf16_t* Vg = (const bf16_t*)(p->ws + WS_VT) + (size_t)hv * HD * SEQ;
    const float* dc2 = (const float*)(p->ws + WS_DC2) + (size_t)head * SEQ;
    const float dcref = (TY == 2) ? dc2[256 * qb] : 0.f;
    const float slope2 = (TY == 0) ? fexp2(-8.0f * (float)(head + 1) / 6.0f) * LOG2E : 0.f;
    const float Bfix = (TY == 0) ? (11.5415603f * 1.01f * ((const float*)(p->ws + WS_LAM))[8 + 2 * l] + 0.25f) : (16.3221377f * 1.01f * ((const float*)(p->ws + WS_LAM))[8 + 2 * l + 1] + 0.25f);
    const float cfix = (TY == 2) ? (dc2[trow] - dcref - Bfix) : -Bfix;

    int j_lo = 0;
    if (TY == 0 && SKIP_A) {
        const float Bq = 11.5415603f * ((const float*)(p->ws + WS_LAM))[8 + 2 * l];
        const float x = ((float)(128 * qb - 63) - (39.f + 2.f * Bq) / slope2) * (1.f / 64.f);
        j_lo = x < 0.f ? 0 : (int)x + 1;
    } else if (TY == 2 && SKIP_C) {
        j_lo = ((const int*)(p->ws + WS_LAM))[64 + head * 32 + qb];
    }
    j_lo = __builtin_amdgcn_readfirstlane(j_lo);
    const int NTP = NT - j_lo;
    const bool elig = (TY == 2) ? (qb >= 8) : ((TY == 0) ? (head >= 4 && qb >= 16) : false);
    const bool split = elig && NTP > 32;
    if (part == 1 && !split) return;
    const int mid = j_lo + (NTP >> 1);
    const int jtop = (part == 1) ? mid - 1 : NT - 1;
    const int cntT = (part == 1) ? (mid - j_lo) : (split ? NT - mid : NTP);
    const int sidx = (TY == 2) ? (head * 32 + qb) : (160 + head * 64 + qb);
    unsigned long long* pay = (unsigned long long*)(p->ws + WS_PART) + ((size_t)sidx * 8 + wid) * 17 * 64 + lane;
    unsigned* aflag = (unsigned*)(p->ws + WS_CTL) + CW_AFLAG + (l * 544 + sidx) * 64;
    LAS unsigned char* buf0 = lds; LAS unsigned char* buf1 = lds + BUF_BYTES;
    LAS int* flags = (LAS int*)(lds + 2 * BUF_BYTES);
    if (TY == 1 && tid < 16) flags[tid] = 0;
    Stg st; float kbv = 0.f;
    stage_load(st, Kg, Vg, jtop, tid);
    if (TY == 2 && tid < 64) kbv = dcref - dc2[64 * jtop + tid];
    bf16x8 qr[NKS];
#pragma unroll
    for (int ks = 0; ks < NKS; ++ks) qr[ks] = *(const bf16x8*)(QKB + (size_t)trow * NQK + qcol + ks * 16 + hi * 8);
    stage_write(st, buf0, tid);
    if (TY == 2 && tid < 64) *(LAS float*)(buf0 + KT_BYTES + VT_BYTES + tid * 4) = kbv;
    if (cntT > 1) { stage_load(st, Kg, Vg, jtop - 1, tid); if (TY == 2 && tid < 64) kbv = dcref - dc2[64 * (jtop - 1) + tid]; }
    __syncthreads();

    f32x16 o[4];
#pragma unroll
    for (int d0 = 0; d0 < 4; ++d0)
#pragma unroll
        for (int r = 0; r < 16; ++r) o[d0][r] = 0.f;
    float m = 0.f, lsum = 0.f, R = 0.f;
    const int koff = r32 * KP + hi * 16 + ((TY == 0) ? br * 128 : 0), voff = KT_BYTES + r32 * VP + hi * 16;

    for (int it = 0; it < cntT; ++it) {
        if (TY == 1 && (SKIP_B & 1) && it > 0) { const i32x4 f0 = *(const LAS i32x4*)(flags + ((it - 1) & 1) * 8), f1 = *(const LAS i32x4*)(flags + ((it - 1) & 1) * 8 + 4);
            if (__builtin_amdgcn_readfirstlane((f0[0] & f0[1] & f0[2] & f0[3] & f1[0] & f1[1] & f1[2] & f1[3])) != 0) break; }
        const int j = jtop - it;
        LAS unsigned char* cur = (it & 1) ? buf1 : buf0; LAS unsigned char* oth = (it & 1) ? buf0 : buf1;
        const bool more = it + 1 < cntT;
        if (TY == 0) {
            const int cw = 2 * qb + (rg >> 1);
            if (j <= cw) {
                f32x16 y0, y1;
                const int trel = trow - 64 * j;
                if (j == cw) {
                    const float tq = (float)(trel - 4 * hi);
#pragma unroll
                    for (int r = 0; r < 16; ++r) { y0[r] = fmaf(-slope2, fabsf(tq - (float)KIDX(r)), cfix); y1[r] = fmaf(-slope2, fabsf(tq - (float)(KIDX(r) + 32)), cfix); }
                } else {
                    const float A = fmaf(-slope2, (float)(trel - 4 * hi), cfix);
#pragma unroll
                    for (int r = 0; r < 16; ++r) { y0[r] = fmaf(slope2, (float)KIDX(r), A); y1[r] = fmaf(slope2, (float)(KIDX(r) + 32), A); }
                }
                tile_fixed<NKS>(o, cur + koff, cur + voff, qr, y0, y1, lsum);
            }
        } else {
            const int jj = j - 4 * qb;
            if (jj <= (wid >> 1) && !(TY == 1 && (SKIP_B & 2) && __all(R <= -40.f))) {
                const bool partial = (jj == (wid >> 1));
                const int tin = 32 * (wid & 1) + r32 - 4 * hi;
                f32x16 y0, y1;
                if (TY == 2) {
                    const LAS f32x4* kbp = (const LAS f32x4*)(cur + KT_BYTES + VT_BYTES) + hi;
#pragma unroll
                    for (int g = 0; g < 4; ++g) { const f32x4 b0 = kbp[2 * g], b1 = kbp[2 * g + 8];
#pragma unroll
                        for (int i = 0; i < 4; ++i) { y0[4 * g + i] = b0[i] + cfix; y1[4 * g + i] = b1[i] + cfix; } }
                    if (partial) {
#pragma unroll
                        for (int r = 0; r < 16; ++r) { if (KIDX(r) > tin) y0[r] = -__builtin_inff(); if (KIDX(r) + 32 > tin) y1[r] = -__builtin_inff(); }
                    }
                    tile_fixed<NKS>(o, cur + koff, cur + voff, qr, y0, y1, lsum);
                } else {
#pragma unroll
                    for (int r = 0; r < 16; ++r) { y0[r] = 0.f; y1[r] = 0.f; }
                    qk_tile<NKS>(y0, y1, cur + koff, qr);
                    f32x16 lb0, lb1;
#pragma unroll
                    for (int r = 0; r < 16; ++r) {
                        { const float z = fminf(fmaxf(y0[r], -100.f), 100.f), b = -flog2(1.f + fexp2(-z)); float k = b - z, bb = b;
                          if (partial && KIDX(r) >= tin) { k = 0.f; bb = -__builtin_inff(); } lb0[r] = bb; y0[r] = k; }
                        { const float z = fminf(fmaxf(y1[r], -100.f), 100.f), b = -flog2(1.f + fexp2(-z)); float k = b - z, bb = b;
                          if (partial && KIDX(r) + 32 >= tin) { k = 0.f; bb = -__builtin_inff(); } lb1[r] = bb; y1[r] = k; }
                    }
                    float gs0[4], gs1[4];
#pragma unroll
                    for (int g = 0; g < 4; ++g) {
                        { const float e0 = y0[4 * g], e1 = y0[4 * g + 1], e2 = y0[4 * g + 2], e3 = y0[4 * g + 3]; const float s2 = e3, s1 = e3 + e2, s0 = s1 + e1;
                          y0[4 * g + 3] = 0.f; y0[4 * g + 2] = s2; y0[4 * g + 1] = s1; y0[4 * g] = s0; gs0[g] = s0 + e0; }
                        { const float e0 = y1[4 * g], e1 = y1[4 * g + 1], e2 = y1[4 * g + 2], e3 = y1[4 * g + 3]; const float s2 = e3, s1 = e3 + e2, s0 = s1 + e1;
                          y1[4 * g + 3] = 0.f; y1[4 * g + 2] = s2; y1[4 * g + 1] = s1; y1[4 * g] = s0; gs1[g] = s0 + e0; }
                    }
                    float run = R;
#pragma unroll
                    for (int half = 1; half >= 0; --half)
#pragma unroll
                        for (int g = 3; g >= 0; --g) {
                            const float mine = half ? gs1[g] : gs0[g];
                            auto rr = __builtin_amdgcn_permlane32_swap(__float_as_uint(mine), __float_as_uint(mine), false, false);
                            const float g_lo = __uint_as_float(rr[0]), g_hi = __uint_as_float(rr[1]);
                            const float off_hi = run; run += g_hi; const float off_lo = run; run += g_lo;
                            const float off = hi ? off_hi : off_lo;
#pragma unroll
                            for (int i = 0; i < 4; ++i) {
                                if (half) y1[4 * g + i] = fexp2(lb1[4 * g + i] + y1[4 * g + i] + off);
                                else y0[4 * g + i] = fexp2(lb0[4 * g + i] + y0[4 * g + i] + off);
                            }
                        }
                    R = run;
                    pv_tile(o, cur + voff, y0, y1);
                }
            }
        }
        if (TY == 1) { const int dn = __all(R <= -40.f) ? 1 : 0; if (lane == 0) flags[(it & 1) * 8 + wid] = dn; }
        if (more) { stage_write(st, oth, tid); if (TY == 2 && tid < 64) *(LAS float*)(oth + KT_BYTES + VT_BYTES + tid * 4) = kbv; }
        if (it + 2 < cntT) { stage_load(st, Kg, Vg, j - 2, tid); if (TY == 2 && tid < 64) kbv = dcref - dc2[64 * (j - 2) + tid]; }
        __syncthreads();
    }

    bf16_t* MIX = (bf16_t*)(p->ws + WS_MIX);
    float inv = 1.f;
    if (TY != 1) {
        float lt = swap_sum(lsum);
        if (part == 1) {
            __hip_atomic_store(pay, ((unsigned long long)__float_as_uint(lt) << 32) | __float_as_uint(m), __ATOMIC_RELAXED, __HIP_MEMORY_SCOPE_AGENT);
#pragma unroll
            for (int d0 = 0; d0 < 4; ++d0)
#pragma unroll
                for (int g = 0; g < 4; ++g)
                    __hip_atomic_store(pay + (1 + d0 * 4 + g) * 64, ((unsigned long long)cvtpk(o[d0][4 * g + 2], o[d0][4 * g + 3]) << 32) | cvtpk(o[d0][4 * g], o[d0][4 * g + 1]), __ATOMIC_RELAXED, __HIP_MEMORY_SCOPE_AGENT);
            asm volatile("s_waitcnt vmcnt(0)" ::: "memory");
            __syncthreads();
            if (tid == 0) __hip_atomic_store(aflag, 1u, __ATOMIC_RELAXED, __HIP_MEMORY_SCOPE_AGENT);
            __syncthreads();
            return;
        }
        if (split) {
            if (tid == 0) { unsigned sp = 0; while (__hip_atomic_load(aflag, __ATOMIC_RELAXED, __HIP_MEMORY_SCOPE_AGENT) == 0u && ++sp < (1u << 22)) __builtin_amdgcn_s_sleep(2);
                __builtin_amdgcn_fence(__ATOMIC_ACQUIRE, "agent"); asm volatile("s_waitcnt vmcnt(0)" ::: "memory"); }
            __syncthreads();
            const unsigned long long ml = __hip_atomic_load(pay, __ATOMIC_RELAXED, __HIP_MEMORY_SCOPE_AGENT);
            const float mf = __uint_as_float((unsigned)ml), lf = __uint_as_float((unsigned)(ml >> 32));
            const float mn = fmaxf(m, mf), a0 = fexp2(m - mn), a1 = fexp2(mf - mn);
            lt = a0 * lt + a1 * lf;
#pragma unroll
            for (int d0 = 0; d0 < 4; ++d0)
#pragma unroll
                for (int g = 0; g < 4; ++g) {
                    const unsigned long long w = __hip_atomic_load(pay + (1 + d0 * 4 + g) * 64, __ATOMIC_RELAXED, __HIP_MEMORY_SCOPE_AGENT);
                    const unsigned w0 = (unsigned)w, w1 = (unsigned)(w >> 32);
                    o[d0][4 * g] = a0 * o[d0][4 * g] + a1 * bf_lo(w0); o[d0][4 * g + 1] = a0 * o[d0][4 * g + 1] + a1 * bf_hi(w0);
                    o[d0][4 * g + 2] = a0 * o[d0][4 * g + 2] + a1 * bf_lo(w1); o[d0][4 * g + 3] = a0 * o[d0][4 * g + 3] + a1 * bf_hi(w1);
                }
        }
        inv = 1.f / lt;
    }
    float post = 1.f; const float* gain;
    if (TY == 0) {
        const float lam = ((const float*)(p->ws + WS_LAM))[l];
        LAS float* X = (LAS float*)lds + (size_t)rg * 128 * 32;
        if (br == 1) {
            const float sc = inv * lam;
#pragma unroll
            for (int d0 = 0; d0 < 4; ++d0)
#pragma unroll
                for (int r = 0; r < 16; ++r) X[(32 * d0 + KIDX(r) + 4 * hi) * 32 + r32] = o[d0][r] * sc;
        }
        __syncthreads();
        if (br == 0) {
#pragma unroll
            for (int d0 = 0; d0 < 4; ++d0)
#pragma unroll
                for (int r = 0; r < 16; ++r) o[d0][r] = o[d0][r] * inv - X[(32 * d0 + KIDX(r) + 4 * hi) * 32 + r32];
        }
        inv = 1.f;
        post = 1.f - (0.8f - 0.6f * fexp2(-0.3f * LOG2E * (float)l));
        gain = p->subln_diff + l * HD;
    } else if (TY == 1) gain = p->onorm_sb + l * HD;
    else gain = p->onorm_fox + l * HD;
    if (TY != 0 || br == 0) {
        float ss = 0.f;
#pragma unroll
        for (int d0 = 0; d0 < 4; ++d0)
#pragma unroll
            for (int r = 0; r < 16; ++r) { const float v = o[d0][r] * inv; ss += v * v; }
        ss = swap_sum(ss);
        const float sc = inv * post * __builtin_amdgcn_rsqf(ss * (1.f / HD) + EPS);
        bf16_t* orow = MIX + (size_t)trow * DM + hv * HD + 4 * hi;
#pragma unroll
        for (int d0 = 0; d0 < 4; ++d0)
#pragma unroll
            for (int g = 0; g < 4; ++g) {
                const f32x4 g4 = *(const f32x4*)(gain + 32 * d0 + 8 * g + 4 * hi);
                if (FP8_WOUT) { *(unsigned*)((unsigned char*)MIX + (size_t)trow * DM + hv * HD + 4 * hi + 32 * d0 + 8 * g) = cvt4f8(o[d0][4 * g] * sc * g4[0], o[d0][4 * g + 1] * sc * g4[1], o[d0][4 * g + 2] * sc * g4[2], o[d0][4 * g + 3] * sc * g4[3]); continue; }
                u32x2 w; w[0] = cvtpk(o[d0][4 * g] * sc * g4[0], o[d0][4 * g + 1] * sc * g4[1]); w[1] = cvtpk(o[d0][4 * g + 2] * sc * g4[2], o[d0][4 * g + 3] * sc * g4[3]);
                *(u32x2*)(orow + 32 * d0 + 8 * g) = w;
            }
    }
    __syncthreads();
}

constexpr int N_FAR = 5 * 24 + 2 * 48;
constexpr int N_ITEMS = N_FAR + 32 * 22;
__device__ __forceinline__ void attention_phase(KArgs p, int l, LAS unsigned char* lds, volatile LAS unsigned* itemw, int wv, int qi, int tmask = 7) {
    unsigned* q = (unsigned*)(p->ws + WS_CTL) + CW_ATTQ + qi * 64;
    for (;;) {
        if (otid(wv) == 0) *itemw = __hip_atomic_fetch_add(q, 1u, __ATOMIC_RELAXED, __HIP_MEMORY_SCOPE_AGENT);
        __syncthreads();
        int item = (int)*itemw;
        __syncthreads();
        if (item >= N_ITEMS) break;
        if (item < N_FAR) {
            if (item < 120) { if (tmask & 1) att_item<2>(p, l, item % 5, 31 - item / 5, lds, wv, 1); }
            else { const int i2 = item - 120; if (tmask & 2) att_item<0>(p, l, 5 - (i2 & 1), 63 - (i2 >> 1), lds, wv, 1); }
            continue;
        }
        item -= N_FAR;
        if (item < 288) { const int w = item % 9, pp = 31 - item / 9;
            if (w < 5) { if (tmask & 1) att_item<2>(p, l, w, pp, lds, wv); }
            else if (tmask & 2) att_item<0>(p, l, 5 - ((w - 5) >> 1), 2 * pp + 1 - ((w - 5) & 1), lds, wv); }
        else if (item < 544) { const int it2 = item - 288, w = it2 % 8, pp = 31 - it2 / 8;
            if (tmask & 2) att_item<0>(p, l, 3 - (w >> 1), 2 * pp + 1 - (w & 1), lds, wv); }
        else if (tmask & 4) { const int it3 = item - 544; att_item<1>(p, l, it3 % 5, 31 - it3 / 5, lds, wv); }
    }
}
}

__device__ __forceinline__ void phase_route(KArgs p, int l, LAS unsigned char* lds, int wv, int ci, bool waitp = true) {
    const int tid = otid(wv), lane = tid & 63, wave = tid >> 6;
    LAS float* wrt = (LAS float*)lds;
    LAS int* bsel = (LAS int*)(lds + 16 * DM * 4);
    LAS float* bsc = (LAS float*)(bsel + 64);
    LAS float* bgate = bsc + 64;
    LAS float* brs = bgate + 64;
    { const f32x4* src = (const f32x4*)(p->ws + WS_WRT); for (int i = tid; i < 16 * DM / 4; i += 512) ((LAS f32x4*)wrt)[i] = src[i]; }
    __syncthreads();
    bf16_t* XN = (bf16_t*)(p->ws + WS_XN);
    for (int blk = blockIdx.x; blk < SEQ / 32; blk += gridDim.x) {
        const int tid = otid(wv), lane = tid & 63, wave = tid >> 6;
        if (waitp) { if (wave == 0) {
            const unsigned* wc = (const unsigned*)(p->ws + WS_CTL) + CW_WOC + l * 32 * 64 + 64 * (blk >> 3);
            unsigned sp = 0;
            while ((unsigned)__builtin_amdgcn_readfirstlane((int)__hip_atomic_load(wc, __ATOMIC_RELAXED, __HIP_MEMORY_SCOPE_AGENT)) < 64u && ++sp < (1u << 22)) __builtin_amdgcn_s_sleep(2);
            __builtin_amdgcn_fence(__ATOMIC_ACQUIRE, "agent");
            asm volatile("s_waitcnt vmcnt(0)" ::: "memory");
            } __syncthreads(); }
        const int tb = blk * 32 + wave * 4;
        f32x4 hx[4][8];
#pragma unroll
        for (int i = 0; i < 4; ++i) { const u32x2* xr = (const u32x2*)((const bf16_t*)(p->ws + WS_OUTB) + (size_t)(tb + i) * DM) + lane;
#pragma unroll
            for (int j = 0; j < 8; ++j) { const u32x2 a = xr[64 * j]; hx[i][j] = (f32x4){bf_lo(a[0]), bf_hi(a[0]), bf_lo(a[1]), bf_hi(a[1])}; } }
#pragma unroll
        for (int i = 0; i < 4; ++i) {
            float ss = 0.f;
#pragma unroll
            for (int j = 0; j < 8; ++j) ss += (hx[i][j][0] * hx[i][j][0] + hx[i][j][1] * hx[i][j][1]) + (hx[i][j][2] * hx[i][j][2] + hx[i][j][3] * hx[i][j][3]);
            const float rstd = __builtin_amdgcn_rsqf(wave_sum(ss) * (1.f / DM) + EPS);
            if (lane == 0) brs[wave * 4 + i] = rstd;
            const f32x4* gr = (const f32x4*)(p->ffn_norm + (size_t)l * DM) + lane;
#pragma unroll
            for (int j = 0; j < 8; ++j) hx[i][j] = hx[i][j] * rstd * gr[64 * j];
        }
#pragma unroll
        for (int h2 = 0; h2 < 2; ++h2) {
            f32x4 (&hn)[2][8] = *reinterpret_cast<f32x4 (*)[2][8]>(&hx[2 * h2]);
            asm volatile("" ::: "memory"); __builtin_amdgcn_sched_barrier(0);
            float acc[32];
#pragma unroll
            for (int k = 0; k < 32; ++k) acc[k] = 0.f;
#pragma unroll
            for (int j = 0; j < 8; ++j)
#pragma unroll
                for (int eh = 0; eh < 2; ++eh) {
#pragma unroll
                    for (int e = 8 * eh; e < 8 * eh + 8; ++e) { const f32x4 w4 = *(const LAS f32x4*)(wrt + e * DM + 4 * lane + 256 * j);
#pragma unroll
                        for (int i = 0; i < 2; ++i) acc[i * 16 + e] += (hn[i][j][0] * w4[0] + hn[i][j][1] * w4[1]) + (hn[i][j][2] * w4[2] + hn[i][j][3] * w4[3]); }
                    __builtin_amdgcn_sched_barrier(0);
                }
#pragma unroll
            for (int k = 0; k < 32; ++k) acc[k] = sum_xor32(acc[k]);
#define RSTEP(H) { const bool up = (lane & H) != 0; _Pragma("unroll") for (int k = 0; k < H; ++k) { const float a = acc[k], b = acc[k + H]; const float give = up ? a : b, keep = up ? b : a; acc[k] = keep + swz_xor<H>(give); } }
            RSTEP(16) RSTEP(8) RSTEP(4) RSTEP(2) RSTEP(1)
#undef RSTEP
            const float logit = acc[0];
            const float score = __builtin_amdgcn_rcpf(1.f + fexp2(-logit * LOG2E));
            const float sel = score + p->router_bias[lane & 15];
            const float v1 = swz_xor<1>(sel), v2 = swz_xor<2>(sel), v3 = swz_xor<3>(sel);
            const float a = fmaxf(sel, v1), b = fminf(sel, v1), c = fmaxf(v2, v3), d = fminf(v2, v3);
            const float gs = fmaxf(a, c) + fmaxf(fminf(a, c), fmaxf(b, d));
            const float g1 = swz_xor<4>(gs), g2 = swz_xor<8>(gs), g3 = swz_xor<12>(gs);
            const int myg = (lane >> 2) & 3, k = lane & 3;
            const bool best = (gs > g1 || (gs == g1 && myg < (myg ^ 1))) && (gs > g2 || (gs == g2 && myg < (myg ^ 2))) && (gs > g3 || (gs == g3 && myg < (myg ^ 3)));
            const int rank = ((v1 > sel || (v1 == sel && (k ^ 1) < k)) ? 1 : 0) + ((v2 > sel || (v2 == sel && (k ^ 2) < k)) ? 1 : 0) + ((v3 > sel || (v3 == sel && (k ^ 3) < k)) ? 1 : 0);
            if (best && rank < 2 && lane < 32) { const int row = wave * 4 + h2 * 2 + (lane >> 4); bsel[row * 2 + rank] = lane & 15; bsc[row * 2 + rank] = score; }
        }
        asm volatile("s_waitcnt lgkmcnt(0)" ::: "memory");
        if (lane < 8) { const int idx = wave * 8 + lane; const float sm = bsc[idx], so = bsc[idx ^ 1]; bgate[idx] = sm / (sm + so); }
        __syncthreads();
        if (wave == 0) {
            unsigned* cnt = (unsigned*)(p->ws + WS_CTL) + CW_CNT + ci * 16 * 64;
            const int mye = bsel[lane]; int myrank = 0, n = 0;
            const unsigned long long below = (1ull << lane) - 1ull;
#pragma unroll
            for (int e = 0; e < 16; ++e) { const unsigned long long mk = __ballot(mye == e); if (mye == e) myrank = (int)__popcll(mk & below); if (lane == e) n = (int)__popcll(mk); }
            int base = 0;
            if (lane < 16 && n) base = (int)__hip_atomic_fetch_add(cnt + lane * 64, (unsigned)n, __ATOMIC_RELAXED, __HIP_MEMORY_SCOPE_AGENT);
            const int pos = __builtin_amdgcn_ds_bpermute(mye << 2, base) + myrank, tok = blk * 32 + (lane >> 1);
            ((int*)(p->ws + WS_TOK))[mye * SEQ + pos] = tok; ((f32x2_t*)(p->ws + WS_GATE))[mye * SEQ + pos] = (f32x2_t){bgate[lane], brs[lane >> 1]};
            int* ts = (int*)(p->ws + WS_TSEL) + tok * 4 + (lane & 1) * 2; ts[0] = mye; ts[1] = pos;
        }
        __syncthreads();
    }
}

__device__ __forceinline__ void moe_table(KArgs p, int l, LAS int* tbl, int wv) {
    if (otid(wv) == 0) { const unsigned* cnt = (const unsigned*)(p->ws + WS_CTL) + CW_CNT + l * 16 * 64; int acc = 0;
        for (int e = 0; e < 16; ++e) { const int n = (int)cnt[e * 64]; tbl[e] = acc; tbl[17 + e] = n; acc += (n + 255) >> 8; } tbl[16] = acc; }
    __syncthreads();
}

constexpr int N_PHASES = 2 + 7 * DEPTH;
__device__ __forceinline__ int opq(int v) { asm volatile("" : "+s"(v)); return v; }
__device__ __forceinline__ LAS unsigned char* opq(LAS unsigned char* v) { unsigned x = (unsigned)(uintptr_t)v; asm volatile("" : "+s"(x)); return (LAS unsigned char*)(uintptr_t)x; }
__global__ void __launch_bounds__(512, 2) trunk_fwd(Params pk) {
    extern __shared__ __attribute__((aligned(16))) unsigned char lds_raw[];
    LAS unsigned char* lds = (LAS unsigned char*)lds_raw;
    volatile LAS unsigned* MISC = (volatile LAS unsigned*)(lds + MISC_OFF);
    LAS int* mtbl = (LAS int*)(lds + MISC_OFF + 256);
#define p kparams()
    const int wv = __builtin_amdgcn_readfirstlane((int)threadIdx.x >> 6);
    for (int u = threadIdx.x; u < (LDS_BYTES - MISC_OFF) / 4; u += 512) ((LAS unsigned*)(lds + MISC_OFF))[u] = 0u;
    __syncthreads();
    unsigned* ctl = (unsigned*)(p->ws + WS_CTL);
    XcdBarrier bar; bar.bar = ctl + CW_BAR; bar.x = 0; bar.st = nullptr; bar.wv = wv;
    const bool multi = (p->ph_hi - p->ph_lo) > 1;
    if (multi) bar = xcd_barrier_post(ctl + CW_BAR, MISC + 8, wv);
    const int lo = p->ph_lo, hi = p->ph_hi;
#define IN(k) (lo <= (k) && (k) < hi)
#define SEAM(k) do { if (IN(k) && IN((k) + 1)) xcd_barrier(bar); } while (0)
    const int G0 = gridDim.x, c0 = blockIdx.x; LAS unsigned char* const lds0 = lds;
#define PHASE_LOCALS const int G = opq(G0), c = opq(c0); LAS unsigned char* const lds = opq(lds0); LAS int* const mtbl = (LAS int*)(lds + MISC_OFF + 256); volatile LAS unsigned* const MISC = (volatile LAS unsigned*)(lds + MISC_OFF); (void)G; (void)c; (void)mtbl; (void)MISC;

    if (PK(0) && IN(0)) { PHASE_LOCALS phase_prologue(p, lds, wv); if (DUP_PHASE == 0) { __syncthreads(); phase_prologue(p, lds, wv); } SEAM(0); }
    for (int l = 0; l < DEPTH; ++l) {
        const int pb = 1 + 7 * l;
        if (PK(1) && IN(pb + 0)) { PHASE_LOCALS phase_norm1(p, l, lds, wv); if (DUP_PHASE == 1) { xcd_barrier(bar); phase_norm1(p, l, lds, wv, true); } SEAM(pb + 0); }
        if (PK(2) && IN(pb + 1)) { PHASE_LOCALS
            if (c < H_FOX) scan_head(p, c, l, lds, wv);
            for (int rep = 0; rep < (DUP_PHASE == 2 ? 2 : 1); ++rep) {
            { pg8::Gemm g{(const bf16_t*)(p->ws + (FP8_PROJ ? WS_OUTB8 : WS_OUTB)), (const bf16_t*)(p->ws + WS_WQK + (size_t)l * NQK * DM * (FP8_PROJ ? 1 : 2)), SEQ, NQK, FP8_PROJ ? DM / 2 : DM};
              pg8::StaticOrder S; S.init(SEQ, NQK, G, c);
              pg8::EpiQK E{(bf16_t*)(p->ws + WS_QKB), p->qnorm_diff + l * 64, p->knorm_diff + l * 64, p->qnorm_fox + l * 128, p->knorm_fox + l * 128, (LAS float*)(lds + TBL_OFF), (const float*)(p->ws + WS_RSTD)};
              pg8::gemm_phase<pg8::EpiQK, pg8::StaticOrder>(lds, g, S, E, wv); }
            { pg8::Gemm g{(const bf16_t*)(p->ws + WS_WV + (size_t)l * NV * DM * (FP8_PROJ ? 1 : 2)), (const bf16_t*)(p->ws + (FP8_PROJ ? WS_OUTB8 : WS_OUTB)), NV, SEQ, FP8_PROJ ? DM / 2 : DM};
              pg8::StaticOrder S; S.init(NV, SEQ, G, c);
              pg8::EpiVT E{(bf16_t*)(p->ws + WS_VT), SEQ, (const float*)(p->ws + WS_RSTD)};
              pg8::gemm_phase<pg8::EpiVT, pg8::StaticOrder>(lds, g, S, E, wv); }
            }
            SEAM(pb + 1);
        }
        if (PK(3) && IN(pb + 2)) { PHASE_LOCALS att::attention_phase(p, l, lds, MISC + 16, wv, l); if (DUP_PHASE == 3) { __syncthreads(); att::attention_phase(p, l, lds, MISC + 16, wv, l + 4, ATT_MASK2); } SEAM(pb + 2); }
        if (PK(4) && IN(pb + 3)) { PHASE_LOCALS
            pg8::Gemm g{(const bf16_t*)(p->ws + WS_MIX), (const bf16_t*)(p->ws + WS_WO + (size_t)l * DM * DM * (FP8_WOUT ? 1 : 2)), SEQ, DM, FP8_WOUT ? DM / 2 : DM};
            pg8::StaticOrder S; S.init(SEQ, DM, G, c);
            pg8::EpiResAdd E{(bf16_t*)(p->ws + WS_OUTB), 1.f, (unsigned*)(p->ws + WS_CTL) + CW_WOC + l * 32 * 64, p->ws + WS_OUTB8};
            pg8::gemm_phase<pg8::EpiResAdd, pg8::StaticOrder>(lds, g, S, E, wv);
        }
        if (PK(5) && IN(pb + 4)) { PHASE_LOCALS phase_route(p, l, lds, wv, l); if (DUP_PHASE == 5) { xcd_barrier(bar); phase_route(p, l, lds, wv, l + 4); } SEAM(pb + 4); }
        if (PK(6) && IN(pb + 5)) { PHASE_LOCALS
            moe_table(p, l, mtbl, wv);
            pg8::Gemm g{(const bf16_t*)(p->ws + WS_OUTB8), (const bf16_t*)(p->ws + WS_WGU + (size_t)l * NEXP * 1024 * DM), MOE_ROWS, NEXP * 1024, DM / 2};
            pg8::MoeOrder<4, true> S{mtbl, (const int*)(p->ws + WS_TOK), G, c, DM / 2};
            pg8::EpiGU E{p->ws + WS_ACT, (const float*)(p->ws + WS_GATE), mtbl, (unsigned*)(p->ws + WS_CTL) + CW_GUC + l * 80 * 64};
            for (int rep = 0; rep < (DUP_PHASE == 6 ? 2 : 1); ++rep)
            pg8::gemm_phase<pg8::EpiGU, pg8::MoeOrder<4, true>>(lds, g, S, E, wv);
        }
        if (PK(7) && IN(pb + 6)) { PHASE_LOCALS
            moe_table(p, l, mtbl, wv);
            pg8::Gemm g{(const bf16_t*)(p->ws + WS_ACT), (const bf16_t*)(p->ws + WS_WD + (size_t)l * NEXP * DM * FEXP), MOE_ROWS, NEXP * DM, FEXP / 2};
            pg8::DownOrder S{mtbl, (unsigned*)(p->ws + WS_CTL) + CW_GUC + l * 80 * 64, (unsigned*)(p->ws + WS_CTL) + CW_BAR + XB_TMO, G, c};
            pg8::EpiDown E{(bf16_t*)(p->ws + WS_Y)};
            pg8::gemm_phase<pg8::EpiDown, pg8::DownOrder>(lds, g, S, E, wv);
            SEAM(pb + 6);
        }
    }
    if (PK(1) && IN(N_PHASES - 1)) { PHASE_LOCALS phase_norm1(p, DEPTH, lds, wv); }
#undef IN
#undef SEAM
#undef PHASE_LOCALS
#undef p
}

extern "C" void kernel_launch(void* const* d_in, const int* in_sizes, int n_in, void* d_out, int out_size, void* d_ws, size_t ws_size, hipStream_t stream) {
    static int grid = 0;
    if (grid == 0) {
        if (n_in != 22 || in_sizes[0] != SEQ * DM || out_size != SEQ * DM || ws_size < WS_END) {
            fprintf(stderr, "kernel_launch: unexpected shapes (n_in %d, in0 %d, out %d, ws %zu < %zu); nothing launched\n", n_in, n_in > 0 ? in_sizes[0] : -1, out_size, ws_size, (size_t)WS_END); grid = -1; return; }
        int dev = 0, cus = 0, per_cu = 0;
        if (hipGetDevice(&dev) != hipSuccess || hipDeviceGetAttribute(&cus, hipDeviceAttributeMultiprocessorCount, dev) != hipSuccess) { grid = -1; return; }
        if (hipFuncSetAttribute((const void*)trunk_fwd, hipFuncAttributeMaxDynamicSharedMemorySize, LDS_BYTES) != hipSuccess) { fprintf(stderr, "kernel_launch: hipFuncSetAttribute failed\n"); grid = -1; return; }
        if (hipOccupancyMaxActiveBlocksPerMultiprocessor(&per_cu, (const void*)trunk_fwd, 512, LDS_BYTES) != hipSuccess || per_cu < 1)
            fprintf(stderr, "kernel_launch: note: occupancy query reports %d workgroups per CU\n", per_cu);
        (void)hipGetLastError();
        grid = cus;
    }
    if (grid < 0) return;
    if (hipMemsetAsync((char*)d_ws + WS_CTL, 0, CTL_ZERO_BYTES, stream) != hipSuccess) { fprintf(stderr, "kernel_launch: memset failed\n"); return; }
    Params hp{};
    const float** pp = (const float**)&hp;
    for (int i = 0; i < 22; ++i) pp[i] = (const float*)d_in[i];
    hp.out = (float*)d_out; hp.ws = (unsigned char*)d_ws;
#if MK_ONE_LAUNCH
    hp.ph_lo = 0; hp.ph_hi = N_PHASES;
    hipLaunchKernelGGL(trunk_fwd, dim3(grid), dim3(512), LDS_BYTES, stream, hp);
#else
    for (int ph = 0; ph < N_PHASES; ++ph) { hp.ph_lo = ph; hp.ph_hi = ph + 1; hipLaunchKernelGGL(trunk_fwd, dim3(grid), dim3(512), LDS_BYTES, stream, hp); }
#endif
    const hipError_t le = hipPeekAtLastError();
    if (le != hipSuccess) fprintf(stderr, "kernel_launch: launch failed: %s\n", hipGetErrorName(le));
}
```

```cpp
#include <hip/hip_runtime.h>
#include <cstdio>
#include <cstdint>

#ifndef MK_ONE_LAUNCH
#define MK_ONE_LAUNCH 1
#endif
#ifndef PHASE_MASK
#define PHASE_MASK 0xff
#endif
#define PK(k) (((PHASE_MASK) >> (k)) & 1)
#ifndef FP8_PROJ
#define FP8_PROJ 1
#endif
#ifndef FP8_WOUT
#define FP8_WOUT 1
#endif
#ifndef DUP_PHASE
#define DUP_PHASE -1
#endif
#ifndef ATT_MASK2
#define ATT_MASK2 7
#endif
#ifndef SKIP_A
#define SKIP_A 1
#endif
#ifndef SKIP_B
#define SKIP_B 3
#endif
#ifndef SKIP_C
#define SKIP_C 1
#endif

#define GAS __attribute__((address_space(1)))
#define LAS __attribute__((address_space(3)))
typedef unsigned short bf16_t;
typedef short bf16x8 __attribute__((ext_vector_type(8)));
typedef float f32x4 __attribute__((ext_vector_type(4)));
typedef float f32x16 __attribute__((ext_vector_type(16)));
typedef unsigned u32x4 __attribute__((ext_vector_type(4)));
typedef unsigned u32x2 __attribute__((ext_vector_type(2)));
typedef int i32x4 __attribute__((ext_vector_type(4)));

constexpr int SEQ = 8192, DM = 2048, DEPTH = 4, NQK = 4096, NV = 2048, NEXP = 16, FEXP = 512, NIN = 6149;
constexpr int HD = 128, H_DIFF = 6, H_SB = 5, H_FOX = 5;
constexpr float EPS = 1e-6f;
constexpr float LOG2E = 1.4426950408889634f;
constexpr int MOE_ROWS = 16384 + 16 * 256;

constexpr size_t MiB = 1u << 20;
constexpr size_t WS_CTL = 0, CTL_ZERO_BYTES = 1 * MiB;
constexpr size_t WS_WF = 1 * MiB;
constexpr size_t WS_LAM = 1 * MiB + 512 * 1024;
constexpr size_t WS_LOGF = 2 * MiB;
constexpr size_t WS_DC2 = 3 * MiB;
constexpr size_t WS_TOK = 4 * MiB;
constexpr size_t WS_GATE = 5 * MiB;
constexpr size_t WS_TSEL = 6 * MiB;
constexpr size_t WS_WRT = 7 * MiB;
constexpr size_t WS_RSTD = 8 * MiB;
constexpr size_t WS_WQK = 16 * MiB;
constexpr size_t WS_WV = 80 * MiB;
constexpr size_t WS_WO = 112 * MiB;
constexpr size_t WS_WGU = 144 * MiB;
constexpr size_t WS_WD = 400 * MiB;
constexpr size_t WS_XN = 528 * MiB;
constexpr size_t WS_QKB = 560 * MiB;
constexpr size_t WS_VT = 624 * MiB;
constexpr size_t WS_MIX = 656 * MiB;
constexpr size_t WS_ACT = 688 * MiB;
constexpr size_t WS_Y = 708 * MiB;
constexpr size_t WS_PART = 788 * MiB;
constexpr size_t WS_OUTB = 828 * MiB;
constexpr size_t WS_OUTB8 = 862 * MiB;
constexpr size_t WS_END = 878 * MiB;
constexpr int CW_BAR = 4096;
constexpr int CW_ATTQ = 16384;
constexpr int CW_CNT = 32768;
constexpr int CW_AFLAG = 65536;
constexpr int CW_WOC = 233472;
constexpr int CW_GUC = 212992;

constexpr int RING_BYTES = 131072;
constexpr int TBL_OFF = RING_BYTES;
constexpr int MISC_OFF = RING_BYTES + 8192;
constexpr int LDS_BYTES = 147456;

typedef float f32x2_t __attribute__((ext_vector_type(2)));
typedef __bf16 bf16x2_t __attribute__((ext_vector_type(2)));
typedef int i32x8 __attribute__((ext_vector_type(8)));
__device__ __forceinline__ unsigned cvt4f8(float a, float b, float c, float d) {
    int w = 0; w = __builtin_amdgcn_cvt_pk_fp8_f32(a, b, w, false); w = __builtin_amdgcn_cvt_pk_fp8_f32(c, d, w, true); return (unsigned)w; }
constexpr float W8_SCALE = 256.f, ACT8_SCALE = 4.f, Y8_SCALE = 32.f;
__device__ __forceinline__ unsigned cvtpk(float lo, float hi) { const f32x2_t v = {lo, hi}; const bf16x2_t b = __builtin_convertvector(v, bf16x2_t); return __builtin_bit_cast(unsigned, b); }
__device__ __forceinline__ float bf_lo(unsigned u) { return __uint_as_float(u << 16); }
__device__ __forceinline__ float bf_hi(unsigned u) { return __uint_as_float(u & 0xffff0000u); }
__device__ __forceinline__ float fexp2(float x) { return __builtin_amdgcn_exp2f(x); }
__device__ __forceinline__ float flog2(float x) { return __builtin_amdgcn_logf(x); }
__device__ __forceinline__ int otid(int wv) { int t; asm volatile("v_mbcnt_lo_u32_b32 %0, -1, 0\n\tv_mbcnt_hi_u32_b32 %0, -1, %0" : "=v"(t)); return wv * 64 + t; }
template <int M> __device__ __forceinline__ float swz_xor(float v) { return __int_as_float(__builtin_amdgcn_ds_swizzle(__float_as_int(v), 0x1F | (M << 10))); }
__device__ __forceinline__ float sum_xor32(float v) { auto rr = __builtin_amdgcn_permlane32_swap(__float_as_uint(v), __float_as_uint(v), false, false); return __uint_as_float(rr[0]) + __uint_as_float(rr[1]); }
__device__ __forceinline__ float wave_sum(float v) {
    v += swz_xor<1>(v); v += swz_xor<2>(v); v += swz_xor<4>(v); v += swz_xor<8>(v); v += swz_xor<16>(v);
    return sum_xor32(v);
}

namespace pg8 {
constexpr int BM = 256, BK = 64, HALF = 128, HTB = HALF * BK * 2, STAGE_BYTES = 8 * HTB, NXCD = 8, WGM = 8;
__host__ __device__ __forceinline__ int lds_byte(int r, int c) { const int st = (r >> 4) * 2 + (c >> 5), rr = r & 15, cc = c & 31, ob = rr * 64 + cc * 2; return st * 1024 + (ob ^ (((ob >> 9) & 1) << 5)); }
__host__ __device__ __forceinline__ void stage_rc(int b, int& R, int& C) { const int st = b / 1024, sb = b % 1024, swz = sb ^ (((sb >> 9) & 1) << 5); R = (st >> 1) * 16 + swz / 64; C = (st & 1) * 32 + (swz % 64) / 2; }
__host__ __device__ __forceinline__ int perm32(int rho) { const int n = rho >> 4, i = rho & 15; return 8 * (i >> 2) + 4 * n + (i & 3); }
__host__ __device__ __forceinline__ int permV(int rho) { const int n = rho >> 4, i = rho & 15; return 16 * (i >> 3) + 8 * n + (i & 7); }
template <int P> __host__ __device__ __forceinline__ int permf(int rho) { return P == 1 ? perm32(rho) : (P == 2 ? permV(rho) : rho); }

struct Unit { int pm, pn, e, rt; };
struct Gemm { const bf16_t* A; const bf16_t* Bt; int M, N, K; };

struct StaticOrder {
    int nM, nN, nwg, G, c;
    __device__ void init(int M, int N, int G_, int c_) { nM = M / BM; nN = N / BM; nwg = nM * nN; G = G_; c = c_; }
    __device__ bool next(int i, Unit& u) const {
        const long L = (long)i * G + c; if (L >= nwg) return false;
        int wgid = (int)L; { const int q = nwg / NXCD, r = nwg % NXCD, xcd = wgid % NXCD, off = wgid / NXCD; wgid = (xcd < r ? xcd * (q + 1) : r * (q + 1) + (xcd - r) * q) + off; }
        const int nig = WGM * nN, gid = wgid / nig, fm = gid * WGM, gsz = (nM - fm) < WGM ? (nM - fm) : WGM;
        u.pm = fm + ((wgid % nig) % gsz); u.pn = (wgid % nig) / gsz; u.e = 0; u.rt = 0; return true;
    }
    __device__ __forceinline__ size_t a_base(const Unit& u, size_t tstep) const { return (size_t)u.pm * tstep; }
    __device__ __forceinline__ unsigned row_off(const Unit&, int r, int K) const { return (unsigned)(r * K) * 2u; }
    __device__ __forceinline__ void a_ready(const Unit&, int) const {}
};

template <int NCT, bool GATHER> struct MoeOrder {
    const LAS int* tbl; const int* tok; int G, c, K;
    __device__ bool next(int i, Unit& u) const {
        const int L = i * G + c, total = __builtin_amdgcn_readfirstlane(tbl[16]) * NCT; if (L >= total) return false;
        const int g = L / NCT, ct = L % NCT; int e = 0;
#pragma unroll
        for (int k = 1; k < 16; ++k) e += (g >= tbl[k]) ? 1 : 0;
        e = __builtin_amdgcn_readfirstlane(e);
        u.pm = g; u.pn = e * NCT + ct; u.e = e; u.rt = __builtin_amdgcn_readfirstlane(g - tbl[e]); return true;
    }
    __device__ __forceinline__ size_t a_base(const Unit& u, size_t tstep) const { return GATHER ? 0 : (size_t)u.pm * tstep; }
    __device__ __forceinline__ unsigned row_off(const Unit& u, int r, int K_) const {
        if (!GATHER) return (unsigned)(r * K_) * 2u;
        const int pos = u.rt * 256 + r; const int n = __builtin_amdgcn_readfirstlane(tbl[17 + u.e]);
        const int t = pos < n ? tok[u.e * SEQ + pos] : 0;
        return (unsigned)(t * K_) * 2u;
    }
    __device__ __forceinline__ void a_ready(const Unit&, int) const {}
};

struct DownOrder {
    const LAS int* tbl; unsigned* cnt; unsigned* tmo; int G, c;
    __device__ bool next(int i, Unit& u) const {
        const int T = __builtin_amdgcn_readfirstlane(tbl[16]);
        const int U1 = 4 * T, nb2 = U1 > G ? U1 - G : 0, F = G - nb2;
        const int g1 = T < (G >> 2) ? T : (G >> 2), E = 8 * g1, Lt = 8 * (T - g1);
        int k = -1, late = 0;
        int ii = i;
        if (c >= nb2) { const int cf = c - nb2; const int nE = E > cf ? (E - cf + F - 1) / F : 0; if (ii < nE) k = cf + ii * F; else ii -= nE; }
        int g, ct;
        if (k >= 0) { g = k >> 3; ct = k & 7; }
        else { const int k0 = (c - nb2 + G) % G; const int kk = k0 + ii * G; if (kk >= Lt) return false; g = g1 + (kk >> 3); ct = kk & 7; late = 1; }
        (void)late;
        int e = 0;
#pragma unroll
        for (int q = 1; q < 16; ++q) e += (g >= tbl[q]) ? 1 : 0;
        e = __builtin_amdgcn_readfirstlane(e);
        u.pm = g; u.pn = e * 8 + ct; u.e = e; u.rt = __builtin_amdgcn_readfirstlane(g - tbl[e]); return true;
    }
    __device__ __forceinline__ size_t a_base(const Unit& u, size_t tstep) const { return (size_t)u.pm * tstep; }
    __device__ __forceinline__ unsigned row_off(const Unit&, int r, int K_) const { return (unsigned)(r * K_) * 2u; }
    __device__ __forceinline__ void a_ready(const Unit& u, int wid) const {
        if (wid == 0) {
            unsigned sp = 0;
            while ((unsigned)__builtin_amdgcn_readfirstlane((int)__hip_atomic_load(cnt + 64 * u.pm, __ATOMIC_RELAXED, __HIP_MEMORY_SCOPE_AGENT)) < 32u) {
                __builtin_amdgcn_s_sleep(2);
                if (++sp > (1u << 22)) { __hip_atomic_store(tmo, 1u, __ATOMIC_RELAXED, __HIP_MEMORY_SCOPE_AGENT); break; }
            }
            __builtin_amdgcn_fence(__ATOMIC_ACQUIRE, "agent");
            asm volatile("s_waitcnt vmcnt(0)" ::: "memory");
        }
        asm volatile("" ::: "memory"); __builtin_amdgcn_s_barrier(); asm volatile("" ::: "memory");
    }
};

template <class Epi, class Sched, bool SP2 = true>
__device__ __forceinline__ void gemm_phase(LAS unsigned char* lds, const Gemm g, const Sched& S, const Epi& E, int wv) {
    const int tid = otid(wv), wid = __builtin_amdgcn_readfirstlane(tid >> 6), lane = tid & 63, wr = wid >> 2, wc = wid & 3, fr = lane & 15, fq = lane >> 4;
    const int K = g.K, nt = K / BK;
    unsigned voffB[2]; int Rr[2], Cc[2];
#pragma unroll
    for (int i = 0; i < 2; ++i) { int R, C; stage_rc(tid * 16 + i * 8192, R, C); const int Rb = (R & ~31) + permf<Epi::PERM>(R & 31);
        Rr[i] = R; Cc[i] = C; voffB[i] = (unsigned)(Rb * K + C) * 2u; }
    const size_t kstep = (size_t)(BK * 2);
    const size_t hstep = (size_t)HALF * K * 2;
    const size_t tstep = 2 * hstep;
    const unsigned ldsw = (unsigned)wid * 1024u;
    const int aoff = lds_byte(wr * 64 + fr, fq * 8), boff = lds_byte(wc * 32 + fr, fq * 8);
#define PG8_SA(b, h) (((b) * 2 + (h)) * HTB)
#define PG8_SB(b, h) ((4 + (b) * 2 + (h)) * HTB)
#define PG8_STAGE(bufoff, gbase, voff) do { _Pragma("unroll") for (int _i = 0; _i < 2; ++_i) \
        __builtin_amdgcn_global_load_lds((const unsigned*)((const char*)(gbase) + (voff)[_i]), (LAS unsigned*)(lds + (bufoff) + ldsw + _i * 8192), 16, 0, 0); } while (0)
#define PG8_LDA(dst, b, h) do { _Pragma("unroll") for (int m = 0; m < 4; ++m) _Pragma("unroll") for (int k = 0; k < 2; ++k) dst[m][k] = *(const LAS bf16x8*)(lds + PG8_SA(b, h) + aoff + m * 2048 + k * 1024); } while (0)
#define PG8_LDB(dst, b, h) do { _Pragma("unroll") for (int n = 0; n < 2; ++n) _Pragma("unroll") for (int k = 0; k < 2; ++k) dst[n][k] = *(const LAS bf16x8*)(lds + PG8_SB(b, h) + boff + n * 2048 + k * 1024); } while (0)
#define PG8_CAT(x) __builtin_shufflevector(__builtin_bit_cast(i32x4, (x)[0]), __builtin_bit_cast(i32x4, (x)[1]), 0, 1, 2, 3, 4, 5, 6, 7)
#define PG8_MMA(ai, bj, At, Bt) do { __builtin_amdgcn_s_setprio(1); \
        if constexpr (Epi::FP8) { _Pragma("unroll") for (int m = 0; m < 4; ++m) _Pragma("unroll") for (int n = 0; n < 2; ++n) \
            asm volatile("v_mfma_scale_f32_16x16x128_f8f6f4 %0, %1, %2, %0, %3, %3 op_sel_hi:[0,0,0]" : "+v"(acc[ai][bj][m][n]) : "v"(PG8_CAT(Bt[n])), "v"(PG8_CAT(At[m])), "v"(one8)); } \
        else { _Pragma("unroll") for (int m = 0; m < 4; ++m) _Pragma("unroll") for (int n = 0; n < 2; ++n) _Pragma("unroll") for (int k = 0; k < 2; ++k) \
            acc[ai][bj][m][n] = __builtin_amdgcn_mfma_f32_16x16x32_bf16(Bt[n][k], At[m][k], acc[ai][bj][m][n], 0, 0, 0); } \
        __builtin_amdgcn_s_setprio(0); } while (0)
#define PG8_WAIT_V(n) asm volatile("s_waitcnt vmcnt(" #n ")" ::: "memory")
#define PG8_WAIT_L(n) asm volatile("s_waitcnt lgkmcnt(" #n ")" ::: "memory")
#define PG8_BAR __builtin_amdgcn_s_barrier()
#define PG8_SCHED __builtin_amdgcn_sched_barrier(0)
    Unit cur, nxt; int ui = 0;
    if (!S.next(0, cur)) return;
    const unsigned one8 = 0x7F7F7F7Fu;
    (void)one8;
    f32x4 acc[2][2][4][2];
    if constexpr (Epi::LOAD_INIT) E.init(acc, cur, wr, wc, fr, fq);
    else {
#pragma unroll
    for (int a = 0; a < 2; ++a)
#pragma unroll
        for (int b = 0; b < 2; ++b)
#pragma unroll
            for (int m = 0; m < 4; ++m)
#pragma unroll
                for (int n = 0; n < 2; ++n) acc[a][b][m][n] = (f32x4){0.f, 0.f, 0.f, 0.f};
    }
    bf16x8 At[4][2], B0[2][2], B1[2][2];
    unsigned oc[2][2], on[2][2];
#pragma unroll
    for (int h = 0; h < 2; ++h)
#pragma unroll
        for (int i = 0; i < 2; ++i) { oc[h][i] = S.row_off(cur, h * HALF + Rr[i], K) + (unsigned)Cc[i] * 2u; on[h][i] = oc[h][i]; }
    const char* cA = (const char*)g.A + S.a_base(cur, tstep); const char* cB = (const char*)g.Bt + (size_t)cur.pn * tstep;
    S.a_ready(cur, wid);
    if constexpr (SP2) {
        PG8_STAGE(PG8_SB(0, 0), cB, voffB); PG8_STAGE(PG8_SB(0, 1), cB + hstep, voffB); PG8_STAGE(PG8_SA(0, 0), cA, oc[0]); PG8_STAGE(PG8_SA(0, 1), cA, oc[1]);
        if (wr == 1) PG8_BAR;
        PG8_WAIT_V(2); PG8_BAR;
        PG8_STAGE(PG8_SB(1, 0), cB + kstep, voffB); PG8_STAGE(PG8_SA(1, 0), cA + kstep, oc[0]); PG8_STAGE(PG8_SB(1, 1), cB + hstep + kstep, voffB);
        PG8_WAIT_V(6); PG8_BAR;
    } else {
        PG8_STAGE(PG8_SB(0, 0), cB, voffB); PG8_STAGE(PG8_SA(0, 0), cA, oc[0]); PG8_STAGE(PG8_SB(0, 1), cB + hstep, voffB); PG8_STAGE(PG8_SA(0, 1), cA, oc[1]);
        if (wr == 1) PG8_BAR;
        PG8_WAIT_V(4); PG8_BAR;
        PG8_STAGE(PG8_SB(1, 0), cB + kstep, voffB); PG8_STAGE(PG8_SA(1, 0), cA + kstep, oc[0]); PG8_STAGE(PG8_SB(1, 1), cB + hstep + kstep, voffB);
        PG8_WAIT_V(6); PG8_BAR;
    }
    for (;;) {
        const bool has_next = S.next(ui + 1, nxt);
        const char* nA = has_next ? (const char*)g.A + S.a_base(nxt, tstep) : cA; const char* nB = has_next ? (const char*)g.Bt + (size_t)nxt.pn * tstep : cB;
        if (has_next) {
#pragma unroll
            for (int h = 0; h < 2; ++h)
#pragma unroll
                for (int i = 0; i < 2; ++i) on[h][i] = S.row_off(nxt, h * HALF + Rr[i], K) + (unsigned)Cc[i] * 2u;
        }
        for (int t = 0; t < nt; t += 2) {
            const bool last = (t == nt - 2);
            if (last && has_next) S.a_ready(nxt, wid);
            const char* a1 = cA + (size_t)(t + 1) * kstep;
            const char* a2 = last ? nA : cA + (size_t)(t + 2) * kstep; const char* b2 = last ? nB : cB + (size_t)(t + 2) * kstep;
            const char* a3 = a2 + kstep; const char* b3 = b2 + kstep;
            unsigned o2a[2], o2b[2];
            o2a[0] = last ? on[0][0] : oc[0][0]; o2a[1] = last ? on[0][1] : oc[0][1]; o2b[0] = last ? on[1][0] : oc[1][0]; o2b[1] = last ? on[1][1] : oc[1][1];
            if constexpr (SP2) {
            PG8_LDB(B0, 0, 0); PG8_LDB(B1, 0, 1); PG8_SCHED; PG8_LDA(At, 0, 0); PG8_STAGE(PG8_SA(1, 1), a1, oc[1]);
            PG8_WAIT_V(8); PG8_WAIT_L(0); PG8_BAR; PG8_MMA(0, 0, At, B0); PG8_MMA(0, 1, At, B1); PG8_BAR; PG8_SCHED;
            PG8_LDA(At, 0, 1); PG8_STAGE(PG8_SB(0, 0), b2, voffB); PG8_STAGE(PG8_SB(0, 1), b2 + hstep, voffB); PG8_STAGE(PG8_SA(0, 0), a2, o2a);
            PG8_WAIT_V(8); PG8_WAIT_L(0); PG8_BAR; PG8_MMA(1, 0, At, B0); PG8_MMA(1, 1, At, B1); PG8_BAR; PG8_SCHED;
            PG8_LDB(B0, 1, 0); PG8_LDB(B1, 1, 1); PG8_SCHED; PG8_LDA(At, 1, 0); PG8_STAGE(PG8_SA(0, 1), a2, o2b);
            PG8_WAIT_V(8); PG8_WAIT_L(0); PG8_BAR; PG8_MMA(0, 0, At, B0); PG8_MMA(0, 1, At, B1); PG8_BAR; PG8_SCHED;
            PG8_LDA(At, 1, 1); PG8_STAGE(PG8_SB(1, 0), b3, voffB); PG8_STAGE(PG8_SB(1, 1), b3 + hstep, voffB); PG8_STAGE(PG8_SA(1, 0), a3, o2a);
            PG8_WAIT_V(8); PG8_WAIT_L(0); PG8_BAR; PG8_MMA(1, 0, At, B0); PG8_MMA(1, 1, At, B1); PG8_BAR; PG8_SCHED;
            } else {
            PG8_LDB(B0, 0, 0); PG8_SCHED; PG8_LDA(At, 0, 0); PG8_STAGE(PG8_SA(1, 1), a1, oc[1]);
            PG8_WAIT_L(8); PG8_BAR; PG8_WAIT_L(0); PG8_MMA(0, 0, At, B0); PG8_BAR; PG8_SCHED;
            PG8_LDB(B1, 0, 1); PG8_STAGE(PG8_SB(0, 0), b2, voffB);
            PG8_BAR; PG8_WAIT_L(0); PG8_MMA(0, 1, At, B1); PG8_BAR;
            PG8_LDA(At, 0, 1); PG8_STAGE(PG8_SA(0, 0), a2, o2a);
            PG8_BAR; PG8_WAIT_L(0); PG8_MMA(1, 0, At, B0); PG8_BAR; PG8_SCHED;
            PG8_STAGE(PG8_SB(0, 1), b2 + hstep, voffB);
            PG8_WAIT_V(6); PG8_BAR; PG8_MMA(1, 1, At, B1); PG8_BAR;
            PG8_LDB(B0, 1, 0); PG8_SCHED; PG8_LDA(At, 1, 0); PG8_STAGE(PG8_SA(0, 1), a2, o2b);
            PG8_WAIT_L(8); PG8_BAR; PG8_WAIT_L(0); PG8_MMA(0, 0, At, B0); PG8_BAR; PG8_SCHED;
            PG8_LDB(B1, 1, 1); PG8_STAGE(PG8_SB(1, 0), b3, voffB);
            PG8_BAR; PG8_WAIT_L(0); PG8_MMA(0, 1, At, B1); PG8_BAR;
            PG8_LDA(At, 1, 1); PG8_STAGE(PG8_SA(1, 0), a3, o2a);
            PG8_BAR; PG8_WAIT_L(0); PG8_MMA(1, 0, At, B0); PG8_BAR; PG8_SCHED;
            PG8_STAGE(PG8_SB(1, 1), b3 + hstep, voffB);
            PG8_WAIT_V(6); PG8_BAR; PG8_MMA(1, 1, At, B1); PG8_BAR;
            }
        }
        if (wr == 0) PG8_BAR;
        if constexpr (Epi::FP8) asm volatile("s_nop 15\n\ts_nop 15" ::: "memory");
        { const int tz = otid(wv) & 63; E(acc, cur, wr, wc, tz & 15, tz >> 4); }
        if (!has_next) break;
#pragma unroll
        for (int a = 0; a < 2; ++a)
#pragma unroll
            for (int b = 0; b < 2; ++b)
#pragma unroll
                for (int m = 0; m < 4; ++m)
#pragma unroll
                    for (int n = 0; n < 2; ++n) acc[a][b][m][n] = (f32x4){0.f, 0.f, 0.f, 0.f};
        if constexpr (Epi::LOAD_INIT) { const int tz2 = otid(wv) & 63; E.init(acc, nxt, wr, wc, tz2 & 15, tz2 >> 4); }
        cur = nxt; cA = nA; cB = nB; ++ui;
#pragma unroll
        for (int h = 0; h < 2; ++h)
#pragma unroll
            for (int i = 0; i < 2; ++i) oc[h][i] = on[h][i];
        if (wr == 1) PG8_BAR;
    }
    PG8_WAIT_V(0);
    PG8_BAR;
#undef PG8_SA
#undef PG8_SB
#undef PG8_STAGE
#undef PG8_LDA
#undef PG8_LDB
#undef PG8_MMA
#undef PG8_CAT
#undef PG8_WAIT_V
#undef PG8_WAIT_L
#undef PG8_BAR
#undef PG8_SCHED
}


struct EpiQK {
    static constexpr int PERM = 1; static constexpr bool LOAD_INIT = false; static constexpr bool FP8 = (FP8_PROJ != 0);
    bf16_t* O; const float *gqd, *gkd, *gqf, *gkf; LAS float* tbl; const float* rstd;
    __device__ __forceinline__ void operator()(const f32x4 (&acc)[2][2][4][2], const Unit& u, int wr, int wc, int fr, int fq) const {
#pragma unroll
        for (int ai = 0; ai < 2; ++ai)
#pragma unroll
            for (int m = 0; m < 4; ++m)
#pragma unroll
                for (int bj = 0; bj < 2; ++bj) {
                    const f32x4 a = acc[ai][bj][m][0], b = acc[ai][bj][m][1];
                    float ss = (a[0] * a[0] + a[1] * a[1]) + (a[2] * a[2] + a[3] * a[3]) + (b[0] * b[0] + b[1] * b[1]) + (b[2] * b[2] + b[3] * b[3]);
                    ss += swz_xor<16>(ss); ss = sum_xor32(ss);
                    if (fq == 0) tbl[(bj * 256 + ai * 128 + wr * 64 + m * 16 + fr) * 4 + wc] = FP8 ? ss * (1.f / (W8_SCALE * W8_SCALE)) : ss;
                }
        asm volatile("s_waitcnt lgkmcnt(0)" ::: "memory"); __builtin_amdgcn_s_barrier(); asm volatile("" ::: "memory");
        const int colh = wc * 32 + fq * 8;
#pragma unroll
        for (int bj = 0; bj < 2; ++bj) {
            const int hh = u.pn * 2 + bj;
            int mode; const float* gp; float extra;
            if (hh < 6) { mode = 0; gp = gqd + (colh & 63); extra = 0.125f * LOG2E; }
            else if (hh < 12) { mode = 0; gp = gkd + (colh & 63); extra = 1.f; }
            else if (hh < 17) { mode = 1; gp = gqf + colh; extra = 0.08838834764831845f * LOG2E; }
            else if (hh < 22) { mode = 1; gp = gkf + colh; extra = 1.f; }
            else if (hh < 27) { mode = 2; gp = gqd; extra = 0.08838834764831845f * LOG2E; }
            else { mode = 2; gp = gqd; extra = 1.f; }
            f32x4 g0 = (f32x4){1.f, 1.f, 1.f, 1.f}, g1 = g0;
            if (mode != 2) { g0 = *(const f32x4*)gp; g1 = *(const f32x4*)(gp + 4); }
            g0 = g0 * (FP8 ? extra * (1.f / W8_SCALE) : extra); g1 = g1 * (FP8 ? extra * (1.f / W8_SCALE) : extra);
#pragma unroll
            for (int ai = 0; ai < 2; ++ai)
#pragma unroll
                for (int m = 0; m < 4; ++m) {
                    const int rl = ai * 128 + wr * 64 + m * 16 + fr;
                    const float rr = rstd[u.pm * 256 + rl];
                    float rs = rr;
                    if (mode != 2) {
                        const f32x4 t = *(const LAS f32x4*)(tbl + (bj * 256 + rl) * 4);
                        const float tot = (mode == 0) ? ((wc < 2) ? (t[0] + t[1]) : (t[2] + t[3])) : ((t[0] + t[1]) + (t[2] + t[3]));
                        rs = rr * __builtin_amdgcn_rsqf(rr * rr * tot * (mode == 0 ? (1.f / 64.f) : (1.f / 128.f)) + EPS);
                    }
                    const f32x4 v0 = acc[ai][bj][m][0] * g0 * rs, v1 = acc[ai][bj][m][1] * g1 * rs;
                    u32x4 w; w.x = cvtpk(v0[0], v0[1]); w.y = cvtpk(v0[2], v0[3]); w.z = cvtpk(v1[0], v1[1]); w.w = cvtpk(v1[2], v1[3]);
                    *(u32x4*)(O + (size_t)(u.pm * 256 + rl) * NQK + u.pn * 256 + bj * 128 + colh) = w;
                }
        }
    }
};
struct EpiVT {
    static constexpr int PERM = 2; static constexpr bool LOAD_INIT = false; static constexpr bool FP8 = (FP8_PROJ != 0);
    bf16_t* O; int ldc; const float* rstd;
    __device__ __forceinline__ void operator()(const f32x4 (&acc)[2][2][4][2], const Unit& u, int wr, int wc, int fr, int fq) const {
        f32x4 r0[2], r1[2];
#pragma unroll
        for (int bj = 0; bj < 2; ++bj) { const float* rp = rstd + u.pn * 256 + bj * 128 + wc * 32 + 16 * (fq >> 1) + 4 * (fq & 1);
            r0[bj] = *(const f32x4*)rp; r1[bj] = *(const f32x4*)(rp + 8); if (FP8) { r0[bj] = r0[bj] * (1.f / W8_SCALE); r1[bj] = r1[bj] * (1.f / W8_SCALE); } }
#pragma unroll
        for (int ai = 0; ai < 2; ++ai)
#pragma unroll
            for (int m = 0; m < 4; ++m)
#pragma unroll
                for (int bj = 0; bj < 2; ++bj) {
                    const f32x4 v0 = acc[ai][bj][m][0] * r0[bj], v1 = acc[ai][bj][m][1] * r1[bj];
                    u32x4 w; w.x = cvtpk(v0[0], v0[1]); w.y = cvtpk(v0[2], v0[3]); w.z = cvtpk(v1[0], v1[1]); w.w = cvtpk(v1[2], v1[3]);
                    *(u32x4*)(O + (size_t)(u.pm * 256 + ai * 128 + wr * 64 + m * 16 + fr) * ldc + u.pn * 256 + bj * 128 + wc * 32 + fq * 8) = w;
                }
    }
};
struct EpiResAdd {
    static constexpr int PERM = 1; static constexpr bool LOAD_INIT = true; static constexpr bool FP8 = (FP8_WOUT != 0);
    bf16_t* X; float sc; unsigned* done; unsigned char* X8;
    __device__ __forceinline__ void init(f32x4 (&acc)[2][2][4][2], const Unit& u, int wr, int wc, int fr, int fq) const {
#pragma unroll
        for (int ai = 0; ai < 2; ++ai)
#pragma unroll
            for (int m = 0; m < 4; ++m)
#pragma unroll
                for (int bj = 0; bj < 2; ++bj) {
                    const u32x4 w = *(const u32x4*)(X + (size_t)(u.pm * 256 + ai * 128 + wr * 64 + m * 16 + fr) * DM + u.pn * 256 + bj * 128 + wc * 32 + fq * 8);
                    acc[ai][bj][m][0] = (f32x4){bf_lo(w.x), bf_hi(w.x), bf_lo(w.y), bf_hi(w.y)};
                    acc[ai][bj][m][1] = (f32x4){bf_lo(w.z), bf_hi(w.z), bf_lo(w.w), bf_hi(w.w)};
                    if (FP8) { acc[ai][bj][m][0] = acc[ai][bj][m][0] * W8_SCALE; acc[ai][bj][m][1] = acc[ai][bj][m][1] * W8_SCALE; }
                }
    }
    __device__ __forceinline__ void operator()(const f32x4 (&acc)[2][2][4][2], const Unit& u, int wr, int wc, int fr, int fq) const {
        const __amdgpu_buffer_rsrc_t rsrc = __builtin_amdgcn_make_buffer_rsrc((void*)X, 0, SEQ * DM * 2, 0x00020000);
        const __amdgpu_buffer_rsrc_t rsrc8 = __builtin_amdgcn_make_buffer_rsrc((void*)X8, 0, SEQ * DM, 0x00020000);
#pragma unroll
        for (int ai = 0; ai < 2; ++ai)
#pragma unroll
            for (int m = 0; m < 4; ++m)
#pragma unroll
                for (int bj = 0; bj < 2; ++bj) {
                    const f32x4 v0 = FP8 ? acc[ai][bj][m][0] * (1.f / W8_SCALE) : acc[ai][bj][m][0], v1 = FP8 ? acc[ai][bj][m][1] * (1.f / W8_SCALE) : acc[ai][bj][m][1];
                    u32x4 w; w.x = cvtpk(v0[0], v0[1]); w.y = cvtpk(v0[2], v0[3]); w.z = cvtpk(v1[0], v1[1]); w.w = cvtpk(v1[2], v1[3]);
                    u32x2 w8; w8.x = cvt4f8(v0[0], v0[1], v0[2], v0[3]); w8.y = cvt4f8(v1[0], v1[1], v1[2], v1[3]);
                    __builtin_amdgcn_raw_buffer_store_b64(w8, rsrc8, (int)((u.pm * 256 + ai * 128 + wr * 64 + m * 16 + fr) * DM + u.pn * 256 + bj * 128 + wc * 32 + fq * 8), 0, 16);
                    __builtin_amdgcn_raw_buffer_store_b128(w, rsrc, (int)(((u.pm * 256 + ai * 128 + wr * 64 + m * 16 + fr) * DM + u.pn * 256 + bj * 128 + wc * 32 + fq * 8) * 2), 0, 16);
                }
        asm volatile("s_waitcnt vmcnt(0)" ::: "memory");
        if (fr == 0 && fq == 0) __hip_atomic_fetch_add(done + 64 * u.pm, 1u, __ATOMIC_RELAXED, __HIP_MEMORY_SCOPE_AGENT);
    }
};
struct EpiGU {
    static constexpr int PERM = 1; static constexpr bool LOAD_INIT = false; static constexpr bool FP8 = true;
    unsigned char* ACT; const float* gate; const LAS int* tbl; unsigned* done;
    __device__ __forceinline__ void operator()(const f32x4 (&acc)[2][2][4][2], const Unit& u, int wr, int wc, int fr, int fq) const {
        const int ct = u.pn & 3, n_e = __builtin_amdgcn_readfirstlane(tbl[17 + u.e]);
        const __amdgpu_buffer_rsrc_t rsrc = __builtin_amdgcn_make_buffer_rsrc((void*)ACT, 0, MOE_ROWS * FEXP, 0x00020000);
#pragma unroll
        for (int ai = 0; ai < 2; ++ai)
#pragma unroll
            for (int m = 0; m < 4; ++m) {
                const int rl = ai * 128 + wr * 64 + m * 16 + fr, pos = u.rt * 256 + rl;
                f32x2_t gr2 = {0.f, 0.f}; if (pos < n_e) gr2 = *(const f32x2_t*)(gate + 2 * (u.e * SEQ + pos));
                const float gt = gr2[0] * ACT8_SCALE, rs = gr2[1] * (1.f / W8_SCALE);
                float o[8];
#pragma unroll
                for (int n = 0; n < 2; ++n)
#pragma unroll
                    for (int j = 0; j < 4; ++j) { const float gv = acc[ai][0][m][n][j] * rs, uv = acc[ai][1][m][n][j] * rs;
                        const float sg = gv * __builtin_amdgcn_rcpf(1.f + fexp2(-gv * LOG2E)); o[n * 4 + j] = sg * uv * gt; }
                u32x2 w; w.x = cvt4f8(o[0], o[1], o[2], o[3]); w.y = cvt4f8(o[4], o[5], o[6], o[7]);
                __builtin_amdgcn_raw_buffer_store_b64(w, rsrc, (int)((u.pm * 256 + rl) * FEXP + ct * 128 + wc * 32 + fq * 8), 0, 16);
            }
        asm volatile("s_waitcnt vmcnt(0)" ::: "memory");
        if (fr == 0 && fq == 0) __hip_atomic_fetch_add(done + 64 * u.pm, 1u, __ATOMIC_RELAXED, __HIP_MEMORY_SCOPE_AGENT);
    }
};
struct EpiDown {
    static constexpr int PERM = 1; static constexpr bool LOAD_INIT = false; static constexpr bool FP8 = true;
    unsigned char* Y;
    __device__ __forceinline__ void operator()(const f32x4 (&acc)[2][2][4][2], const Unit& u, int wr, int wc, int fr, int fq) const {
        const int ct = u.pn & 7;
#pragma unroll
        for (int ai = 0; ai < 2; ++ai)
#pragma unroll
            for (int m = 0; m < 4; ++m)
#pragma unroll
                for (int bj = 0; bj < 2; ++bj) {
                    const f32x4 v0 = acc[ai][bj][m][0] * (Y8_SCALE / (W8_SCALE * ACT8_SCALE)), v1 = acc[ai][bj][m][1] * (Y8_SCALE / (W8_SCALE * ACT8_SCALE));
                    u32x2 w; w.x = cvt4f8(v0[0], v0[1], v0[2], v0[3]); w.y = cvt4f8(v1[0], v1[1], v1[2], v1[3]);
                    *(u32x2*)(Y + (size_t)(u.pm * 256 + ai * 128 + wr * 64 + m * 16 + fr) * DM + ct * 256 + bj * 128 + wc * 32 + fq * 8) = w;
                }
    }
};
}

#define XB_TMO      128
#define XB_XCNT(j)  (256  + 64 * (j))
#define XB_XSUB(j)  (1280 + 64 * (j))
#define XB_XGEN(j)  (2304 + 64 * (j))
#define XB_TOP      3328
#define XB_TOPGEN   3392
#define XCD_BAR_WORDS 3456
#define XB_SPIN_CAP (1u << 18)

__device__ __forceinline__ unsigned xb_ld(unsigned* p)              { return __hip_atomic_load(p, __ATOMIC_RELAXED, __HIP_MEMORY_SCOPE_AGENT); }
__device__ __forceinline__ unsigned xb_add(unsigned* p, unsigned v) { return __hip_atomic_fetch_add(p, v, __ATOMIC_RELAXED, __HIP_MEMORY_SCOPE_AGENT); }
__device__ __forceinline__ unsigned xb_xcc_id() { return (unsigned)__builtin_amdgcn_s_getreg((3 << 11) | 20) & 0xFu; }
#define XB_SPIN(cond, bar) do { unsigned _sp = 0; while (cond) { __builtin_amdgcn_s_sleep(1); \
    if ((++_sp & 255u) == 0u) { if (xb_ld(&(bar)[XB_TMO])) break; if (_sp > XB_SPIN_CAP) { atomicAdd(&(bar)[XB_TMO], 1u); break; } } } } while (0)

struct XcdBarrier { unsigned* bar; unsigned x; volatile LAS unsigned* st; int wv; };

__device__ __forceinline__ XcdBarrier xcd_barrier_post(unsigned* bar, volatile LAS unsigned* st, int wv) {
    XcdBarrier b; b.bar = bar; b.x = xb_xcc_id(); b.st = st; b.wv = wv;
    if (otid(wv) == 0) (void)xb_add(&bar[XB_XCNT(b.x)], 1u);
    return b;
}
__device__ __forceinline__ void xcd_barrier_complete(unsigned* bar, unsigned x, unsigned& nloc, unsigned& nx) {
    const unsigned G = gridDim.x * gridDim.y * gridDim.z;
    unsigned sum, cnt, mine, sp = 0u;
    for (;;) {
        sum = 0u; cnt = 0u; mine = 0u;
#pragma unroll
        for (unsigned j = 0; j < 16; ++j) { const unsigned c = xb_ld(&bar[XB_XCNT(j)]); sum += c; cnt += (c > 0u) ? 1u : 0u; mine = (j == x) ? c : mine; }
        if (sum == G) break;
        __builtin_amdgcn_s_sleep(1);
        if ((++sp & 255u) == 0u) { if (xb_ld(&bar[XB_TMO])) break; if (sp > XB_SPIN_CAP) { atomicAdd(&bar[XB_TMO], 1u); break; } }
    }
    nloc = mine > 0u ? mine : 1u; nx = cnt > 0u ? cnt : 1u;
}
__device__ __attribute__((noinline)) void xcd_barrier_impl(unsigned* bar_, unsigned bx, volatile LAS unsigned* bst, int bwv) {
    XcdBarrier b; b.bar = bar_; b.x = bx; b.st = bst; b.wv = bwv;
    asm volatile("s_waitcnt vmcnt(0)" ::: "memory");
    __syncthreads();
    if (otid(b.wv) == 0) {
        unsigned* bar = b.bar;
        __builtin_amdgcn_s_waitcnt(0);
        unsigned nloc = b.st[0], nx = b.st[1];
        if (nloc == 0u) { xcd_barrier_complete(bar, b.x, nloc, nx); b.st[0] = nloc; b.st[1] = nx; }
        const unsigned old = xb_add(&bar[XB_XSUB(b.x)], 1u);
        const unsigned gen = old / nloc;
        if (old + 1u == (gen + 1u) * nloc) {
            __builtin_amdgcn_fence(__ATOMIC_RELEASE, "agent");
            asm volatile("s_waitcnt vmcnt(0)" ::: "memory");
            const unsigned og = xb_add(&bar[XB_TOP], 1u);
            const unsigned tg = og / nx;
            if (og + 1u == (tg + 1u) * nx) xb_add(&bar[XB_TOPGEN], 1u);
            else XB_SPIN(xb_ld(&bar[XB_TOPGEN]) == tg, bar);
            __builtin_amdgcn_fence(__ATOMIC_ACQUIRE, "agent");
            xb_add(&bar[XB_XGEN(b.x)], 1u);
            asm volatile("s_waitcnt vmcnt(0)" ::: "memory");
        } else {
            XB_SPIN(xb_ld(&bar[XB_XGEN(b.x)]) == gen, bar);
            __builtin_amdgcn_fence(__ATOMIC_ACQUIRE, "agent");
            asm volatile("s_waitcnt vmcnt(0)" ::: "memory");
        }
    }
    __syncthreads();
}

__device__ __forceinline__ void xcd_barrier(const XcdBarrier& b) { xcd_barrier_impl(b.bar, b.x, b.st, b.wv); }

struct Params {
    const float *x, *attn_norm, *w_in, *b_forget, *qnorm_diff, *knorm_diff, *lam_q1, *lam_k1, *lam_q2, *lam_k2, *subln_diff, *onorm_sb,
        *qnorm_fox, *knorm_fox, *onorm_fox, *w_out, *ffn_norm, *w_router, *router_bias, *w_gate, *w_up, *w_down;
    float* out; unsigned char* ws; int ph_lo, ph_hi;
};
typedef const __attribute__((address_space(4))) Params* KArgs;
__device__ __forceinline__ KArgs kparams() { KArgs k = (KArgs)__builtin_amdgcn_kernarg_segment_ptr(); asm volatile("" : "+s"(k)); return k; }

__device__ __forceinline__ void transpose_item(const float* W, int ldn, int k0, int n0, bf16_t* WT, int K, int drow, LAS float* scr, int lane, const float* kgain = nullptr, bool f8 = false) {
#pragma unroll 8
    for (int i = 0; i < 32; ++i) { const int kk = 2 * i + (lane >> 5); scr[kk * 33 + (lane & 31)] = W[(size_t)(k0 + kk) * ldn + n0 + (lane & 31)]; }
    asm volatile("s_waitcnt lgkmcnt(0)" ::: "memory");
    const int c = lane & 7;
    f32x4 ga = {1.f, 1.f, 1.f, 1.f}, gb = ga;
    if (kgain) { ga = *(const f32x4*)(kgain + k0 + 8 * c); gb = *(const f32x4*)(kgain + k0 + 8 * c + 4); }
#pragma unroll
    for (int j = 0; j < 4; ++j) { const int n = (lane >> 3) + 8 * j; const LAS float* s = scr + (8 * c) * 33 + n;
        if (f8) { u32x2 o8; o8.x = cvt4f8(s[0 * 33] * ga[0] * W8_SCALE, s[1 * 33] * ga[1] * W8_SCALE, s[2 * 33] * ga[2] * W8_SCALE, s[3 * 33] * ga[3] * W8_SCALE);
            o8.y = cvt4f8(s[4 * 33] * gb[0] * W8_SCALE, s[5 * 33] * gb[1] * W8_SCALE, s[6 * 33] * gb[2] * W8_SCALE, s[7 * 33] * gb[3] * W8_SCALE);
            *(u32x2*)((unsigned char*)WT + (size_t)(drow + n) * K + k0 + 8 * c) = o8; continue; }
        u32x4 o; o.x = cvtpk(s[0 * 33] * ga[0], s[1 * 33] * ga[1]); o.y = cvtpk(s[2 * 33] * ga[2], s[3 * 33] * ga[3]); o.z = cvtpk(s[4 * 33] * gb[0], s[5 * 33] * gb[1]); o.w = cvtpk(s[6 * 33] * gb[2], s[7 * 33] * gb[3]);
        *(u32x4*)(WT + (size_t)(drow + n) * K + k0 + 8 * c) = o; }
    asm volatile("s_waitcnt lgkmcnt(0)" ::: "memory");
}
__device__ __forceinline__ int win_dest(int n0, int& sel) {
    if (n0 < 768) { sel = 0; return n0; }
    if (n0 < 1536) { sel = 0; return n0; }
    if (n0 < 2304) { sel = 1; return n0 - 1536; }
    if (n0 < 2944) { sel = 0; return 2816 + (n0 - 2304); }
    if (n0 < 3584) { sel = 0; return 3456 + (n0 - 2944); }
    if (n0 < 4224) { sel = 1; return 768 + (n0 - 3584); }
    if (n0 < 4864) { sel = 0; return 1536 + (n0 - 4224); }
    if (n0 < 5504) { sel = 0; return 2176 + (n0 - 4864); }
    sel = 1; return 1408 + (n0 - 5504);
}
__device__ __forceinline__ void phase_prologue(KArgs p, LAS unsigned char* lds, int wv) {
    const int tid = otid(wv), lane = tid & 63, wave = tid >> 6;
    LAS float* scr = (LAS float*)(lds + wave * 16384);
    const int gw = blockIdx.x * 8 + wave, NGW = gridDim.x * 8;
    constexpr int I_IN = 32 * 192, I_O = 32 * 64, I_G = 16 * 32 * 16, I_D = 16 * 8 * 64, I_L = I_IN + I_O + 2 * I_G + I_D;
    bf16_t* Wqk = (bf16_t*)(p->ws + WS_WQK); bf16_t* Wv = (bf16_t*)(p->ws + WS_WV); bf16_t* Wo = (bf16_t*)(p->ws + WS_WO);
    bf16_t* Wgu = (bf16_t*)(p->ws + WS_WGU); bf16_t* Wd = (bf16_t*)(p->ws + WS_WD);
    for (int it = gw; it < DEPTH * I_L; it += NGW) {
        const int l = it / I_L; int r = it % I_L;
        if (r < I_IN) { const int kb = r / 192, nb = r % 192; int sel; const int drow = win_dest(nb * 32, sel);
            if (FP8_PROJ) transpose_item(p->w_in + (size_t)l * DM * NIN, NIN, kb * 64, nb * 32, (bf16_t*)(sel ? (unsigned char*)Wv + (size_t)l * NV * DM : (unsigned char*)Wqk + (size_t)l * NQK * DM), DM, drow, scr, lane, p->attn_norm + (size_t)l * DM, true);
            else transpose_item(p->w_in + (size_t)l * DM * NIN, NIN, kb * 64, nb * 32, sel ? Wv + (size_t)l * NV * DM : Wqk + (size_t)l * NQK * DM, DM, drow, scr, lane, p->attn_norm + (size_t)l * DM); continue; }
        r -= I_IN;
        if (r < I_O) { const int kb = r / 64, nb = r % 64;
            if (FP8_WOUT) transpose_item(p->w_out + (size_t)l * DM * DM, DM, kb * 64, nb * 32, (bf16_t*)((unsigned char*)Wo + (size_t)l * DM * DM), DM, nb * 32, scr, lane, nullptr, true);
            else transpose_item(p->w_out + (size_t)l * DM * DM, DM, kb * 64, nb * 32, Wo + (size_t)l * DM * DM, DM, nb * 32, scr, lane); continue; }
        r -= I_O;
        if (r < 2 * I_G) { const int up = r / I_G; r %= I_G; const int e = r / 512, kb = (r % 512) / 16, nb = r % 16; const int n0 = nb * 32;
            const float* src = (up ? p->w_up : p->w_gate) + ((size_t)l * NEXP + e) * DM * FEXP;
            transpose_item(src, FEXP, kb * 64, n0, (bf16_t*)((unsigned char*)Wgu + ((size_t)l * NEXP + e) * 1024 * DM), DM, (n0 >> 7) * 256 + up * 128 + (n0 & 127), scr, lane, p->ffn_norm + (size_t)l * DM, true); continue; }
        r -= 2 * I_G;
        { const int e = r / 512, kb = (r % 512) / 64, nb = r % 64;
            transpose_item(p->w_down + ((size_t)l * NEXP + e) * FEXP * DM, DM, kb * 64, nb * 32, (bf16_t*)((unsigned char*)Wd + ((size_t)l * NEXP + e) * DM * FEXP), FEXP, nb * 32, scr, lane, nullptr, true); }
    }
    { float* WRT = (float*)(p->ws + WS_WRT); for (int i = blockIdx.x * 512 + tid; i < 16 * DM; i += gridDim.x * 512) WRT[(i & 15) * DM + (i >> 4)] = p->w_router[i]; }
    float* WF = (float*)(p->ws + WS_WF);
    for (int i = blockIdx.x * 512 + tid; i < DEPTH * 5 * DM; i += gridDim.x * 512) { const int l = i / (5 * DM), h = (i / DM) % 5, d = i % DM;
        WF[i] = p->w_in[((size_t)l * DM + d) * NIN + 6144 + h]; }
    if (blockIdx.x == 1 && wave < DEPTH) {
        const int l = wave;
        float a = fabsf(p->qnorm_diff[l * 64 + lane]), b = fabsf(p->knorm_diff[l * 64 + lane]);
        float c2 = fmaxf(fabsf(p->qnorm_fox[l * 128 + lane]), fabsf(p->qnorm_fox[l * 128 + 64 + lane])), d2 = fmaxf(fabsf(p->knorm_fox[l * 128 + lane]), fabsf(p->knorm_fox[l * 128 + 64 + lane]));
#pragma unroll
        for (int o = 1; o < 32; o <<= 1) { a = fmaxf(a, __int_as_float(__builtin_amdgcn_ds_bpermute(((lane ^ o) << 2), __float_as_int(a)))); b = fmaxf(b, __int_as_float(__builtin_amdgcn_ds_bpermute(((lane ^ o) << 2), __float_as_int(b))));
            c2 = fmaxf(c2, __int_as_float(__builtin_amdgcn_ds_bpermute(((lane ^ o) << 2), __float_as_int(c2)))); d2 = fmaxf(d2, __int_as_float(__builtin_amdgcn_ds_bpermute(((lane ^ o) << 2), __float_as_int(d2)))); }
        a = fmaxf(a, __int_as_float(__builtin_amdgcn_ds_bpermute(((lane ^ 32) << 2), __float_as_int(a)))); b = fmaxf(b, __int_as_float(__builtin_amdgcn_ds_bpermute(((lane ^ 32) << 2), __float_as_int(b))));
        c2 = fmaxf(c2, __int_as_float(__builtin_amdgcn_ds_bpermute(((lane ^ 32) << 2), __float_as_int(c2)))); d2 = fmaxf(d2, __int_as_float(__builtin_amdgcn_ds_bpermute(((lane ^ 32) << 2), __float_as_int(d2))));
        if (lane == 0) { ((float*)(p->ws + WS_LAM))[8 + 2 * l] = a * b; ((float*)(p->ws + WS_LAM))[8 + 2 * l + 1] = c2 * d2; }
    }
    if (blockIdx.x == 0 && wave < DEPTH) {
        const int l = wave;
        float a = wave_sum(p->lam_q1[l * 64 + lane] * p->lam_k1[l * 64 + lane]), b = wave_sum(p->lam_q2[l * 64 + lane] * p->lam_k2[l * 64 + lane]);
        if (lane == 0) ((float*)(p->ws + WS_LAM))[l] = fexp2(a * LOG2E) - fexp2(b * LOG2E) + (0.8f - 0.6f * fexp2(-0.3f * LOG2E * (float)l));
    }
}

__device__ __forceinline__ float log_sigmoid(float x) { return fminf(x, 0.f) - 0.6931471805599453f * flog2(1.f + fexp2(-fabsf(x) * LOG2E)); }

__device__ __forceinline__ void phase_norm1(KArgs p, int l, LAS unsigned char* lds, int wv, bool probe2 = false) {
    const int tid = otid(wv), lane = tid & 63, wave = tid >> 6;
    LAS float* wf = (LAS float*)lds;
    LAS int* rbase = (LAS int*)(lds + 5 * DM * 4);
    if (l < DEPTH) { const float* WF = (const float*)(p->ws + WS_WF) + (size_t)l * 5 * DM; for (int i = tid; i < 5 * DM; i += 512) wf[i] = WF[i]; }
    if (l > 0 && tid == 0) { const unsigned* cnt = (const unsigned*)(p->ws + WS_CTL) + CW_CNT + (l - 1) * 16 * 64; int acc = 0;
        for (int e = 0; e < 16; ++e) { rbase[e] = acc * 256; acc += ((int)cnt[e * 64] + 255) >> 8; } }
    __syncthreads();
    const bf16_t* Y = (const bf16_t*)(p->ws + WS_Y); const i32x4* tsel = (const i32x4*)(p->ws + WS_TSEL);
    bf16_t* XN = (bf16_t*)(p->ws + WS_XN); float* LOGF = (float*)(p->ws + WS_LOGF);
    const int gw = blockIdx.x * 8 + wave, NGW = gridDim.x * 8;
    for (int t = gw; t < SEQ; t += NGW) {
        asm volatile("" ::: "memory");
        f32x4 v[8];
        if (l == 0 && !probe2) { const f32x4* xr = (const f32x4*)(p->x + (size_t)t * DM) + lane;
#pragma unroll
            for (int j = 0; j < 8; ++j) v[j] = xr[64 * j]; }
        else { const u32x2* xr = (const u32x2*)((const bf16_t*)(p->ws + WS_OUTB) + (size_t)t * DM) + lane;
#pragma unroll
            for (int j = 0; j < 8; ++j) { const u32x2 a = xr[64 * j]; v[j] = (f32x4){bf_lo(a[0]), bf_hi(a[0]), bf_lo(a[1]), bf_hi(a[1])}; } }
        if (l > 0) {
            const float ysc = probe2 ? 0.f : 1.f;
            const i32x4 ts = tsel[t];
            const unsigned* y1 = (const unsigned*)((const unsigned char*)Y + (size_t)(rbase[ts[0]] + ts[1]) * DM) + lane; const unsigned* y2 = (const unsigned*)((const unsigned char*)Y + (size_t)(rbase[ts[2]] + ts[3]) * DM) + lane;
            const float ys8 = ysc * (1.f / Y8_SCALE);
#pragma unroll
            for (int j = 0; j < 8; ++j) { const unsigned a = y1[64 * j], b = y2[64 * j];
                const f32x2_t a0 = __builtin_amdgcn_cvt_pk_f32_fp8((int)a, false), a1 = __builtin_amdgcn_cvt_pk_f32_fp8((int)a, true), b0 = __builtin_amdgcn_cvt_pk_f32_fp8((int)b, false), b1 = __builtin_amdgcn_cvt_pk_f32_fp8((int)b, true);
                v[j][0] += ys8 * (a0[0] + b0[0]); v[j][1] += ys8 * (a0[1] + b0[1]); v[j][2] += ys8 * (a1[0] + b1[0]); v[j][3] += ys8 * (a1[1] + b1[1]); }
        }
        if (l == DEPTH) { f32x4* orow = (f32x4*)(p->out + (size_t)t * DM) + lane;
#pragma unroll
            for (int j = 0; j < 8; ++j) orow[64 * j] = v[j]; }
        else { u32x2* orow = (u32x2*)((bf16_t*)(p->ws + WS_OUTB) + (size_t)t * DM) + lane;
#pragma unroll
            for (int j = 0; j < 8; ++j) { u32x2 w; w[0] = cvtpk(v[j][0], v[j][1]); w[1] = cvtpk(v[j][2], v[j][3]); orow[64 * j] = w; }
            if (FP8_PROJ) { unsigned* orow8 = (unsigned*)(p->ws + WS_OUTB8 + (size_t)t * DM) + lane;
#pragma unroll
                for (int j = 0; j < 8; ++j) orow8[64 * j] = cvt4f8(v[j][0], v[j][1], v[j][2], v[j][3]); } }
        if (l == DEPTH) continue;
        float ss = 0.f;
#pragma unroll
        for (int j = 0; j < 8; ++j) ss += (v[j][0] * v[j][0] + v[j][1] * v[j][1]) + (v[j][2] * v[j][2] + v[j][3] * v[j][3]);
        const float rstd = __builtin_amdgcn_rsqf(wave_sum(ss) * (1.f / DM) + EPS);
        const f32x4* gr = (const f32x4*)(p->attn_norm + (size_t)l * DM) + lane;
        float fc[5] = {0.f, 0.f, 0.f, 0.f, 0.f};
        if (lane == 0) ((float*)(p->ws + WS_RSTD))[t] = rstd;
#pragma unroll
        for (int j = 0; j < 8; ++j) { const f32x4 xn = v[j] * rstd * gr[64 * j];
#pragma unroll
            for (int h = 0; h < 5; ++h) { const f32x4 w4 = *(const LAS f32x4*)(wf + h * DM + 4 * lane + 256 * j); fc[h] += (xn[0] * w4[0] + xn[1] * w4[1]) + (xn[2] * w4[2] + xn[3] * w4[3]); } }
#pragma unroll
        for (int h = 0; h < 5; ++h) { const float s = wave_sum(fc[h]); if (lane == 0) LOGF[h * SEQ + t] = log_sigmoid(s + p->b_forget[l * 5 + h]); }
    }
}

__device__ __forceinline__ void scan_head(KArgs p, int h, int l, LAS unsigned char* lds, int wv) {
    const int tid = otid(wv), lane = tid & 63, wave = tid >> 6;
    const float* src = (const float*)(p->ws + WS_LOGF) + (size_t)h * SEQ + tid * 16; float* dst = (float*)(p->ws + WS_DC2) + (size_t)h * SEQ + tid * 16;
    LAS float* wt = (LAS float*)lds;
    float v[16]; float s = 0.f;
#pragma unroll
    for (int i = 0; i < 4; ++i) { const f32x4 a = ((const f32x4*)src)[i]; v[4 * i] = a[0]; v[4 * i + 1] = a[1]; v[4 * i + 2] = a[2]; v[4 * i + 3] = a[3]; }
#pragma unroll
    for (int i = 0; i < 16; ++i) { s += v[i]; v[i] = s; }
    float inc = s;
#pragma unroll
    for (int o = 1; o < 64; o <<= 1) { const float n = __int_as_float(__builtin_amdgcn_ds_bpermute(((lane - o) & 63) << 2, __float_as_int(inc))); if (lane >= o) inc += n; }
    if (lane == 63) wt[wave] = inc;
    __syncthreads();
    float base = inc - s;
    for (int w = 0; w < wave; ++w) base += wt[w];
#pragma unroll
    for (int i = 0; i < 4; ++i) ((f32x4*)dst)[i] = (f32x4){(v[4 * i] + base) * LOG2E, (v[4 * i + 1] + base) * LOG2E, (v[4 * i + 2] + base) * LOG2E, (v[4 * i + 3] + base) * LOG2E};
    LAS float* dl = (LAS float*)(lds + 64);
#pragma unroll
    for (int i = 0; i < 16; ++i) dl[tid * 16 + i] = (v[i] + base) * LOG2E;
    __syncthreads();
    { const float thr = 39.f + 2.f * 16.3221377f * ((const float*)(p->ws + WS_LAM))[8 + 2 * l + 1];
      const int qb = tid >> 4, part = tid & 15; const float dref = dl[256 * qb]; int cnt = 0;
      for (int i = part; i < 4 * qb; i += 16) cnt += (dref - dl[64 * i + 63] <= -thr) ? 1 : 0;
      float c = (float)cnt; c += swz_xor<1>(c); c += swz_xor<2>(c); c += swz_xor<4>(c); c += swz_xor<8>(c);
      if (part == 0) ((int*)(p->ws + WS_LAM))[64 + h * 32 + qb] = (int)c; }
    __syncthreads();
}

namespace att {
constexpr int KP = 272, VP = 144;
constexpr int KT_BYTES = 64 * KP, VT_BYTES = 128 * VP, KB_BYTES = 256;
constexpr int BUF_BYTES = KT_BYTES + VT_BYTES + KB_BYTES;
constexpr float THR = 8.f;
static_assert(2 * BUF_BYTES <= RING_BYTES && 4 * 128 * 32 * 4 <= RING_BYTES, "attention LDS");

struct Stg { u32x4 k0, k1, v0, v1; };
__device__ __forceinline__ void stage_load(Stg& s, const bf16_t* Kg, const bf16_t* Vg, int j, int tid) {
    const bf16_t* kp = Kg + (size_t)(64 * j + (tid >> 3)) * NQK + (tid & 7) * 8;
    s.k0 = *(const u32x4*)kp; s.k1 = *(const u32x4*)(kp + 64);
    const bf16_t* vp = Vg + (size_t)(tid >> 2) * SEQ + 64 * j + (tid & 3) * 8;
    s.v0 = *(const u32x4*)vp; s.v1 = *(const u32x4*)(vp + 32);
}
__device__ __forceinline__ void stage_write(const Stg& s, LAS unsigned char* buf, int tid) {
    LAS unsigned char* kd = buf + (tid >> 3) * KP + (tid & 7) * 16; *(LAS u32x4*)kd = s.k0; *(LAS u32x4*)(kd + 128) = s.k1;
    LAS unsigned char* vd = buf + KT_BYTES + (tid >> 2) * VP + (tid & 3) * 16; *(LAS u32x4*)vd = s.v0; *(LAS u32x4*)(vd + 64) = s.v1;
}
template <int NKS>
__device__ __forceinline__ void qk_tile(f32x16& p0, f32x16& p1, const LAS unsigned char* kb, const bf16x8* qr) {
    bf16x8 ka[NKS], kc[NKS];
#pragma unroll
    for (int ks = 0; ks < NKS; ++ks) { ka[ks] = *(const LAS bf16x8*)(kb + ks * 32); kc[ks] = *(const LAS bf16x8*)(kb + 32 * KP + ks * 32); }
    __builtin_amdgcn_sched_barrier(0);
#pragma unroll
    for (int ks = 0; ks < NKS; ++ks) {
        p0 = __builtin_amdgcn_mfma_f32_32x32x16_bf16(ka[ks], qr[ks], p0, 0, 0, 0);
        p1 = __builtin_amdgcn_mfma_f32_32x32x16_bf16(kc[ks], qr[ks], p1, 0, 0, 0);
    }
    __builtin_amdgcn_sched_barrier(0);
}
__device__ __forceinline__ bf16x8 pack8(const f32x16& p, int b) {
    u32x4 w = {cvtpk(p[b + 0], p[b + 1]), cvtpk(p[b + 2], p[b + 3]), cvtpk(p[b + 4], p[b + 5]), cvtpk(p[b + 6], p[b + 7])};
    return *reinterpret_cast<bf16x8*>(&w);
}
__device__ __forceinline__ void pv_tile(f32x16 (&o)[4], const LAS unsigned char* vb, const f32x16& p0, const f32x16& p1) {
    const bf16x8 pb0 = pack8(p0, 0), pb1 = pack8(p0, 8), pb2 = pack8(p1, 0), pb3 = pack8(p1, 8);
#pragma unroll
    for (int dh = 0; dh < 2; ++dh) {
        bf16x8 va[8];
#pragma unroll
        for (int i = 0; i < 8; ++i) va[i] = *(const LAS bf16x8*)(vb + (2 * dh + (i >> 2)) * 32 * VP + (i & 3) * 32);
        __builtin_amdgcn_sched_barrier(0);
#pragma unroll
        for (int i = 0; i < 8; ++i) { const int d0 = 2 * dh + (i >> 2), s4 = i & 3;
            o[d0] = __builtin_amdgcn_mfma_f32_32x32x16_bf16(va[i], s4 == 0 ? pb0 : (s4 == 1 ? pb1 : (s4 == 2 ? pb2 : pb3)), o[d0], 0, 0, 0); }
        __builtin_amdgcn_sched_barrier(0);
    }
}
template <int NKS>
__device__ __forceinline__ void tile_fixed(f32x16 (&o)[4], const LAS unsigned char* kb, const LAS unsigned char* vb, const bf16x8* qr, f32x16& y0, f32x16& y1, float& l) {
    bf16x8 ka[NKS], kc[NKS];
#pragma unroll
    for (int ks = 0; ks < NKS; ++ks) { ka[ks] = *(const LAS bf16x8*)(kb + ks * 32); kc[ks] = *(const LAS bf16x8*)(kb + 32 * KP + ks * 32); }
    __builtin_amdgcn_sched_barrier(0);
#pragma unroll
    for (int ks = 0; ks < NKS; ++ks) y0 = __builtin_amdgcn_mfma_f32_32x32x16_bf16(ka[ks], qr[ks], y0, 0, 0, 0);
    __builtin_amdgcn_sched_barrier(0);
    asm volatile("" : "+v"(y0));
#pragma unroll
    for (int ks = 0; ks < NKS; ++ks) y1 = __builtin_amdgcn_mfma_f32_32x32x16_bf16(kc[ks], qr[ks], y1, 0, 0, 0);
    float s = 0.f;
#pragma unroll
    for (int r = 0; r < 16; ++r) { y0[r] = fexp2(y0[r]); s += y0[r]; }
    const bf16x8 pb0 = pack8(y0, 0), pb1 = pack8(y0, 8);
#pragma unroll
    for (int q = 0; q < NKS; ++q) { __builtin_amdgcn_sched_group_barrier(0x008, 1, 0);
#pragma unroll
        for (int h = 0; h < 8 / NKS; ++h) { __builtin_amdgcn_sched_group_barrier(0x400, 2, 0); __builtin_amdgcn_sched_group_barrier(0x002, 3, 0); } }
    __builtin_amdgcn_sched_barrier(0);
    bf16x8 va[8];
#pragma unroll
    for (int i = 0; i < 8; ++i) va[i] = *(const LAS bf16x8*)(vb + (i >> 1) * 32 * VP + (i & 1) * 32);
    __builtin_amdgcn_sched_barrier(0);
    asm volatile("" : "+v"(y1));
#pragma unroll
    for (int i = 0; i < 8; ++i) o[i >> 1] = __builtin_amdgcn_mfma_f32_32x32x16_bf16(va[i], (i & 1) ? pb1 : pb0, o[i >> 1], 0, 0, 0);
    float s1 = 0.f;
#pragma unroll
    for (int r = 0; r < 16; ++r) { y1[r] = fexp2(y1[r]); s1 += y1[r]; }
    const bf16x8 pb2 = pack8(y1, 0), pb3 = pack8(y1, 8);
#pragma unroll
    for (int q = 0; q < 8; ++q) { __builtin_amdgcn_sched_group_barrier(0x008, 1, 0); __builtin_amdgcn_sched_group_barrier(0x400, 2, 0); __builtin_amdgcn_sched_group_barrier(0x002, 3, 0); }
    __builtin_amdgcn_sched_barrier(0);
    l += s + s1;
    bf16x8 vb2[8];
#pragma unroll
    for (int i = 0; i < 8; ++i) vb2[i] = *(const LAS bf16x8*)(vb + (i >> 1) * 32 * VP + 64 + (i & 1) * 32);
    __builtin_amdgcn_sched_barrier(0);
#pragma unroll
    for (int i = 0; i < 8; ++i) o[i >> 1] = __builtin_amdgcn_mfma_f32_32x32x16_bf16(vb2[i], (i & 1) ? pb3 : pb2, o[i >> 1], 0, 0, 0);
    __builtin_amdgcn_sched_barrier(0);
}
__device__ __forceinline__ float swap_max(float v) { auto rr = __builtin_amdgcn_permlane32_swap(__float_as_uint(v), __float_as_uint(v), false, false); return fmaxf(__uint_as_float(rr[0]), __uint_as_float(rr[1])); }
__device__ __forceinline__ float swap_sum(float v) { auto rr = __builtin_amdgcn_permlane32_swap(__float_as_uint(v), __float_as_uint(v), false, false); return __uint_as_float(rr[0]) + __uint_as_float(rr[1]); }
__device__ __forceinline__ void softmax_step(f32x16& y0, f32x16& y1, float A, float& m, float& l, f32x16 (&o)[4]) {
    float mx = y0[0];
#pragma unroll
    for (int r = 1; r < 16; ++r) mx = fmaxf(mx, y0[r]);
#pragma unroll
    for (int r = 0; r < 16; ++r) mx = fmaxf(mx, y1[r]);
    mx = swap_max(mx) + A;
    if (__any(mx > m + THR)) {
        const float mn = fmaxf(m, mx), al = fexp2(m - mn); m = mn; l *= al;
#pragma unroll
        for (int d0 = 0; d0 < 4; ++d0)
#pragma unroll
            for (int r = 0; r < 16; ++r) o[d0][r] *= al;
    }
    const float mA = m - A; float s = 0.f;
#pragma unroll
    for (int r = 0; r < 16; ++r) { y0[r] = fexp2(y0[r] - mA); s += y0[r]; }
#pragma unroll
    for (int r = 0; r < 16; ++r) { y1[r] = fexp2(y1[r] - mA); s += y1[r]; }
    l += s;
}
__device__ __forceinline__ void softmax_fixed(f32x16& y0, f32x16& y1, float c, float& l) {
    float s = 0.f;
#pragma unroll
    for (int r = 0; r < 16; ++r) { y0[r] = fexp2(y0[r] + c); s += y0[r]; }
#pragma unroll
    for (int r = 0; r < 16; ++r) { y1[r] = fexp2(y1[r] + c); s += y1[r]; }
    l += s;
}
#define KIDX(r) (((r) & 3) + 8 * ((r) >> 2))

template <int TY>
__device__ __forceinline__ void att_item(KArgs p, int l, int head, int qb, LAS unsigned char* lds, int wv, int part = 0) {
    const int tid = otid(wv), wid = __builtin_amdgcn_readfirstlane(tid >> 6), lane = tid & 63, r32 = lane & 31, hi = lane >> 5;
    constexpr int NKS = (TY == 0) ? 4 : 8;
    const int br = (TY == 0) ? (wid >> 2) : 0, rg = (TY == 0) ? (wid & 3) : wid;
    const int t0w = (TY == 0) ? (128 * qb + 32 * rg) : (256 * qb + 32 * wid);
    const int trow = t0w + r32;
    const int NT = (TY == 0) ? (2 * qb + 2) : (4 * qb + 4);
    const int qcol = (TY == 0) ? (128 * head + 64 * br) : (TY == 1 ? 2816 + 128 * head : 1536 + 128 * head);
    const int kcol = (TY == 0) ? (768 + 128 * head) : (TY == 1 ? 3456 + 128 * head : 2176 + 128 * head);
    const int hv = (TY == 0) ? head : (TY == 1 ? 6 + head : 11 + head);
    const bf16_t* QKB = (const bf16_t*)(p->ws + WS_QKB);
    const bf16_t* Kg = QKB + kcol; const bf16_t* Vg = (const bf16_t*)(p->ws + WS_VT) + (size_t)hv * HD * SEQ;
    const float* dc2 = (const float*)(p->ws + WS_DC2) + (size_t)head * SEQ;
    const float dcref = (TY == 2) ? dc2[256 * qb] : 0.f;
    const float slope2 = (TY == 0) ? fexp2(-8.0f * (float)(head + 1) / 6.0f) * LOG2E : 0.f;
    const float Bfix = (TY == 0) ? (11.5415603f * 1.01f * ((const float*)(p->ws + WS_LAM))[8 + 2 * l] + 0.25f) : (16.3221377f * 1.01f * ((const float*)(p->ws + WS_LAM))[8 + 2 * l + 1] + 0.25f);
    const float cfix = (TY == 2) ? (dc2[trow] - dcref - Bfix) : -Bfix;

    int j_lo = 0;
    if (TY == 0 && SKIP_A) {
        const float Bq = 11.5415603f * ((const float*)(p->ws + WS_LAM))[8 + 2 * l];
        const float x = ((float)(128 * qb - 63) - (39.f + 2.f * Bq) / slope2) * (1.f / 64.f);
        j_lo = x < 0.f ? 0 : (int)x + 1;
    } else if (TY == 2 && SKIP_C) {
        j_lo = ((const int*)(p->ws + WS_LAM))[64 + head * 32 + qb];
    }
    j_lo = __builtin_amdgcn_readfirstlane(j_lo);
    const int NTP = NT - j_lo;
    const bool elig = (TY == 2) ? (qb >= 8) : ((TY == 0) ? (head >= 4 && qb >= 16) : false);
    const bool split = elig && NTP > 32;
    if (part == 1 && !split) return;
    const int mid = j_lo + (NTP >> 1);
    const int jtop = (part == 1) ? mid - 1 : NT - 1;
    const int cntT = (part == 1) ? (mid - j_lo) : (split ? NT - mid : NTP);
    const int sidx = (TY == 2) ? (head * 32 + qb) : (160 + head * 64 + qb);
    unsigned long long* pay = (unsigned long long*)(p->ws + WS_PART) + ((size_t)sidx * 8 + wid) * 17 * 64 + lane;
    unsigned* aflag = (unsigned*)(p->ws + WS_CTL) + CW_AFLAG + (l * 544 + sidx) * 64;
    LAS unsigned char* buf0 = lds; LAS unsigned char* buf1 = lds + BUF_BYTES;
    LAS int* flags = (LAS int*)(lds + 2 * BUF_BYTES);
    if (TY == 1 && tid < 16) flags[tid] = 0;
    Stg st; float kbv = 0.f;
    stage_load(st, Kg, Vg, jtop, tid);
    if (TY == 2 && tid < 64) kbv = dcref - dc2[64 * jtop + tid];
    bf16x8 qr[NKS];
#pragma unroll
    for (int ks = 0; ks < NKS; ++ks) qr[ks] = *(const bf16x8*)(QKB + (size_t)trow * NQK + qcol + ks * 16 + hi * 8);
    stage_write(st, buf0, tid);
    if (TY == 2 && tid < 64) *(LAS float*)(buf0 + KT_BYTES + VT_BYTES + tid * 4) = kbv;
    if (cntT > 1) { stage_load(st, Kg, Vg, jtop - 1, tid); if (TY == 2 && tid < 64) kbv = dcref - dc2[64 * (jtop - 1) + tid]; }
    __syncthreads();

    f32x16 o[4];
#pragma unroll
    for (int d0 = 0; d0 < 4; ++d0)
#pragma unroll
        for (int r = 0; r < 16; ++r) o[d0][r] = 0.f;
    float m = 0.f, lsum = 0.f, R = 0.f;
    const int koff = r32 * KP + hi * 16 + ((TY == 0) ? br * 128 : 0), voff = KT_BYTES + r32 * VP + hi * 16;

    for (int it = 0; it < cntT; ++it) {
        if (TY == 1 && (SKIP_B & 1) && it > 0) { const i32x4 f0 = *(const LAS i32x4*)(flags + ((it - 1) & 1) * 8), f1 = *(const LAS i32x4*)(flags + ((it - 1) & 1) * 8 + 4);
            if (__builtin_amdgcn_readfirstlane((f0[0] & f0[1] & f0[2] & f0[3] & f1[0] & f1[1] & f1[2] & f1[3])) != 0) break; }
        const int j = jtop - it;
        LAS unsigned char* cur = (it & 1) ? buf1 : buf0; LAS unsigned char* oth = (it & 1) ? buf0 : buf1;
        const bool more = it + 1 < cntT;
        if (TY == 0) {
            const int cw = 2 * qb + (rg >> 1);
            if (j <= cw) {
                f32x16 y0, y1;
                const int trel = trow - 64 * j;
                if (j == cw) {
                    const float tq = (float)(trel - 4 * hi);
#pragma unroll
                    for (int r = 0; r < 16; ++r) { y0[r] = fmaf(-slope2, fabsf(tq - (float)KIDX(r)), cfix); y1[r] = fmaf(-slope2, fabsf(tq - (float)(KIDX(r) + 32)), cfix); }
                } else {
                    const float A = fmaf(-slope2, (float)(trel - 4 * hi), cfix);
#pragma unroll
                    for (int r = 0; r < 16; ++r) { y0[r] = fmaf(slope2, (float)KIDX(r), A); y1[r] = fmaf(slope2, (float)(KIDX(r) + 32), A); }
                }
                tile_fixed<NKS>(o, cur + koff, cur + voff, qr, y0, y1, lsum);
            }
        } else {
            const int jj = j - 4 * qb;
            if (jj <= (wid >> 1) && !(TY == 1 && (SKIP_B & 2) && __all(R <= -40.f))) {
                const bool partial = (jj == (wid >> 1));
                const int tin = 32 * (wid & 1) + r32 - 4 * hi;
                f32x16 y0, y1;
                if (TY == 2) {
                    const LAS f32x4* kbp = (const LAS f32x4*)(cur + KT_BYTES + VT_BYTES) + hi;
#pragma unroll
                    for (int g = 0; g < 4; ++g) { const f32x4 b0 = kbp[2 * g], b1 = kbp[2 * g + 8];
#pragma unroll
                        for (int i = 0; i < 4; ++i) { y0[4 * g + i] = b0[i] + cfix; y1[4 * g + i] = b1[i] + cfix; } }
                    if (partial) {
#pragma unroll
                        for (int r = 0; r < 16; ++r) { if (KIDX(r) > tin) y0[r] = -__builtin_inff(); if (KIDX(r) + 32 > tin) y1[r] = -__builtin_inff(); }
                    }
                    tile_fixed<NKS>(o, cur + koff, cur + voff, qr, y0, y1, lsum);
                } else {
#pragma unroll
                    for (int r = 0; r < 16; ++r) { y0[r] = 0.f; y1[r] = 0.f; }
                    qk_tile<NKS>(y0, y1, cur + koff, qr);
                    f32x16 lb0, lb1;
#pragma unroll
                    for (int r = 0; r < 16; ++r) {
                        { const float z = fminf(fmaxf(y0[r], -100.f), 100.f), b = -flog2(1.f + fexp2(-z)); float k = b - z, bb = b;
                          if (partial && KIDX(r) >= tin) { k = 0.f; bb = -__builtin_inff(); } lb0[r] = bb; y0[r] = k; }
                        { const float z = fminf(fmaxf(y1[r], -100.f), 100.f), b = -flog2(1.f + fexp2(-z)); float k = b - z, bb = b;
                          if (partial && KIDX(r) + 32 >= tin) { k = 0.f; bb = -__builtin_inff(); } lb1[r] = bb; y1[r] = k; }
                    }
                    float gs0[4], gs1[4];
#pragma unroll
                    for (int g = 0; g < 4; ++g) {
                        { const float e0 = y0[4 * g], e1 = y0[4 * g + 1], e2 = y0[4 * g + 2], e3 = y0[4 * g + 3]; const float s2 = e3, s1 = e3 + e2, s0 = s1 + e1;
                          y0[4 * g + 3] = 0.f; y0[4 * g + 2] = s2; y0[4 * g + 1] = s1; y0[4 * g] = s0; gs0[g] = s0 + e0; }
                        { const float e0 = y1[4 * g], e1 = y1[4 * g + 1], e2 = y1[4 * g + 2], e3 = y1[4 * g + 3]; const float s2 = e3, s1 = e3 + e2, s0 = s1 + e1;
                          y1[4 * g + 3] = 0.f; y1[4 * g + 2] = s2; y1[4 * g + 1] = s1; y1[4 * g] = s0; gs1[g] = s0 + e0; }
                    }
                    float run = R;
#pragma unroll
                    for (int half = 1; half >= 0; --half)
#pragma unroll
                        for (int g = 3; g >= 0; --g) {
                            const float mine = half ? gs1[g] : gs0[g];
                            auto rr = __builtin_amdgcn_permlane32_swap(__float_as_uint(mine), __float_as_uint(mine), false, false);
                            const float g_lo = __uint_as_float(rr[0]), g_hi = __uint_as_float(rr[1]);
                            const float off_hi = run; run += g_hi; const float off_lo = run; run += g_lo;
                            const float off = hi ? off_hi : off_lo;
#pragma unroll
                            for (int i = 0; i < 4; ++i) {
                                if (half) y1[4 * g + i] = fexp2(lb1[4 * g + i] + y1[4 * g + i] + off);
                                else y0[4 * g + i] = fexp2(lb0[4 * g + i] + y0[4 * g + i] + off);
                            }
                        }
                    R = run;
                    pv_tile(o, cur + voff, y0, y1);
                }
            }
        }
        if (TY == 1) { const int dn = __all(R <= -40.f) ? 1 : 0; if (lane == 0) flags[(it & 1) * 8 + wid] = dn; }
        if (more) { stage_write(st, oth, tid); if (TY == 2 && tid < 64) *(LAS float*)(oth + KT_BYTES + VT_BYTES + tid * 4) = kbv; }
        if (it + 2 < cntT) { stage_load(st, Kg, Vg, j - 2, tid); if (TY == 2 && tid < 64) kbv = dcref - dc2[64 * (j - 2) + tid]; }
        __syncthreads();
    }

    bf16_t* MIX = (bf16_t*)(p->ws + WS_MIX);
    float inv = 1.f;
    if (TY != 1) {
        float lt = swap_sum(lsum);
        if (part == 1) {
            __hip_atomic_store(pay, ((unsigned long long)__float_as_uint(lt) << 32) | __float_as_uint(m), __ATOMIC_RELAXED, __HIP_MEMORY_SCOPE_AGENT);
#pragma unroll
            for (int d0 = 0; d0 < 4; ++d0)
#pragma unroll
                for (int g = 0; g < 4; ++g)
                    __hip_atomic_store(pay + (1 + d0 * 4 + g) * 64, ((unsigned long long)cvtpk(o[d0][4 * g + 2], o[d0][4 * g + 3]) << 32) | cvtpk(o[d0][4 * g], o[d0][4 * g + 1]), __ATOMIC_RELAXED, __HIP_MEMORY_SCOPE_AGENT);
            asm volatile("s_waitcnt vmcnt(0)" ::: "memory");
            __syncthreads();
            if (tid == 0) __hip_atomic_store(aflag, 1u, __ATOMIC_RELAXED, __HIP_MEMORY_SCOPE_AGENT);
            __syncthreads();
            return;
        }
        if (split) {
            if (tid == 0) { unsigned sp = 0; while (__hip_atomic_load(aflag, __ATOMIC_RELAXED, __HIP_MEMORY_SCOPE_AGENT) == 0u && ++sp < (1u << 22)) __builtin_amdgcn_s_sleep(2);
                __builtin_amdgcn_fence(__ATOMIC_ACQUIRE, "agent"); asm volatile("s_waitcnt vmcnt(0)" ::: "memory"); }
            __syncthreads();
            const unsigned long long ml = __hip_atomic_load(pay, __ATOMIC_RELAXED, __HIP_MEMORY_SCOPE_AGENT);
            const float mf = __uint_as_float((unsigned)ml), lf = __uint_as_float((unsigned)(ml >> 32));
            const float mn = fmaxf(m, mf), a0 = fexp2(m - mn), a1 = fexp2(mf - mn);
            lt = a0 * lt + a1 * lf;
#pragma unroll
            for (int d0 = 0; d0 < 4; ++d0)
#pragma unroll
                for (int g = 0; g < 4; ++g) {
                    const unsigned long long w = __hip_atomic_load(pay + (1 + d0 * 4 + g) * 64, __ATOMIC_RELAXED, __HIP_MEMORY_SCOPE_AGENT);
                    const unsigned w0 = (unsigned)w, w1 = (unsigned)(w >> 32);
                    o[d0][4 * g] = a0 * o[d0][4 * g] + a1 * bf_lo(w0); o[d0][4 * g + 1] = a0 * o[d0][4 * g + 1] + a1 * bf_hi(w0);
                    o[d0][4 * g + 2] = a0 * o[d0][4 * g + 2] + a1 * bf_lo(w1); o[d0][4 * g + 3] = a0 * o[d0][4 * g + 3] + a1 * bf_hi(w1);
                }
        }
        inv = 1.f / lt;
    }
    float post = 1.f; const float* gain;
    if (TY == 0) {
        const float lam = ((const float*)(p->ws + WS_LAM))[l];
        LAS float* X = (LAS float*)lds + (size_t)rg * 128 * 32;
        if (br == 1) {
            const float sc = inv * lam;
#pragma unroll
            for (int d0 = 0; d0 < 4; ++d0)
#pragma unroll
                for (int r = 0; r < 16; ++r) X[(32 * d0 + KIDX(r) + 4 * hi) * 32 + r32] = o[d0][r] * sc;
        }
        __syncthreads();
        if (br == 0) {
#pragma unroll
            for (int d0 = 0; d0 < 4; ++d0)
#pragma unroll
                for (int r = 0; r < 16; ++r) o[d0][r] = o[d0][r] * inv - X[(32 * d0 + KIDX(r) + 4 * hi) * 32 + r32];
        }
        inv = 1.f;
        post = 1.f - (0.8f - 0.6f * fexp2(-0.3f * LOG2E * (float)l));
        gain = p->subln_diff + l * HD;
    } else if (TY == 1) gain = p->onorm_sb + l * HD;
    else gain = p->onorm_fox + l * HD;
    if (TY != 0 || br == 0) {
        float ss = 0.f;
#pragma unroll
        for (int d0 = 0; d0 < 4; ++d0)
#pragma unroll
            for (int r = 0; r < 16; ++r) { const float v = o[d0][r] * inv; ss += v * v; }
        ss = swap_sum(ss);
        const float sc = inv * post * __builtin_amdgcn_rsqf(ss * (1.f / HD) + EPS);
        bf16_t* orow = MIX + (size_t)trow * DM + hv * HD + 4 * hi;
#pragma unroll
        for (int d0 = 0; d0 < 4; ++d0)
#pragma unroll
            for (int g = 0; g < 4; ++g) {
                const f32x4 g4 = *(const f32x4*)(gain + 32 * d0 + 8 * g + 4 * hi);
                if (FP8_WOUT) { *(unsigned*)((unsigned char*)MIX + (size_t)trow * DM + hv * HD + 4 * hi + 32 * d0 + 8 * g) = cvt4f8(o[d0][4 * g] * sc * g4[0], o[d0][4 * g + 1] * sc * g4[1], o[d0][4 * g + 2] * sc * g4[2], o[d0][4 * g + 3] * sc * g4[3]); continue; }
                u32x2 w; w[0] = cvtpk(o[d0][4 * g] * sc * g4[0], o[d0][4 * g + 1] * sc * g4[1]); w[1] = cvtpk(o[d0][4 * g + 2] * sc * g4[2], o[d0][4 * g + 3] * sc * g4[3]);
                *(u32x2*)(orow + 32 * d0 + 8 * g) = w;
            }
    }
    __syncthreads();
}

constexpr int N_FAR = 5 * 24 + 2 * 48;
constexpr int N_ITEMS = N_FAR + 32 * 22;
__device__ __forceinline__ void attention_phase(KArgs p, int l, LAS unsigned char* lds, volatile LAS unsigned* itemw, int wv, int qi, int tmask = 7) {
    unsigned* q = (unsigned*)(p->ws + WS_CTL) + CW_ATTQ + qi * 64;
    for (;;) {
        if (otid(wv) == 0) *itemw = __hip_atomic_fetch_add(q, 1u, __ATOMIC_RELAXED, __HIP_MEMORY_SCOPE_AGENT);
        __syncthreads();
        int item = (int)*itemw;
        __syncthreads();
        if (item >= N_ITEMS) break;
        if (item < N_FAR) {
            if (item < 120) { if (tmask & 1) att_item<2>(p, l, item % 5, 31 - item / 5, lds, wv, 1); }
            else { const int i2 = item - 120; if (tmask & 2) att_item<0>(p, l, 5 - (i2 & 1), 63 - (i2 >> 1), lds, wv, 1); }
            continue;
        }
        item -= N_FAR;
        if (item < 288) { const int w = item % 9, pp = 31 - item / 9;
            if (w < 5) { if (tmask & 1) att_item<2>(p, l, w, pp, lds, wv); }
            else if (tmask & 2) att_item<0>(p, l, 5 - ((w - 5) >> 1), 2 * pp + 1 - ((w - 5) & 1), lds, wv); }
        else if (item < 544) { const int it2 = item - 288, w = it2 % 8, pp = 31 - it2 / 8;
            if (tmask & 2) att_item<0>(p, l, 3 - (w >> 1), 2 * pp + 1 - (w & 1), lds, wv); }
        else if (tmask & 4) { const int it3 = item - 544; att_item<1>(p, l, it3 % 5, 31 - it3 / 5, lds, wv); }
    }
}
}

__device__ __forceinline__ void phase_route(KArgs p, int l, LAS unsigned char* lds, int wv, int ci, bool waitp = true) {
    const int tid = otid(wv), lane = tid & 63, wave = tid >> 6;
    LAS float* wrt = (LAS float*)lds;
    LAS int* bsel = (LAS int*)(lds + 16 * DM * 4);
    LAS float* bsc = (LAS float*)(bsel + 64);
    LAS float* bgate = bsc + 64;
    LAS float* brs = bgate + 64;
    { const f32x4* src = (const f32x4*)(p->ws + WS_WRT); for (int i = tid; i < 16 * DM / 4; i += 512) ((LAS f32x4*)wrt)[i] = src[i]; }
    __syncthreads();
    bf16_t* XN = (bf16_t*)(p->ws + WS_XN);
    for (int blk = blockIdx.x; blk < SEQ / 32; blk += gridDim.x) {
        const int tid = otid(wv), lane = tid & 63, wave = tid >> 6;
        if (waitp) { if (wave == 0) {
            const unsigned* wc = (const unsigned*)(p->ws + WS_CTL) + CW_WOC + l * 32 * 64 + 64 * (blk >> 3);
            unsigned sp = 0;
            while ((unsigned)__builtin_amdgcn_readfirstlane((int)__hip_atomic_load(wc, __ATOMIC_RELAXED, __HIP_MEMORY_SCOPE_AGENT)) < 64u && ++sp < (1u << 22)) __builtin_amdgcn_s_sleep(2);
            __builtin_amdgcn_fence(__ATOMIC_ACQUIRE, "agent");
            asm volatile("s_waitcnt vmcnt(0)" ::: "memory");
            } __syncthreads(); }
        const int tb = blk * 32 + wave * 4;
        f32x4 hx[4][8];
#pragma unroll
        for (int i = 0; i < 4; ++i) { const u32x2* xr = (const u32x2*)((const bf16_t*)(p->ws + WS_OUTB) + (size_t)(tb + i) * DM) + lane;
#pragma unroll
            for (int j = 0; j < 8; ++j) { const u32x2 a = xr[64 * j]; hx[i][j] = (f32x4){bf_lo(a[0]), bf_hi(a[0]), bf_lo(a[1]), bf_hi(a[1])}; } }
#pragma unroll
        for (int i = 0; i < 4; ++i) {
            float ss = 0.f;
#pragma unroll
            for (int j = 0; j < 8; ++j) ss += (hx[i][j][0] * hx[i][j][0] + hx[i][j][1] * hx[i][j][1]) + (hx[i][j][2] * hx[i][j][2] + hx[i][j][3] * hx[i][j][3]);
            const float rstd = __builtin_amdgcn_rsqf(wave_sum(ss) * (1.f / DM) + EPS);
            if (lane == 0) brs[wave * 4 + i] = rstd;
            const f32x4* gr = (const f32x4*)(p->ffn_norm + (size_t)l * DM) + lane;
#pragma unroll
            for (int j = 0; j < 8; ++j) hx[i][j] = hx[i][j] * rstd * gr[64 * j];
        }
#pragma unroll
        for (int h2 = 0; h2 < 2; ++h2) {
            f32x4 (&hn)[2][8] = *reinterpret_cast<f32x4 (*)[2][8]>(&hx[2 * h2]);
            asm volatile("" ::: "memory"); __builtin_amdgcn_sched_barrier(0);
            float acc[32];
#pragma unroll
            for (int k = 0; k < 32; ++k) acc[k] = 0.f;
#pragma unroll
            for (int j = 0; j < 8; ++j)
#pragma unroll
                for (int eh = 0; eh < 2; ++eh) {
#pragma unroll
                    for (int e = 8 * eh; e < 8 * eh + 8; ++e) { const f32x4 w4 = *(const LAS f32x4*)(wrt + e * DM + 4 * lane + 256 * j);
#pragma unroll
                        for (int i = 0; i < 2; ++i) acc[i * 16 + e] += (hn[i][j][0] * w4[0] + hn[i][j][1] * w4[1]) + (hn[i][j][2] * w4[2] + hn[i][j][3] * w4[3]); }
                    __builtin_amdgcn_sched_barrier(0);
                }
#pragma unroll
            for (int k = 0; k < 32; ++k) acc[k] = sum_xor32(acc[k]);
#define RSTEP(H) { const bool up = (lane & H) != 0; _Pragma("unroll") for (int k = 0; k < H; ++k) { const float a = acc[k], b = acc[k + H]; const float give = up ? a : b, keep = up ? b : a; acc[k] = keep + swz_xor<H>(give); } }
            RSTEP(16) RSTEP(8) RSTEP(4) RSTEP(2) RSTEP(1)
#undef RSTEP
            const float logit = acc[0];
            const float score = __builtin_amdgcn_rcpf(1.f + fexp2(-logit * LOG2E));
            const float sel = score + p->router_bias[lane & 15];
            const float v1 = swz_xor<1>(sel), v2 = swz_xor<2>(sel), v3 = swz_xor<3>(sel);
            const float a = fmaxf(sel, v1), b = fminf(sel, v1), c = fmaxf(v2, v3), d = fminf(v2, v3);
            const float gs = fmaxf(a, c) + fmaxf(fminf(a, c), fmaxf(b, d));
            const float g1 = swz_xor<4>(gs), g2 = swz_xor<8>(gs), g3 = swz_xor<12>(gs);
            const int myg = (lane >> 2) & 3, k = lane & 3;
            const bool best = (gs > g1 || (gs == g1 && myg < (myg ^ 1))) && (gs > g2 || (gs == g2 && myg < (myg ^ 2))) && (gs > g3 || (gs == g3 && myg < (myg ^ 3)));
            const int rank = ((v1 > sel || (v1 == sel && (k ^ 1) < k)) ? 1 : 0) + ((v2 > sel || (v2 == sel && (k ^ 2) < k)) ? 1 : 0) + ((v3 > sel || (v3 == sel && (k ^ 3) < k)) ? 1 : 0);
            if (best && rank < 2 && lane < 32) { const int row = wave * 4 + h2 * 2 + (lane >> 4); bsel[row * 2 + rank] = lane & 15; bsc[row * 2 + rank] = score; }
        }
        asm volatile("s_waitcnt lgkmcnt(0)" ::: "memory");
        if (lane < 8) { const int idx = wave * 8 + lane; const float sm = bsc[idx], so = bsc[idx ^ 1]; bgate[idx] = sm / (sm + so); }
        __syncthreads();
        if (wave == 0) {
            unsigned* cnt = (unsigned*)(p->ws + WS_CTL) + CW_CNT + ci * 16 * 64;
            const int mye = bsel[lane]; int myrank = 0, n = 0;
            const unsigned long long below = (1ull << lane) - 1ull;
#pragma unroll
            for (int e = 0; e < 16; ++e) { const unsigned long long mk = __ballot(mye == e); if (mye == e) myrank = (int)__popcll(mk & below); if (lane == e) n = (int)__popcll(mk); }
            int base = 0;
            if (lane < 16 && n) base = (int)__hip_atomic_fetch_add(cnt + lane * 64, (unsigned)n, __ATOMIC_RELAXED, __HIP_MEMORY_SCOPE_AGENT);
            const int pos = __builtin_amdgcn_ds_bpermute(mye << 2, base) + myrank, tok = blk * 32 + (lane >> 1);
            ((int*)(p->ws + WS_TOK))[mye * SEQ + pos] = tok; ((f32x2_t*)(p->ws + WS_GATE))[mye * SEQ + pos] = (f32x2_t){bgate[lane], brs[lane >> 1]};
            int* ts = (int*)(p->ws + WS_TSEL) + tok * 4 + (lane & 1) * 2; ts[0] = mye; ts[1] = pos;
        }
        __syncthreads();
    }
}

__device__ __forceinline__ void moe_table(KArgs p, int l, LAS int* tbl, int wv) {
    if (otid(wv) == 0) { const unsigned* cnt = (const unsigned*)(p->ws + WS_CTL) + CW_CNT + l * 16 * 64; int acc = 0;
        for (int e = 0; e < 16; ++e) { const int n = (int)cnt[e * 64]; tbl[e] = acc; tbl[17 + e] = n; acc += (n + 255) >> 8; } tbl[16] = acc; }
    __syncthreads();
}

constexpr int N_PHASES = 2 + 7 * DEPTH;
__device__ __forceinline__ int opq(int v) { asm volatile("" : "+s"(v)); return v; }
__device__ __forceinline__ LAS unsigned char* opq(LAS unsigned char* v) { unsigned x = (unsigned)(uintptr_t)v; asm volatile("" : "+s"(x)); return (LAS unsigned char*)(uintptr_t)x; }
__global__ void __launch_bounds__(512, 2) trunk_fwd(Params pk) {
    extern __shared__ __attribute__((aligned(16))) unsigned char lds_raw[];
    LAS unsigned char* lds = (LAS unsigned char*)lds_raw;
    volatile LAS unsigned* MISC = (volatile LAS unsigned*)(lds + MISC_OFF);
    LAS int* mtbl = (LAS int*)(lds + MISC_OFF + 256);
#define p kparams()
    const int wv = __builtin_amdgcn_readfirstlane((int)threadIdx.x >> 6);
    for (int u = threadIdx.x; u < (LDS_BYTES - MISC_OFF) / 4; u += 512) ((LAS unsigned*)(lds + MISC_OFF))[u] = 0u;
    __syncthreads();
    unsigned* ctl = (unsigned*)(p->ws + WS_CTL);
    XcdBarrier bar; bar.bar = ctl + CW_BAR; bar.x = 0; bar.st = nullptr; bar.wv = wv;
    const bool multi = (p->ph_hi - p->ph_lo) > 1;
    if (multi) bar = xcd_barrier_post(ctl + CW_BAR, MISC + 8, wv);
    const int lo = p->ph_lo, hi = p->ph_hi;
#define IN(k) (lo <= (k) && (k) < hi)
#define SEAM(k) do { if (IN(k) && IN((k) + 1)) xcd_barrier(bar); } while (0)
    const int G0 = gridDim.x, c0 = blockIdx.x; LAS unsigned char* const lds0 = lds;
#define PHASE_LOCALS const int G = opq(G0), c = opq(c0); LAS unsigned char* const lds = opq(lds0); LAS int* const mtbl = (LAS int*)(lds + MISC_OFF + 256); volatile LAS unsigned* const MISC = (volatile LAS unsigned*)(lds + MISC_OFF); (void)G; (void)c; (void)mtbl; (void)MISC;

    if (PK(0) && IN(0)) { PHASE_LOCALS phase_prologue(p, lds, wv); if (DUP_PHASE == 0) { __syncthreads(); phase_prologue(p, lds, wv); } SEAM(0); }
    for (int l = 0; l < DEPTH; ++l) {
        const int pb = 1 + 7 * l;
        if (PK(1) && IN(pb + 0)) { PHASE_LOCALS phase_norm1(p, l, lds, wv); if (DUP_PHASE == 1) { xcd_barrier(bar); phase_norm1(p, l, lds, wv, true); } SEAM(pb + 0); }
        if (PK(2) && IN(pb + 1)) { PHASE_LOCALS
            if (c < H_FOX) scan_head(p, c, l, lds, wv);
            for (int rep = 0; rep < (DUP_PHASE == 2 ? 2 : 1); ++rep) {
            { pg8::Gemm g{(const bf16_t*)(p->ws + (FP8_PROJ ? WS_OUTB8 : WS_OUTB)), (const bf16_t*)(p->ws + WS_WQK + (size_t)l * NQK * DM * (FP8_PROJ ? 1 : 2)), SEQ, NQK, FP8_PROJ ? DM / 2 : DM};
              pg8::StaticOrder S; S.init(SEQ, NQK, G, c);
              pg8::EpiQK E{(bf16_t*)(p->ws + WS_QKB), p->qnorm_diff + l * 64, p->knorm_diff + l * 64, p->qnorm_fox + l * 128, p->knorm_fox + l * 128, (LAS float*)(lds + TBL_OFF), (const float*)(p->ws + WS_RSTD)};
              pg8::gemm_phase<pg8::EpiQK, pg8::StaticOrder>(lds, g, S, E, wv); }
            { pg8::Gemm g{(const bf16_t*)(p->ws + WS_WV + (size_t)l * NV * DM * (FP8_PROJ ? 1 : 2)), (const bf16_t*)(p->ws + (FP8_PROJ ? WS_OUTB8 : WS_OUTB)), NV, SEQ, FP8_PROJ ? DM / 2 : DM};
              pg8::StaticOrder S; S.init(NV, SEQ, G, c);
              pg8::EpiVT E{(bf16_t*)(p->ws + WS_VT), SEQ, (const float*)(p->ws + WS_RSTD)};
              pg8::gemm_phase<pg8::EpiVT, pg8::StaticOrder>(lds, g, S, E, wv); }
            }
            SEAM(pb + 1);
        }
        if (PK(3) && IN(pb + 2)) { PHASE_LOCALS att::attention_phase(p, l, lds, MISC + 16, wv, l); if (DUP_PHASE == 3) { __syncthreads(); att::attention_phase(p, l, lds, MISC + 16, wv, l + 4, ATT_MASK2); } SEAM(pb + 2); }
        if (PK(4) && IN(pb + 3)) { PHASE_LOCALS
            pg8::Gemm g{(const bf16_t*)(p->ws + WS_MIX), (const bf16_t*)(p->ws + WS_WO + (size_t)l * DM * DM * (FP8_WOUT ? 1 : 2)), SEQ, DM, FP8_WOUT ? DM / 2 : DM};
            pg8::StaticOrder S; S.init(SEQ, DM, G, c);
            pg8::EpiResAdd E{(bf16_t*)(p->ws + WS_OUTB), 1.f, (unsigned*)(p->ws + WS_CTL) + CW_WOC + l * 32 * 64, p->ws + WS_OUTB8};
            pg8::gemm_phase<pg8::EpiResAdd, pg8::StaticOrder>(lds, g, S, E, wv);
        }
        if (PK(5) && IN(pb + 4)) { PHASE_LOCALS phase_route(p, l, lds, wv, l); if (DUP_PHASE == 5) { xcd_barrier(bar); phase_route(p, l, lds, wv, l + 4); } SEAM(pb + 4); }
        if (PK(6) && IN(pb + 5)) { PHASE_LOCALS
            moe_table(p, l, mtbl, wv);
            pg8::Gemm g{(const bf16_t*)(p->ws + WS_OUTB8), (const bf16_t*)(p->ws + WS_WGU + (size_t)l * NEXP * 1024 * DM), MOE_ROWS, NEXP * 1024, DM / 2};
            pg8::MoeOrder<4, true> S{mtbl, (const int*)(p->ws + WS_TOK), G, c, DM / 2};
            pg8::EpiGU E{p->ws + WS_ACT, (const float*)(p->ws + WS_GATE), mtbl, (unsigned*)(p->ws + WS_CTL) + CW_GUC + l * 80 * 64};
            for (int rep = 0; rep < (DUP_PHASE == 6 ? 2 : 1); ++rep)
            pg8::gemm_phase<pg8::EpiGU, pg8::MoeOrder<4, true>>(lds, g, S, E, wv);
        }
        if (PK(7) && IN(pb + 6)) { PHASE_LOCALS
            moe_table(p, l, mtbl, wv);
            pg8::Gemm g{(const bf16_t*)(p->ws + WS_ACT), (const bf16_t*)(p->ws + WS_WD + (size_t)l * NEXP * DM * FEXP), MOE_ROWS, NEXP * DM, FEXP / 2};
            pg8::DownOrder S{mtbl, (unsigned*)(p->ws + WS_CTL) + CW_GUC + l * 80 * 64, (unsigned*)(p->ws + WS_CTL) + CW_BAR + XB_TMO, G, c};
            pg8::EpiDown E{p->ws + WS_Y};
            pg8::gemm_phase<pg8::EpiDown, pg8::DownOrder>(lds, g, S, E, wv);
            SEAM(pb + 6);
        }
    }
    if (PK(1) && IN(N_PHASES - 1)) { PHASE_LOCALS phase_norm1(p, DEPTH, lds, wv); }
#undef IN
#undef SEAM
#undef PHASE_LOCALS
#undef p
}

extern "C" void kernel_launch(void* const* d_in, const int* in_sizes, int n_in, void* d_out, int out_size, void* d_ws, size_t ws_size, hipStream_t stream) {
    static int grid = 0;
    if (grid == 0) {
        if (n_in != 22 || in_sizes[0] != SEQ * DM || out_size != SEQ * DM || ws_size < WS_END) {
            fprintf(stderr, "kernel_launch: unexpected shapes (n_in %d, in0 %d, out %d, ws %zu < %zu); nothing launched\n", n_in, n_in > 0 ? in_sizes[0] : -1, out_size, ws_size, (size_t)WS_END); grid = -1; return; }
        int dev = 0, cus = 0, per_cu = 0;
        if (hipGetDevice(&dev) != hipSuccess || hipDeviceGetAttribute(&cus, hipDeviceAttributeMultiprocessorCount, dev) != hipSuccess) { grid = -1; return; }
        if (hipFuncSetAttribute((const void*)trunk_fwd, hipFuncAttributeMaxDynamicSharedMemorySize, LDS_BYTES) != hipSuccess) { fprintf(stderr, "kernel_launch: hipFuncSetAttribute failed\n"); grid = -1; return; }
        if (hipOccupancyMaxActiveBlocksPerMultiprocessor(&per_cu, (const void*)trunk_fwd, 512, LDS_BYTES) != hipSuccess || per_cu < 1)
            fprintf(stderr, "kernel_launch: note: occupancy query reports %d workgroups per CU\n", per_cu);
        (void)hipGetLastError();
        grid = cus;
    }
    if (grid < 0) return;
    if (hipMemsetAsync((char*)d_ws + WS_CTL, 0, CTL_ZERO_BYTES, stream) != hipSuccess) { fprintf(stderr, "kernel_launch: memset failed\n"); return; }
    Params hp{};
    const float** pp = (const float**)&hp;
    for (int i = 0; i < 22; ++i) pp[i] = (const float*)d_in[i];
    hp.out = (float*)d_out; hp.ws = (unsigned char*)d_ws;
#if MK_ONE_LAUNCH
    hp.ph_lo = 0; hp.ph_hi = N_PHASES;
    hipLaunchKernelGGL(trunk_fwd, dim3(grid), dim3(512), LDS_BYTES, stream, hp);
#else
    for (int ph = 0; ph < N_PHASES; ++ph) { hp.ph_lo = ph; hp.ph_hi = ph + 1; hipLaunchKernelGGL(trunk_fwd, dim3(grid), dim3(512), LDS_BYTES, stream, hp); }
#endif
    const hipError_t le = hipPeekAtLastError();
    if (le != hipSuccess) fprintf(stderr, "kernel_launch: launch failed: %s\n", hipGetErrorName(le));
}
```

```cpp
#include <hip/hip_runtime.h>
#include <cstdio>
#include <cstdint>

#ifndef MK_ONE_LAUNCH
#define MK_ONE_LAUNCH 1
#endif
#ifndef PHASE_MASK
#define PHASE_MASK 0xff
#endif
#define PK(k) (((PHASE_MASK) >> (k)) & 1)
#ifndef FP8_PROJ
#define FP8_PROJ 1
#endif
#ifndef FP8_WOUT
#define FP8_WOUT 1
#endif
#ifndef DUP_PHASE
#define DUP_PHASE -1
#endif
#ifndef ATT_MASK2
#define ATT_MASK2 7
#endif
#ifndef SKIP_A
#define SKIP_A 1
#endif
#ifndef SKIP_B
#define SKIP_B 3
#endif
#ifndef SKIP_C
#define SKIP_C 1
#endif

#define GAS __attribute__((address_space(1)))
#define LAS __attribute__((address_space(3)))
typedef unsigned short bf16_t;
typedef short bf16x8 __attribute__((ext_vector_type(8)));
typedef float f32x4 __attribute__((ext_vector_type(4)));
typedef float f32x16 __attribute__((ext_vector_type(16)));
typedef unsigned u32x4 __attribute__((ext_vector_type(4)));
typedef unsigned u32x2 __attribute__((ext_vector_type(2)));
typedef int i32x4 __attribute__((ext_vector_type(4)));

constexpr int SEQ = 8192, DM = 2048, DEPTH = 4, NQK = 4096, NV = 2048, NEXP = 16, FEXP = 512, NIN = 6149;
constexpr int HD = 128, H_DIFF = 6, H_SB = 5, H_FOX = 5;
constexpr float EPS = 1e-6f;
constexpr float LOG2E = 1.4426950408889634f;
constexpr int MOE_ROWS = 16384 + 16 * 256;

constexpr size_t MiB = 1u << 20;
constexpr size_t WS_CTL = 0, CTL_ZERO_BYTES = 1 * MiB;
constexpr size_t WS_WF = 1 * MiB;
constexpr size_t WS_LAM = 1 * MiB + 512 * 1024;
constexpr size_t WS_LOGF = 2 * MiB;
constexpr size_t WS_DC2 = 3 * MiB;
constexpr size_t WS_TOK = 4 * MiB;
constexpr size_t WS_GATE = 5 * MiB;
constexpr size_t WS_TSEL = 6 * MiB;
constexpr size_t WS_WRT = 7 * MiB;
constexpr size_t WS_RSTD = 8 * MiB;
constexpr size_t WS_WQK = 16 * MiB;
constexpr size_t WS_WV = 80 * MiB;
constexpr size_t WS_WO = 112 * MiB;
constexpr size_t WS_WGU = 144 * MiB;
constexpr size_t WS_WD = 400 * MiB;
constexpr size_t WS_XN = 528 * MiB;
constexpr size_t WS_QKB = 560 * MiB;
constexpr size_t WS_VT = 624 * MiB;
constexpr size_t WS_MIX = 656 * MiB;
constexpr size_t WS_ACT = 688 * MiB;
constexpr size_t WS_Y = 708 * MiB;
constexpr size_t WS_PART = 788 * MiB;
constexpr size_t WS_OUTB = 828 * MiB;
constexpr size_t WS_OUTB8 = 862 * MiB;
constexpr size_t WS_QKB8 = 878 * MiB;
constexpr size_t WS_END = 910 * MiB;
constexpr int CW_BAR = 4096;
constexpr int CW_ATTQ = 16384;
constexpr int CW_CNT = 32768;
constexpr int CW_AFLAG = 65536;
constexpr int CW_WOC = 233472;
constexpr int CW_GUC = 212992;

constexpr int RING_BYTES = 131072;
constexpr int TBL_OFF = RING_BYTES;
constexpr int MISC_OFF = RING_BYTES + 8192;
constexpr int LDS_BYTES = 147456;

typedef float f32x2_t __attribute__((ext_vector_type(2)));
typedef __bf16 bf16x2_t __attribute__((ext_vector_type(2)));
typedef int i32x8 __attribute__((ext_vector_type(8)));
__device__ __forceinline__ unsigned cvt4f8(float a, float b, float c, float d) {
    int w = 0; w = __builtin_amdgcn_cvt_pk_fp8_f32(a, b, w, false); w = __builtin_amdgcn_cvt_pk_fp8_f32(c, d, w, true); return (unsigned)w; }
constexpr float W8_SCALE = 256.f, ACT8_SCALE = 4.f, Y8_SCALE = 32.f;
__device__ __forceinline__ unsigned cvtpk(float lo, float hi) { const f32x2_t v = {lo, hi}; const bf16x2_t b = __builtin_convertvector(v, bf16x2_t); return __builtin_bit_cast(unsigned, b); }
__device__ __forceinline__ float bf_lo(unsigned u) { return __uint_as_float(u << 16); }
__device__ __forceinline__ float bf_hi(unsigned u) { return __uint_as_float(u & 0xffff0000u); }
__device__ __forceinline__ float fexp2(float x) { return __builtin_amdgcn_exp2f(x); }
__device__ __forceinline__ float flog2(float x) { return __builtin_amdgcn_logf(x); }
__device__ __forceinline__ int otid(int wv) { int t; asm volatile("v_mbcnt_lo_u32_b32 %0, -1, 0\n\tv_mbcnt_hi_u32_b32 %0, -1, %0" : "=v"(t)); return wv * 64 + t; }
template <int M> __device__ __forceinline__ float swz_xor(float v) { return __int_as_float(__builtin_amdgcn_ds_swizzle(__float_as_int(v), 0x1F | (M << 10))); }
__device__ __forceinline__ float sum_xor32(float v) { auto rr = __builtin_amdgcn_permlane32_swap(__float_as_uint(v), __float_as_uint(v), false, false); return __uint_as_float(rr[0]) + __uint_as_float(rr[1]); }
__device__ __forceinline__ float wave_sum(float v) {
    v += swz_xor<1>(v); v += swz_xor<2>(v); v += swz_xor<4>(v); v += swz_xor<8>(v); v += swz_xor<16>(v);
    return sum_xor32(v);
}

namespace pg8 {
constexpr int BM = 256, BK = 64, HALF = 128, HTB = HALF * BK * 2, STAGE_BYTES = 8 * HTB, NXCD = 8, WGM = 8;
__host__ __device__ __forceinline__ int lds_byte(int r, int c) { const int st = (r >> 4) * 2 + (c >> 5), rr = r & 15, cc = c & 31, ob = rr * 64 + cc * 2; return st * 1024 + (ob ^ (((ob >> 9) & 1) << 5)); }
__host__ __device__ __forceinline__ void stage_rc(int b, int& R, int& C) { const int st = b / 1024, sb = b % 1024, swz = sb ^ (((sb >> 9) & 1) << 5); R = (st >> 1) * 16 + swz / 64; C = (st & 1) * 32 + (swz % 64) / 2; }
__host__ __device__ __forceinline__ int perm32(int rho) { const int n = rho >> 4, i = rho & 15; return 8 * (i >> 2) + 4 * n + (i & 3); }
__host__ __device__ __forceinline__ int permV(int rho) { const int n = rho >> 4, i = rho & 15; return 16 * (i >> 3) + 8 * n + (i & 7); }
template <int P> __host__ __device__ __forceinline__ int permf(int rho) { return P == 1 ? perm32(rho) : (P == 2 ? permV(rho) : rho); }

struct Unit { int pm, pn, e, rt; };
struct Gemm { const bf16_t* A; const bf16_t* Bt; int M, N, K; };

struct StaticOrder {
    int nM, nN, nwg, G, c;
    __device__ void init(int M, int N, int G_, int c_) { nM = M / BM; nN = N / BM; nwg = nM * nN; G = G_; c = c_; }
    __device__ bool next(int i, Unit& u) const {
        const long L = (long)i * G + c; if (L >= nwg) return false;
        int wgid = (int)L; { const int q = nwg / NXCD, r = nwg % NXCD, xcd = wgid % NXCD, off = wgid / NXCD; wgid = (xcd < r ? xcd * (q + 1) : r * (q + 1) + (xcd - r) * q) + off; }
        const int nig = WGM * nN, gid = wgid / nig, fm = gid * WGM, gsz = (nM - fm) < WGM ? (nM - fm) : WGM;
        u.pm = fm + ((wgid % nig) % gsz); u.pn = (wgid % nig) / gsz; u.e = 0; u.rt = 0; return true;
    }
    __device__ __forceinline__ size_t a_base(const Unit& u, size_t tstep) const { return (size_t)u.pm * tstep; }
    __device__ __forceinline__ unsigned row_off(const Unit&, int r, int K) const { return (unsigned)(r * K) * 2u; }
    __device__ __forceinline__ void a_ready(const Unit&, int) const {}
};

template <int NCT, bool GATHER> struct MoeOrder {
    const LAS int* tbl; const int* tok; int G, c, K;
    __device__ bool next(int i, Unit& u) const {
        const int L = i * G + c, total = __builtin_amdgcn_readfirstlane(tbl[16]) * NCT; if (L >= total) return false;
        const int g = L / NCT, ct = L % NCT; int e = 0;
#pragma unroll
        for (int k = 1; k < 16; ++k) e += (g >= tbl[k]) ? 1 : 0;
        e = __builtin_amdgcn_readfirstlane(e);
        u.pm = g; u.pn = e * NCT + ct; u.e = e; u.rt = __builtin_amdgcn_readfirstlane(g - tbl[e]); return true;
    }
    __device__ __forceinline__ size_t a_base(const Unit& u, size_t tstep) const { return GATHER ? 0 : (size_t)u.pm * tstep; }
    __device__ __forceinline__ unsigned row_off(const Unit& u, int r, int K_) const {
        if (!GATHER) return (unsigned)(r * K_) * 2u;
        const int pos = u.rt * 256 + r; const int n = __builtin_amdgcn_readfirstlane(tbl[17 + u.e]);
        const int t = pos < n ? tok[u.e * SEQ + pos] : 0;
        return (unsigned)(t * K_) * 2u;
    }
    __device__ __forceinline__ void a_ready(const Unit&, int) const {}
};

struct DownOrder {
    const LAS int* tbl; unsigned* cnt; unsigned* tmo; int G, c;
    __device__ bool next(int i, Unit& u) const {
        const int T = __builtin_amdgcn_readfirstlane(tbl[16]);
        const int U1 = 4 * T, nb2 = U1 > G ? U1 - G : 0, F = G - nb2;
        const int g1 = T < (G >> 2) ? T : (G >> 2), E = 8 * g1, Lt = 8 * (T - g1);
        int k = -1, late = 0;
        int ii = i;
        if (c >= nb2) { const int cf = c - nb2; const int nE = E > cf ? (E - cf + F - 1) / F : 0; if (ii < nE) k = cf + ii * F; else ii -= nE; }
        int g, ct;
        if (k >= 0) { g = k >> 3; ct = k & 7; }
        else { const int k0 = (c - nb2 + G) % G; const int kk = k0 + ii * G; if (kk >= Lt) return false; g = g1 + (kk >> 3); ct = kk & 7; late = 1; }
        (void)late;
        int e = 0;
#pragma unroll
        for (int q = 1; q < 16; ++q) e += (g >= tbl[q]) ? 1 : 0;
        e = __builtin_amdgcn_readfirstlane(e);
        u.pm = g; u.pn = e * 8 + ct; u.e = e; u.rt = __builtin_amdgcn_readfirstlane(g - tbl[e]); return true;
    }
    __device__ __forceinline__ size_t a_base(const Unit& u, size_t tstep) const { return (size_t)u.pm * tstep; }
    __device__ __forceinline__ unsigned row_off(const Unit&, int r, int K_) const { return (unsigned)(r * K_) * 2u; }
    __device__ __forceinline__ void a_ready(const Unit& u, int wid) const {
        if (wid == 0) {
            unsigned sp = 0;
            while ((unsigned)__builtin_amdgcn_readfirstlane((int)__hip_atomic_load(cnt + 64 * u.pm, __ATOMIC_RELAXED, __HIP_MEMORY_SCOPE_AGENT)) < 32u) {
                __builtin_amdgcn_s_sleep(2);
                if (++sp > (1u << 22)) { __hip_atomic_store(tmo, 1u, __ATOMIC_RELAXED, __HIP_MEMORY_SCOPE_AGENT); break; }
            }
            __builtin_amdgcn_fence(__ATOMIC_ACQUIRE, "agent");
            asm volatile("s_waitcnt vmcnt(0)" ::: "memory");
        }
        asm volatile("" ::: "memory"); __builtin_amdgcn_s_barrier(); asm volatile("" ::: "memory");
    }
};

template <class Epi, class Sched, bool SP2 = true>
__device__ __forceinline__ void gemm_phase(LAS unsigned char* lds, const Gemm g, const Sched& S, const Epi& E, int wv) {
    const int tid = otid(wv), wid = __builtin_amdgcn_readfirstlane(tid >> 6), lane = tid & 63, wr = wid >> 2, wc = wid & 3, fr = lane & 15, fq = lane >> 4;
    const int K = g.K, nt = K / BK;
    unsigned voffB[2]; int Rr[2], Cc[2];
#pragma unroll
    for (int i = 0; i < 2; ++i) { int R, C; stage_rc(tid * 16 + i * 8192, R, C); const int Rb = (R & ~31) + permf<Epi::PERM>(R & 31);
        Rr[i] = R; Cc[i] = C; voffB[i] = (unsigned)(Rb * K + C) * 2u; }
    const size_t kstep = (size_t)(BK * 2);
    const size_t hstep = (size_t)HALF * K * 2;
    const size_t tstep = 2 * hstep;
    const unsigned ldsw = (unsigned)wid * 1024u;
    const int aoff = lds_byte(wr * 64 + fr, fq * 8), boff = lds_byte(wc * 32 + fr, fq * 8);
#define PG8_SA(b, h) (((b) * 2 + (h)) * HTB)
#define PG8_SB(b, h) ((4 + (b) * 2 + (h)) * HTB)
#define PG8_STAGE(bufoff, gbase, voff) do { _Pragma("unroll") for (int _i = 0; _i < 2; ++_i) \
        __builtin_amdgcn_global_load_lds((const unsigned*)((const char*)(gbase) + (voff)[_i]), (LAS unsigned*)(lds + (bufoff) + ldsw + _i * 8192), 16, 0, 0); } while (0)
#define PG8_LDA(dst, b, h) do { _Pragma("unroll") for (int m = 0; m < 4; ++m) _Pragma("unroll") for (int k = 0; k < 2; ++k) dst[m][k] = *(const LAS bf16x8*)(lds + PG8_SA(b, h) + aoff + m * 2048 + k * 1024); } while (0)
#define PG8_LDB(dst, b, h) do { _Pragma("unroll") for (int n = 0; n < 2; ++n) _Pragma("unroll") for (int k = 0; k < 2; ++k) dst[n][k] = *(const LAS bf16x8*)(lds + PG8_SB(b, h) + boff + n * 2048 + k * 1024); } while (0)
#define PG8_CAT(x) __builtin_shufflevector(__builtin_bit_cast(i32x4, (x)[0]), __builtin_bit_cast(i32x4, (x)[1]), 0, 1, 2, 3, 4, 5, 6, 7)
#define PG8_MMA(ai, bj, At, Bt) do { __builtin_amdgcn_s_setprio(1); \
        if constexpr (Epi::FP8) { _Pragma("unroll") for (int m = 0; m < 4; ++m) _Pragma("unroll") for (int n = 0; n < 2; ++n) \
            asm volatile("v_mfma_scale_f32_16x16x128_f8f6f4 %0, %1, %2, %0, %3, %3 op_sel_hi:[0,0,0]" : "+v"(acc[ai][bj][m][n]) : "v"(PG8_CAT(Bt[n])), "v"(PG8_CAT(At[m])), "v"(one8)); } \
        else { _Pragma("unroll") for (int m = 0; m < 4; ++m) _Pragma("unroll") for (int n = 0; n < 2; ++n) _Pragma("unroll") for (int k = 0; k < 2; ++k) \
            acc[ai][bj][m][n] = __builtin_amdgcn_mfma_f32_16x16x32_bf16(Bt[n][k], At[m][k], acc[ai][bj][m][n], 0, 0, 0); } \
        __builtin_amdgcn_s_setprio(0); } while (0)
#define PG8_WAIT_V(n) asm volatile("s_waitcnt vmcnt(" #n ")" ::: "memory")
#define PG8_WAIT_L(n) asm volatile("s_waitcnt lgkmcnt(" #n ")" ::: "memory")
#define PG8_BAR __builtin_amdgcn_s_barrier()
#define PG8_SCHED __builtin_amdgcn_sched_barrier(0)
    Unit cur, nxt; int ui = 0;
    if (!S.next(0, cur)) return;
    const unsigned one8 = 0x7F7F7F7Fu;
    (void)one8;
    f32x4 acc[2][2][4][2];
    if constexpr (Epi::LOAD_INIT) E.init(acc, cur, wr, wc, fr, fq);
    else {
#pragma unroll
    for (int a = 0; a < 2; ++a)
#pragma unroll
        for (int b = 0; b < 2; ++b)
#pragma unroll
            for (int m = 0; m < 4; ++m)
#pragma unroll
                for (int n = 0; n < 2; ++n) acc[a][b][m][n] = (f32x4){0.f, 0.f, 0.f, 0.f};
    }
    bf16x8 At[4][2], B0[2][2], B1[2][2];
    unsigned oc[2][2], on[2][2];
#pragma unroll
    for (int h = 0; h < 2; ++h)
#pragma unroll
        for (int i = 0; i < 2; ++i) { oc[h][i] = S.row_off(cur, h * HALF + Rr[i], K) + (unsigned)Cc[i] * 2u; on[h][i] = oc[h][i]; }
    const char* cA = (const char*)g.A + S.a_base(cur, tstep); const char* cB = (const char*)g.Bt + (size_t)cur.pn * tstep;
    S.a_ready(cur, wid);
    if constexpr (SP2) {
        PG8_STAGE(PG8_SB(0, 0), cB, voffB); PG8_STAGE(PG8_SB(0, 1), cB + hstep, voffB); PG8_STAGE(PG8_SA(0, 0), cA, oc[0]); PG8_STAGE(PG8_SA(0, 1), cA, oc[1]);
        if (wr == 1) PG8_BAR;
        PG8_WAIT_V(2); PG8_BAR;
        PG8_STAGE(PG8_SB(1, 0), cB + kstep, voffB); PG8_STAGE(PG8_SA(1, 0), cA + kstep, oc[0]); PG8_STAGE(PG8_SB(1, 1), cB + hstep + kstep, voffB);
        PG8_WAIT_V(6); PG8_BAR;
    } else {
        PG8_STAGE(PG8_SB(0, 0), cB, voffB); PG8_STAGE(PG8_SA(0, 0), cA, oc[0]); PG8_STAGE(PG8_SB(0, 1), cB + hstep, voffB); PG8_STAGE(PG8_SA(0, 1), cA, oc[1]);
        if (wr == 1) PG8_BAR;
        PG8_WAIT_V(4); PG8_BAR;
        PG8_STAGE(PG8_SB(1, 0), cB + kstep, voffB); PG8_STAGE(PG8_SA(1, 0), cA + kstep, oc[0]); PG8_STAGE(PG8_SB(1, 1), cB + hstep + kstep, voffB);
        PG8_WAIT_V(6); PG8_BAR;
    }
    for (;;) {
        const bool has_next = S.next(ui + 1, nxt);
        const char* nA = has_next ? (const char*)g.A + S.a_base(nxt, tstep) : cA; const char* nB = has_next ? (const char*)g.Bt + (size_t)nxt.pn * tstep : cB;
        if (has_next) {
#pragma unroll
            for (int h = 0; h < 2; ++h)
#pragma unroll
                for (int i = 0; i < 2; ++i) on[h][i] = S.row_off(nxt, h * HALF + Rr[i], K) + (unsigned)Cc[i] * 2u;
        }
        for (int t = 0; t < nt; t += 2) {
            const bool last = (t == nt - 2);
            if (last && has_next) S.a_ready(nxt, wid);
            const char* a1 = cA + (size_t)(t + 1) * kstep;
            const char* a2 = last ? nA : cA + (size_t)(t + 2) * kstep; const char* b2 = last ? nB : cB + (size_t)(t + 2) * kstep;
            const char* a3 = a2 + kstep; const char* b3 = b2 + kstep;
            unsigned o2a[2], o2b[2];
            o2a[0] = last ? on[0][0] : oc[0][0]; o2a[1] = last ? on[0][1] : oc[0][1]; o2b[0] = last ? on[1][0] : oc[1][0]; o2b[1] = last ? on[1][1] : oc[1][1];
            if constexpr (SP2) {
            PG8_LDB(B0, 0, 0); PG8_LDB(B1, 0, 1); PG8_SCHED; PG8_LDA(At, 0, 0); PG8_STAGE(PG8_SA(1, 1), a1, oc[1]);
            PG8_WAIT_V(8); PG8_WAIT_L(0); PG8_BAR; PG8_MMA(0, 0, At, B0); PG8_MMA(0, 1, At, B1); PG8_BAR; PG8_SCHED;
            PG8_LDA(At, 0, 1); PG8_STAGE(PG8_SB(0, 0), b2, voffB); PG8_STAGE(PG8_SB(0, 1), b2 + hstep, voffB); PG8_STAGE(PG8_SA(0, 0), a2, o2a);
            PG8_WAIT_V(8); PG8_WAIT_L(0); PG8_BAR; PG8_MMA(1, 0, At, B0); PG8_MMA(1, 1, At, B1); PG8_BAR; PG8_SCHED;
            PG8_LDB(B0, 1, 0); PG8_LDB(B1, 1, 1); PG8_SCHED; PG8_LDA(At, 1, 0); PG8_STAGE(PG8_SA(0, 1), a2, o2b);
            PG8_WAIT_V(8); PG8_WAIT_L(0); PG8_BAR; PG8_MMA(0, 0, At, B0); PG8_MMA(0, 1, At, B1); PG8_BAR; PG8_SCHED;
            PG8_LDA(At, 1, 1); PG8_STAGE(PG8_SB(1, 0), b3, voffB); PG8_STAGE(PG8_SB(1, 1), b3 + hstep, voffB); PG8_STAGE(PG8_SA(1, 0), a3, o2a);
            PG8_WAIT_V(8); PG8_WAIT_L(0); PG8_BAR; PG8_MMA(1, 0, At, B0); PG8_MMA(1, 1, At, B1); PG8_BAR; PG8_SCHED;
            } else {
            PG8_LDB(B0, 0, 0); PG8_SCHED; PG8_LDA(At, 0, 0); PG8_STAGE(PG8_SA(1, 1), a1, oc[1]);
            PG8_WAIT_L(8); PG8_BAR; PG8_WAIT_L(0); PG8_MMA(0, 0, At, B0); PG8_BAR; PG8_SCHED;
            PG8_LDB(B1, 0, 1); PG8_STAGE(PG8_SB(0, 0), b2, voffB);
            PG8_BAR; PG8_WAIT_L(0); PG8_MMA(0, 1, At, B1); PG8_BAR;
            PG8_LDA(At, 0, 1); PG8_STAGE(PG8_SA(0, 0), a2, o2a);
            PG8_BAR; PG8_WAIT_L(0); PG8_MMA(1, 0, At, B0); PG8_BAR; PG8_SCHED;
            PG8_STAGE(PG8_SB(0, 1), b2 + hstep, voffB);
            PG8_WAIT_V(6); PG8_BAR; PG8_MMA(1, 1, At, B1); PG8_BAR;
            PG8_LDB(B0, 1, 0); PG8_SCHED; PG8_LDA(At, 1, 0); PG8_STAGE(PG8_SA(0, 1), a2, o2b);
            PG8_WAIT_L(8); PG8_BAR; PG8_WAIT_L(0); PG8_MMA(0, 0, At, B0); PG8_BAR; PG8_SCHED;
            PG8_LDB(B1, 1, 1); PG8_STAGE(PG8_SB(1, 0), b3, voffB);
            PG8_BAR; PG8_WAIT_L(0); PG8_MMA(0, 1, At, B1); PG8_BAR;
            PG8_LDA(At, 1, 1); PG8_STAGE(PG8_SA(1, 0), a3, o2a);
            PG8_BAR; PG8_WAIT_L(0); PG8_MMA(1, 0, At, B0); PG8_BAR; PG8_SCHED;
            PG8_STAGE(PG8_SB(1, 1), b3 + hstep, voffB);
            PG8_WAIT_V(6); PG8_BAR; PG8_MMA(1, 1, At, B1); PG8_BAR;
            }
        }
        if (wr == 0) PG8_BAR;
        if constexpr (Epi::FP8) asm volatile("s_nop 15\n\ts_nop 15" ::: "memory");
        { const int tz = otid(wv) & 63; E(acc, cur, wr, wc, tz & 15, tz >> 4); }
        if (!has_next) break;
#pragma unroll
        for (int a = 0; a < 2; ++a)
#pragma unroll
            for (int b = 0; b < 2; ++b)
#pragma unroll
                for (int m = 0; m < 4; ++m)
#pragma unroll
                    for (int n = 0; n < 2; ++n) acc[a][b][m][n] = (f32x4){0.f, 0.f, 0.f, 0.f};
        if constexpr (Epi::LOAD_INIT) { const int tz2 = otid(wv) & 63; E.init(acc, nxt, wr, wc, tz2 & 15, tz2 >> 4); }
        cur = nxt; cA = nA; cB = nB; ++ui;
#pragma unroll
        for (int h = 0; h < 2; ++h)
#pragma unroll
            for (int i = 0; i < 2; ++i) oc[h][i] = on[h][i];
        if (wr == 1) PG8_BAR;
    }
    PG8_WAIT_V(0);
    PG8_BAR;
#undef PG8_SA
#undef PG8_SB
#undef PG8_STAGE
#undef PG8_LDA
#undef PG8_LDB
#undef PG8_MMA
#undef PG8_CAT
#undef PG8_WAIT_V
#undef PG8_WAIT_L
#undef PG8_BAR
#undef PG8_SCHED
}


struct EpiQK {
    static constexpr int PERM = 1; static constexpr bool LOAD_INIT = false; static constexpr bool FP8 = (FP8_PROJ != 0);
    bf16_t* O; const float *gqd, *gkd, *gqf, *gkf; LAS float* tbl; const float* rstd; unsigned char* O8;
    __device__ __forceinline__ void operator()(const f32x4 (&acc)[2][2][4][2], const Unit& u, int wr, int wc, int fr, int fq) const {
#pragma unroll
        for (int ai = 0; ai < 2; ++ai)
#pragma unroll
            for (int m = 0; m < 4; ++m)
#pragma unroll
                for (int bj = 0; bj < 2; ++bj) {
                    const f32x4 a = acc[ai][bj][m][0], b = acc[ai][bj][m][1];
                    float ss = (a[0] * a[0] + a[1] * a[1]) + (a[2] * a[2] + a[3] * a[3]) + (b[0] * b[0] + b[1] * b[1]) + (b[2] * b[2] + b[3] * b[3]);
                    ss += swz_xor<16>(ss); ss = sum_xor32(ss);
                    if (fq == 0) tbl[(bj * 256 + ai * 128 + wr * 64 + m * 16 + fr) * 4 + wc] = FP8 ? ss * (1.f / (W8_SCALE * W8_SCALE)) : ss;
                }
        asm volatile("s_waitcnt lgkmcnt(0)" ::: "memory"); __builtin_amdgcn_s_barrier(); asm volatile("" ::: "memory");
        const int colh = wc * 32 + fq * 8;
#pragma unroll
        for (int bj = 0; bj < 2; ++bj) {
            const int hh = u.pn * 2 + bj;
            int mode; const float* gp; float extra;
            if (hh < 6) { mode = 0; gp = gqd + (colh & 63); extra = 0.125f * LOG2E * 4.f; }
            else if (hh < 12) { mode = 0; gp = gkd + (colh & 63); extra = 0.25f; }
            else if (hh < 17) { mode = 1; gp = gqf + colh; extra = 0.08838834764831845f * LOG2E * 4.f; }
            else if (hh < 22) { mode = 1; gp = gkf + colh; extra = 0.25f; }
            else if (hh < 27) { mode = 2; gp = gqd; extra = 0.08838834764831845f * LOG2E; }
            else { mode = 2; gp = gqd; extra = 1.f; }
            f32x4 g0 = (f32x4){1.f, 1.f, 1.f, 1.f}, g1 = g0;
            if (mode != 2) { g0 = *(const f32x4*)gp; g1 = *(const f32x4*)(gp + 4); }
            g0 = g0 * (FP8 ? extra * (1.f / W8_SCALE) : extra); g1 = g1 * (FP8 ? extra * (1.f / W8_SCALE) : extra);
#pragma unroll
            for (int ai = 0; ai < 2; ++ai)
#pragma unroll
                for (int m = 0; m < 4; ++m) {
                    const int rl = ai * 128 + wr * 64 + m * 16 + fr;
                    const float rr = rstd[u.pm * 256 + rl];
                    float rs = rr;
                    if (mode != 2) {
                        const f32x4 t = *(const LAS f32x4*)(tbl + (bj * 256 + rl) * 4);
                        const float tot = (mode == 0) ? ((wc < 2) ? (t[0] + t[1]) : (t[2] + t[3])) : ((t[0] + t[1]) + (t[2] + t[3]));
                        rs = rr * __builtin_amdgcn_rsqf(rr * rr * tot * (mode == 0 ? (1.f / 64.f) : (1.f / 128.f)) + EPS);
                    }
                    const f32x4 v0 = acc[ai][bj][m][0] * g0 * rs, v1 = acc[ai][bj][m][1] * g1 * rs;
                    if (mode != 2) { u32x2 w8; w8.x = cvt4f8(v0[0], v0[1], v0[2], v0[3]); w8.y = cvt4f8(v1[0], v1[1], v1[2], v1[3]);
                        *(u32x2*)(O8 + (size_t)(u.pm * 256 + rl) * NQK + u.pn * 256 + bj * 128 + colh) = w8; continue; }
                    u32x4 w; w.x = cvtpk(v0[0], v0[1]); w.y = cvtpk(v0[2], v0[3]); w.z = cvtpk(v1[0], v1[1]); w.w = cvtpk(v1[2], v1[3]);
                    *(u32x4*)(O + (size_t)(u.pm * 256 + rl) * NQK + u.pn * 256 + bj * 128 + colh) = w;
                }
        }
    }
};
struct EpiVT {
    static constexpr int PERM = 2; static constexpr bool LOAD_INIT = false; static constexpr bool FP8 = (FP8_PROJ != 0);
    bf16_t* O; int ldc; const float* rstd;
    __device__ __forceinline__ void operator()(const f32x4 (&acc)[2][2][4][2], const Unit& u, int wr, int wc, int fr, int fq) const {
        f32x4 r0[2], r1[2];
#pragma unroll
        for (int bj = 0; bj < 2; ++bj) { const float* rp = rstd + u.pn * 256 + bj * 128 + wc * 32 + 16 * (fq >> 1) + 4 * (fq & 1);
            r0[bj] = *(const f32x4*)rp; r1[bj] = *(const f32x4*)(rp + 8); if (FP8) { r0[bj] = r0[bj] * (1.f / W8_SCALE); r1[bj] = r1[bj] * (1.f / W8_SCALE); } }
#pragma unroll
        for (int ai = 0; ai < 2; ++ai)
#pragma unroll
            for (int m = 0; m < 4; ++m)
#pragma unroll
                for (int bj = 0; bj < 2; ++bj) {
                    const f32x4 v0 = acc[ai][bj][m][0] * r0[bj], v1 = acc[ai][bj][m][1] * r1[bj];
                    u32x4 w; w.x = cvtpk(v0[0], v0[1]); w.y = cvtpk(v0[2], v0[3]); w.z = cvtpk(v1[0], v1[1]); w.w = cvtpk(v1[2], v1[3]);
                    *(u32x4*)(O + (size_t)(u.pm * 256 + ai * 128 + wr * 64 + m * 16 + fr) * ldc + u.pn * 256 + bj * 128 + wc * 32 + fq * 8) = w;
                }
    }
};
struct EpiResAdd {
    static constexpr int PERM = 1; static constexpr bool LOAD_INIT = true; static constexpr bool FP8 = (FP8_WOUT != 0);
    bf16_t* X; float sc; unsigned* done; unsigned char* X8;
    __device__ __forceinline__ void init(f32x4 (&acc)[2][2][4][2], const Unit& u, int wr, int wc, int fr, int fq) const {
#pragma unroll
        for (int ai = 0; ai < 2; ++ai)
#pragma unroll
            for (int m = 0; m < 4; ++m)
#pragma unroll
                for (int bj = 0; bj < 2; ++bj) {
                    const u32x4 w = *(const u32x4*)(X + (size_t)(u.pm * 256 + ai * 128 + wr * 64 + m * 16 + fr) * DM + u.pn * 256 + bj * 128 + wc * 32 + fq * 8);
                    acc[ai][bj][m][0] = (f32x4){bf_lo(w.x), bf_hi(w.x), bf_lo(w.y), bf_hi(w.y)};
                    acc[ai][bj][m][1] = (f32x4){bf_lo(w.z), bf_hi(w.z), bf_lo(w.w), bf_hi(w.w)};
                    if (FP8) { acc[ai][bj][m][0] = acc[ai][bj][m][0] * W8_SCALE; acc[ai][bj][m][1] = acc[ai][bj][m][1] * W8_SCALE; }
                }
    }
    __device__ __forceinline__ void operator()(const f32x4 (&acc)[2][2][4][2], const Unit& u, int wr, int wc, int fr, int fq) const {
        const __amdgpu_buffer_rsrc_t rsrc = __builtin_amdgcn_make_buffer_rsrc((void*)X, 0, SEQ * DM * 2, 0x00020000);
        const __amdgpu_buffer_rsrc_t rsrc8 = __builtin_amdgcn_make_buffer_rsrc((void*)X8, 0, SEQ * DM, 0x00020000);
#pragma unroll
        for (int ai = 0; ai < 2; ++ai)
#pragma unroll
            for (int m = 0; m < 4; ++m)
#pragma unroll
                for (int bj = 0; bj < 2; ++bj) {
                    const f32x4 v0 = FP8 ? acc[ai][bj][m][0] * (1.f / W8_SCALE) : acc[ai][bj][m][0], v1 = FP8 ? acc[ai][bj][m][1] * (1.f / W8_SCALE) : acc[ai][bj][m][1];
                    u32x4 w; w.x = cvtpk(v0[0], v0[1]); w.y = cvtpk(v0[2], v0[3]); w.z = cvtpk(v1[0], v1[1]); w.w = cvtpk(v1[2], v1[3]);
                    u32x2 w8; w8.x = cvt4f8(v0[0], v0[1], v0[2], v0[3]); w8.y = cvt4f8(v1[0], v1[1], v1[2], v1[3]);
                    __builtin_amdgcn_raw_buffer_store_b64(w8, rsrc8, (int)((u.pm * 256 + ai * 128 + wr * 64 + m * 16 + fr) * DM + u.pn * 256 + bj * 128 + wc * 32 + fq * 8), 0, 16);
                    __builtin_amdgcn_raw_buffer_store_b128(w, rsrc, (int)(((u.pm * 256 + ai * 128 + wr * 64 + m * 16 + fr) * DM + u.pn * 256 + bj * 128 + wc * 32 + fq * 8) * 2), 0, 16);
                }
        asm volatile("s_waitcnt vmcnt(0)" ::: "memory");
        if (fr == 0 && fq == 0) __hip_atomic_fetch_add(done + 64 * u.pm, 1u, __ATOMIC_RELAXED, __HIP_MEMORY_SCOPE_AGENT);
    }
};
struct EpiGU {
    static constexpr int PERM = 1; static constexpr bool LOAD_INIT = false; static constexpr bool FP8 = true;
    unsigned char* ACT; const float* gate; const LAS int* tbl; unsigned* done;
    __device__ __forceinline__ void operator()(const f32x4 (&acc)[2][2][4][2], const Unit& u, int wr, int wc, int fr, int fq) const {
        const int ct = u.pn & 3, n_e = __builtin_amdgcn_readfirstlane(tbl[17 + u.e]);
        const __amdgpu_buffer_rsrc_t rsrc = __builtin_amdgcn_make_buffer_rsrc((void*)ACT, 0, MOE_ROWS * FEXP, 0x00020000);
#pragma unroll
        for (int ai = 0; ai < 2; ++ai)
#pragma unroll
            for (int m = 0; m < 4; ++m) {
                const int rl = ai * 128 + wr * 64 + m * 16 + fr, pos = u.rt * 256 + rl;
                f32x2_t gr2 = {0.f, 0.f}; if (pos < n_e) gr2 = *(const f32x2_t*)(gate + 2 * (u.e * SEQ + pos));
                const float gt = gr2[0] * ACT8_SCALE, rs = gr2[1] * (1.f / W8_SCALE);
                float o[8];
#pragma unroll
                for (int n = 0; n < 2; ++n)
#pragma unroll
                    for (int j = 0; j < 4; ++j) { const float gv = acc[ai][0][m][n][j] * rs, uv = acc[ai][1][m][n][j] * rs;
                        const float sg = gv * __builtin_amdgcn_rcpf(1.f + fexp2(-gv * LOG2E)); o[n * 4 + j] = sg * uv * gt; }
                u32x2 w; w.x = cvt4f8(o[0], o[1], o[2], o[3]); w.y = cvt4f8(o[4], o[5], o[6], o[7]);
                __builtin_amdgcn_raw_buffer_store_b64(w, rsrc, (int)((u.pm * 256 + rl) * FEXP + ct * 128 + wc * 32 + fq * 8), 0, 16);
            }
        asm volatile("s_waitcnt vmcnt(0)" ::: "memory");
        if (fr == 0 && fq == 0) __hip_atomic_fetch_add(done + 64 * u.pm, 1u, __ATOMIC_RELAXED, __HIP_MEMORY_SCOPE_AGENT);
    }
};
struct EpiDown {
    static constexpr int PERM = 1; static constexpr bool LOAD_INIT = false; static constexpr bool FP8 = true;
    unsigned char* Y;
    __device__ __forceinline__ void operator()(const f32x4 (&acc)[2][2][4][2], const Unit& u, int wr, int wc, int fr, int fq) const {
        const int ct = u.pn & 7;
#pragma unroll
        for (int ai = 0; ai < 2; ++ai)
#pragma unroll
            for (int m = 0; m < 4; ++m)
#pragma unroll
                for (int bj = 0; bj < 2; ++bj) {
                    const f32x4 v0 = acc[ai][bj][m][0] * (Y8_SCALE / (W8_SCALE * ACT8_SCALE)), v1 = acc[ai][bj][m][1] * (Y8_SCALE / (W8_SCALE * ACT8_SCALE));
                    u32x2 w; w.x = cvt4f8(v0[0], v0[1], v0[2], v0[3]); w.y = cvt4f8(v1[0], v1[1], v1[2], v1[3]);
                    *(u32x2*)(Y + (size_t)(u.pm * 256 + ai * 128 + wr * 64 + m * 16 + fr) * DM + ct * 256 + bj * 128 + wc * 32 + fq * 8) = w;
                }
    }
};
}

#define XB_TMO      128
#define XB_XCNT(j)  (256  + 64 * (j))
#define XB_XSUB(j)  (1280 + 64 * (j))
#define XB_XGEN(j)  (2304 + 64 * (j))
#define XB_TOP      3328
#define XB_TOPGEN   3392
#define XCD_BAR_WORDS 3456
#define XB_SPIN_CAP (1u << 18)

__device__ __forceinline__ unsigned xb_ld(unsigned* p)              { return __hip_atomic_load(p, __ATOMIC_RELAXED, __HIP_MEMORY_SCOPE_AGENT); }
__device__ __forceinline__ unsigned xb_add(unsigned* p, unsigned v) { return __hip_atomic_fetch_add(p, v, __ATOMIC_RELAXED, __HIP_MEMORY_SCOPE_AGENT); }
__device__ __forceinline__ unsigned xb_xcc_id() { return (unsigned)__builtin_amdgcn_s_getreg((3 << 11) | 20) & 0xFu; }
#define XB_SPIN(cond, bar) do { unsigned _sp = 0; while (cond) { __builtin_amdgcn_s_sleep(1); \
    if ((++_sp & 255u) == 0u) { if (xb_ld(&(bar)[XB_TMO])) break; if (_sp > XB_SPIN_CAP) { atomicAdd(&(bar)[XB_TMO], 1u); break; } } } } while (0)

struct XcdBarrier { unsigned* bar; unsigned x; volatile LAS unsigned* st; int wv; };

__device__ __forceinline__ XcdBarrier xcd_barrier_post(unsigned* bar, volatile LAS unsigned* st, int wv) {
    XcdBarrier b; b.bar = bar; b.x = xb_xcc_id(); b.st = st; b.wv = wv;
    if (otid(wv) == 0) (void)xb_add(&bar[XB_XCNT(b.x)], 1u);
    return b;
}
__device__ __forceinline__ void xcd_barrier_complete(unsigned* bar, unsigned x, unsigned& nloc, unsigned& nx) {
    const unsigned G = gridDim.x * gridDim.y * gridDim.z;
    unsigned sum, cnt, mine, sp = 0u;
    for (;;) {
        sum = 0u; cnt = 0u; mine = 0u;
#pragma unroll
        for (unsigned j = 0; j < 16; ++j) { const unsigned c = xb_ld(&bar[XB_XCNT(j)]); sum += c; cnt += (c > 0u) ? 1u : 0u; mine = (j == x) ? c : mine; }
        if (sum == G) break;
        __builtin_amdgcn_s_sleep(1);
        if ((++sp & 255u) == 0u) { if (xb_ld(&bar[XB_TMO])) break; if (sp > XB_SPIN_CAP) { atomicAdd(&bar[XB_TMO], 1u); break; } }
    }
    nloc = mine > 0u ? mine : 1u; nx = cnt > 0u ? cnt : 1u;
}
__device__ __attribute__((noinline)) void xcd_barrier_impl(unsigned* bar_, unsigned bx, volatile LAS unsigned* bst, int bwv) {
    XcdBarrier b; b.bar = bar_; b.x = bx; b.st = bst; b.wv = bwv;
    asm volatile("s_waitcnt vmcnt(0)" ::: "memory");
    __syncthreads();
    if (otid(b.wv) == 0) {
        unsigned* bar = b.bar;
        __builtin_amdgcn_s_waitcnt(0);
        unsigned nloc = b.st[0], nx = b.st[1];
        if (nloc == 0u) { xcd_barrier_complete(bar, b.x, nloc, nx); b.st[0] = nloc; b.st[1] = nx; }
        const unsigned old = xb_add(&bar[XB_XSUB(b.x)], 1u);
        const unsigned gen = old / nloc;
        if (old + 1u == (gen + 1u) * nloc) {
            __builtin_amdgcn_fence(__ATOMIC_RELEASE, "agent");
            asm volatile("s_waitcnt vmcnt(0)" ::: "memory");
            const unsigned og = xb_add(&bar[XB_TOP], 1u);
            const unsigned tg = og / nx;
            if (og + 1u == (tg + 1u) * nx) xb_add(&bar[XB_TOPGEN], 1u);
            else XB_SPIN(xb_ld(&bar[XB_TOPGEN]) == tg, bar);
            __builtin_amdgcn_fence(__ATOMIC_ACQUIRE, "agent");
            xb_add(&bar[XB_XGEN(b.x)], 1u);
            asm volatile("s_waitcnt vmcnt(0)" ::: "memory");
        } else {
            XB_SPIN(xb_ld(&bar[XB_XGEN(b.x)]) == gen, bar);
            __builtin_amdgcn_fence(__ATOMIC_ACQUIRE, "agent");
            asm volatile("s_waitcnt vmcnt(0)" ::: "memory");
        }
    }
    __syncthreads();
}

__device__ __forceinline__ void xcd_barrier(const XcdBarrier& b) { xcd_barrier_impl(b.bar, b.x, b.st, b.wv); }

struct Params {
    const float *x, *attn_norm, *w_in, *b_forget, *qnorm_diff, *knorm_diff, *lam_q1, *lam_k1, *lam_q2, *lam_k2, *subln_diff, *onorm_sb,
        *qnorm_fox, *knorm_fox, *onorm_fox, *w_out, *ffn_norm, *w_router, *router_bias, *w_gate, *w_up, *w_down;
    float* out; unsigned char* ws; int ph_lo, ph_hi;
};
typedef const __attribute__((address_space(4))) Params* KArgs;
__device__ __forceinline__ KArgs kparams() { KArgs k = (KArgs)__builtin_amdgcn_kernarg_segment_ptr(); asm volatile("" : "+s"(k)); return k; }

__device__ __forceinline__ void transpose_item(const float* W, int ldn, int k0, int n0, bf16_t* WT, int K, int drow, LAS float* scr, int lane, const float* kgain = nullptr, bool f8 = false) {
#pragma unroll 8
    for (int i = 0; i < 32; ++i) { const int kk = 2 * i + (lane >> 5); scr[kk * 33 + (lane & 31)] = W[(size_t)(k0 + kk) * ldn + n0 + (lane & 31)]; }
    asm volatile("s_waitcnt lgkmcnt(0)" ::: "memory");
    const int c = lane & 7;
    f32x4 ga = {1.f, 1.f, 1.f, 1.f}, gb = ga;
    if (kgain) { ga = *(const f32x4*)(kgain + k0 + 8 * c); gb = *(const f32x4*)(kgain + k0 + 8 * c + 4); }
#pragma unroll
    for (int j = 0; j < 4; ++j) { const int n = (lane >> 3) + 8 * j; const LAS float* s = scr + (8 * c) * 33 + n;
        if (f8) { u32x2 o8; o8.x = cvt4f8(s[0 * 33] * ga[0] * W8_SCALE, s[1 * 33] * ga[1] * W8_SCALE, s[2 * 33] * ga[2] * W8_SCALE, s[3 * 33] * ga[3] * W8_SCALE);
            o8.y = cvt4f8(s[4 * 33] * gb[0] * W8_SCALE, s[5 * 33] * gb[1] * W8_SCALE, s[6 * 33] * gb[2] * W8_SCALE, s[7 * 33] * gb[3] * W8_SCALE);
            *(u32x2*)((unsigned char*)WT + (size_t)(drow + n) * K + k0 + 8 * c) = o8; continue; }
        u32x4 o; o.x = cvtpk(s[0 * 33] * ga[0], s[1 * 33] * ga[1]); o.y = cvtpk(s[2 * 33] * ga[2], s[3 * 33] * ga[3]); o.z = cvtpk(s[4 * 33] * gb[0], s[5 * 33] * gb[1]); o.w = cvtpk(s[6 * 33] * gb[2], s[7 * 33] * gb[3]);
        *(u32x4*)(WT + (size_t)(drow + n) * K + k0 + 8 * c) = o; }
    asm volatile("s_waitcnt lgkmcnt(0)" ::: "memory");
}
__device__ __forceinline__ int win_dest(int n0, int& sel) {
    if (n0 < 768) { sel = 0; return n0; }
    if (n0 < 1536) { sel = 0; return n0; }
    if (n0 < 2304) { sel = 1; return n0 - 1536; }
    if (n0 < 2944) { sel = 0; return 2816 + (n0 - 2304); }
    if (n0 < 3584) { sel = 0; return 3456 + (n0 - 2944); }
    if (n0 < 4224) { sel = 1; return 768 + (n0 - 3584); }
    if (n0 < 4864) { sel = 0; return 1536 + (n0 - 4224); }
    if (n0 < 5504) { sel = 0; return 2176 + (n0 - 4864); }
    sel = 1; return 1408 + (n0 - 5504);
}
__device__ __forceinline__ void phase_prologue(KArgs p, LAS unsigned char* lds, int wv) {
    const int tid = otid(wv), lane = tid & 63, wave = tid >> 6;
    LAS float* scr = (LAS float*)(lds + wave * 16384);
    const int gw = blockIdx.x * 8 + wave, NGW = gridDim.x * 8;
    constexpr int I_IN = 32 * 192, I_O = 32 * 64, I_G = 16 * 32 * 16, I_D = 16 * 8 * 64, I_L = I_IN + I_O + 2 * I_G + I_D;
    bf16_t* Wqk = (bf16_t*)(p->ws + WS_WQK); bf16_t* Wv = (bf16_t*)(p->ws + WS_WV); bf16_t* Wo = (bf16_t*)(p->ws + WS_WO);
    bf16_t* Wgu = (bf16_t*)(p->ws + WS_WGU); bf16_t* Wd = (bf16_t*)(p->ws + WS_WD);
    for (int it = gw; it < DEPTH * I_L; it += NGW) {
        const int l = it / I_L; int r = it % I_L;
        if (r < I_IN) { const int kb = r / 192, nb = r % 192; int sel; const int drow = win_dest(nb * 32, sel);
            if (FP8_PROJ) transpose_item(p->w_in + (size_t)l * DM * NIN, NIN, kb * 64, nb * 32, (bf16_t*)(sel ? (unsigned char*)Wv + (size_t)l * NV * DM : (unsigned char*)Wqk + (size_t)l * NQK * DM), DM, drow, scr, lane, p->attn_norm + (size_t)l * DM, true);
            else transpose_item(p->w_in + (size_t)l * DM * NIN, NIN, kb * 64, nb * 32, sel ? Wv + (size_t)l * NV * DM : Wqk + (size_t)l * NQK * DM, DM, drow, scr, lane, p->attn_norm + (size_t)l * DM); continue; }
        r -= I_IN;
        if (r < I_O) { const int kb = r / 64, nb = r % 64;
            if (FP8_WOUT) transpose_item(p->w_out + (size_t)l * DM * DM, DM, kb * 64, nb * 32, (bf16_t*)((unsigned char*)Wo + (size_t)l * DM * DM), DM, nb * 32, scr, lane, nullptr, true);
            else transpose_item(p->w_out + (size_t)l * DM * DM, DM, kb * 64, nb * 32, Wo + (size_t)l * DM * DM, DM, nb * 32, scr, lane); continue; }
        r -= I_O;
        if (r < 2 * I_G) { const int up = r / I_G; r %= I_G; const int e = r / 512, kb = (r % 512) / 16, nb = r % 16; const int n0 = nb * 32;
            const float* src = (up ? p->w_up : p->w_gate) + ((size_t)l * NEXP + e) * DM * FEXP;
            transpose_item(src, FEXP, kb * 64, n0, (bf16_t*)((unsigned char*)Wgu + ((size_t)l * NEXP + e) * 1024 * DM), DM, (n0 >> 7) * 256 + up * 128 + (n0 & 127), scr, lane, p->ffn_norm + (size_t)l * DM, true); continue; }
        r -= 2 * I_G;
        { const int e = r / 512, kb = (r % 512) / 64, nb = r % 64;
            transpose_item(p->w_down + ((size_t)l * NEXP + e) * FEXP * DM, DM, kb * 64, nb * 32, (bf16_t*)((unsigned char*)Wd + ((size_t)l * NEXP + e) * DM * FEXP), FEXP, nb * 32, scr, lane, nullptr, true); }
    }
    { float* WRT = (float*)(p->ws + WS_WRT); for (int i = blockIdx.x * 512 + tid; i < 16 * DM; i += gridDim.x * 512) WRT[(i & 15) * DM + (i >> 4)] = p->w_router[i]; }
    float* WF = (float*)(p->ws + WS_WF);
    for (int i = blockIdx.x * 512 + tid; i < DEPTH * 5 * DM; i += gridDim.x * 512) { const int l = i / (5 * DM), h = (i / DM) % 5, d = i % DM;
        WF[i] = p->w_in[((size_t)l * DM + d) * NIN + 6144 + h]; }
    if (blockIdx.x == 1 && wave < DEPTH) {
        const int l = wave;
        float a = fabsf(p->qnorm_diff[l * 64 + lane]), b = fabsf(p->knorm_diff[l * 64 + lane]);
        float c2 = fmaxf(fabsf(p->qnorm_fox[l * 128 + lane]), fabsf(p->qnorm_fox[l * 128 + 64 + lane])), d2 = fmaxf(fabsf(p->knorm_fox[l * 128 + lane]), fabsf(p->knorm_fox[l * 128 + 64 + lane]));
#pragma unroll
        for (int o = 1; o < 32; o <<= 1) { a = fmaxf(a, __int_as_float(__builtin_amdgcn_ds_bpermute(((lane ^ o) << 2), __float_as_int(a)))); b = fmaxf(b, __int_as_float(__builtin_amdgcn_ds_bpermute(((lane ^ o) << 2), __float_as_int(b))));
            c2 = fmaxf(c2, __int_as_float(__builtin_amdgcn_ds_bpermute(((lane ^ o) << 2), __float_as_int(c2)))); d2 = fmaxf(d2, __int_as_float(__builtin_amdgcn_ds_bpermute(((lane ^ o) << 2), __float_as_int(d2)))); }
        a = fmaxf(a, __int_as_float(__builtin_amdgcn_ds_bpermute(((lane ^ 32) << 2), __float_as_int(a)))); b = fmaxf(b, __int_as_float(__builtin_amdgcn_ds_bpermute(((lane ^ 32) << 2), __float_as_int(b))));
        c2 = fmaxf(c2, __int_as_float(__builtin_amdgcn_ds_bpermute(((lane ^ 32) << 2), __float_as_int(c2)))); d2 = fmaxf(d2, __int_as_float(__builtin_amdgcn_ds_bpermute(((lane ^ 32) << 2), __float_as_int(d2))));
        if (lane == 0) { ((float*)(p->ws + WS_LAM))[8 + 2 * l] = a * b; ((float*)(p->ws + WS_LAM))[8 + 2 * l + 1] = c2 * d2; }
    }
    if (blockIdx.x == 0 && wave < DEPTH) {
        const int l = wave;
        float a = wave_sum(p->lam_q1[l * 64 + lane] * p->lam_k1[l * 64 + lane]), b = wave_sum(p->lam_q2[l * 64 + lane] * p->lam_k2[l * 64 + lane]);
        if (lane == 0) ((float*)(p->ws + WS_LAM))[l] = fexp2(a * LOG2E) - fexp2(b * LOG2E) + (0.8f - 0.6f * fexp2(-0.3f * LOG2E * (float)l));
    }
}

__device__ __forceinline__ float log_sigmoid(float x) { return fminf(x, 0.f) - 0.6931471805599453f * flog2(1.f + fexp2(-fabsf(x) * LOG2E)); }

__device__ __forceinline__ void phase_norm1(KArgs p, int l, LAS unsigned char* lds, int wv, bool probe2 = false) {
    const int tid = otid(wv), lane = tid & 63, wave = tid >> 6;
    LAS float* wf = (LAS float*)lds;
    LAS int* rbase = (LAS int*)(lds + 5 * DM * 4);
    if (l < DEPTH) { const float* WF = (const float*)(p->ws + WS_WF) + (size_t)l * 5 * DM; for (int i = tid; i < 5 * DM; i += 512) wf[i] = WF[i]; }
    if (l > 0 && tid == 0) { const unsigned* cnt = (const unsigned*)(p->ws + WS_CTL) + CW_CNT + (l - 1) * 16 * 64; int acc = 0;
        for (int e = 0; e < 16; ++e) { rbase[e] = acc * 256; acc += ((int)cnt[e * 64] + 255) >> 8; } }
    __syncthreads();
    const bf16_t* Y = (const bf16_t*)(p->ws + WS_Y); const i32x4* tsel = (const i32x4*)(p->ws + WS_TSEL);
    bf16_t* XN = (bf16_t*)(p->ws + WS_XN); float* LOGF = (float*)(p->ws + WS_LOGF);
    const int gw = blockIdx.x * 8 + wave, NGW = gridDim.x * 8;
    for (int t = gw; t < SEQ; t += NGW) {
        asm volatile("" ::: "memory");
        f32x4 v[8];
        if (l == 0 && !probe2) { const f32x4* xr = (const f32x4*)(p->x + (size_t)t * DM) + lane;
#pragma unroll
            for (int j = 0; j < 8; ++j) v[j] = xr[64 * j]; }
        else { const u32x2* xr = (const u32x2*)((const bf16_t*)(p->ws + WS_OUTB) + (size_t)t * DM) + lane;
#pragma unroll
            for (int j = 0; j < 8; ++j) { const u32x2 a = xr[64 * j]; v[j] = (f32x4){bf_lo(a[0]), bf_hi(a[0]), bf_lo(a[1]), bf_hi(a[1])}; } }
        if (l > 0) {
            const float ysc = probe2 ? 0.f : 1.f;
            const i32x4 ts = tsel[t];
            const unsigned* y1 = (const unsigned*)((const unsigned char*)Y + (size_t)(rbase[ts[0]] + ts[1]) * DM) + lane; const unsigned* y2 = (const unsigned*)((const unsigned char*)Y + (size_t)(rbase[ts[2]] + ts[3]) * DM) + lane;
            const float ys8 = ysc * (1.f / Y8_SCALE);
#pragma unroll
            for (int j = 0; j < 8; ++j) { const unsigned a = y1[64 * j], b = y2[64 * j];
                const f32x2_t a0 = __builtin_amdgcn_cvt_pk_f32_fp8((int)a, false), a1 = __builtin_amdgcn_cvt_pk_f32_fp8((int)a, true), b0 = __builtin_amdgcn_cvt_pk_f32_fp8((int)b, false), b1 = __builtin_amdgcn_cvt_pk_f32_fp8((int)b, true);
                v[j][0] += ys8 * (a0[0] + b0[0]); v[j][1] += ys8 * (a0[1] + b0[1]); v[j][2] += ys8 * (a1[0] + b1[0]); v[j][3] += ys8 * (a1[1] + b1[1]); }
        }
        if (l == DEPTH) { f32x4* orow = (f32x4*)(p->out + (size_t)t * DM) + lane;
#pragma unroll
            for (int j = 0; j < 8; ++j) orow[64 * j] = v[j]; }
        else { u32x2* orow = (u32x2*)((bf16_t*)(p->ws + WS_OUTB) + (size_t)t * DM) + lane;
#pragma unroll
            for (int j = 0; j < 8; ++j) { u32x2 w; w[0] = cvtpk(v[j][0], v[j][1]); w[1] = cvtpk(v[j][2], v[j][3]); orow[64 * j] = w; }
            if (FP8_PROJ) { unsigned* orow8 = (unsigned*)(p->ws + WS_OUTB8 + (size_t)t * DM) + lane;
#pragma unroll
                for (int j = 0; j < 8; ++j) orow8[64 * j] = cvt4f8(v[j][0], v[j][1], v[j][2], v[j][3]); } }
        if (l == DEPTH) continue;
        float ss = 0.f;
#pragma unroll
        for (int j = 0; j < 8; ++j) ss += (v[j][0] * v[j][0] + v[j][1] * v[j][1]) + (v[j][2] * v[j][2] + v[j][3] * v[j][3]);
        const float rstd = __builtin_amdgcn_rsqf(wave_sum(ss) * (1.f / DM) + EPS);
        const f32x4* gr = (const f32x4*)(p->attn_norm + (size_t)l * DM) + lane;
        float fc[5] = {0.f, 0.f, 0.f, 0.f, 0.f};
        if (lane == 0) ((float*)(p->ws + WS_RSTD))[t] = rstd;
#pragma unroll
        for (int j = 0; j < 8; ++j) { const f32x4 xn = v[j] * rstd * gr[64 * j];
#pragma unroll
            for (int h = 0; h < 5; ++h) { const f32x4 w4 = *(const LAS f32x4*)(wf + h * DM + 4 * lane + 256 * j); fc[h] += (xn[0] * w4[0] + xn[1] * w4[1]) + (xn[2] * w4[2] + xn[3] * w4[3]); } }
#pragma unroll
        for (int h = 0; h < 5; ++h) { const float s = wave_sum(fc[h]); if (lane == 0) LOGF[h * SEQ + t] = log_sigmoid(s + p->b_forget[l * 5 + h]); }
    }
}

__device__ __forceinline__ void scan_head(KArgs p, int h, int l, LAS unsigned char* lds, int wv) {
    const int tid = otid(wv), lane = tid & 63, wave = tid >> 6;
    const float* src = (const float*)(p->ws + WS_LOGF) + (size_t)h * SEQ + tid * 16; float* dst = (float*)(p->ws + WS_DC2) + (size_t)h * SEQ + tid * 16;
    LAS float* wt = (LAS float*)lds;
    float v[16]; float s = 0.f;
#pragma unroll
    for (int i = 0; i < 4; ++i) { const f32x4 a = ((const f32x4*)src)[i]; v[4 * i] = a[0]; v[4 * i + 1] = a[1]; v[4 * i + 2] = a[2]; v[4 * i + 3] = a[3]; }
#pragma unroll
    for (int i = 0; i < 16; ++i) { s += v[i]; v[i] = s; }
    float inc = s;
#pragma unroll
    for (int o = 1; o < 64; o <<= 1) { const float n = __int_as_float(__builtin_amdgcn_ds_bpermute(((lane - o) & 63) << 2, __float_as_int(inc))); if (lane >= o) inc += n; }
    if (lane == 63) wt[wave] = inc;
    __syncthreads();
    float base = inc - s;
    for (int w = 0; w < wave; ++w) base += wt[w];
#pragma unroll
    for (int i = 0; i < 4; ++i) ((f32x4*)dst)[i] = (f32x4){(v[4 * i] + base) * LOG2E, (v[4 * i + 1] + base) * LOG2E, (v[4 * i + 2] + base) * LOG2E, (v[4 * i + 3] + base) * LOG2E};
    LAS float* dl = (LAS float*)(lds + 64);
#pragma unroll
    for (int i = 0; i < 16; ++i) dl[tid * 16 + i] = (v[i] + base) * LOG2E;
    __syncthreads();
    { const float thr = 39.f + 2.f * 16.3221377f * ((const float*)(p->ws + WS_LAM))[8 + 2 * l + 1];
      const int qb = tid >> 4, part = tid & 15; const float dref = dl[256 * qb]; int cnt = 0;
      for (int i = part; i < 4 * qb; i += 16) cnt += (dref - dl[64 * i + 63] <= -thr) ? 1 : 0;
      float c = (float)cnt; c += swz_xor<1>(c); c += swz_xor<2>(c); c += swz_xor<4>(c); c += swz_xor<8>(c);
      if (part == 0) ((int*)(p->ws + WS_LAM))[64 + h * 32 + qb] = (int)c; }
    __syncthreads();
}

namespace att {
constexpr int KP = 272, VP = 144;
constexpr int KT_BYTES = 64 * KP, VT_BYTES = 128 * VP, KB_BYTES = 256;
constexpr int BUF_BYTES = KT_BYTES + VT_BYTES + KB_BYTES;
constexpr float THR = 8.f;
static_assert(2 * BUF_BYTES <= RING_BYTES && 4 * 128 * 32 * 4 <= RING_BYTES, "attention LDS");

constexpr int KP8 = 144;
struct Stg { u32x4 k0, k1, v0, v1; };
template <bool F8K = false>
__device__ __forceinline__ void stage_load(Stg& s, const bf16_t* Kg, const bf16_t* Vg, int j, int tid) {
    if (F8K) { s.k0 = *(const u32x4*)((const unsigned char*)Kg + (size_t)(64 * j + (tid >> 3)) * NQK + (tid & 7) * 16); }
    else { const bf16_t* kp = Kg + (size_t)(64 * j + (tid >> 3)) * NQK + (tid & 7) * 8;
    s.k0 = *(const u32x4*)kp; s.k1 = *(const u32x4*)(kp + 64); }
    const bf16_t* vp = Vg + (size_t)(tid >> 2) * SEQ + 64 * j + (tid & 3) * 8;
    s.v0 = *(const u32x4*)vp; s.v1 = *(const u32x4*)(vp + 32);
}
template <bool F8K = false>
__device__ __forceinline__ void stage_write(const Stg& s, LAS unsigned char* buf, int tid) {
    if (F8K) { *(LAS u32x4*)(buf + (tid >> 3) * KP8 + (tid & 7) * 16) = s.k0; }
    else { LAS unsigned char* kd = buf + (tid >> 3) * KP + (tid & 7) * 16; *(LAS u32x4*)kd = s.k0; *(LAS u32x4*)(kd + 128) = s.k1; }
    LAS unsigned char* vd = buf + KT_BYTES + (tid >> 2) * VP + (tid & 3) * 16; *(LAS u32x4*)vd = s.v0; *(LAS u32x4*)(vd + 64) = s.v1;
}
template <int NKS>
__device__ __forceinline__ void qk_tile(f32x16& p0, f32x16& p1, const LAS unsigned char* kb, const bf16x8* qr) {
    bf16x8 ka[NKS], kc[NKS];
#pragma unroll
    for (int ks = 0; ks < NKS; ++ks) { ka[ks] = *(const LAS bf16x8*)(kb + ks * 32); kc[ks] = *(const LAS bf16x8*)(kb + 32 * KP + ks * 32); }
    __builtin_amdgcn_sched_barrier(0);
#pragma unroll
    for (int ks = 0; ks < NKS; ++ks) {
        p0 = __builtin_amdgcn_mfma_f32_32x32x16_bf16(ka[ks], qr[ks], p0, 0, 0, 0);
        p1 = __builtin_amdgcn_mfma_f32_32x32x16_bf16(kc[ks], qr[ks], p1, 0, 0, 0);
    }
    __builtin_amdgcn_sched_barrier(0);
}
__device__ __forceinline__ bf16x8 pack8(const f32x16& p, int b) {
    u32x4 w = {cvtpk(p[b + 0], p[b + 1]), cvtpk(p[b + 2], p[b + 3]), cvtpk(p[b + 4], p[b + 5]), cvtpk(p[b + 6], p[b + 7])};
    return *reinterpret_cast<bf16x8*>(&w);
}
__device__ __forceinline__ void pv_tile(f32x16 (&o)[4], const LAS unsigned char* vb, const f32x16& p0, const f32x16& p1) {
    const bf16x8 pb0 = pack8(p0, 0), pb1 = pack8(p0, 8), pb2 = pack8(p1, 0), pb3 = pack8(p1, 8);
#pragma unroll
    for (int dh = 0; dh < 2; ++dh) {
        bf16x8 va[8];
#pragma unroll
        for (int i = 0; i < 8; ++i) va[i] = *(const LAS bf16x8*)(vb + (2 * dh + (i >> 2)) * 32 * VP + (i & 3) * 32);
        __builtin_amdgcn_sched_barrier(0);
#pragma unroll
        for (int i = 0; i < 8; ++i) { const int d0 = 2 * dh + (i >> 2), s4 = i & 3;
            o[d0] = __builtin_amdgcn_mfma_f32_32x32x16_bf16(va[i], s4 == 0 ? pb0 : (s4 == 1 ? pb1 : (s4 == 2 ? pb2 : pb3)), o[d0], 0, 0, 0); }
        __builtin_amdgcn_sched_barrier(0);
    }
}
template <int NKS>
__device__ __forceinline__ void tile_fixed(f32x16 (&o)[4], const LAS unsigned char* kb, const LAS unsigned char* vb, const bf16x8* qr, f32x16& y0, f32x16& y1, float& l) {
    bf16x8 ka[NKS], kc[NKS];
#pragma unroll
    for (int ks = 0; ks < NKS; ++ks) { ka[ks] = *(const LAS bf16x8*)(kb + ks * 32); kc[ks] = *(const LAS bf16x8*)(kb + 32 * KP + ks * 32); }
    __builtin_amdgcn_sched_barrier(0);
#pragma unroll
    for (int ks = 0; ks < NKS; ++ks) y0 = __builtin_amdgcn_mfma_f32_32x32x16_bf16(ka[ks], qr[ks], y0, 0, 0, 0);
    __builtin_amdgcn_sched_barrier(0);
    asm volatile("" : "+v"(y0));
#pragma unroll
    for (int ks = 0; ks < NKS; ++ks) y1 = __builtin_amdgcn_mfma_f32_32x32x16_bf16(kc[ks], qr[ks], y1, 0, 0, 0);
    float s = 0.f;
#pragma unroll
    for (int r = 0; r < 16; ++r) { y0[r] = fexp2(y0[r]); s += y0[r]; }
    const bf16x8 pb0 = pack8(y0, 0), pb1 = pack8(y0, 8);
#pragma unroll
    for (int q = 0; q < NKS; ++q) { __builtin_amdgcn_sched_group_barrier(0x008, 1, 0);
#pragma unroll
        for (int h = 0; h < 8 / NKS; ++h) { __builtin_amdgcn_sched_group_barrier(0x400, 2, 0); __builtin_amdgcn_sched_group_barrier(0x002, 3, 0); } }
    __builtin_amdgcn_sched_barrier(0);
    bf16x8 va[8];
#pragma unroll
    for (int i = 0; i < 8; ++i) va[i] = *(const LAS bf16x8*)(vb + (i >> 1) * 32 * VP + (i & 1) * 32);
    __builtin_amdgcn_sched_barrier(0);
    asm volatile("" : "+v"(y1));
#pragma unroll
    for (int i = 0; i < 8; ++i) o[i >> 1] = __builtin_amdgcn_mfma_f32_32x32x16_bf16(va[i], (i & 1) ? pb1 : pb0, o[i >> 1], 0, 0, 0);
    float s1 = 0.f;
#pragma unroll
    for (int r = 0; r < 16; ++r) { y1[r] = fexp2(y1[r]); s1 += y1[r]; }
    const bf16x8 pb2 = pack8(y1, 0), pb3 = pack8(y1, 8);
#pragma unroll
    for (int q = 0; q < 8; ++q) { __builtin_amdgcn_sched_group_barrier(0x008, 1, 0); __builtin_amdgcn_sched_group_barrier(0x400, 2, 0); __builtin_amdgcn_sched_group_barrier(0x002, 3, 0); }
    __builtin_amdgcn_sched_barrier(0);
    l += s + s1;
    bf16x8 vb2[8];
#pragma unroll
    for (int i = 0; i < 8; ++i) vb2[i] = *(const LAS bf16x8*)(vb + (i >> 1) * 32 * VP + 64 + (i & 1) * 32);
    __builtin_amdgcn_sched_barrier(0);
#pragma unroll
    for (int i = 0; i < 8; ++i) o[i >> 1] = __builtin_amdgcn_mfma_f32_32x32x16_bf16(vb2[i], (i & 1) ? pb3 : pb2, o[i >> 1], 0, 0, 0);
    __builtin_amdgcn_sched_barrier(0);
}
template <int NKS>
__device__ __forceinline__ void tile_fixed8(f32x16 (&o)[4], const LAS unsigned char* kb, const LAS unsigned char* vb, const i32x8* qr, f32x16& y0, f32x16& y1, float& l) {
    i32x8 ka[NKS], kc[NKS];
#pragma unroll
    for (int ks = 0; ks < NKS; ++ks) { const i32x4 a0 = *(const LAS i32x4*)(kb + ks * 64), a1 = *(const LAS i32x4*)(kb + ks * 64 + 16), c0 = *(const LAS i32x4*)(kb + 32 * KP8 + ks * 64), c1 = *(const LAS i32x4*)(kb + 32 * KP8 + ks * 64 + 16);
        ka[ks] = __builtin_shufflevector(a0, a1, 0, 1, 2, 3, 4, 5, 6, 7); kc[ks] = __builtin_shufflevector(c0, c1, 0, 1, 2, 3, 4, 5, 6, 7); }
    __builtin_amdgcn_sched_barrier(0);
#pragma unroll
    for (int ks = 0; ks < NKS; ++ks) y0 = __builtin_amdgcn_mfma_scale_f32_32x32x64_f8f6f4(ka[ks], qr[ks], y0, 0, 0, 0, 0x7F7F7F7F, 0, 0x7F7F7F7F);
    __builtin_amdgcn_sched_barrier(0);
    asm volatile("" : "+v"(y0));
#pragma unroll
    for (int ks = 0; ks < NKS; ++ks) y1 = __builtin_amdgcn_mfma_scale_f32_32x32x64_f8f6f4(kc[ks], qr[ks], y1, 0, 0, 0, 0x7F7F7F7F, 0, 0x7F7F7F7F);
    float s = 0.f;
#pragma unroll
    for (int r = 0; r < 16; ++r) { y0[r] = fexp2(y0[r]); s += y0[r]; }
    const bf16x8 pb0 = pack8(y0, 0), pb1 = pack8(y0, 8);
#pragma unroll
    for (int q = 0; q < NKS; ++q) { __builtin_amdgcn_sched_group_barrier(0x008, 1, 0);
#pragma unroll
        for (int h = 0; h < 8 / NKS; ++h) { __builtin_amdgcn_sched_group_barrier(0x400, 2, 0); __builtin_amdgcn_sched_group_barrier(0x002, 3, 0); } }
    __builtin_amdgcn_sched_barrier(0);
    bf16x8 va[8];
#pragma unroll
    for (int i = 0; i < 8; ++i) va[i] = *(const LAS bf16x8*)(vb + (i >> 1) * 32 * VP + (i & 1) * 32);
    __builtin_amdgcn_sched_barrier(0);
    asm volatile("" : "+v"(y1));
#pragma unroll
    for (int i = 0; i < 8; ++i) o[i >> 1] = __builtin_amdgcn_mfma_f32_32x32x16_bf16(va[i], (i & 1) ? pb1 : pb0, o[i >> 1], 0, 0, 0);
    float s1 = 0.f;
#pragma unroll
    for (int r = 0; r < 16; ++r) { y1[r] = fexp2(y1[r]); s1 += y1[r]; }
    const bf16x8 pb2 = pack8(y1, 0), pb3 = pack8(y1, 8);
#pragma unroll
    for (int q = 0; q < 8; ++q) { __builtin_amdgcn_sched_group_barrier(0x008, 1, 0); __builtin_amdgcn_sched_group_barrier(0x400, 2, 0); __builtin_amdgcn_sched_group_barrier(0x002, 3, 0); }
    __builtin_amdgcn_sched_barrier(0);
    l += s + s1;
    bf16x8 vb2[8];
#pragma unroll
    for (int i = 0; i < 8; ++i) vb2[i] = *(const LAS bf16x8*)(vb + (i >> 1) * 32 * VP + 64 + (i & 1) * 32);
    __builtin_amdgcn_sched_barrier(0);
#pragma unroll
    for (int i = 0; i < 8; ++i) o[i >> 1] = __builtin_amdgcn_mfma_f32_32x32x16_bf16(vb2[i], (i & 1) ? pb3 : pb2, o[i >> 1], 0, 0, 0);
    __builtin_amdgcn_sched_barrier(0);
}
__device__ __forceinline__ float swap_max(float v) { auto rr = __builtin_amdgcn_permlane32_swap(__float_as_uint(v), __float_as_uint(v), false, false); return fmaxf(__uint_as_float(rr[0]), __uint_as_float(rr[1])); }
__device__ __forceinline__ float swap_sum(float v) { auto rr = __builtin_amdgcn_permlane32_swap(__float_as_uint(v), __float_as_uint(v), false, false); return __uint_as_float(rr[0]) + __uint_as_float(rr[1]); }
__device__ __forceinline__ void softmax_step(f32x16& y0, f32x16& y1, float A, float& m, float& l, f32x16 (&o)[4]) {
    float mx = y0[0];
#pragma unroll
    for (int r = 1; r < 16; ++r) mx = fmaxf(mx, y0[r]);
#pragma unroll
    for (int r = 0; r < 16; ++r) mx = fmaxf(mx, y1[r]);
    mx = swap_max(mx) + A;
    if (__any(mx > m + THR)) {
        const float mn = fmaxf(m, mx), al = fexp2(m - mn); m = mn; l *= al;
#pragma unroll
        for (int d0 = 0; d0 < 4; ++d0)
#pragma unroll
            for (int r = 0; r < 16; ++r) o[d0][r] *= al;
    }
    const float mA = m - A; float s = 0.f;
#pragma unroll
    for (int r = 0; r < 16; ++r) { y0[r] = fexp2(y0[r] - mA); s += y0[r]; }
#pragma unroll
    for (int r = 0; r < 16; ++r) { y1[r] = fexp2(y1[r] - mA); s += y1[r]; }
    l += s;
}
__device__ __forceinline__ void softmax_fixed(f32x16& y0, f32x16& y1, float c, float& l) {
    float s = 0.f;
#pragma unroll
    for (int r = 0; r < 16; ++r) { y0[r] = fexp2(y0[r] + c); s += y0[r]; }
#pragma unroll
    for (int r = 0; r < 16; ++r) { y1[r] = fexp2(y1[r] + c); s += y1[r]; }
    l += s;
}
#define KIDX(r) (((r) & 3) + 8 * ((r) >> 2))

template <int TY>
__device__ __forceinline__ void att_item(KArgs p, int l, int head, int qb, LAS unsigned char* lds, int wv, int part = 0) {
    const int tid = otid(wv), wid = __builtin_amdgcn_readfirstlane(tid >> 6), lane = tid & 63, r32 = lane & 31, hi = lane >> 5;
    constexpr int NKS = (TY == 0) ? 4 : 8;
    const int br = (TY == 0) ? (wid >> 2) : 0, rg = (TY == 0) ? (wid & 3) : wid;
    const int t0w = (TY == 0) ? (128 * qb + 32 * rg) : (256 * qb + 32 * wid);
    const int trow = t0w + r32;
    const int NT = (TY == 0) ? (2 * qb + 2) : (4 * qb + 4);
    const int qcol = (TY == 0) ? (128 * head + 64 * br) : (TY == 1 ? 2816 + 128 * head : 1536 + 128 * head);
    const int kcol = (TY == 0) ? (768 + 128 * head) : (TY == 1 ? 3456 + 128 * head : 2176 + 128 * head);
    const int hv = (TY == 0) ? head : (TY == 1 ? 6 + head : 11 + head);
    const bf16_t* QKB = (const bf16_t*)(p->ws + WS_QKB);
    constexpr bool F8 = (TY != 1);
    const unsigned char* QKB8 = p->ws + WS_QKB8;
    const bf16_t* Kg = F8 ? (const bf16_t*)(QKB8 + kcol) : QKB + kcol; const bf16_t* Vg = (const bf16_t*)(p->ws + WS_VT) + (size_t)hv * HD * SEQ;
    const float* dc2 = (const float*)(p->ws + WS_DC2) + (size_t)head * SEQ;
    const float dcref = (TY == 2) ? dc2[256 * qb] : 0.f;
    const float slope2 = (TY == 0) ? fexp2(-8.0f * (float)(head + 1) / 6.0f) * LOG2E : 0.f;
    const float Bfix = (TY == 0) ? (11.5415603f * 1.01f * ((const float*)(p->ws + WS_LAM))[8 + 2 * l] + 0.25f) : (16.3221377f * 1.01f * ((const float*)(p->ws + WS_LAM))[8 + 2 * l + 1] + 0.25f);
    const float cfix = (TY == 2) ? (dc2[trow] - dcref - Bfix) : -Bfix;

    int j_lo = 0;
    if (TY == 0 && SKIP_A) {
        const float Bq = 11.5415603f * ((const float*)(p->ws + WS_LAM))[8 + 2 * l];
        const float x = ((float)(128 * qb - 63) - (39.f + 2.f * Bq) / slope2) * (1.f / 64.f);
        j_lo = x < 0.f ? 0 : (int)x + 1;
    } else if (TY == 2 && SKIP_C) {
        j_lo = ((const int*)(p->ws + WS_LAM))[64 + head * 32 + qb];
    }
    j_lo = __builtin_amdgcn_readfirstlane(j_lo);
    const int NTP = NT - j_lo;
    const bool elig = (TY == 2) ? (qb >= 8) : ((TY == 0) ? (head >= 4 && qb >= 16) : false);
    const bool split = elig && NTP > 32;
    if (part == 1 && !split) return;
    const int mid = j_lo + (NTP >> 1);
    const int jtop = (part == 1) ? mid - 1 : NT - 1;
    const int cntT = (part == 1) ? (mid - j_lo) : (split ? NT - mid : NTP);
    const int sidx = (TY == 2) ? (head * 32 + qb) : (160 + head * 64 + qb);
    unsigned long long* pay = (unsigned long long*)(p->ws + WS_PART) + ((size_t)sidx * 8 + wid) * 17 * 64 + lane;
    unsigned* aflag = (unsigned*)(p->ws + WS_CTL) + CW_AFLAG + (l * 544 + sidx) * 64;
    LAS unsigned char* buf0 = lds; LAS unsigned char* buf1 = lds + BUF_BYTES;
    LAS int* flags = (LAS int*)(lds + 2 * BUF_BYTES);
    if (TY == 1 && tid < 16) flags[tid] = 0;
    Stg st; float kbv = 0.f;
    stage_load<F8>(st, Kg, Vg, jtop, tid);
    if (TY == 2 && tid < 64) kbv = dcref - dc2[64 * jtop + tid];
    bf16x8 qr[NKS]; constexpr int NK8 = (TY == 0) ? 1 : 2; i32x8 q8[NK8];
    if (F8) {
#pragma unroll
        for (int ks = 0; ks < NK8; ++ks) { const i32x4 a = *(const i32x4*)(QKB8 + (size_t)trow * NQK + qcol + ks * 64 + hi * 32), b = *(const i32x4*)(QKB8 + (size_t)trow * NQK + qcol + ks * 64 + hi * 32 + 16);
            q8[ks] = __builtin_shufflevector(a, b, 0, 1, 2, 3, 4, 5, 6, 7); }
    } else {
#pragma unroll
        for (int ks = 0; ks < NKS; ++ks) qr[ks] = *(const bf16x8*)(QKB + (size_t)trow * NQK + qcol + ks * 16 + hi * 8);
    }
    stage_write<F8>(st, buf0, tid);
    if (TY == 2 && tid < 64) *(LAS float*)(buf0 + KT_BYTES + VT_BYTES + tid * 4) = kbv;
    if (cntT > 1) { stage_load<F8>(st, Kg, Vg, jtop - 1, tid); if (TY == 2 && tid < 64) kbv = dcref - dc2[64 * (jtop - 1) + tid]; }
    __syncthreads();

    f32x16 o[4];
#pragma unroll
    for (int d0 = 0; d0 < 4; ++d0)
#pragma unroll
        for (int r = 0; r < 16; ++r) o[d0][r] = 0.f;
    float m = 0.f, lsum = 0.f, R = 0.f;
    const int koff = F8 ? (r32 * KP8 + hi * 32 + ((TY == 0) ? br * 64 : 0)) : (r32 * KP + hi * 16 + ((TY == 0) ? br * 128 : 0)), voff = KT_BYTES + r32 * VP + hi * 16;

    for (int it = 0; it < cntT; ++it) {
        if (TY == 1 && (SKIP_B & 1) && it > 0) { const i32x4 f0 = *(const LAS i32x4*)(flags + ((it - 1) & 1) * 8), f1 = *(const LAS i32x4*)(flags + ((it - 1) & 1) * 8 + 4);
            if (__builtin_amdgcn_readfirstlane((f0[0] & f0[1] & f0[2] & f0[3] & f1[0] & f1[1] & f1[2] & f1[3])) != 0) break; }
        const int j = jtop - it;
        LAS unsigned char* cur = (it & 1) ? buf1 : buf0; LAS unsigned char* oth = (it & 1) ? buf0 : buf1;
        const bool more = it + 1 < cntT;
        if (TY == 0) {
            const int cw = 2 * qb + (rg >> 1);
            if (j <= cw) {
                f32x16 y0, y1;
                const int trel = trow - 64 * j;
                if (j == cw) {
                    const float tq = (float)(trel - 4 * hi);
#pragma unroll
                    for (int r = 0; r < 16; ++r) { y0[r] = fmaf(-slope2, fabsf(tq - (float)KIDX(r)), cfix); y1[r] = fmaf(-slope2, fabsf(tq - (float)(KIDX(r) + 32)), cfix); }
                } else {
                    const float A = fmaf(-slope2, (float)(trel - 4 * hi), cfix);
#pragma unroll
                    for (int r = 0; r < 16; ++r) { y0[r] = fmaf(slope2, (float)KIDX(r), A); y1[r] = fmaf(slope2, (float)(KIDX(r) + 32), A); }
                }
                tile_fixed8<NK8>(o, cur + koff, cur + voff, q8, y0, y1, lsum);
            }
        } else {
            const int jj = j - 4 * qb;
            if (jj <= (wid >> 1) && !(TY == 1 && (SKIP_B & 2) && __all(R <= -40.f))) {
                const bool partial = (jj == (wid >> 1));
                const int tin = 32 * (wid & 1) + r32 - 4 * hi;
                f32x16 y0, y1;
                if (TY == 2) {
                    const LAS f32x4* kbp = (const LAS f32x4*)(cur + KT_BYTES + VT_BYTES) + hi;
#pragma unroll
                    for (int g = 0; g < 4; ++g) { const f32x4 b0 = kbp[2 * g], b1 = kbp[2 * g + 8];
#pragma unroll
                        for (int i = 0; i < 4; ++i) { y0[4 * g + i] = b0[i] + cfix; y1[4 * g + i] = b1[i] + cfix; } }
                    if (partial) {
#pragma unroll
                        for (int r = 0; r < 16; ++r) { if (KIDX(r) > tin) y0[r] = -__builtin_inff(); if (KIDX(r) + 32 > tin) y1[r] = -__builtin_inff(); }
                    }
                    tile_fixed8<NK8>(o, cur + koff, cur + voff, q8, y0, y1, lsum);
                } else {
#pragma unroll
                    for (int r = 0; r < 16; ++r) { y0[r] = 0.f; y1[r] = 0.f; }
                    qk_tile<NKS>(y0, y1, cur + koff, qr);
                    f32x16 lb0, lb1;
#pragma unroll
                    for (int r = 0; r < 16; ++r) {
                        { const float z = fminf(fmaxf(y0[r], -100.f), 100.f), b = -flog2(1.f + fexp2(-z)); float k = b - z, bb = b;
                          if (partial && KIDX(r) >= tin) { k = 0.f; bb = -__builtin_inff(); } lb0[r] = bb; y0[r] = k; }
                        { const float z = fminf(fmaxf(y1[r], -100.f), 100.f), b = -flog2(1.f + fexp2(-z)); float k = b - z, bb = b;
                          if (partial && KIDX(r) + 32 >= tin) { k = 0.f; bb = -__builtin_inff(); } lb1[r] = bb; y1[r] = k; }
                    }
                    float gs0[4], gs1[4];
#pragma unroll
                    for (int g = 0; g < 4; ++g) {
                        { const float e0 = y0[4 * g], e1 = y0[4 * g + 1], e2 = y0[4 * g + 2], e3 = y0[4 * g + 3]; const float s2 = e3, s1 = e3 + e2, s0 = s1 + e1;
                          y0[4 * g + 3] = 0.f; y0[4 * g + 2] = s2; y0[4 * g + 1] = s1; y0[4 * g] = s0; gs0[g] = s0 + e0; }
                        { const float e0 = y1[4 * g], e1 = y1[4 * g + 1], e2 = y1[4 * g + 2], e3 = y1[4 * g + 3]; const float s2 = e3, s1 = e3 + e2, s0 = s1 + e1;
                          y1[4 * g + 3] = 0.f; y1[4 * g + 2] = s2; y1[4 * g + 1] = s1; y1[4 * g] = s0; gs1[g] = s0 + e0; }
                    }
                    float run = R;
#pragma unroll
                    for (int half = 1; half >= 0; --half)
#pragma unroll
                        for (int g = 3; g >= 0; --g) {
                            const float mine = half ? gs1[g] : gs0[g];
                            auto rr = __builtin_amdgcn_permlane32_swap(__float_as_uint(mine), __float_as_uint(mine), false, false);
                            const float g_lo = __uint_as_float(rr[0]), g_hi = __uint_as_float(rr[1]);
                            const float off_hi = run; run += g_hi; const float off_lo = run; run += g_lo;
                            const float off = hi ? off_hi : off_lo;
#pragma unroll
                            for (int i = 0; i < 4; ++i) {
                                if (half) y1[4 * g + i] = fexp2(lb1[4 * g + i] + y1[4 * g + i] + off);
                                else y0[4 * g + i] = fexp2(lb0[4 * g + i] + y0[4 * g + i] + off);
                            }
                        }
                    R = run;
                    pv_tile(o, cur + voff, y0, y1);
                }
            }
        }
        if (TY == 1) { const int dn = __all(R <= -40.f) ? 1 : 0; if (lane == 0) flags[(it & 1) * 8 + wid] = dn; }
        if (more) { stage_write<F8>(st, oth, tid); if (TY == 2 && tid < 64) *(LAS float*)(oth + KT_BYTES + VT_BYTES + tid * 4) = kbv; }
        if (it + 2 < cntT) { stage_load<F8>(st, Kg, Vg, j - 2, tid); if (TY == 2 && tid < 64) kbv = dcref - dc2[64 * (j - 2) + tid]; }
        __syncthreads();
    }

    bf16_t* MIX = (bf16_t*)(p->ws + WS_MIX);
    float inv = 1.f;
    if (TY != 1) {
        float lt = swap_sum(lsum);
        if (part == 1) {
            __hip_atomic_store(pay, ((unsigned long long)__float_as_uint(lt) << 32) | __float_as_uint(m), __ATOMIC_RELAXED, __HIP_MEMORY_SCOPE_AGENT);
#pragma unroll
            for (int d0 = 0; d0 < 4; ++d0)
#pragma unroll
                for (int g = 0; g < 4; ++g)
                    __hip_atomic_store(pay + (1 + d0 * 4 + g) * 64, ((unsigned long long)cvtpk(o[d0][4 * g + 2], o[d0][4 * g + 3]) << 32) | cvtpk(o[d0][4 * g], o[d0][4 * g + 1]), __ATOMIC_RELAXED, __HIP_MEMORY_SCOPE_AGENT);
            asm volatile("s_waitcnt vmcnt(0)" ::: "memory");
            __syncthreads();
            if (tid == 0) __hip_atomic_store(aflag, 1u, __ATOMIC_RELAXED, __HIP_MEMORY_SCOPE_AGENT);
            __syncthreads();
            return;
        }
        if (split) {
            if (tid == 0) { unsigned sp = 0; while (__hip_atomic_load(aflag, __ATOMIC_RELAXED, __HIP_MEMORY_SCOPE_AGENT) == 0u && ++sp < (1u << 22)) __builtin_amdgcn_s_sleep(2);
                __builtin_amdgcn_fence(__ATOMIC_ACQUIRE, "agent"); asm volatile("s_waitcnt vmcnt(0)" ::: "memory"); }
            __syncthreads();
            const unsigned long long ml = __hip_atomic_load(pay, __ATOMIC_RELAXED, __HIP_MEMORY_SCOPE_AGENT);
            const float mf = __uint_as_float((unsigned)ml), lf = __uint_as_float((unsigned)(ml >> 32));
            const float mn = fmaxf(m, mf), a0 = fexp2(m - mn), a1 = fexp2(mf - mn);
            lt = a0 * lt + a1 * lf;
#pragma unroll
            for (int d0 = 0; d0 < 4; ++d0)
#pragma unroll
                for (int g = 0; g < 4; ++g) {
                    const unsigned long long w = __hip_atomic_load(pay + (1 + d0 * 4 + g) * 64, __ATOMIC_RELAXED, __HIP_MEMORY_SCOPE_AGENT);
                    const unsigned w0 = (unsigned)w, w1 = (unsigned)(w >> 32);
                    o[d0][4 * g] = a0 * o[d0][4 * g] + a1 * bf_lo(w0); o[d0][4 * g + 1] = a0 * o[d0][4 * g + 1] + a1 * bf_hi(w0);
                    o[d0][4 * g + 2] = a0 * o[d0][4 * g + 2] + a1 * bf_lo(w1); o[d0][4 * g + 3] = a0 * o[d0][4 * g + 3] + a1 * bf_hi(w1);
                }
        }
        inv = 1.f / lt;
    }
    float post = 1.f; const float* gain;
    if (TY == 0) {
        const float lam = ((const float*)(p->ws + WS_LAM))[l];
        LAS float* X = (LAS float*)lds + (size_t)rg * 128 * 32;
        if (br == 1) {
            const float sc = inv * lam;
#pragma unroll
            for (int d0 = 0; d0 < 4; ++d0)
#pragma unroll
                for (int r = 0; r < 16; ++r) X[(32 * d0 + KIDX(r) + 4 * hi) * 32 + r32] = o[d0][r] * sc;
        }
        __syncthreads();
        if (br == 0) {
#pragma unroll
            for (int d0 = 0; d0 < 4; ++d0)
#pragma unroll
                for (int r = 0; r < 16; ++r) o[d0][r] = o[d0][r] * inv - X[(32 * d0 + KIDX(r) + 4 * hi) * 32 + r32];
        }
        inv = 1.f;
        post = 1.f - (0.8f - 0.6f * fexp2(-0.3f * LOG2E * (float)l));
        gain = p->subln_diff + l * HD;
    } else if (TY == 1) gain = p->onorm_sb + l * HD;
    else gain = p->onorm_fox + l * HD;
    if (TY != 0 || br == 0) {
        float ss = 0.f;
#pragma unroll
        for (int d0 = 0; d0 < 4; ++d0)
#pragma unroll
            for (int r = 0; r < 16; ++r) { const float v = o[d0][r] * inv; ss += v * v; }
        ss = swap_sum(ss);
        const float sc = inv * post * __builtin_amdgcn_rsqf(ss * (1.f / HD) + EPS);
        bf16_t* orow = MIX + (size_t)trow * DM + hv * HD + 4 * hi;
#pragma unroll
        for (int d0 = 0; d0 < 4; ++d0)
#pragma unroll
            for (int g = 0; g < 4; ++g) {
                const f32x4 g4 = *(const f32x4*)(gain + 32 * d0 + 8 * g + 4 * hi);
                if (FP8_WOUT) { *(unsigned*)((unsigned char*)MIX + (size_t)trow * DM + hv * HD + 4 * hi + 32 * d0 + 8 * g) = cvt4f8(o[d0][4 * g] * sc * g4[0], o[d0][4 * g + 1] * sc * g4[1], o[d0][4 * g + 2] * sc * g4[2], o[d0][4 * g + 3] * sc * g4[3]); continue; }
                u32x2 w; w[0] = cvtpk(o[d0][4 * g] * sc * g4[0], o[d0][4 * g + 1] * sc * g4[1]); w[1] = cvtpk(o[d0][4 * g + 2] * sc * g4[2], o[d0][4 * g + 3] * sc * g4[3]);
                *(u32x2*)(orow + 32 * d0 + 8 * g) = w;
            }
    }
    __syncthreads();
}

constexpr int N_FAR = 5 * 24 + 2 * 48;
constexpr int N_ITEMS = N_FAR + 32 * 22;
__device__ __forceinline__ void attention_phase(KArgs p, int l, LAS unsigned char* lds, volatile LAS unsigned* itemw, int wv, int qi, int tmask = 7) {
    unsigned* q = (unsigned*)(p->ws + WS_CTL) + CW_ATTQ + qi * 64;
    for (;;) {
        if (otid(wv) == 0) *itemw = __hip_atomic_fetch_add(q, 1u, __ATOMIC_RELAXED, __HIP_MEMORY_SCOPE_AGENT);
        __syncthreads();
        int item = (int)*itemw;
        __syncthreads();
        if (item >= N_ITEMS) break;
        if (item < N_FAR) {
            if (item < 120) { if (tmask & 1) att_item<2>(p, l, item % 5, 31 - item / 5, lds, wv, 1); }
            else { const int i2 = item - 120; if (tmask & 2) att_item<0>(p, l, 5 - (i2 & 1), 63 - (i2 >> 1), lds, wv, 1); }
            continue;
        }
        item -= N_FAR;
        if (item < 288) { const int w = item % 9, pp = 31 - item / 9;
            if (w < 5) { if (tmask & 1) att_item<2>(p, l, w, pp, lds, wv); }
            else if (tmask & 2) att_item<0>(p, l, 5 - ((w - 5) >> 1), 2 * pp + 1 - ((w - 5) & 1), lds, wv); }
        else if (item < 544) { const int it2 = item - 288, w = it2 % 8, pp = 31 - it2 / 8;
            if (tmask & 2) att_item<0>(p, l, 3 - (w >> 1), 2 * pp + 1 - (w & 1), lds, wv); }
        else if (tmask & 4) { const int it3 = item - 544; att_item<1>(p, l, it3 % 5, 31 - it3 / 5, lds, wv); }
    }
}
}

__device__ __forceinline__ void phase_route(KArgs p, int l, LAS unsigned char* lds, int wv, int ci, bool waitp = true) {
    const int tid = otid(wv), lane = tid & 63, wave = tid >> 6;
    LAS float* wrt = (LAS float*)lds;
    LAS int* bsel = (LAS int*)(lds + 16 * DM * 4);
    LAS float* bsc = (LAS float*)(bsel + 64);
    LAS float* bgate = bsc + 64;
    LAS float* brs = bgate + 64;
    { const f32x4* src = (const f32x4*)(p->ws + WS_WRT); for (int i = tid; i < 16 * DM / 4; i += 512) ((LAS f32x4*)wrt)[i] = src[i]; }
    __syncthreads();
    bf16_t* XN = (bf16_t*)(p->ws + WS_XN);
    for (int blk = blockIdx.x; blk < SEQ / 32; blk += gridDim.x) {
        const int tid = otid(wv), lane = tid & 63, wave = tid >> 6;
        if (waitp) { if (wave == 0) {
            const unsigned* wc = (const unsigned*)(p->ws + WS_CTL) + CW_WOC + l * 32 * 64 + 64 * (blk >> 3);
            unsigned sp = 0;
            while ((unsigned)__builtin_amdgcn_readfirstlane((int)__hip_atomic_load(wc, __ATOMIC_RELAXED, __HIP_MEMORY_SCOPE_AGENT)) < 64u && ++sp < (1u << 22)) __builtin_amdgcn_s_sleep(2);
            __builtin_amdgcn_fence(__ATOMIC_ACQUIRE, "agent");
            asm volatile("s_waitcnt vmcnt(0)" ::: "memory");
            } __syncthreads(); }
        const int tb = blk * 32 + wave * 4;
        f32x4 hx[4][8];
#pragma unroll
        for (int i = 0; i < 4; ++i) { const u32x2* xr = (const u32x2*)((const bf16_t*)(p->ws + WS_OUTB) + (size_t)(tb + i) * DM) + lane;
#pragma unroll
            for (int j = 0; j < 8; ++j) { const u32x2 a = xr[64 * j]; hx[i][j] = (f32x4){bf_lo(a[0]), bf_hi(a[0]), bf_lo(a[1]), bf_hi(a[1])}; } }
#pragma unroll
        for (int i = 0; i < 4; ++i) {
            float ss = 0.f;
#pragma unroll
            for (int j = 0; j < 8; ++j) ss += (hx[i][j][0] * hx[i][j][0] + hx[i][j][1] * hx[i][j][1]) + (hx[i][j][2] * hx[i][j][2] + hx[i][j][3] * hx[i][j][3]);
            const float rstd = __builtin_amdgcn_rsqf(wave_sum(ss) * (1.f / DM) + EPS);
            if (lane == 0) brs[wave * 4 + i] = rstd;
            const f32x4* gr = (const f32x4*)(p->ffn_norm + (size_t)l * DM) + lane;
#pragma unroll
            for (int j = 0; j < 8; ++j) hx[i][j] = hx[i][j] * rstd * gr[64 * j];
        }
#pragma unroll
        for (int h2 = 0; h2 < 2; ++h2) {
            f32x4 (&hn)[2][8] = *reinterpret_cast<f32x4 (*)[2][8]>(&hx[2 * h2]);
            asm volatile("" ::: "memory"); __builtin_amdgcn_sched_barrier(0);
            float acc[32];
#pragma unroll
            for (int k = 0; k < 32; ++k) acc[k] = 0.f;
#pragma unroll
            for (int j = 0; j < 8; ++j)
#pragma unroll
                for (int eh = 0; eh < 2; ++eh) {
#pragma unroll
                    for (int e = 8 * eh; e < 8 * eh + 8; ++e) { const f32x4 w4 = *(const LAS f32x4*)(wrt + e * DM + 4 * lane + 256 * j);
#pragma unroll
                        for (int i = 0; i < 2; ++i) acc[i * 16 + e] += (hn[i][j][0] * w4[0] + hn[i][j][1] * w4[1]) + (hn[i][j][2] * w4[2] + hn[i][j][3] * w4[3]); }
                    __builtin_amdgcn_sched_barrier(0);
                }
#pragma unroll
            for (int k = 0; k < 32; ++k) acc[k] = sum_xor32(acc[k]);
#define RSTEP(H) { const bool up = (lane & H) != 0; _Pragma("unroll") for (int k = 0; k < H; ++k) { const float a = acc[k], b = acc[k + H]; const float give = up ? a : b, keep = up ? b : a; acc[k] = keep + swz_xor<H>(give); } }
            RSTEP(16) RSTEP(8) RSTEP(4) RSTEP(2) RSTEP(1)
#undef RSTEP
            const float logit = acc[0];
            const float score = __builtin_amdgcn_rcpf(1.f + fexp2(-logit * LOG2E));
            const float sel = score + p->router_bias[lane & 15];
            const float v1 = swz_xor<1>(sel), v2 = swz_xor<2>(sel), v3 = swz_xor<3>(sel);
            const float a = fmaxf(sel, v1), b = fminf(sel, v1), c = fmaxf(v2, v3), d = fminf(v2, v3);
            const float gs = fmaxf(a, c) + fmaxf(fminf(a, c), fmaxf(b, d));
            const float g1 = swz_xor<4>(gs), g2 = swz_xor<8>(gs), g3 = swz_xor<12>(gs);
            const int myg = (lane >> 2) & 3, k = lane & 3;
            const bool best = (gs > g1 || (gs == g1 && myg < (myg ^ 1))) && (gs > g2 || (gs == g2 && myg < (myg ^ 2))) && (gs > g3 || (gs == g3 && myg < (myg ^ 3)));
            const int rank = ((v1 > sel || (v1 == sel && (k ^ 1) < k)) ? 1 : 0) + ((v2 > sel || (v2 == sel && (k ^ 2) < k)) ? 1 : 0) + ((v3 > sel || (v3 == sel && (k ^ 3) < k)) ? 1 : 0);
            if (best && rank < 2 && lane < 32) { const int row = wave * 4 + h2 * 2 + (lane >> 4); bsel[row * 2 + rank] = lane & 15; bsc[row * 2 + rank] = score; }
        }
        asm volatile("s_waitcnt lgkmcnt(0)" ::: "memory");
        if (lane < 8) { const int idx = wave * 8 + lane; const float sm = bsc[idx], so = bsc[idx ^ 1]; bgate[idx] = sm / (sm + so); }
        __syncthreads();
        if (wave == 0) {
            unsigned* cnt = (unsigned*)(p->ws + WS_CTL) + CW_CNT + ci * 16 * 64;
            const int mye = bsel[lane]; int myrank = 0, n = 0;
            const unsigned long long below = (1ull << lane) - 1ull;
#pragma unroll
            for (int e = 0; e < 16; ++e) { const unsigned long long mk = __ballot(mye == e); if (mye == e) myrank = (int)__popcll(mk & below); if (lane == e) n = (int)__popcll(mk); }
            int base = 0;
            if (lane < 16 && n) base = (int)__hip_atomic_fetch_add(cnt + lane * 64, (unsigned)n, __ATOMIC_RELAXED, __HIP_MEMORY_SCOPE_AGENT);
            const int pos = __builtin_amdgcn_ds_bpermute(mye << 2, base) + myrank, tok = blk * 32 + (lane >> 1);
            ((int*)(p->ws + WS_TOK))[mye * SEQ + pos] = tok; ((f32x2_t*)(p->ws + WS_GATE))[mye * SEQ + pos] = (f32x2_t){bgate[lane], brs[lane >> 1]};
            int* ts = (int*)(p->ws + WS_TSEL) + tok * 4 + (lane & 1) * 2; ts[0] = mye; ts[1] = pos;
        }
        __syncthreads();
    }
}

__device__ __forceinline__ void moe_table(KArgs p, int l, LAS int* tbl, int wv) {
    if (otid(wv) == 0) { const unsigned* cnt = (const unsigned*)(p->ws + WS_CTL) + CW_CNT + l * 16 * 64; int acc = 0;
        for (int e = 0; e < 16; ++e) { const int n = (int)cnt[e * 64]; tbl[e] = acc; tbl[17 + e] = n; acc += (n + 255) >> 8; } tbl[16] = acc; }
    __syncthreads();
}

constexpr int N_PHASES = 2 + 7 * DEPTH;
__device__ __forceinline__ int opq(int v) { asm volatile("" : "+s"(v)); return v; }
__device__ __forceinline__ LAS unsigned char* opq(LAS unsigned char* v) { unsigned x = (unsigned)(uintptr_t)v; asm volatile("" : "+s"(x)); return (LAS unsigned char*)(uintptr_t)x; }
__global__ void __launch_bounds__(512, 2) trunk_fwd(Params pk) {
    extern __shared__ __attribute__((aligned(16))) unsigned char lds_raw[];
    LAS unsigned char* lds = (LAS unsigned char*)lds_raw;
    volatile LAS unsigned* MISC = (volatile LAS unsigned*)(lds + MISC_OFF);
    LAS int* mtbl = (LAS int*)(lds + MISC_OFF + 256);
#define p kparams()
    const int wv = __builtin_amdgcn_readfirstlane((int)threadIdx.x >> 6);
    for (int u = threadIdx.x; u < (LDS_BYTES - MISC_OFF) / 4; u += 512) ((LAS unsigned*)(lds + MISC_OFF))[u] = 0u;
    __syncthreads();
    unsigned* ctl = (unsigned*)(p->ws + WS_CTL);
    XcdBarrier bar; bar.bar = ctl + CW_BAR; bar.x = 0; bar.st = nullptr; bar.wv = wv;
    const bool multi = (p->ph_hi - p->ph_lo) > 1;
    if (multi) bar = xcd_barrier_post(ctl + CW_BAR, MISC + 8, wv);
    const int lo = p->ph_lo, hi = p->ph_hi;
#define IN(k) (lo <= (k) && (k) < hi)
#define SEAM(k) do { if (IN(k) && IN((k) + 1)) xcd_barrier(bar); } while (0)
    const int G0 = gridDim.x, c0 = blockIdx.x; LAS unsigned char* const lds0 = lds;
#define PHASE_LOCALS const int G = opq(G0), c = opq(c0); LAS unsigned char* const lds = opq(lds0); LAS int* const mtbl = (LAS int*)(lds + MISC_OFF + 256); volatile LAS unsigned* const MISC = (volatile LAS unsigned*)(lds + MISC_OFF); (void)G; (void)c; (void)mtbl; (void)MISC;

    if (PK(0) && IN(0)) { PHASE_LOCALS phase_prologue(p, lds, wv); if (DUP_PHASE == 0) { __syncthreads(); phase_prologue(p, lds, wv); } SEAM(0); }
    for (int l = 0; l < DEPTH; ++l) {
        const int pb = 1 + 7 * l;
        if (PK(1) && IN(pb + 0)) { PHASE_LOCALS phase_norm1(p, l, lds, wv); if (DUP_PHASE == 1) { xcd_barrier(bar); phase_norm1(p, l, lds, wv, true); } SEAM(pb + 0); }
        if (PK(2) && IN(pb + 1)) { PHASE_LOCALS
            if (c < H_FOX) scan_head(p, c, l, lds, wv);
            for (int rep = 0; rep < (DUP_PHASE == 2 ? 2 : 1); ++rep) {
            { pg8::Gemm g{(const bf16_t*)(p->ws + (FP8_PROJ ? WS_OUTB8 : WS_OUTB)), (const bf16_t*)(p->ws + WS_WQK + (size_t)l * NQK * DM * (FP8_PROJ ? 1 : 2)), SEQ, NQK, FP8_PROJ ? DM / 2 : DM};
              pg8::StaticOrder S; S.init(SEQ, NQK, G, c);
              pg8::EpiQK E{(bf16_t*)(p->ws + WS_QKB), p->qnorm_diff + l * 64, p->knorm_diff + l * 64, p->qnorm_fox + l * 128, p->knorm_fox + l * 128, (LAS float*)(lds + TBL_OFF), (const float*)(p->ws + WS_RSTD), p->ws + WS_QKB8};
              pg8::gemm_phase<pg8::EpiQK, pg8::StaticOrder>(lds, g, S, E, wv); }
            { pg8::Gemm g{(const bf16_t*)(p->ws + WS_WV + (size_t)l * NV * DM * (FP8_PROJ ? 1 : 2)), (const bf16_t*)(p->ws + (FP8_PROJ ? WS_OUTB8 : WS_OUTB)), NV, SEQ, FP8_PROJ ? DM / 2 : DM};
              pg8::StaticOrder S; S.init(NV, SEQ, G, c);
              pg8::EpiVT E{(bf16_t*)(p->ws + WS_VT), SEQ, (const float*)(p->ws + WS_RSTD)};
              pg8::gemm_phase<pg8::EpiVT, pg8::StaticOrder>(lds, g, S, E, wv); }
            }
            SEAM(pb + 1);
        }
        if (PK(3) && IN(pb + 2)) { PHASE_LOCALS att::attention_phase(p, l, lds, MISC + 16, wv, l); if (DUP_PHASE == 3) { __syncthreads(); att::attention_phase(p, l, lds, MISC + 16, wv, l + 4, ATT_MASK2); } SEAM(pb + 2); }
        if (PK(4) && IN(pb + 3)) { PHASE_LOCALS
            pg8::Gemm g{(const bf16_t*)(p->ws + WS_MIX), (const bf16_t*)(p->ws + WS_WO + (size_t)l * DM * DM * (FP8_WOUT ? 1 : 2)), SEQ, DM, FP8_WOUT ? DM / 2 : DM};
            pg8::StaticOrder S; S.init(SEQ, DM, G, c);
            pg8::EpiResAdd E{(bf16_t*)(p->ws + WS_OUTB), 1.f, (unsigned*)(p->ws + WS_CTL) + CW_WOC + l * 32 * 64, p->ws + WS_OUTB8};
            pg8::gemm_phase<pg8::EpiResAdd, pg8::StaticOrder>(lds, g, S, E, wv);
        }
        if (PK(5) && IN(pb + 4)) { PHASE_LOCALS phase_route(p, l, lds, wv, l); if (DUP_PHASE == 5) { xcd_barrier(bar); phase_route(p, l, lds, wv, l + 4); } SEAM(pb + 4); }
        if (PK(6) && IN(pb + 5)) { PHASE_LOCALS
            moe_table(p, l, mtbl, wv);
            pg8::Gemm g{(const bf16_t*)(p->ws + WS_OUTB8), (const bf16_t*)(p->ws + WS_WGU + (size_t)l * NEXP * 1024 * DM), MOE_ROWS, NEXP * 1024, DM / 2};
            pg8::MoeOrder<4, true> S{mtbl, (const int*)(p->ws + WS_TOK), G, c, DM / 2};
            pg8::EpiGU E{p->ws + WS_ACT, (const float*)(p->ws + WS_GATE), mtbl, (unsigned*)(p->ws + WS_CTL) + CW_GUC + l * 80 * 64};
            for (int rep = 0; rep < (DUP_PHASE == 6 ? 2 : 1); ++rep)
            pg8::gemm_phase<pg8::EpiGU, pg8::MoeOrder<4, true>>(lds, g, S, E, wv);
        }
        if (PK(7) && IN(pb + 6)) { PHASE_LOCALS
            moe_table(p, l, mtbl, wv);
            pg8::Gemm g{(const bf16_t*)(p->ws + WS_ACT), (const bf16_t*)(p->ws + WS_WD + (size_t)l * NEXP * DM * FEXP), MOE_ROWS, NEXP * DM, FEXP / 2};
            pg8::DownOrder S{mtbl, (unsigned*)(p->ws + WS_CTL) + CW_GUC + l * 80 * 64, (unsigned*)(p->ws + WS_CTL) + CW_BAR + XB_TMO, G, c};
            pg8::EpiDown E{p->ws + WS_Y};
            pg8::gemm_phase<pg8::EpiDown, pg8::DownOrder>(lds, g, S, E, wv);
            SEAM(pb + 6);
        }
    }
    if (PK(1) && IN(N_PHASES - 1)) { PHASE_LOCALS phase_norm1(p, DEPTH, lds, wv); }
#undef IN
#undef SEAM
#undef PHASE_LOCALS
#undef p
}

extern "C" void kernel_launch(void* const* d_in, const int* in_sizes, int n_in, void* d_out, int out_size, void* d_ws, size_t ws_size, hipStream_t stream) {
    static int grid = 0;
    if (grid == 0) {
        if (n_in != 22 || in_sizes[0] != SEQ * DM || out_size != SEQ * DM || ws_size < WS_END) {
            fprintf(stderr, "kernel_launch: unexpected shapes (n_in %d, in0 %d, out %d, ws %zu < %zu); nothing launched\n", n_in, n_in > 0 ? in_sizes[0] : -1, out_size, ws_size, (size_t)WS_END); grid = -1; return; }
        int dev = 0, cus = 0, per_cu = 0;
        if (hipGetDevice(&dev) != hipSuccess || hipDeviceGetAttribute(&cus, hipDeviceAttributeMultiprocessorCount, dev) != hipSuccess) { grid = -1; return; }
        if (hipFuncSetAttribute((const void*)trunk_fwd, hipFuncAttributeMaxDynamicSharedMemorySize, LDS_BYTES) != hipSuccess) { fprintf(stderr, "kernel_launch: hipFuncSetAttribute failed\n"); grid = -1; return; }
        if (hipOccupancyMaxActiveBlocksPerMultiprocessor(&per_cu, (const void*)trunk_fwd, 512, LDS_BYTES) != hipSuccess || per_cu < 1)
            fprintf(stderr, "kernel_launch: note: occupancy query reports %d workgroups per CU\n", per_cu);
        (void)hipGetLastError();
        grid = cus;
    }
    if (grid < 0) return;
    if (hipMemsetAsync((char*)d_ws + WS_CTL, 0, CTL_ZERO_BYTES, stream) != hipSuccess) { fprintf(stderr, "kernel_launch: memset failed\n"); return; }
    Params hp{};
    const float** pp = (const float**)&hp;
    for (int i = 0; i < 22; ++i) pp[i] = (const float*)d_in[i];
    hp.out = (float*)d_out; hp.ws = (unsigned char*)d_ws;
#if MK_ONE_LAUNCH
    hp.ph_lo = 0; hp.ph_hi = N_PHASES;
    hipLaunchKernelGGL(trunk_fwd, dim3(grid), dim3(512), LDS_BYTES, stream, hp);
#else
    for (int ph = 0; ph < N_PHASES; ++ph) { hp.ph_lo = ph; hp.ph_hi = ph + 1; hipLaunchKernelGGL(trunk_fwd, dim3(grid), dim3(512), LDS_BYTES, stream, hp); }
#endif
    const hipError_t le = hipPeekAtLastError();
    if (le != hipSuccess) fprintf(stderr, "kernel_launch: launch failed: %s\n", hipGetErrorName(le));
}
```

```cpp
#include <hip/hip_runtime.h>
#include <cstdio>
#include <cstdint>

#ifndef MK_ONE_LAUNCH
#define MK_ONE_LAUNCH 1
#endif
#ifndef PHASE_MASK
#define PHASE_MASK 0xff
#endif
#define PK(k) (((PHASE_MASK) >> (k)) & 1)
#ifndef FP8_PROJ
#define FP8_PROJ 1
#endif
#ifndef FP8_WOUT
#define FP8_WOUT 1
#endif
#ifndef DUP_PHASE
#define DUP_PHASE -1
#endif
#ifndef ATT_MASK2
#define ATT_MASK2 7
#endif
#ifndef SKIP_A
#define SKIP_A 1
#endif
#ifndef SKIP_B
#define SKIP_B 3
#endif
#ifndef SKIP_C
#define SKIP_C 1
#endif

#define GAS __attribute__((address_space(1)))
#define LAS __attribute__((address_space(3)))
typedef unsigned short bf16_t;
typedef short bf16x8 __attribute__((ext_vector_type(8)));
typedef float f32x4 __attribute__((ext_vector_type(4)));
typedef float f32x16 __attribute__((ext_vector_type(16)));
typedef unsigned u32x4 __attribute__((ext_vector_type(4)));
typedef unsigned u32x2 __attribute__((ext_vector_type(2)));
typedef int i32x4 __attribute__((ext_vector_type(4)));

constexpr int SEQ = 8192, DM = 2048, DEPTH = 4, NQK = 4096, NV = 2048, NEXP = 16, FEXP = 512, NIN = 6149;
constexpr int HD = 128, H_DIFF = 6, H_SB = 5, H_FOX = 5;
constexpr float EPS = 1e-6f;
constexpr float LOG2E = 1.4426950408889634f;
constexpr int MOE_ROWS = 16384 + 16 * 256;

constexpr size_t MiB = 1u << 20;
constexpr size_t WS_CTL = 0, CTL_ZERO_BYTES = 1 * MiB;
constexpr size_t WS_WF = 1 * MiB;
constexpr size_t WS_LAM = 1 * MiB + 512 * 1024;
constexpr size_t WS_LOGF = 2 * MiB;
constexpr size_t WS_DC2 = 3 * MiB;
constexpr size_t WS_TOK = 4 * MiB;
constexpr size_t WS_GATE = 5 * MiB;
constexpr size_t WS_TSEL = 6 * MiB;
constexpr size_t WS_WRT = 7 * MiB;
constexpr size_t WS_RSTD = 8 * MiB;
constexpr size_t WS_WQK = 16 * MiB;
constexpr size_t WS_WV = 80 * MiB;
constexpr size_t WS_WO = 112 * MiB;
constexpr size_t WS_WGU = 144 * MiB;
constexpr size_t WS_WD = 400 * MiB;
constexpr size_t WS_XN = 528 * MiB;
constexpr size_t WS_QKB = 560 * MiB;
constexpr size_t WS_VT = 624 * MiB;
constexpr size_t WS_MIX = 656 * MiB;
constexpr size_t WS_ACT = 688 * MiB;
constexpr size_t WS_Y = 708 * MiB;
constexpr size_t WS_PART = 788 * MiB;
constexpr size_t WS_OUTB = 828 * MiB;
constexpr size_t WS_OUTB8 = 862 * MiB;
constexpr size_t WS_QKB8 = 878 * MiB;
constexpr size_t WS_END = 910 * MiB;
constexpr int CW_BAR = 4096;
constexpr int CW_ATTQ = 16384;
constexpr int CW_CNT = 32768;
constexpr int CW_AFLAG = 65536;
constexpr int CW_WOC = 233472;
constexpr int CW_GUC = 212992;

constexpr int RING_BYTES = 131072;
constexpr int TBL_OFF = RING_BYTES;
constexpr int MISC_OFF = RING_BYTES + 8192;
constexpr int LDS_BYTES = 147456;

typedef float f32x2_t __attribute__((ext_vector_type(2)));
typedef __bf16 bf16x2_t __attribute__((ext_vector_type(2)));
typedef int i32x8 __attribute__((ext_vector_type(8)));
__device__ __forceinline__ unsigned cvt4f8(float a, float b, float c, float d) {
    int w = 0; w = __builtin_amdgcn_cvt_pk_fp8_f32(a, b, w, false); w = __builtin_amdgcn_cvt_pk_fp8_f32(c, d, w, true); return (unsigned)w; }
constexpr float W8_SCALE = 256.f, ACT8_SCALE = 4.f, Y8_SCALE = 32.f;
__device__ __forceinline__ unsigned cvtpk(float lo, float hi) { const f32x2_t v = {lo, hi}; const bf16x2_t b = __builtin_convertvector(v, bf16x2_t); return __builtin_bit_cast(unsigned, b); }
__device__ __forceinline__ float bf_lo(unsigned u) { return __uint_as_float(u << 16); }
__device__ __forceinline__ float bf_hi(unsigned u) { return __uint_as_float(u & 0xffff0000u); }
__device__ __forceinline__ float fexp2(float x) { return __builtin_amdgcn_exp2f(x); }
__device__ __forceinline__ float flog2(float x) { return __builtin_amdgcn_logf(x); }
__device__ __forceinline__ int otid(int wv) { int t; asm volatile("v_mbcnt_lo_u32_b32 %0, -1, 0\n\tv_mbcnt_hi_u32_b32 %0, -1, %0" : "=v"(t)); return wv * 64 + t; }
template <int M> __device__ __forceinline__ float swz_xor(float v) { return __int_as_float(__builtin_amdgcn_ds_swizzle(__float_as_int(v), 0x1F | (M << 10))); }
__device__ __forceinline__ float sum_xor32(float v) { auto rr = __builtin_amdgcn_permlane32_swap(__float_as_uint(v), __float_as_uint(v), false, false); return __uint_as_float(rr[0]) + __uint_as_float(rr[1]); }
__device__ __forceinline__ float wave_sum(float v) {
    v += swz_xor<1>(v); v += swz_xor<2>(v); v += swz_xor<4>(v); v += swz_xor<8>(v); v += swz_xor<16>(v);
    return sum_xor32(v);
}

namespace pg8 {
constexpr int BM = 256, BK = 64, HALF = 128, HTB = HALF * BK * 2, STAGE_BYTES = 8 * HTB, NXCD = 8, WGM = 8;
__host__ __device__ __forceinline__ int lds_byte(int r, int c) { const int st = (r >> 4) * 2 + (c >> 5), rr = r & 15, cc = c & 31, ob = rr * 64 + cc * 2; return st * 1024 + (ob ^ (((ob >> 9) & 1) << 5)); }
__host__ __device__ __forceinline__ void stage_rc(int b, int& R, int& C) { const int st = b / 1024, sb = b % 1024, swz = sb ^ (((sb >> 9) & 1) << 5); R = (st >> 1) * 16 + swz / 64; C = (st & 1) * 32 + (swz % 64) / 2; }
__host__ __device__ __forceinline__ int perm32(int rho) { const int n = rho >> 4, i = rho & 15; return 8 * (i >> 2) + 4 * n + (i & 3); }
__host__ __device__ __forceinline__ int permV(int rho) { const int n = rho >> 4, i = rho & 15; return 16 * (i >> 3) + 8 * n + (i & 7); }
template <int P> __host__ __device__ __forceinline__ int permf(int rho) { return P == 1 ? perm32(rho) : (P == 2 ? permV(rho) : rho); }

struct Unit { int pm, pn, e, rt; };
struct Gemm { const bf16_t* A; const bf16_t* Bt; int M, N, K; };

struct StaticOrder {
    int nM, nN, nwg, G, c;
    __device__ void init(int M, int N, int G_, int c_) { nM = M / BM; nN = N / BM; nwg = nM * nN; G = G_; c = c_; }
    __device__ bool next(int i, Unit& u) const {
        const long L = (long)i * G + c; if (L >= nwg) return false;
        int wgid = (int)L; { const int q = nwg / NXCD, r = nwg % NXCD, xcd = wgid % NXCD, off = wgid / NXCD; wgid = (xcd < r ? xcd * (q + 1) : r * (q + 1) + (xcd - r) * q) + off; }
        const int nig = WGM * nN, gid = wgid / nig, fm = gid * WGM, gsz = (nM - fm) < WGM ? (nM - fm) : WGM;
        u.pm = fm + ((wgid % nig) % gsz); u.pn = (wgid % nig) / gsz; u.e = 0; u.rt = 0; return true;
    }
    __device__ __forceinline__ size_t a_base(const Unit& u, size_t tstep) const { return (size_t)u.pm * tstep; }
    __device__ __forceinline__ unsigned row_off(const Unit&, int r, int K) const { return (unsigned)(r * K) * 2u; }
    __device__ __forceinline__ void a_ready(const Unit&, int) const {}
};

template <int NCT, bool GATHER> struct MoeOrder {
    const LAS int* tbl; const int* tok; int G, c, K;
    __device__ bool next(int i, Unit& u) const {
        const int L = i * G + c, total = __builtin_amdgcn_readfirstlane(tbl[16]) * NCT; if (L >= total) return false;
        const int g = L / NCT, ct = L % NCT; int e = 0;
#pragma unroll
        for (int k = 1; k < 16; ++k) e += (g >= tbl[k]) ? 1 : 0;
        e = __builtin_amdgcn_readfirstlane(e);
        u.pm = g; u.pn = e * NCT + ct; u.e = e; u.rt = __builtin_amdgcn_readfirstlane(g - tbl[e]); return true;
    }
    __device__ __forceinline__ size_t a_base(const Unit& u, size_t tstep) const { return GATHER ? 0 : (size_t)u.pm * tstep; }
    __device__ __forceinline__ unsigned row_off(const Unit& u, int r, int K_) const {
        if (!GATHER) return (unsigned)(r * K_) * 2u;
        const int pos = u.rt * 256 + r; const int n = __builtin_amdgcn_readfirstlane(tbl[17 + u.e]);
        const int t = pos < n ? tok[u.e * SEQ + pos] : 0;
        return (unsigned)(t * K_) * 2u;
    }
    __device__ __forceinline__ void a_ready(const Unit&, int) const {}
};

struct DownOrder {
    const LAS int* tbl; unsigned* cnt; unsigned* tmo; int G, c;
    __device__ bool next(int i, Unit& u) const {
        const int T = __builtin_amdgcn_readfirstlane(tbl[16]);
        const int U1 = 4 * T, nb2 = U1 > G ? U1 - G : 0, F = G - nb2;
        const int g1 = T < (G >> 2) ? T : (G >> 2), E = 8 * g1, Lt = 8 * (T - g1);
        int k = -1, late = 0;
        int ii = i;
        if (c >= nb2) { const int cf = c - nb2; const int nE = E > cf ? (E - cf + F - 1) / F : 0; if (ii < nE) k = cf + ii * F; else ii -= nE; }
        int g, ct;
        if (k >= 0) { g = k >> 3; ct = k & 7; }
        else { const int k0 = (c - nb2 + G) % G; const int kk = k0 + ii * G; if (kk >= Lt) return false; g = g1 + (kk >> 3); ct = kk & 7; late = 1; }
        (void)late;
        int e = 0;
#pragma unroll
        for (int q = 1; q < 16; ++q) e += (g >= tbl[q]) ? 1 : 0;
        e = __builtin_amdgcn_readfirstlane(e);
        u.pm = g; u.pn = e * 8 + ct; u.e = e; u.rt = __builtin_amdgcn_readfirstlane(g - tbl[e]); return true;
    }
    __device__ __forceinline__ size_t a_base(const Unit& u, size_t tstep) const { return (size_t)u.pm * tstep; }
    __device__ __forceinline__ unsigned row_off(const Unit&, int r, int K_) const { return (unsigned)(r * K_) * 2u; }
    __device__ __forceinline__ void a_ready(const Unit& u, int wid) const {
        if (wid == 0) {
            unsigned sp = 0;
            while ((unsigned)__builtin_amdgcn_readfirstlane((int)__hip_atomic_load(cnt + 64 * u.pm, __ATOMIC_RELAXED, __HIP_MEMORY_SCOPE_AGENT)) < 32u) {
                __builtin_amdgcn_s_sleep(2);
                if (++sp > (1u << 22)) { __hip_atomic_store(tmo, 1u, __ATOMIC_RELAXED, __HIP_MEMORY_SCOPE_AGENT); break; }
            }
            __builtin_amdgcn_fence(__ATOMIC_ACQUIRE, "agent");
            asm volatile("s_waitcnt vmcnt(0)" ::: "memory");
        }
        asm volatile("" ::: "memory"); __builtin_amdgcn_s_barrier(); asm volatile("" ::: "memory");
    }
};

template <class Epi, class Sched, bool SP2 = true>
__device__ __forceinline__ void gemm_phase(LAS unsigned char* lds, const Gemm g, const Sched& S, const Epi& E, int wv) {
    const int tid = otid(wv), wid = __builtin_amdgcn_readfirstlane(tid >> 6), lane = tid & 63, wr = wid >> 2, wc = wid & 3, fr = lane & 15, fq = lane >> 4;
    const int K = g.K, nt = K / BK;
    unsigned voffB[2]; int Rr[2], Cc[2];
#pragma unroll
    for (int i = 0; i < 2; ++i) { int R, C; stage_rc(tid * 16 + i * 8192, R, C); const int Rb = (R & ~31) + permf<Epi::PERM>(R & 31);
        Rr[i] = R; Cc[i] = C; voffB[i] = (unsigned)(Rb * K + C) * 2u; }
    const size_t kstep = (size_t)(BK * 2);
    const size_t hstep = (size_t)HALF * K * 2;
    const size_t tstep = 2 * hstep;
    const unsigned ldsw = (unsigned)wid * 1024u;
    const int aoff = lds_byte(wr * 64 + fr, fq * 8), boff = lds_byte(wc * 32 + fr, fq * 8);
#define PG8_SA(b, h) (((b) * 2 + (h)) * HTB)
#define PG8_SB(b, h) ((4 + (b) * 2 + (h)) * HTB)
#define PG8_STAGE(bufoff, gbase, voff) do { _Pragma("unroll") for (int _i = 0; _i < 2; ++_i) \
        __builtin_amdgcn_global_load_lds((const unsigned*)((const char*)(gbase) + (voff)[_i]), (LAS unsigned*)(lds + (bufoff) + ldsw + _i * 8192), 16, 0, 0); } while (0)
#define PG8_LDA(dst, b, h) do { _Pragma("unroll") for (int m = 0; m < 4; ++m) _Pragma("unroll") for (int k = 0; k < 2; ++k) dst[m][k] = *(const LAS bf16x8*)(lds + PG8_SA(b, h) + aoff + m * 2048 + k * 1024); } while (0)
#define PG8_LDB(dst, b, h) do { _Pragma("unroll") for (int n = 0; n < 2; ++n) _Pragma("unroll") for (int k = 0; k < 2; ++k) dst[n][k] = *(const LAS bf16x8*)(lds + PG8_SB(b, h) + boff + n * 2048 + k * 1024); } while (0)
#define PG8_CAT(x) __builtin_shufflevector(__builtin_bit_cast(i32x4, (x)[0]), __builtin_bit_cast(i32x4, (x)[1]), 0, 1, 2, 3, 4, 5, 6, 7)
#define PG8_MMA(ai, bj, At, Bt) do { __builtin_amdgcn_s_setprio(1); \
        if constexpr (Epi::FP8) { _Pragma("unroll") for (int m = 0; m < 4; ++m) _Pragma("unroll") for (int n = 0; n < 2; ++n) \
            asm volatile("v_mfma_scale_f32_16x16x128_f8f6f4 %0, %1, %2, %0, %3, %3 op_sel_hi:[0,0,0]" : "+v"(acc[ai][bj][m][n]) : "v"(PG8_CAT(Bt[n])), "v"(PG8_CAT(At[m])), "v"(one8)); } \
        else { _Pragma("unroll") for (int m = 0; m < 4; ++m) _Pragma("unroll") for (int n = 0; n < 2; ++n) _Pragma("unroll") for (int k = 0; k < 2; ++k) \
            acc[ai][bj][m][n] = __builtin_amdgcn_mfma_f32_16x16x32_bf16(Bt[n][k], At[m][k], acc[ai][bj][m][n], 0, 0, 0); } \
        __builtin_amdgcn_s_setprio(0); } while (0)
#define PG8_WAIT_V(n) asm volatile("s_waitcnt vmcnt(" #n ")" ::: "memory")
#define PG8_WAIT_L(n) asm volatile("s_waitcnt lgkmcnt(" #n ")" ::: "memory")
#define PG8_BAR __builtin_amdgcn_s_barrier()
#define PG8_SCHED __builtin_amdgcn_sched_barrier(0)
    Unit cur, nxt; int ui = 0;
    if (!S.next(0, cur)) return;
    const unsigned one8 = 0x7F7F7F7Fu;
    (void)one8;
    f32x4 acc[2][2][4][2];
    if constexpr (Epi::LOAD_INIT) E.init(acc, cur, wr, wc, fr, fq);
    else {
#pragma unroll
    for (int a = 0; a < 2; ++a)
#pragma unroll
        for (int b = 0; b < 2; ++b)
#pragma unroll
            for (int m = 0; m < 4; ++m)
#pragma unroll
                for (int n = 0; n < 2; ++n) acc[a][b][m][n] = (f32x4){0.f, 0.f, 0.f, 0.f};
    }
    bf16x8 At[4][2], B0[2][2], B1[2][2];
    unsigned oc[2][2], on[2][2];
#pragma unroll
    for (int h = 0; h < 2; ++h)
#pragma unroll
        for (int i = 0; i < 2; ++i) { oc[h][i] = S.row_off(cur, h * HALF + Rr[i], K) + (unsigned)Cc[i] * 2u; on[h][i] = oc[h][i]; }
    const char* cA = (const char*)g.A + S.a_base(cur, tstep); const char* cB = (const char*)g.Bt + (size_t)cur.pn * tstep;
    S.a_ready(cur, wid);
    if constexpr (SP2) {
        PG8_STAGE(PG8_SB(0, 0), cB, voffB); PG8_STAGE(PG8_SB(0, 1), cB + hstep, voffB); PG8_STAGE(PG8_SA(0, 0), cA, oc[0]); PG8_STAGE(PG8_SA(0, 1), cA, oc[1]);
        if (wr == 1) PG8_BAR;
        PG8_WAIT_V(2); PG8_BAR;
        PG8_STAGE(PG8_SB(1, 0), cB + kstep, voffB); PG8_STAGE(PG8_SA(1, 0), cA + kstep, oc[0]); PG8_STAGE(PG8_SB(1, 1), cB + hstep + kstep, voffB);
        PG8_WAIT_V(6); PG8_BAR;
    } else {
        PG8_STAGE(PG8_SB(0, 0), cB, voffB); PG8_STAGE(PG8_SA(0, 0), cA, oc[0]); PG8_STAGE(PG8_SB(0, 1), cB + hstep, voffB); PG8_STAGE(PG8_SA(0, 1), cA, oc[1]);
        if (wr == 1) PG8_BAR;
        PG8_WAIT_V(4); PG8_BAR;
        PG8_STAGE(PG8_SB(1, 0), cB + kstep, voffB); PG8_STAGE(PG8_SA(1, 0), cA + kstep, oc[0]); PG8_STAGE(PG8_SB(1, 1), cB + hstep + kstep, voffB);
        PG8_WAIT_V(6); PG8_BAR;
    }
    for (;;) {
        const bool has_next = S.next(ui + 1, nxt);
        const char* nA = has_next ? (const char*)g.A + S.a_base(nxt, tstep) : cA; const char* nB = has_next ? (const char*)g.Bt + (size_t)nxt.pn * tstep : cB;
        if (has_next) {
#pragma unroll
            for (int h = 0; h < 2; ++h)
#pragma unroll
                for (int i = 0; i < 2; ++i) on[h][i] = S.row_off(nxt, h * HALF + Rr[i], K) + (unsigned)Cc[i] * 2u;
        }
        for (int t = 0; t < nt; t += 2) {
            const bool last = (t == nt - 2);
            if (last && has_next) S.a_ready(nxt, wid);
            const char* a1 = cA + (size_t)(t + 1) * kstep;
            const char* a2 = last ? nA : cA + (size_t)(t + 2) * kstep; const char* b2 = last ? nB : cB + (size_t)(t + 2) * kstep;
            const char* a3 = a2 + kstep; const char* b3 = b2 + kstep;
            unsigned o2a[2], o2b[2];
            o2a[0] = last ? on[0][0] : oc[0][0]; o2a[1] = last ? on[0][1] : oc[0][1]; o2b[0] = last ? on[1][0] : oc[1][0]; o2b[1] = last ? on[1][1] : oc[1][1];
            if constexpr (SP2) {
            PG8_LDB(B0, 0, 0); PG8_LDB(B1, 0, 1); PG8_SCHED; PG8_LDA(At, 0, 0); PG8_STAGE(PG8_SA(1, 1), a1, oc[1]);
            PG8_WAIT_V(8); PG8_WAIT_L(0); PG8_BAR; PG8_MMA(0, 0, At, B0); PG8_MMA(0, 1, At, B1); PG8_BAR; PG8_SCHED;
            PG8_LDA(At, 0, 1); PG8_STAGE(PG8_SB(0, 0), b2, voffB); PG8_STAGE(PG8_SB(0, 1), b2 + hstep, voffB); PG8_STAGE(PG8_SA(0, 0), a2, o2a);
            PG8_WAIT_V(8); PG8_WAIT_L(0); PG8_BAR; PG8_MMA(1, 0, At, B0); PG8_MMA(1, 1, At, B1); PG8_BAR; PG8_SCHED;
            PG8_LDB(B0, 1, 0); PG8_LDB(B1, 1, 1); PG8_SCHED; PG8_LDA(At, 1, 0); PG8_STAGE(PG8_SA(0, 1), a2, o2b);
            PG8_WAIT_V(8); PG8_WAIT_L(0); PG8_BAR; PG8_MMA(0, 0, At, B0); PG8_MMA(0, 1, At, B1); PG8_BAR; PG8_SCHED;
            PG8_LDA(At, 1, 1); PG8_STAGE(PG8_SB(1, 0), b3, voffB); PG8_STAGE(PG8_SB(1, 1), b3 + hstep, voffB); PG8_STAGE(PG8_SA(1, 0), a3, o2a);
            PG8_WAIT_V(8); PG8_WAIT_L(0); PG8_BAR; PG8_MMA(1, 0, At, B0); PG8_MMA(1, 1, At, B1); PG8_BAR; PG8_SCHED;
            } else {
            PG8_LDB(B0, 0, 0); PG8_SCHED; PG8_LDA(At, 0, 0); PG8_STAGE(PG8_SA(1, 1), a1, oc[1]);
            PG8_WAIT_L(8); PG8_BAR; PG8_WAIT_L(0); PG8_MMA(0, 0, At, B0); PG8_BAR; PG8_SCHED;
            PG8_LDB(B1, 0, 1); PG8_STAGE(PG8_SB(0, 0), b2, voffB);
            PG8_BAR; PG8_WAIT_L(0); PG8_MMA(0, 1, At, B1); PG8_BAR;
            PG8_LDA(At, 0, 1); PG8_STAGE(PG8_SA(0, 0), a2, o2a);
            PG8_BAR; PG8_WAIT_L(0); PG8_MMA(1, 0, At, B0); PG8_BAR; PG8_SCHED;
            PG8_STAGE(PG8_SB(0, 1), b2 + hstep, voffB);
            PG8_WAIT_V(6); PG8_BAR; PG8_MMA(1, 1, At, B1); PG8_BAR;
            PG8_LDB(B0, 1, 0); PG8_SCHED; PG8_LDA(At, 1, 0); PG8_STAGE(PG8_SA(0, 1), a2, o2b);
            PG8_WAIT_L(8); PG8_BAR; PG8_WAIT_L(0); PG8_MMA(0, 0, At, B0); PG8_BAR; PG8_SCHED;
            PG8_LDB(B1, 1, 1); PG8_STAGE(PG8_SB(1, 0), b3, voffB);
            PG8_BAR; PG8_WAIT_L(0); PG8_MMA(0, 1, At, B1); PG8_BAR;
            PG8_LDA(At, 1, 1); PG8_STAGE(PG8_SA(1, 0), a3, o2a);
            PG8_BAR; PG8_WAIT_L(0); PG8_MMA(1, 0, At, B0); PG8_BAR; PG8_SCHED;
            PG8_STAGE(PG8_SB(1, 1), b3 + hstep, voffB);
            PG8_WAIT_V(6); PG8_BAR; PG8_MMA(1, 1, At, B1); PG8_BAR;
            }
        }
        if (wr == 0) PG8_BAR;
        if constexpr (Epi::FP8) asm volatile("s_nop 15\n\ts_nop 15" ::: "memory");
        { const int tz = otid(wv) & 63; E(acc, cur, wr, wc, tz & 15, tz >> 4); }
        if (!has_next) break;
#pragma unroll
        for (int a = 0; a < 2; ++a)
#pragma unroll
            for (int b = 0; b < 2; ++b)
#pragma unroll
                for (int m = 0; m < 4; ++m)
#pragma unroll
                    for (int n = 0; n < 2; ++n) acc[a][b][m][n] = (f32x4){0.f, 0.f, 0.f, 0.f};
        if constexpr (Epi::LOAD_INIT) { const int tz2 = otid(wv) & 63; E.init(acc, nxt, wr, wc, tz2 & 15, tz2 >> 4); }
        cur = nxt; cA = nA; cB = nB; ++ui;
#pragma unroll
        for (int h = 0; h < 2; ++h)
#pragma unroll
            for (int i = 0; i < 2; ++i) oc[h][i] = on[h][i];
        if (wr == 1) PG8_BAR;
    }
    PG8_WAIT_V(0);
    PG8_BAR;
#undef PG8_SA
#undef PG8_SB
#undef PG8_STAGE
#undef PG8_LDA
#undef PG8_LDB
#undef PG8_MMA
#undef PG8_CAT
#undef PG8_WAIT_V
#undef PG8_WAIT_L
#undef PG8_BAR
#undef PG8_SCHED
}


struct EpiQK {
    static constexpr int PERM = 1; static constexpr bool LOAD_INIT = false; static constexpr bool FP8 = (FP8_PROJ != 0);
    bf16_t* O; const float *gqd, *gkd, *gqf, *gkf; LAS float* tbl; const float* rstd; unsigned char* O8;
    __device__ __forceinline__ void operator()(const f32x4 (&acc)[2][2][4][2], const Unit& u, int wr, int wc, int fr, int fq) const {
#pragma unroll
        for (int ai = 0; ai < 2; ++ai)
#pragma unroll
            for (int m = 0; m < 4; ++m)
#pragma unroll
                for (int bj = 0; bj < 2; ++bj) {
                    const f32x4 a = acc[ai][bj][m][0], b = acc[ai][bj][m][1];
                    float ss = (a[0] * a[0] + a[1] * a[1]) + (a[2] * a[2] + a[3] * a[3]) + (b[0] * b[0] + b[1] * b[1]) + (b[2] * b[2] + b[3] * b[3]);
                    ss += swz_xor<16>(ss); ss = sum_xor32(ss);
                    if (fq == 0) tbl[(bj * 256 + ai * 128 + wr * 64 + m * 16 + fr) * 4 + wc] = FP8 ? ss * (1.f / (W8_SCALE * W8_SCALE)) : ss;
                }
        asm volatile("s_waitcnt lgkmcnt(0)" ::: "memory"); __builtin_amdgcn_s_barrier(); asm volatile("" ::: "memory");
        const int colh = wc * 32 + fq * 8;
#pragma unroll
        for (int bj = 0; bj < 2; ++bj) {
            const int hh = u.pn * 2 + bj;
            int mode; const float* gp; float extra;
            if (hh < 6) { mode = 0; gp = gqd + (colh & 63); extra = 0.125f * LOG2E * 4.f; }
            else if (hh < 12) { mode = 0; gp = gkd + (colh & 63); extra = 0.25f; }
            else if (hh < 17) { mode = 1; gp = gqf + colh; extra = 0.08838834764831845f * LOG2E * 4.f; }
            else if (hh < 22) { mode = 1; gp = gkf + colh; extra = 0.25f; }
            else if (hh < 27) { mode = 2; gp = gqd; extra = 0.08838834764831845f * LOG2E; }
            else { mode = 2; gp = gqd; extra = 1.f; }
            f32x4 g0 = (f32x4){1.f, 1.f, 1.f, 1.f}, g1 = g0;
            if (mode != 2) { g0 = *(const f32x4*)gp; g1 = *(const f32x4*)(gp + 4); }
            g0 = g0 * (FP8 ? extra * (1.f / W8_SCALE) : extra); g1 = g1 * (FP8 ? extra * (1.f / W8_SCALE) : extra);
#pragma unroll
            for (int ai = 0; ai < 2; ++ai)
#pragma unroll
                for (int m = 0; m < 4; ++m) {
                    const int rl = ai * 128 + wr * 64 + m * 16 + fr;
                    const float rr = rstd[u.pm * 256 + rl];
                    float rs = rr;
                    if (mode != 2) {
                        const f32x4 t = *(const LAS f32x4*)(tbl + (bj * 256 + rl) * 4);
                        const float tot = (mode == 0) ? ((wc < 2) ? (t[0] + t[1]) : (t[2] + t[3])) : ((t[0] + t[1]) + (t[2] + t[3]));
                        rs = rr * __builtin_amdgcn_rsqf(rr * rr * tot * (mode == 0 ? (1.f / 64.f) : (1.f / 128.f)) + EPS);
                    }
                    const f32x4 v0 = acc[ai][bj][m][0] * g0 * rs, v1 = acc[ai][bj][m][1] * g1 * rs;
                    if (mode != 2) { u32x2 w8; w8.x = cvt4f8(v0[0], v0[1], v0[2], v0[3]); w8.y = cvt4f8(v1[0], v1[1], v1[2], v1[3]);
                        *(u32x2*)(O8 + (size_t)(u.pm * 256 + rl) * NQK + u.pn * 256 + bj * 128 + colh) = w8; continue; }
                    u32x4 w; w.x = cvtpk(v0[0], v0[1]); w.y = cvtpk(v0[2], v0[3]); w.z = cvtpk(v1[0], v1[1]); w.w = cvtpk(v1[2], v1[3]);
                    *(u32x4*)(O + (size_t)(u.pm * 256 + rl) * NQK + u.pn * 256 + bj * 128 + colh) = w;
                }
        }
    }
};
struct EpiVT {
    static constexpr int PERM = 2; static constexpr bool LOAD_INIT = false; static constexpr bool FP8 = (FP8_PROJ != 0);
    bf16_t* O; int ldc; const float* rstd;
    __device__ __forceinline__ void operator()(const f32x4 (&acc)[2][2][4][2], const Unit& u, int wr, int wc, int fr, int fq) const {
        f32x4 r0[2], r1[2];
#pragma unroll
        for (int bj = 0; bj < 2; ++bj) { const float* rp = rstd + u.pn * 256 + bj * 128 + wc * 32 + 16 * (fq >> 1) + 4 * (fq & 1);
            r0[bj] = *(const f32x4*)rp; r1[bj] = *(const f32x4*)(rp + 8); if (FP8) { r0[bj] = r0[bj] * (1.f / W8_SCALE); r1[bj] = r1[bj] * (1.f / W8_SCALE); } }
#pragma unroll
        for (int ai = 0; ai < 2; ++ai)
#pragma unroll
            for (int m = 0; m < 4; ++m)
#pragma unroll
                for (int bj = 0; bj < 2; ++bj) {
                    const f32x4 v0 = acc[ai][bj][m][0] * r0[bj], v1 = acc[ai][bj][m][1] * r1[bj];
                    u32x4 w; w.x = cvtpk(v0[0], v0[1]); w.y = cvtpk(v0[2], v0[3]); w.z = cvtpk(v1[0], v1[1]); w.w = cvtpk(v1[2], v1[3]);
                    *(u32x4*)(O + (size_t)(u.pm * 256 + ai * 128 + wr * 64 + m * 16 + fr) * ldc + u.pn * 256 + bj * 128 + wc * 32 + fq * 8) = w;
                }
    }
};
struct EpiResAdd {
    static constexpr int PERM = 1; static constexpr bool LOAD_INIT = true; static constexpr bool FP8 = (FP8_WOUT != 0);
    bf16_t* X; float sc; unsigned* done; unsigned char* X8;
    __device__ __forceinline__ void init(f32x4 (&acc)[2][2][4][2], const Unit& u, int wr, int wc, int fr, int fq) const {
#pragma unroll
        for (int ai = 0; ai < 2; ++ai)
#pragma unroll
            for (int m = 0; m < 4; ++m)
#pragma unroll
                for (int bj = 0; bj < 2; ++bj) {
                    const u32x4 w = *(const u32x4*)(X + (size_t)(u.pm * 256 + ai * 128 + wr * 64 + m * 16 + fr) * DM + u.pn * 256 + bj * 128 + wc * 32 + fq * 8);
                    acc[ai][bj][m][0] = (f32x4){bf_lo(w.x), bf_hi(w.x), bf_lo(w.y), bf_hi(w.y)};
                    acc[ai][bj][m][1] = (f32x4){bf_lo(w.z), bf_hi(w.z), bf_lo(w.w), bf_hi(w.w)};
                    if (FP8) { acc[ai][bj][m][0] = acc[ai][bj][m][0] * W8_SCALE; acc[ai][bj][m][1] = acc[ai][bj][m][1] * W8_SCALE; }
                }
    }
    __device__ __forceinline__ void operator()(const f32x4 (&acc)[2][2][4][2], const Unit& u, int wr, int wc, int fr, int fq) const {
        const __amdgpu_buffer_rsrc_t rsrc = __builtin_amdgcn_make_buffer_rsrc((void*)X, 0, SEQ * DM * 2, 0x00020000);
        const __amdgpu_buffer_rsrc_t rsrc8 = __builtin_amdgcn_make_buffer_rsrc((void*)X8, 0, SEQ * DM, 0x00020000);
#pragma unroll
        for (int ai = 0; ai < 2; ++ai)
#pragma unroll
            for (int m = 0; m < 4; ++m)
#pragma unroll
                for (int bj = 0; bj < 2; ++bj) {
                    const f32x4 v0 = FP8 ? acc[ai][bj][m][0] * (1.f / W8_SCALE) : acc[ai][bj][m][0], v1 = FP8 ? acc[ai][bj][m][1] * (1.f / W8_SCALE) : acc[ai][bj][m][1];
                    u32x4 w; w.x = cvtpk(v0[0], v0[1]); w.y = cvtpk(v0[2], v0[3]); w.z = cvtpk(v1[0], v1[1]); w.w = cvtpk(v1[2], v1[3]);
                    u32x2 w8; w8.x = cvt4f8(v0[0], v0[1], v0[2], v0[3]); w8.y = cvt4f8(v1[0], v1[1], v1[2], v1[3]);
                    __builtin_amdgcn_raw_buffer_store_b64(w8, rsrc8, (int)((u.pm * 256 + ai * 128 + wr * 64 + m * 16 + fr) * DM + u.pn * 256 + bj * 128 + wc * 32 + fq * 8), 0, 16);
                    __builtin_amdgcn_raw_buffer_store_b128(w, rsrc, (int)(((u.pm * 256 + ai * 128 + wr * 64 + m * 16 + fr) * DM + u.pn * 256 + bj * 128 + wc * 32 + fq * 8) * 2), 0, 16);
                }
        asm volatile("s_waitcnt vmcnt(0)" ::: "memory");
        if (fr == 0 && fq == 0) __hip_atomic_fetch_add(done + 64 * u.pm, 1u, __ATOMIC_RELAXED, __HIP_MEMORY_SCOPE_AGENT);
    }
};
struct EpiGU {
    static constexpr int PERM = 1; static constexpr bool LOAD_INIT = false; static constexpr bool FP8 = true;
    unsigned char* ACT; const float* gate; const LAS int* tbl; unsigned* done;
    __device__ __forceinline__ void operator()(const f32x4 (&acc)[2][2][4][2], const Unit& u, int wr, int wc, int fr, int fq) const {
        const int ct = u.pn & 3, n_e = __builtin_amdgcn_readfirstlane(tbl[17 + u.e]);
        const __amdgpu_buffer_rsrc_t rsrc = __builtin_amdgcn_make_buffer_rsrc((void*)ACT, 0, MOE_ROWS * FEXP, 0x00020000);
#pragma unroll
        for (int ai = 0; ai < 2; ++ai)
#pragma unroll
            for (int m = 0; m < 4; ++m) {
                const int rl = ai * 128 + wr * 64 + m * 16 + fr, pos = u.rt * 256 + rl;
                f32x2_t gr2 = {0.f, 0.f}; if (pos < n_e) gr2 = *(const f32x2_t*)(gate + 2 * (u.e * SEQ + pos));
                const float gt = gr2[0] * ACT8_SCALE, rs = gr2[1] * (1.f / W8_SCALE);
                float o[8];
#pragma unroll
                for (int n = 0; n < 2; ++n)
#pragma unroll
                    for (int j = 0; j < 4; ++j) { const float gv = acc[ai][0][m][n][j] * rs, uv = acc[ai][1][m][n][j] * rs;
                        const float sg = gv * __builtin_amdgcn_rcpf(1.f + fexp2(-gv * LOG2E)); o[n * 4 + j] = sg * uv * gt; }
                u32x2 w; w.x = cvt4f8(o[0], o[1], o[2], o[3]); w.y = cvt4f8(o[4], o[5], o[6], o[7]);
                __builtin_amdgcn_raw_buffer_store_b64(w, rsrc, (int)((u.pm * 256 + rl) * FEXP + ct * 128 + wc * 32 + fq * 8), 0, 16);
            }
        asm volatile("s_waitcnt vmcnt(0)" ::: "memory");
        if (fr == 0 && fq == 0) __hip_atomic_fetch_add(done + 64 * u.pm, 1u, __ATOMIC_RELAXED, __HIP_MEMORY_SCOPE_AGENT);
    }
};
struct EpiDown {
    static constexpr int PERM = 1; static constexpr bool LOAD_INIT = false; static constexpr bool FP8 = true;
    unsigned char* Y;
    __device__ __forceinline__ void operator()(const f32x4 (&acc)[2][2][4][2], const Unit& u, int wr, int wc, int fr, int fq) const {
        const int ct = u.pn & 7;
#pragma unroll
        for (int ai = 0; ai < 2; ++ai)
#pragma unroll
            for (int m = 0; m < 4; ++m)
#pragma unroll
                for (int bj = 0; bj < 2; ++bj) {
                    const f32x4 v0 = acc[ai][bj][m][0] * (Y8_SCALE / (W8_SCALE * ACT8_SCALE)), v1 = acc[ai][bj][m][1] * (Y8_SCALE / (W8_SCALE * ACT8_SCALE));
                    u32x2 w; w.x = cvt4f8(v0[0], v0[1], v0[2], v0[3]); w.y = cvt4f8(v1[0], v1[1], v1[2], v1[3]);
                    *(u32x2*)(Y + (size_t)(u.pm * 256 + ai * 128 + wr * 64 + m * 16 + fr) * DM + ct * 256 + bj * 128 + wc * 32 + fq * 8) = w;
                }
    }
};
}

#define XB_TMO      128
#define XB_XCNT(j)  (256  + 64 * (j))
#define XB_XSUB(j)  (1280 + 64 * (j))
#define XB_XGEN(j)  (2304 + 64 * (j))
#define XB_TOP      3328
#define XB_TOPGEN   3392
#define XCD_BAR_WORDS 3456
#define XB_SPIN_CAP (1u << 18)

__device__ __forceinline__ unsigned xb_ld(unsigned* p)              { return __hip_atomic_load(p, __ATOMIC_RELAXED, __HIP_MEMORY_SCOPE_AGENT); }
__device__ __forceinline__ unsigned xb_add(unsigned* p, unsigned v) { return __hip_atomic_fetch_add(p, v, __ATOMIC_RELAXED, __HIP_MEMORY_SCOPE_AGENT); }
__device__ __forceinline__ unsigned xb_xcc_id() { return (unsigned)__builtin_amdgcn_s_getreg((3 << 11) | 20) & 0xFu; }
#define XB_SPIN(cond, bar) do { unsigned _sp = 0; while (cond) { __builtin_amdgcn_s_sleep(1); \
    if ((++_sp & 255u) == 0u) { if (xb_ld(&(bar)[XB_TMO])) break; if (_sp > XB_SPIN_CAP) { atomicAdd(&(bar)[XB_TMO], 1u); break; } } } } while (0)

struct XcdBarrier { unsigned* bar; unsigned x; volatile LAS unsigned* st; int wv; };

__device__ __forceinline__ XcdBarrier xcd_barrier_post(unsigned* bar, volatile LAS unsigned* st, int wv) {
    XcdBarrier b; b.bar = bar; b.x = xb_xcc_id(); b.st = st; b.wv = wv;
    if (otid(wv) == 0) (void)xb_add(&bar[XB_XCNT(b.x)], 1u);
    return b;
}
__device__ __forceinline__ void xcd_barrier_complete(unsigned* bar, unsigned x, unsigned& nloc, unsigned& nx) {
    const unsigned G = gridDim.x * gridDim.y * gridDim.z;
    unsigned sum, cnt, mine, sp = 0u;
    for (;;) {
        sum = 0u; cnt = 0u; mine = 0u;
#pragma unroll
        for (unsigned j = 0; j < 16; ++j) { const unsigned c = xb_ld(&bar[XB_XCNT(j)]); sum += c; cnt += (c > 0u) ? 1u : 0u; mine = (j == x) ? c : mine; }
        if (sum == G) break;
        __builtin_amdgcn_s_sleep(1);
        if ((++sp & 255u) == 0u) { if (xb_ld(&bar[XB_TMO])) break; if (sp > XB_SPIN_CAP) { atomicAdd(&bar[XB_TMO], 1u); break; } }
    }
    nloc = mine > 0u ? mine : 1u; nx = cnt > 0u ? cnt : 1u;
}
__device__ __attribute__((noinline)) void xcd_barrier_impl(unsigned* bar_, unsigned bx, volatile LAS unsigned* bst, int bwv) {
    XcdBarrier b; b.bar = bar_; b.x = bx; b.st = bst; b.wv = bwv;
    asm volatile("s_waitcnt vmcnt(0)" ::: "memory");
    __syncthreads();
    if (otid(b.wv) == 0) {
        unsigned* bar = b.bar;
        __builtin_amdgcn_s_waitcnt(0);
        unsigned nloc = b.st[0], nx = b.st[1];
        if (nloc == 0u) { xcd_barrier_complete(bar, b.x, nloc, nx); b.st[0] = nloc; b.st[1] = nx; }
        const unsigned old = xb_add(&bar[XB_XSUB(b.x)], 1u);
        const unsigned gen = old / nloc;
        if (old + 1u == (gen + 1u) * nloc) {
            __builtin_amdgcn_fence(__ATOMIC_RELEASE, "agent");
            asm volatile("s_waitcnt vmcnt(0)" ::: "memory");
            const unsigned og = xb_add(&bar[XB_TOP], 1u);
            const unsigned tg = og / nx;
            if (og + 1u == (tg + 1u) * nx) xb_add(&bar[XB_TOPGEN], 1u);
            else XB_SPIN(xb_ld(&bar[XB_TOPGEN]) == tg, bar);
            __builtin_amdgcn_fence(__ATOMIC_ACQUIRE, "agent");
            xb_add(&bar[XB_XGEN(b.x)], 1u);
            asm volatile("s_waitcnt vmcnt(0)" ::: "memory");
        } else {
            XB_SPIN(xb_ld(&bar[XB_XGEN(b.x)]) == gen, bar);
            __builtin_amdgcn_fence(__ATOMIC_ACQUIRE, "agent");
            asm volatile("s_waitcnt vmcnt(0)" ::: "memory");
        }
    }
    __syncthreads();
}

__device__ __forceinline__ void xcd_barrier(const XcdBarrier& b) { xcd_barrier_impl(b.bar, b.x, b.st, b.wv); }

struct Params {
    const float *x, *attn_norm, *w_in, *b_forget, *qnorm_diff, *knorm_diff, *lam_q1, *lam_k1, *lam_q2, *lam_k2, *subln_diff, *onorm_sb,
        *qnorm_fox, *knorm_fox, *onorm_fox, *w_out, *ffn_norm, *w_router, *router_bias, *w_gate, *w_up, *w_down;
    float* out; unsigned char* ws; int ph_lo, ph_hi;
};
typedef const __attribute__((address_space(4))) Params* KArgs;
__device__ __forceinline__ KArgs kparams() { KArgs k = (KArgs)__builtin_amdgcn_kernarg_segment_ptr(); asm volatile("" : "+s"(k)); return k; }

__device__ __forceinline__ void transpose_item(const float* W, int ldn, int k0, int n0, bf16_t* WT, int K, int drow, LAS float* scr, int lane, const float* kgain = nullptr, bool f8 = false) {
#pragma unroll 8
    for (int i = 0; i < 32; ++i) { const int kk = 2 * i + (lane >> 5); scr[kk * 33 + (lane & 31)] = W[(size_t)(k0 + kk) * ldn + n0 + (lane & 31)]; }
    asm volatile("s_waitcnt lgkmcnt(0)" ::: "memory");
    const int c = lane & 7;
    f32x4 ga = {1.f, 1.f, 1.f, 1.f}, gb = ga;
    if (kgain) { ga = *(const f32x4*)(kgain + k0 + 8 * c); gb = *(const f32x4*)(kgain + k0 + 8 * c + 4); }
#pragma unroll
    for (int j = 0; j < 4; ++j) { const int n = (lane >> 3) + 8 * j; const LAS float* s = scr + (8 * c) * 33 + n;
        if (f8) { u32x2 o8; o8.x = cvt4f8(s[0 * 33] * ga[0] * W8_SCALE, s[1 * 33] * ga[1] * W8_SCALE, s[2 * 33] * ga[2] * W8_SCALE, s[3 * 33] * ga[3] * W8_SCALE);
            o8.y = cvt4f8(s[4 * 33] * gb[0] * W8_SCALE, s[5 * 33] * gb[1] * W8_SCALE, s[6 * 33] * gb[2] * W8_SCALE, s[7 * 33] * gb[3] * W8_SCALE);
            *(u32x2*)((unsigned char*)WT + (size_t)(drow + n) * K + k0 + 8 * c) = o8; continue; }
        u32x4 o; o.x = cvtpk(s[0 * 33] * ga[0], s[1 * 33] * ga[1]); o.y = cvtpk(s[2 * 33] * ga[2], s[3 * 33] * ga[3]); o.z = cvtpk(s[4 * 33] * gb[0], s[5 * 33] * gb[1]); o.w = cvtpk(s[6 * 33] * gb[2], s[7 * 33] * gb[3]);
        *(u32x4*)(WT + (size_t)(drow + n) * K + k0 + 8 * c) = o; }
    asm volatile("s_waitcnt lgkmcnt(0)" ::: "memory");
}
__device__ __forceinline__ int win_dest(int n0, int& sel) {
    if (n0 < 768) { sel = 0; return n0; }
    if (n0 < 1536) { sel = 0; return n0; }
    if (n0 < 2304) { sel = 1; return n0 - 1536; }
    if (n0 < 2944) { sel = 0; return 2816 + (n0 - 2304); }
    if (n0 < 3584) { sel = 0; return 3456 + (n0 - 2944); }
    if (n0 < 4224) { sel = 1; return 768 + (n0 - 3584); }
    if (n0 < 4864) { sel = 0; return 1536 + (n0 - 4224); }
    if (n0 < 5504) { sel = 0; return 2176 + (n0 - 4864); }
    sel = 1; return 1408 + (n0 - 5504);
}
__device__ __forceinline__ void phase_prologue(KArgs p, LAS unsigned char* lds, int wv) {
    const int tid = otid(wv), lane = tid & 63, wave = tid >> 6;
    LAS float* scr = (LAS float*)(lds + wave * 16384);
    const int gw = blockIdx.x * 8 + wave, NGW = gridDim.x * 8;
    constexpr int I_IN = 32 * 192, I_O = 32 * 64, I_G = 16 * 32 * 16, I_D = 16 * 8 * 64, I_L = I_IN + I_O + 2 * I_G + I_D;
    bf16_t* Wqk = (bf16_t*)(p->ws + WS_WQK); bf16_t* Wv = (bf16_t*)(p->ws + WS_WV); bf16_t* Wo = (bf16_t*)(p->ws + WS_WO);
    bf16_t* Wgu = (bf16_t*)(p->ws + WS_WGU); bf16_t* Wd = (bf16_t*)(p->ws + WS_WD);
    for (int it = gw; it < DEPTH * I_L; it += NGW) {
        const int l = it / I_L; int r = it % I_L;
        if (r < I_IN) { const int kb = r / 192, nb = r % 192; int sel; const int drow = win_dest(nb * 32, sel);
            if (FP8_PROJ) transpose_item(p->w_in + (size_t)l * DM * NIN, NIN, kb * 64, nb * 32, (bf16_t*)(sel ? (unsigned char*)Wv + (size_t)l * NV * DM : (unsigned char*)Wqk + (size_t)l * NQK * DM), DM, drow, scr, lane, p->attn_norm + (size_t)l * DM, true);
            else transpose_item(p->w_in + (size_t)l * DM * NIN, NIN, kb * 64, nb * 32, sel ? Wv + (size_t)l * NV * DM : Wqk + (size_t)l * NQK * DM, DM, drow, scr, lane, p->attn_norm + (size_t)l * DM); continue; }
        r -= I_IN;
        if (r < I_O) { const int kb = r / 64, nb = r % 64;
            if (FP8_WOUT) transpose_item(p->w_out + (size_t)l * DM * DM, DM, kb * 64, nb * 32, (bf16_t*)((unsigned char*)Wo + (size_t)l * DM * DM), DM, nb * 32, scr, lane, nullptr, true);
            else transpose_item(p->w_out + (size_t)l * DM * DM, DM, kb * 64, nb * 32, Wo + (size_t)l * DM * DM, DM, nb * 32, scr, lane); continue; }
        r -= I_O;
        if (r < 2 * I_G) { const int up = r / I_G; r %= I_G; const int e = r / 512, kb = (r % 512) / 16, nb = r % 16; const int n0 = nb * 32;
            const float* src = (up ? p->w_up : p->w_gate) + ((size_t)l * NEXP + e) * DM * FEXP;
            transpose_item(src, FEXP, kb * 64, n0, (bf16_t*)((unsigned char*)Wgu + ((size_t)l * NEXP + e) * 1024 * DM), DM, (n0 >> 7) * 256 + up * 128 + (n0 & 127), scr, lane, p->ffn_norm + (size_t)l * DM, true); continue; }
        r -= 2 * I_G;
        { const int e = r / 512, kb = (r % 512) / 64, nb = r % 64;
            transpose_item(p->w_down + ((size_t)l * NEXP + e) * FEXP * DM, DM, kb * 64, nb * 32, (bf16_t*)((unsigned char*)Wd + ((size_t)l * NEXP + e) * DM * FEXP), FEXP, nb * 32, scr, lane, nullptr, true); }
    }
    { float* WRT = (float*)(p->ws + WS_WRT); for (int i = blockIdx.x * 512 + tid; i < 16 * DM; i += gridDim.x * 512) WRT[(i & 15) * DM + (i >> 4)] = p->w_router[i]; }
    float* WF = (float*)(p->ws + WS_WF);
    for (int i = blockIdx.x * 512 + tid; i < DEPTH * 5 * DM; i += gridDim.x * 512) { const int l = i / (5 * DM), h = (i / DM) % 5, d = i % DM;
        WF[i] = p->w_in[((size_t)l * DM + d) * NIN + 6144 + h]; }
    if (blockIdx.x == 1 && wave < DEPTH) {
        const int l = wave;
        float a = fabsf(p->qnorm_diff[l * 64 + lane]), b = fabsf(p->knorm_diff[l * 64 + lane]);
        float c2 = fmaxf(fabsf(p->qnorm_fox[l * 128 + lane]), fabsf(p->qnorm_fox[l * 128 + 64 + lane])), d2 = fmaxf(fabsf(p->knorm_fox[l * 128 + lane]), fabsf(p->knorm_fox[l * 128 + 64 + lane]));
#pragma unroll
        for (int o = 1; o < 32; o <<= 1) { a = fmaxf(a, __int_as_float(__builtin_amdgcn_ds_bpermute(((lane ^ o) << 2), __float_as_int(a)))); b = fmaxf(b, __int_as_float(__builtin_amdgcn_ds_bpermute(((lane ^ o) << 2), __float_as_int(b))));
            c2 = fmaxf(c2, __int_as_float(__builtin_amdgcn_ds_bpermute(((lane ^ o) << 2), __float_as_int(c2)))); d2 = fmaxf(d2, __int_as_float(__builtin_amdgcn_ds_bpermute(((lane ^ o) << 2), __float_as_int(d2)))); }
        a = fmaxf(a, __int_as_float(__builtin_amdgcn_ds_bpermute(((lane ^ 32) << 2), __float_as_int(a)))); b = fmaxf(b, __int_as_float(__builtin_amdgcn_ds_bpermute(((lane ^ 32) << 2), __float_as_int(b))));
        c2 = fmaxf(c2, __int_as_float(__builtin_amdgcn_ds_bpermute(((lane ^ 32) << 2), __float_as_int(c2)))); d2 = fmaxf(d2, __int_as_float(__builtin_amdgcn_ds_bpermute(((lane ^ 32) << 2), __float_as_int(d2))));
        if (lane == 0) { ((float*)(p->ws + WS_LAM))[8 + 2 * l] = a * b; ((float*)(p->ws + WS_LAM))[8 + 2 * l + 1] = c2 * d2; }
    }
    if (blockIdx.x == 0 && wave < DEPTH) {
        const int l = wave;
        float a = wave_sum(p->lam_q1[l * 64 + lane] * p->lam_k1[l * 64 + lane]), b = wave_sum(p->lam_q2[l * 64 + lane] * p->lam_k2[l * 64 + lane]);
        if (lane == 0) ((float*)(p->ws + WS_LAM))[l] = fexp2(a * LOG2E) - fexp2(b * LOG2E) + (0.8f - 0.6f * fexp2(-0.3f * LOG2E * (float)l));
    }
}

__device__ __forceinline__ float log_sigmoid(float x) { return fminf(x, 0.f) - 0.6931471805599453f * flog2(1.f + fexp2(-fabsf(x) * LOG2E)); }

__device__ __forceinline__ void phase_norm1(KArgs p, int l, LAS unsigned char* lds, int wv, bool probe2 = false) {
    const int tid = otid(wv), lane = tid & 63, wave = tid >> 6;
    LAS float* wf = (LAS float*)lds;
    LAS int* rbase = (LAS int*)(lds + 5 * DM * 4);
    if (l < DEPTH) { const float* WF = (const float*)(p->ws + WS_WF) + (size_t)l * 5 * DM; for (int i = tid; i < 5 * DM; i += 512) wf[i] = WF[i]; }
    if (l > 0 && tid == 0) { const unsigned* cnt = (const unsigned*)(p->ws + WS_CTL) + CW_CNT + (l - 1) * 16 * 64; int acc = 0;
        for (int e = 0; e < 16; ++e) { rbase[e] = acc * 256; acc += ((int)cnt[e * 64] + 255) >> 8; } }
    __syncthreads();
    const bf16_t* Y = (const bf16_t*)(p->ws + WS_Y); const i32x4* tsel = (const i32x4*)(p->ws + WS_TSEL);
    bf16_t* XN = (bf16_t*)(p->ws + WS_XN); float* LOGF = (float*)(p->ws + WS_LOGF);
    const int gw = blockIdx.x * 8 + wave, NGW = gridDim.x * 8;
    for (int t = gw; t < SEQ; t += NGW) {
        asm volatile("" ::: "memory");
        f32x4 v[8];
        if (l == 0 && !probe2) { const f32x4* xr = (const f32x4*)(p->x + (size_t)t * DM) + lane;
#pragma unroll
            for (int j = 0; j < 8; ++j) v[j] = xr[64 * j]; }
        else { const u32x2* xr = (const u32x2*)((const bf16_t*)(p->ws + WS_OUTB) + (size_t)t * DM) + lane;
#pragma unroll
            for (int j = 0; j < 8; ++j) { const u32x2 a = xr[64 * j]; v[j] = (f32x4){bf_lo(a[0]), bf_hi(a[0]), bf_lo(a[1]), bf_hi(a[1])}; } }
        if (l > 0) {
            const float ysc = probe2 ? 0.f : 1.f;
            const i32x4 ts = tsel[t];
            const unsigned* y1 = (const unsigned*)((const unsigned char*)Y + (size_t)(rbase[ts[0]] + ts[1]) * DM) + lane; const unsigned* y2 = (const unsigned*)((const unsigned char*)Y + (size_t)(rbase[ts[2]] + ts[3]) * DM) + lane;
            const float ys8 = ysc * (1.f / Y8_SCALE);
#pragma unroll
            for (int j = 0; j < 8; ++j) { const unsigned a = y1[64 * j], b = y2[64 * j];
                const f32x2_t a0 = __builtin_amdgcn_cvt_pk_f32_fp8((int)a, false), a1 = __builtin_amdgcn_cvt_pk_f32_fp8((int)a, true), b0 = __builtin_amdgcn_cvt_pk_f32_fp8((int)b, false), b1 = __builtin_amdgcn_cvt_pk_f32_fp8((int)b, true);
                v[j][0] += ys8 * (a0[0] + b0[0]); v[j][1] += ys8 * (a0[1] + b0[1]); v[j][2] += ys8 * (a1[0] + b1[0]); v[j][3] += ys8 * (a1[1] + b1[1]); }
        }
        if (l == DEPTH) { f32x4* orow = (f32x4*)(p->out + (size_t)t * DM) + lane;
#pragma unroll
            for (int j = 0; j < 8; ++j) orow[64 * j] = v[j]; }
        else { u32x2* orow = (u32x2*)((bf16_t*)(p->ws + WS_OUTB) + (size_t)t * DM) + lane;
#pragma unroll
            for (int j = 0; j < 8; ++j) { u32x2 w; w[0] = cvtpk(v[j][0], v[j][1]); w[1] = cvtpk(v[j][2], v[j][3]); orow[64 * j] = w; }
            if (FP8_PROJ) { unsigned* orow8 = (unsigned*)(p->ws + WS_OUTB8 + (size_t)t * DM) + lane;
#pragma unroll
                for (int j = 0; j < 8; ++j) orow8[64 * j] = cvt4f8(v[j][0], v[j][1], v[j][2], v[j][3]); } }
        if (l == DEPTH) continue;
        float ss = 0.f;
#pragma unroll
        for (int j = 0; j < 8; ++j) ss += (v[j][0] * v[j][0] + v[j][1] * v[j][1]) + (v[j][2] * v[j][2] + v[j][3] * v[j][3]);
        const float rstd = __builtin_amdgcn_rsqf(wave_sum(ss) * (1.f / DM) + EPS);
        const f32x4* gr = (const f32x4*)(p->attn_norm + (size_t)l * DM) + lane;
        float fc[5] = {0.f, 0.f, 0.f, 0.f, 0.f};
        if (lane == 0) ((float*)(p->ws + WS_RSTD))[t] = rstd;
#pragma unroll
        for (int j = 0; j < 8; ++j) { const f32x4 xn = v[j] * rstd * gr[64 * j];
#pragma unroll
            for (int h = 0; h < 5; ++h) { const f32x4 w4 = *(const LAS f32x4*)(wf + h * DM + 4 * lane + 256 * j); fc[h] += (xn[0] * w4[0] + xn[1] * w4[1]) + (xn[2] * w4[2] + xn[3] * w4[3]); } }
#pragma unroll
        for (int h = 0; h < 5; ++h) { const float s = wave_sum(fc[h]); if (lane == 0) LOGF[h * SEQ + t] = log_sigmoid(s + p->b_forget[l * 5 + h]); }
    }
}

__device__ __forceinline__ void scan_head(KArgs p, int h, int l, LAS unsigned char* lds, int wv) {
    const int tid = otid(wv), lane = tid & 63, wave = tid >> 6;
    const float* src = (const float*)(p->ws + WS_LOGF) + (size_t)h * SEQ + tid * 16; float* dst = (float*)(p->ws + WS_DC2) + (size_t)h * SEQ + tid * 16;
    LAS float* wt = (LAS float*)lds;
    float v[16]; float s = 0.f;
#pragma unroll
    for (int i = 0; i < 4; ++i) { const f32x4 a = ((const f32x4*)src)[i]; v[4 * i] = a[0]; v[4 * i + 1] = a[1]; v[4 * i + 2] = a[2]; v[4 * i + 3] = a[3]; }
#pragma unroll
    for (int i = 0; i < 16; ++i) { s += v[i]; v[i] = s; }
    float inc = s;
#pragma unroll
    for (int o = 1; o < 64; o <<= 1) { const float n = __int_as_float(__builtin_amdgcn_ds_bpermute(((lane - o) & 63) << 2, __float_as_int(inc))); if (lane >= o) inc += n; }
    if (lane == 63) wt[wave] = inc;
    __syncthreads();
    float base = inc - s;
    for (int w = 0; w < wave; ++w) base += wt[w];
#pragma unroll
    for (int i = 0; i < 4; ++i) ((f32x4*)dst)[i] = (f32x4){(v[4 * i] + base) * LOG2E, (v[4 * i + 1] + base) * LOG2E, (v[4 * i + 2] + base) * LOG2E, (v[4 * i + 3] + base) * LOG2E};
    LAS float* dl = (LAS float*)(lds + 64);
#pragma unroll
    for (int i = 0; i < 16; ++i) dl[tid * 16 + i] = (v[i] + base) * LOG2E;
    __syncthreads();
    { const float thr = 39.f + 2.f * 16.3221377f * ((const float*)(p->ws + WS_LAM))[8 + 2 * l + 1];
      const int qb = tid >> 4, part = tid & 15; const float dref = dl[256 * qb]; int cnt = 0;
      for (int i = part; i < 4 * qb; i += 16) cnt += (dref - dl[64 * i + 63] <= -thr) ? 1 : 0;
      float c = (float)cnt; c += swz_xor<1>(c); c += swz_xor<2>(c); c += swz_xor<4>(c); c += swz_xor<8>(c);
      if (part == 0) ((int*)(p->ws + WS_LAM))[64 + h * 32 + qb] = (int)c; }
    __syncthreads();
}

namespace att {
constexpr int KP = 272, VP = 144;
constexpr int KT_BYTES = 64 * KP, VT_BYTES = 128 * VP, KB_BYTES = 256;
constexpr int BUF_BYTES = KT_BYTES + VT_BYTES + KB_BYTES;
constexpr float THR = 8.f;
static_assert(2 * BUF_BYTES <= RING_BYTES && 4 * 128 * 32 * 4 <= RING_BYTES, "attention LDS");

constexpr int KP8 = 144;
struct Stg { u32x4 k0, k1, v0, v1; };
template <bool F8K = false>
__device__ __forceinline__ void stage_load(Stg& s, const bf16_t* Kg, const bf16_t* Vg, int j, int tid) {
    if (F8K) { s.k0 = *(const u32x4*)((const unsigned char*)Kg + (size_t)(64 * j + (tid >> 3)) * NQK + (tid & 7) * 16); }
    else { const bf16_t* kp = Kg + (size_t)(64 * j + (tid >> 3)) * NQK + (tid & 7) * 8;
    s.k0 = *(const u32x4*)kp; s.k1 = *(const u32x4*)(kp + 64); }
    const bf16_t* vp = Vg + (size_t)(tid >> 2) * SEQ + 64 * j + (tid & 3) * 8;
    s.v0 = *(const u32x4*)vp; s.v1 = *(const u32x4*)(vp + 32);
}
template <bool F8K = false>
__device__ __forceinline__ void stage_write(const Stg& s, LAS unsigned char* buf, int tid) {
    if (F8K) { *(LAS u32x4*)(buf + (tid >> 3) * KP8 + (tid & 7) * 16) = s.k0; }
    else { LAS unsigned char* kd = buf + (tid >> 3) * KP + (tid & 7) * 16; *(LAS u32x4*)kd = s.k0; *(LAS u32x4*)(kd + 128) = s.k1; }
    LAS unsigned char* vd = buf + KT_BYTES + (tid >> 2) * VP + (tid & 3) * 16; *(LAS u32x4*)vd = s.v0; *(LAS u32x4*)(vd + 64) = s.v1;
}
template <int NKS>
__device__ __forceinline__ void qk_tile(f32x16& p0, f32x16& p1, const LAS unsigned char* kb, const bf16x8* qr) {
    bf16x8 ka[NKS], kc[NKS];
#pragma unroll
    for (int ks = 0; ks < NKS; ++ks) { ka[ks] = *(const LAS bf16x8*)(kb + ks * 32); kc[ks] = *(const LAS bf16x8*)(kb + 32 * KP + ks * 32); }
    __builtin_amdgcn_sched_barrier(0);
#pragma unroll
    for (int ks = 0; ks < NKS; ++ks) {
        p0 = __builtin_amdgcn_mfma_f32_32x32x16_bf16(ka[ks], qr[ks], p0, 0, 0, 0);
        p1 = __builtin_amdgcn_mfma_f32_32x32x16_bf16(kc[ks], qr[ks], p1, 0, 0, 0);
    }
    __builtin_amdgcn_sched_barrier(0);
}
__device__ __forceinline__ bf16x8 pack8(const f32x16& p, int b) {
    u32x4 w = {cvtpk(p[b + 0], p[b + 1]), cvtpk(p[b + 2], p[b + 3]), cvtpk(p[b + 4], p[b + 5]), cvtpk(p[b + 6], p[b + 7])};
    return *reinterpret_cast<bf16x8*>(&w);
}
__device__ __forceinline__ void pv_tile(f32x16 (&o)[4], const LAS unsigned char* vb, const f32x16& p0, const f32x16& p1) {
    const bf16x8 pb0 = pack8(p0, 0), pb1 = pack8(p0, 8), pb2 = pack8(p1, 0), pb3 = pack8(p1, 8);
#pragma unroll
    for (int dh = 0; dh < 2; ++dh) {
        bf16x8 va[8];
#pragma unroll
        for (int i = 0; i < 8; ++i) va[i] = *(const LAS bf16x8*)(vb + (2 * dh + (i >> 2)) * 32 * VP + (i & 3) * 32);
        __builtin_amdgcn_sched_barrier(0);
#pragma unroll
        for (int i = 0; i < 8; ++i) { const int d0 = 2 * dh + (i >> 2), s4 = i & 3;
            o[d0] = __builtin_amdgcn_mfma_f32_32x32x16_bf16(va[i], s4 == 0 ? pb0 : (s4 == 1 ? pb1 : (s4 == 2 ? pb2 : pb3)), o[d0], 0, 0, 0); }
        __builtin_amdgcn_sched_barrier(0);
    }
}
template <int NKS>
__device__ __forceinline__ void tile_fixed(f32x16 (&o)[4], const LAS unsigned char* kb, const LAS unsigned char* vb, const bf16x8* qr, f32x16& y0, f32x16& y1, float& l) {
    bf16x8 ka[NKS], kc[NKS];
#pragma unroll
    for (int ks = 0; ks < NKS; ++ks) { ka[ks] = *(const LAS bf16x8*)(kb + ks * 32); kc[ks] = *(const LAS bf16x8*)(kb + 32 * KP + ks * 32); }
    __builtin_amdgcn_sched_barrier(0);
#pragma unroll
    for (int ks = 0; ks < NKS; ++ks) y0 = __builtin_amdgcn_mfma_f32_32x32x16_bf16(ka[ks], qr[ks], y0, 0, 0, 0);
    __builtin_amdgcn_sched_barrier(0);
    asm volatile("" : "+v"(y0));
#pragma unroll
    for (int ks = 0; ks < NKS; ++ks) y1 = __builtin_amdgcn_mfma_f32_32x32x16_bf16(kc[ks], qr[ks], y1, 0, 0, 0);
    float s = 0.f;
#pragma unroll
    for (int r = 0; r < 16; ++r) { y0[r] = fexp2(y0[r]); s += y0[r]; }
    const bf16x8 pb0 = pack8(y0, 0), pb1 = pack8(y0, 8);
#pragma unroll
    for (int q = 0; q < NKS; ++q) { __builtin_amdgcn_sched_group_barrier(0x008, 1, 0);
#pragma unroll
        for (int h = 0; h < 8 / NKS; ++h) { __builtin_amdgcn_sched_group_barrier(0x400, 2, 0); __builtin_amdgcn_sched_group_barrier(0x002, 3, 0); } }
    __builtin_amdgcn_sched_barrier(0);
    bf16x8 va[8];
#pragma unroll
    for (int i = 0; i < 8; ++i) va[i] = *(const LAS bf16x8*)(vb + (i >> 1) * 32 * VP + (i & 1) * 32);
    __builtin_amdgcn_sched_barrier(0);
    asm volatile("" : "+v"(y1));
#pragma unroll
    for (int i = 0; i < 8; ++i) o[i >> 1] = __builtin_amdgcn_mfma_f32_32x32x16_bf16(va[i], (i & 1) ? pb1 : pb0, o[i >> 1], 0, 0, 0);
    float s1 = 0.f;
#pragma unroll
    for (int r = 0; r < 16; ++r) { y1[r] = fexp2(y1[r]); s1 += y1[r]; }
    const bf16x8 pb2 = pack8(y1, 0), pb3 = pack8(y1, 8);
#pragma unroll
    for (int q = 0; q < 8; ++q) { __builtin_amdgcn_sched_group_barrier(0x008, 1, 0); __builtin_amdgcn_sched_group_barrier(0x400, 2, 0); __builtin_amdgcn_sched_group_barrier(0x002, 3, 0); }
    __builtin_amdgcn_sched_barrier(0);
    l += s + s1;
    bf16x8 vb2[8];
#pragma unroll
    for (int i = 0; i < 8; ++i) vb2[i] = *(const LAS bf16x8*)(vb + (i >> 1) * 32 * VP + 64 + (i & 1) * 32);
    __builtin_amdgcn_sched_barrier(0);
#pragma unroll
    for (int i = 0; i < 8; ++i) o[i >> 1] = __builtin_amdgcn_mfma_f32_32x32x16_bf16(vb2[i], (i & 1) ? pb3 : pb2, o[i >> 1], 0, 0, 0);
    __builtin_amdgcn_sched_barrier(0);
}
template <int NKS>
__device__ __forceinline__ void tile_fixed8(f32x16 (&o)[4], const LAS unsigned char* kb, const LAS unsigned char* vb, const i32x8* qr, f32x16& y0, f32x16& y1, float& l) {
    i32x8 ka[NKS], kc[NKS];
#pragma unroll
    for (int ks = 0; ks < NKS; ++ks) { const i32x4 a0 = *(const LAS i32x4*)(kb + ks * 64), a1 = *(const LAS i32x4*)(kb + ks * 64 + 16), c0 = *(const LAS i32x4*)(kb + 32 * KP8 + ks * 64), c1 = *(const LAS i32x4*)(kb + 32 * KP8 + ks * 64 + 16);
        ka[ks] = __builtin_shufflevector(a0, a1, 0, 1, 2, 3, 4, 5, 6, 7); kc[ks] = __builtin_shufflevector(c0, c1, 0, 1, 2, 3, 4, 5, 6, 7); }
    __builtin_amdgcn_sched_barrier(0);
#pragma unroll
    for (int ks = 0; ks < NKS; ++ks) y0 = __builtin_amdgcn_mfma_scale_f32_32x32x64_f8f6f4(ka[ks], qr[ks], y0, 0, 0, 0, 0x7F7F7F7F, 0, 0x7F7F7F7F);
    __builtin_amdgcn_sched_barrier(0);
    asm volatile("" : "+v"(y0));
#pragma unroll
    for (int ks = 0; ks < NKS; ++ks) y1 = __builtin_amdgcn_mfma_scale_f32_32x32x64_f8f6f4(kc[ks], qr[ks], y1, 0, 0, 0, 0x7F7F7F7F, 0, 0x7F7F7F7F);
    float s = 0.f;
#pragma unroll
    for (int r = 0; r < 8; ++r) { y0[r] = fexp2(y0[r]); s += y0[r]; }
    const bf16x8 pb0 = pack8(y0, 0);
#pragma unroll
    for (int q = 0; q < NKS; ++q) { __builtin_amdgcn_sched_group_barrier(0x008, 1, 0);
#pragma unroll
        for (int h = 0; h < 4 / NKS; ++h) { __builtin_amdgcn_sched_group_barrier(0x400, 2, 0); __builtin_amdgcn_sched_group_barrier(0x002, 3, 0); } }
    __builtin_amdgcn_sched_barrier(0);
    bf16x8 va[8];
#pragma unroll
    for (int i = 0; i < 8; ++i) va[i] = *(const LAS bf16x8*)(vb + (i & 3) * 32 * VP + (i >> 2) * 32);
    __builtin_amdgcn_sched_barrier(0);
    asm volatile("" : "+v"(y0));
#pragma unroll
    for (int i = 0; i < 4; ++i) o[i] = __builtin_amdgcn_mfma_f32_32x32x16_bf16(va[i], pb0, o[i], 0, 0, 0);
#pragma unroll
    for (int r = 8; r < 16; ++r) { y0[r] = fexp2(y0[r]); s += y0[r]; }
    const bf16x8 pb1 = pack8(y0, 8);
#pragma unroll
    for (int q = 0; q < 4; ++q) { __builtin_amdgcn_sched_group_barrier(0x008, 1, 0); __builtin_amdgcn_sched_group_barrier(0x400, 2, 0); __builtin_amdgcn_sched_group_barrier(0x002, 3, 0); }
    __builtin_amdgcn_sched_barrier(0);
    bf16x8 vb2[8];
#pragma unroll
    for (int i = 0; i < 8; ++i) vb2[i] = *(const LAS bf16x8*)(vb + (i & 3) * 32 * VP + 64 + (i >> 2) * 32);
    asm volatile("" : "+v"(y1));
#pragma unroll
    for (int i = 0; i < 4; ++i) o[i] = __builtin_amdgcn_mfma_f32_32x32x16_bf16(va[4 + i], pb1, o[i], 0, 0, 0);
#pragma unroll
    for (int r = 0; r < 8; ++r) { y1[r] = fexp2(y1[r]); s += y1[r]; }
    const bf16x8 pb2 = pack8(y1, 0);
#pragma unroll
    for (int q = 0; q < 4; ++q) { __builtin_amdgcn_sched_group_barrier(0x008, 1, 0); __builtin_amdgcn_sched_group_barrier(0x400, 2, 0); __builtin_amdgcn_sched_group_barrier(0x002, 3, 0); }
    __builtin_amdgcn_sched_barrier(0);
    asm volatile("" : "+v"(y1));
#pragma unroll
    for (int i = 0; i < 4; ++i) o[i] = __builtin_amdgcn_mfma_f32_32x32x16_bf16(vb2[i], pb2, o[i], 0, 0, 0);
#pragma unroll
    for (int r = 8; r < 16; ++r) { y1[r] = fexp2(y1[r]); s += y1[r]; }
    const bf16x8 pb3 = pack8(y1, 8);
#pragma unroll
    for (int q = 0; q < 4; ++q) { __builtin_amdgcn_sched_group_barrier(0x008, 1, 0); __builtin_amdgcn_sched_group_barrier(0x400, 2, 0); __builtin_amdgcn_sched_group_barrier(0x002, 3, 0); }
    __builtin_amdgcn_sched_barrier(0);
    l += s;
#pragma unroll
    for (int i = 0; i < 4; ++i) o[i] = __builtin_amdgcn_mfma_f32_32x32x16_bf16(vb2[4 + i], pb3, o[i], 0, 0, 0);
    __builtin_amdgcn_sched_barrier(0);
}
__device__ __forceinline__ float swap_max(float v) { auto rr = __builtin_amdgcn_permlane32_swap(__float_as_uint(v), __float_as_uint(v), false, false); return fmaxf(__uint_as_float(rr[0]), __uint_as_float(rr[1])); }
__device__ __forceinline__ float swap_sum(float v) { auto rr = __builtin_amdgcn_permlane32_swap(__float_as_uint(v), __float_as_uint(v), false, false); return __uint_as_float(rr[0]) + __uint_as_float(rr[1]); }
__device__ __forceinline__ void softmax_step(f32x16& y0, f32x16& y1, float A, float& m, float& l, f32x16 (&o)[4]) {
    float mx = y0[0];
#pragma unroll
    for (int r = 1; r < 16; ++r) mx = fmaxf(mx, y0[r]);
#pragma unroll
    for (int r = 0; r < 16; ++r) mx = fmaxf(mx, y1[r]);
    mx = swap_max(mx) + A;
    if (__any(mx > m + THR)) {
        const float mn = fmaxf(m, mx), al = fexp2(m - mn); m = mn; l *= al;
#pragma unroll
        for (int d0 = 0; d0 < 4; ++d0)
#pragma unroll
            for (int r = 0; r < 16; ++r) o[d0][r] *= al;
    }
    const float mA = m - A; float s = 0.f;
#pragma unroll
    for (int r = 0; r < 16; ++r) { y0[r] = fexp2(y0[r] - mA); s += y0[r]; }
#pragma unroll
    for (int r = 0; r < 16; ++r) { y1[r] = fexp2(y1[r] - mA); s += y1[r]; }
    l += s;
}
__device__ __forceinline__ void softmax_fixed(f32x16& y0, f32x16& y1, float c, float& l) {
    float s = 0.f;
#pragma unroll
    for (int r = 0; r < 16; ++r) { y0[r] = fexp2(y0[r] + c); s += y0[r]; }
#pragma unroll
    for (int r = 0; r < 16; ++r) { y1[r] = fexp2(y1[r] + c); s += y1[r]; }
    l += s;
}
#define KIDX(r) (((r) & 3) + 8 * ((r) >> 2))

template <int TY>
__device__ __forceinline__ void att_item(KArgs p, int l, int head, int qb, LAS unsigned char* lds, int wv, int part = 0) {
    const int tid = otid(wv), wid = __builtin_amdgcn_readfirstlane(tid >> 6), lane = tid & 63, r32 = lane & 31, hi = lane >> 5;
    constexpr int NKS = (TY == 0) ? 4 : 8;
    const int br = (TY == 0) ? (wid >> 2) : 0, rg = (TY == 0) ? (wid & 3) : wid;
    const int t0w = (TY == 0) ? (128 * qb + 32 * rg) : (256 * qb + 32 * wid);
    const int trow = t0w + r32;
    const int NT = (TY == 0) ? (2 * qb + 2) : (4 * qb + 4);
    const int qcol = (TY == 0) ? (128 * head + 64 * br) : (TY == 1 ? 2816 + 128 * head : 1536 + 128 * head);
    const int kcol = (TY == 0) ? (768 + 128 * head) : (TY == 1 ? 3456 + 128 * head : 2176 + 128 * head);
    const int hv = (TY == 0) ? head : (TY == 1 ? 6 + head : 11 + head);
    const bf16_t* QKB = (const bf16_t*)(p->ws + WS_QKB);
    constexpr bool F8 = (TY != 1);
    const unsigned char* QKB8 = p->ws + WS_QKB8;
    const bf16_t* Kg = F8 ? (const bf16_t*)(QKB8 + kcol) : QKB + kcol; const bf16_t* Vg = (const bf16_t*)(p->ws + WS_VT) + (size_t)hv * HD * SEQ;
    const float* dc2 = (const float*)(p->ws + WS_DC2) + (size_t)head * SEQ;
    const float dcref = (TY == 2) ? dc2[256 * qb] : 0.f;
    const float slope2 = (TY == 0) ? fexp2(-8.0f * (float)(head + 1) / 6.0f) * LOG2E : 0.f;
    const float Bfix = (TY == 0) ? (11.5415603f * 1.01f * ((const float*)(p->ws + WS_LAM))[8 + 2 * l] + 0.25f) : (16.3221377f * 1.01f * ((const float*)(p->ws + WS_LAM))[8 + 2 * l + 1] + 0.25f);
    const float cfix = (TY == 2) ? (dc2[trow] - dcref - Bfix) : -Bfix;

    int j_lo = 0;
    if (TY == 0 && SKIP_A) {
        const float Bq = 11.5415603f * ((const float*)(p->ws + WS_LAM))[8 + 2 * l];
        const float x = ((float)(128 * qb - 63) - (39.f + 2.f * Bq) / slope2) * (1.f / 64.f);
        j_lo = x < 0.f ? 0 : (int)x + 1;
    } else if (TY == 2 && SKIP_C) {
        j_lo = ((const int*)(p->ws + WS_LAM))[64 + head * 32 + qb];
    }
    j_lo = __builtin_amdgcn_readfirstlane(j_lo);
    const int NTP = NT - j_lo;
    const bool elig = (TY == 2) ? (qb >= 8) : ((TY == 0) ? (head >= 4 && qb >= 16) : false);
    const bool split = elig && NTP > 32;
    if (part == 1 && !split) return;
    const int mid = j_lo + (NTP >> 1);
    const int jtop = (part == 1) ? mid - 1 : NT - 1;
    const int cntT = (part == 1) ? (mid - j_lo) : (split ? NT - mid : NTP);
    const int sidx = (TY == 2) ? (head * 32 + qb) : (160 + head * 64 + qb);
    unsigned long long* pay = (unsigned long long*)(p->ws + WS_PART) + ((size_t)sidx * 8 + wid) * 17 * 64 + lane;
    unsigned* aflag = (unsigned*)(p->ws + WS_CTL) + CW_AFLAG + (l * 544 + sidx) * 64;
    LAS unsigned char* buf0 = lds; LAS unsigned char* buf1 = lds + BUF_BYTES;
    LAS int* flags = (LAS int*)(lds + 2 * BUF_BYTES);
    if (TY == 1 && tid < 16) flags[tid] = 0;
    Stg st; float kbv = 0.f;
    stage_load<F8>(st, Kg, Vg, jtop, tid);
    if (TY == 2 && tid < 64) kbv = dcref - dc2[64 * jtop + tid];
    bf16x8 qr[NKS]; constexpr int NK8 = (TY == 0) ? 1 : 2; i32x8 q8[NK8];
    if (F8) {
#pragma unroll
        for (int ks = 0; ks < NK8; ++ks) { const i32x4 a = *(const i32x4*)(QKB8 + (size_t)trow * NQK + qcol + ks * 64 + hi * 32), b = *(const i32x4*)(QKB8 + (size_t)trow * NQK + qcol + ks * 64 + hi * 32 + 16);
            q8[ks] = __builtin_shufflevector(a, b, 0, 1, 2, 3, 4, 5, 6, 7); }
    } else {
#pragma unroll
        for (int ks = 0; ks < NKS; ++ks) qr[ks] = *(const bf16x8*)(QKB + (size_t)trow * NQK + qcol + ks * 16 + hi * 8);
    }
    stage_write<F8>(st, buf0, tid);
    if (TY == 2 && tid < 64) *(LAS float*)(buf0 + KT_BYTES + VT_BYTES + tid * 4) = kbv;
    if (cntT > 1) { stage_load<F8>(st, Kg, Vg, jtop - 1, tid); if (TY == 2 && tid < 64) kbv = dcref - dc2[64 * (jtop - 1) + tid]; }
    __syncthreads();

    f32x16 o[4];
#pragma unroll
    for (int d0 = 0; d0 < 4; ++d0)
#pragma unroll
        for (int r = 0; r < 16; ++r) o[d0][r] = 0.f;
    float m = 0.f, lsum = 0.f, R = 0.f;
    const int koff = F8 ? (r32 * KP8 + hi * 32 + ((TY == 0) ? br * 64 : 0)) : (r32 * KP + hi * 16 + ((TY == 0) ? br * 128 : 0)), voff = KT_BYTES + r32 * VP + hi * 16;

    for (int it = 0; it < cntT; ++it) {
        if (TY == 1 && (SKIP_B & 1) && it > 0) { const i32x4 f0 = *(const LAS i32x4*)(flags + ((it - 1) & 1) * 8), f1 = *(const LAS i32x4*)(flags + ((it - 1) & 1) * 8 + 4);
            if (__builtin_amdgcn_readfirstlane((f0[0] & f0[1] & f0[2] & f0[3] & f1[0] & f1[1] & f1[2] & f1[3])) != 0) break; }
        const int j = jtop - it;
        LAS unsigned char* cur = (it & 1) ? buf1 : buf0; LAS unsigned char* oth = (it & 1) ? buf0 : buf1;
        const bool more = it + 1 < cntT;
        if (TY == 0) {
            const int cw = 2 * qb + (rg >> 1);
            if (j <= cw) {
                f32x16 y0, y1;
                const int trel = trow - 64 * j;
                if (j == cw) {
                    const float tq = (float)(trel - 4 * hi);
#pragma unroll
                    for (int r = 0; r < 16; ++r) { y0[r] = fmaf(-slope2, fabsf(tq - (float)KIDX(r)), cfix); y1[r] = fmaf(-slope2, fabsf(tq - (float)(KIDX(r) + 32)), cfix); }
                } else {
                    const float A = fmaf(-slope2, (float)(trel - 4 * hi), cfix);
#pragma unroll
                    for (int r = 0; r < 16; ++r) { y0[r] = fmaf(slope2, (float)KIDX(r), A); y1[r] = fmaf(slope2, (float)(KIDX(r) + 32), A); }
                }
                tile_fixed8<NK8>(o, cur + koff, cur + voff, q8, y0, y1, lsum);
            }
        } else {
            const int jj = j - 4 * qb;
            if (jj <= (wid >> 1) && !(TY == 1 && (SKIP_B & 2) && __all(R <= -40.f))) {
                const bool partial = (jj == (wid >> 1));
                const int tin = 32 * (wid & 1) + r32 - 4 * hi;
                f32x16 y0, y1;
                if (TY == 2) {
                    const LAS f32x4* kbp = (const LAS f32x4*)(cur + KT_BYTES + VT_BYTES) + hi;
#pragma unroll
                    for (int g = 0; g < 4; ++g) { const f32x4 b0 = kbp[2 * g], b1 = kbp[2 * g + 8];
#pragma unroll
                        for (int i = 0; i < 4; ++i) { y0[4 * g + i] = b0[i] + cfix; y1[4 * g + i] = b1[i] + cfix; } }
                    if (partial) {
#pragma unroll
                        for (int r = 0; r < 16; ++r) { if (KIDX(r) > tin) y0[r] = -__builtin_inff(); if (KIDX(r) + 32 > tin) y1[r] = -__builtin_inff(); }
                    }
                    tile_fixed8<NK8>(o, cur + koff, cur + voff, q8, y0, y1, lsum);
                } else {
#pragma unroll
                    for (int r = 0; r < 16; ++r) { y0[r] = 0.f; y1[r] = 0.f; }
                    qk_tile<NKS>(y0, y1, cur + koff, qr);
                    f32x16 lb0, lb1;
#pragma unroll
                    for (int r = 0; r < 16; ++r) {
                        { const float z = fminf(fmaxf(y0[r], -100.f), 100.f), b = -flog2(1.f + fexp2(-z)); float k = b - z, bb = b;
                          if (partial && KIDX(r) >= tin) { k = 0.f; bb = -__builtin_inff(); } lb0[r] = bb; y0[r] = k; }
                        { const float z = fminf(fmaxf(y1[r], -100.f), 100.f), b = -flog2(1.f + fexp2(-z)); float k = b - z, bb = b;
                          if (partial && KIDX(r) + 32 >= tin) { k = 0.f; bb = -__builtin_inff(); } lb1[r] = bb; y1[r] = k; }
                    }
                    float gs0[4], gs1[4];
#pragma unroll
                    for (int g = 0; g < 4; ++g) {
                        { const float e0 = y0[4 * g], e1 = y0[4 * g + 1], e2 = y0[4 * g + 2], e3 = y0[4 * g + 3]; const float s2 = e3, s1 = e3 + e2, s0 = s1 + e1;
                          y0[4 * g + 3] = 0.f; y0[4 * g + 2] = s2; y0[4 * g + 1] = s1; y0[4 * g] = s0; gs0[g] = s0 + e0; }
                        { const float e0 = y1[4 * g], e1 = y1[4 * g + 1], e2 = y1[4 * g + 2], e3 = y1[4 * g + 3]; const float s2 = e3, s1 = e3 + e2, s0 = s1 + e1;
                          y1[4 * g + 3] = 0.f; y1[4 * g + 2] = s2; y1[4 * g + 1] = s1; y1[4 * g] = s0; gs1[g] = s0 + e0; }
                    }
                    float run = R;
#pragma unroll
                    for (int half = 1; half >= 0; --half)
#pragma unroll
                        for (int g = 3; g >= 0; --g) {
                            const float mine = half ? gs1[g] : gs0[g];
                            auto rr = __builtin_amdgcn_permlane32_swap(__float_as_uint(mine), __float_as_uint(mine), false, false);
                            const float g_lo = __uint_as_float(rr[0]), g_hi = __uint_as_float(rr[1]);
                            const float off_hi = run; run += g_hi; const float off_lo = run; run += g_lo;
                            const float off = hi ? off_hi : off_lo;
#pragma unroll
                            for (int i = 0; i < 4; ++i) {
                                if (half) y1[4 * g + i] = fexp2(lb1[4 * g + i] + y1[4 * g + i] + off);
                                else y0[4 * g + i] = fexp2(lb0[4 * g + i] + y0[4 * g + i] + off);
                            }
                        }
                    R = run;
                    pv_tile(o, cur + voff, y0, y1);
                }
            }
        }
        if (TY == 1) { const int dn = __all(R <= -40.f) ? 1 : 0; if (lane == 0) flags[(it & 1) * 8 + wid] = dn; }
        if (more) { stage_write<F8>(st, oth, tid); if (TY == 2 && tid < 64) *(LAS float*)(oth + KT_BYTES + VT_BYTES + tid * 4) = kbv; }
        if (it + 2 < cntT) { stage_load<F8>(st, Kg, Vg, j - 2, tid); if (TY == 2 && tid < 64) kbv = dcref - dc2[64 * (j - 2) + tid]; }
        __syncthreads();
    }

    bf16_t* MIX = (bf16_t*)(p->ws + WS_MIX);
    float inv = 1.f;
    if (TY != 1) {
        float lt = swap_sum(lsum);
        if (part == 1) {
            __hip_atomic_store(pay, ((unsigned long long)__float_as_uint(lt) << 32) | __float_as_uint(m), __ATOMIC_RELAXED, __HIP_MEMORY_SCOPE_AGENT);
#pragma unroll
            for (int d0 = 0; d0 < 4; ++d0)
#pragma unroll
                for (int g = 0; g < 4; ++g)
                    __hip_atomic_store(pay + (1 + d0 * 4 + g) * 64, ((unsigned long long)cvtpk(o[d0][4 * g + 2], o[d0][4 * g + 3]) << 32) | cvtpk(o[d0][4 * g], o[d0][4 * g + 1]), __ATOMIC_RELAXED, __HIP_MEMORY_SCOPE_AGENT);
            asm volatile("s_waitcnt vmcnt(0)" ::: "memory");
            __syncthreads();
            if (tid == 0) __hip_atomic_store(aflag, 1u, __ATOMIC_RELAXED, __HIP_MEMORY_SCOPE_AGENT);
            __syncthreads();
            return;
        }
        if (split) {
            if (tid == 0) { unsigned sp = 0; while (__hip_atomic_load(aflag, __ATOMIC_RELAXED, __HIP_MEMORY_SCOPE_AGENT) == 0u && ++sp < (1u << 22)) __builtin_amdgcn_s_sleep(2);
                __builtin_amdgcn_fence(__ATOMIC_ACQUIRE, "agent"); asm volatile("s_waitcnt vmcnt(0)" ::: "memory"); }
            __syncthreads();
            const unsigned long long ml = __hip_atomic_load(pay, __ATOMIC_RELAXED, __HIP_MEMORY_SCOPE_AGENT);
            const float mf = __uint_as_float((unsigned)ml), lf = __uint_as_float((unsigned)(ml >> 32));
            const float mn = fmaxf(m, mf), a0 = fexp2(m - mn), a1 = fexp2(mf - mn);
            lt = a0 * lt + a1 * lf;
#pragma unroll
            for (int d0 = 0; d0 < 4; ++d0)
#pragma unroll
                for (int g = 0; g < 4; ++g) {
                    const unsigned long long w = __hip_atomic_load(pay + (1 + d0 * 4 + g) * 64, __ATOMIC_RELAXED, __HIP_MEMORY_SCOPE_AGENT);
                    const unsigned w0 = (unsigned)w, w1 = (unsigned)(w >> 32);
                    o[d0][4 * g] = a0 * o[d0][4 * g] + a1 * bf_lo(w0); o[d0][4 * g + 1] = a0 * o[d0][4 * g + 1] + a1 * bf_hi(w0);
                    o[d0][4 * g + 2] = a0 * o[d0][4 * g + 2] + a1 * bf_lo(w1); o[d0][4 * g + 3] = a0 * o[d0][4 * g + 3] + a1 * bf_hi(w1);
                }
        }
        inv = 1.f / lt;
    }
    float post = 1.f; const float* gain;
    if (TY == 0) {
        const float lam = ((const float*)(p->ws + WS_LAM))[l];
        LAS float* X = (LAS float*)lds + (size_t)rg * 128 * 32;
        if (br == 1) {
            const float sc = inv * lam;
#pragma unroll
            for (int d0 = 0; d0 < 4; ++d0)
#pragma unroll
                for (int r = 0; r < 16; ++r) X[(32 * d0 + KIDX(r) + 4 * hi) * 32 + r32] = o[d0][r] * sc;
        }
        __syncthreads();
        if (br == 0) {
#pragma unroll
            for (int d0 = 0; d0 < 4; ++d0)
#pragma unroll
                for (int r = 0; r < 16; ++r) o[d0][r] = o[d0][r] * inv - X[(32 * d0 + KIDX(r) + 4 * hi) * 32 + r32];
        }
        inv = 1.f;
        post = 1.f - (0.8f - 0.6f * fexp2(-0.3f * LOG2E * (float)l));
        gain = p->subln_diff + l * HD;
    } else if (TY == 1) gain = p->onorm_sb + l * HD;
    else gain = p->onorm_fox + l * HD;
    if (TY != 0 || br == 0) {
        float ss = 0.f;
#pragma unroll
        for (int d0 = 0; d0 < 4; ++d0)
#pragma unroll
            for (int r = 0; r < 16; ++r) { const float v = o[d0][r] * inv; ss += v * v; }
        ss = swap_sum(ss);
        const float sc = inv * post * __builtin_amdgcn_rsqf(ss * (1.f / HD) + EPS);
        bf16_t* orow = MIX + (size_t)trow * DM + hv * HD + 4 * hi;
#pragma unroll
        for (int d0 = 0; d0 < 4; ++d0)
#pragma unroll
            for (int g = 0; g < 4; ++g) {
                const f32x4 g4 = *(const f32x4*)(gain + 32 * d0 + 8 * g + 4 * hi);
                if (FP8_WOUT) { *(unsigned*)((unsigned char*)MIX + (size_t)trow * DM + hv * HD + 4 * hi + 32 * d0 + 8 * g) = cvt4f8(o[d0][4 * g] * sc * g4[0], o[d0][4 * g + 1] * sc * g4[1], o[d0][4 * g + 2] * sc * g4[2], o[d0][4 * g + 3] * sc * g4[3]); continue; }
                u32x2 w; w[0] = cvtpk(o[d0][4 * g] * sc * g4[0], o[d0][4 * g + 1] * sc * g4[1]); w[1] = cvtpk(o[d0][4 * g + 2] * sc * g4[2], o[d0][4 * g + 3] * sc * g4[3]);
                *(u32x2*)(orow + 32 * d0 + 8 * g) = w;
            }
    }
    __syncthreads();
}

constexpr int N_FAR = 5 * 24 + 2 * 48;
constexpr int N_ITEMS = N_FAR + 32 * 22;
__device__ __forceinline__ void attention_phase(KArgs p, int l, LAS unsigned char* lds, volatile LAS unsigned* itemw, int wv, int qi, int tmask = 7) {
    unsigned* q = (unsigned*)(p->ws + WS_CTL) + CW_ATTQ + qi * 64;
    for (;;) {
        if (otid(wv) == 0) *itemw = __hip_atomic_fetch_add(q, 1u, __ATOMIC_RELAXED, __HIP_MEMORY_SCOPE_AGENT);
        __syncthreads();
        int item = (int)*itemw;
        __syncthreads();
        if (item >= N_ITEMS) break;
        if (item < N_FAR) {
            if (item < 120) { if (tmask & 1) att_item<2>(p, l, item % 5, 31 - item / 5, lds, wv, 1); }
            else { const int i2 = item - 120; if (tmask & 2) att_item<0>(p, l, 5 - (i2 & 1), 63 - (i2 >> 1), lds, wv, 1); }
            continue;
        }
        item -= N_FAR;
        if (item < 288) { const int w = item % 9, pp = 31 - item / 9;
            if (w < 5) { if (tmask & 1) att_item<2>(p, l, w, pp, lds, wv); }
            else if (tmask & 2) att_item<0>(p, l, 5 - ((w - 5) >> 1), 2 * pp + 1 - ((w - 5) & 1), lds, wv); }
        else if (item < 544) { const int it2 = item - 288, w = it2 % 8, pp = 31 - it2 / 8;
            if (tmask & 2) att_item<0>(p, l, 3 - (w >> 1), 2 * pp + 1 - (w & 1), lds, wv); }
        else if (tmask & 4) { const int it3 = item - 544; att_item<1>(p, l, it3 % 5, 31 - it3 / 5, lds, wv); }
    }
}
}

__device__ __forceinline__ void phase_route(KArgs p, int l, LAS unsigned char* lds, int wv, int ci, bool waitp = true) {
    const int tid = otid(wv), lane = tid & 63, wave = tid >> 6;
    LAS float* wrt = (LAS float*)lds;
    LAS int* bsel = (LAS int*)(lds + 16 * DM * 4);
    LAS float* bsc = (LAS float*)(bsel + 64);
    LAS float* bgate = bsc + 64;
    LAS float* brs = bgate + 64;
    { const f32x4* src = (const f32x4*)(p->ws + WS_WRT); for (int i = tid; i < 16 * DM / 4; i += 512) ((LAS f32x4*)wrt)[i] = src[i]; }
    __syncthreads();
    bf16_t* XN = (bf16_t*)(p->ws + WS_XN);
    for (int blk = blockIdx.x; blk < SEQ / 32; blk += gridDim.x) {
        const int tid = otid(wv), lane = tid & 63, wave = tid >> 6;
        if (waitp) { if (wave == 0) {
            const unsigned* wc = (const unsigned*)(p->ws + WS_CTL) + CW_WOC + l * 32 * 64 + 64 * (blk >> 3);
            unsigned sp = 0;
            while ((unsigned)__builtin_amdgcn_readfirstlane((int)__hip_atomic_load(wc, __ATOMIC_RELAXED, __HIP_MEMORY_SCOPE_AGENT)) < 64u && ++sp < (1u << 22)) __builtin_amdgcn_s_sleep(2);
            __builtin_amdgcn_fence(__ATOMIC_ACQUIRE, "agent");
            asm volatile("s_waitcnt vmcnt(0)" ::: "memory");
            } __syncthreads(); }
        const int tb = blk * 32 + wave * 4;
        f32x4 hx[4][8];
#pragma unroll
        for (int i = 0; i < 4; ++i) { const u32x2* xr = (const u32x2*)((const bf16_t*)(p->ws + WS_OUTB) + (size_t)(tb + i) * DM) + lane;
#pragma unroll
            for (int j = 0; j < 8; ++j) { const u32x2 a = xr[64 * j]; hx[i][j] = (f32x4){bf_lo(a[0]), bf_hi(a[0]), bf_lo(a[1]), bf_hi(a[1])}; } }
#pragma unroll
        for (int i = 0; i < 4; ++i) {
            float ss = 0.f;
#pragma unroll
            for (int j = 0; j < 8; ++j) ss += (hx[i][j][0] * hx[i][j][0] + hx[i][j][1] * hx[i][j][1]) + (hx[i][j][2] * hx[i][j][2] + hx[i][j][3] * hx[i][j][3]);
            const float rstd = __builtin_amdgcn_rsqf(wave_sum(ss) * (1.f / DM) + EPS);
            if (lane == 0) brs[wave * 4 + i] = rstd;
            const f32x4* gr = (const f32x4*)(p->ffn_norm + (size_t)l * DM) + lane;
#pragma unroll
            for (int j = 0; j < 8; ++j) hx[i][j] = hx[i][j] * rstd * gr[64 * j];
        }
#pragma unroll
        for (int h2 = 0; h2 < 2; ++h2) {
            f32x4 (&hn)[2][8] = *reinterpret_cast<f32x4 (*)[2][8]>(&hx[2 * h2]);
            asm volatile("" ::: "memory"); __builtin_amdgcn_sched_barrier(0);
            float acc[32];
#pragma unroll
            for (int k = 0; k < 32; ++k) acc[k] = 0.f;
#pragma unroll
            for (int j = 0; j < 8; ++j)
#pragma unroll
                for (int eh = 0; eh < 2; ++eh) {
#pragma unroll
                    for (int e = 8 * eh; e < 8 * eh + 8; ++e) { const f32x4 w4 = *(const LAS f32x4*)(wrt + e * DM + 4 * lane + 256 * j);
#pragma unroll
                        for (int i = 0; i < 2; ++i) acc[i * 16 + e] += (hn[i][j][0] * w4[0] + hn[i][j][1] * w4[1]) + (hn[i][j][2] * w4[2] + hn[i][j][3] * w4[3]); }
                    __builtin_amdgcn_sched_barrier(0);
                }
#pragma unroll
            for (int k = 0; k < 32; ++k) acc[k] = sum_xor32(acc[k]);
#define RSTEP(H) { const bool up = (lane & H) != 0; _Pragma("unroll") for (int k = 0; k < H; ++k) { const float a = acc[k], b = acc[k + H]; const float give = up ? a : b, keep = up ? b : a; acc[k] = keep + swz_xor<H>(give); } }
            RSTEP(16) RSTEP(8) RSTEP(4) RSTEP(2) RSTEP(1)
#undef RSTEP
            const float logit = acc[0];
            const float score = __builtin_amdgcn_rcpf(1.f + fexp2(-logit * LOG2E));
            const float sel = score + p->router_bias[lane & 15];
            const float v1 = swz_xor<1>(sel), v2 = swz_xor<2>(sel), v3 = swz_xor<3>(sel);
            const float a = fmaxf(sel, v1), b = fminf(sel, v1), c = fmaxf(v2, v3), d = fminf(v2, v3);
            const float gs = fmaxf(a, c) + fmaxf(fminf(a, c), fmaxf(b, d));
            const float g1 = swz_xor<4>(gs), g2 = swz_xor<8>(gs), g3 = swz_xor<12>(gs);
            const int myg = (lane >> 2) & 3, k = lane & 3;
            const bool best = (gs > g1 || (gs == g1 && myg < (myg ^ 1))) && (gs > g2 || (gs == g2 && myg < (myg ^ 2))) && (gs > g3 || (gs == g3 && myg < (myg ^ 3)));
            const int rank = ((v1 > sel || (v1 == sel && (k ^ 1) < k)) ? 1 : 0) + ((v2 > sel || (v2 == sel && (k ^ 2) < k)) ? 1 : 0) + ((v3 > sel || (v3 == sel && (k ^ 3) < k)) ? 1 : 0);
            if (best && rank < 2 && lane < 32) { const int row = wave * 4 + h2 * 2 + (lane >> 4); bsel[row * 2 + rank] = lane & 15; bsc[row * 2 + rank] = score; }
        }
        asm volatile("s_waitcnt lgkmcnt(0)" ::: "memory");
        if (lane < 8) { const int idx = wave * 8 + lane; const float sm = bsc[idx], so = bsc[idx ^ 1]; bgate[idx] = sm / (sm + so); }
        __syncthreads();
        if (wave == 0) {
            unsigned* cnt = (unsigned*)(p->ws + WS_CTL) + CW_CNT + ci * 16 * 64;
            const int mye = bsel[lane]; int myrank = 0, n = 0;
            const unsigned long long below = (1ull << lane) - 1ull;
#pragma unroll
            for (int e = 0; e < 16; ++e) { const unsigned long long mk = __ballot(mye == e); if (mye == e) myrank = (int)__popcll(mk & below); if (lane == e) n = (int)__popcll(mk); }
            int base = 0;
            if (lane < 16 && n) base = (int)__hip_atomic_fetch_add(cnt + lane * 64, (unsigned)n, __ATOMIC_RELAXED, __HIP_MEMORY_SCOPE_AGENT);
            const int pos = __builtin_amdgcn_ds_bpermute(mye << 2, base) + myrank, tok = blk * 32 + (lane >> 1);
            ((int*)(p->ws + WS_TOK))[mye * SEQ + pos] = tok; ((f32x2_t*)(p->ws + WS_GATE))[mye * SEQ + pos] = (f32x2_t){bgate[lane], brs[lane >> 1]};
            int* ts = (int*)(p->ws + WS_TSEL) + tok * 4 + (lane & 1) * 2; ts[0] = mye; ts[1] = pos;
        }
        __syncthreads();
    }
}

__device__ __forceinline__ void moe_table(KArgs p, int l, LAS int* tbl, int wv) {
    if (otid(wv) == 0) { const unsigned* cnt = (const unsigned*)(p->ws + WS_CTL) + CW_CNT + l * 16 * 64; int acc = 0;
        for (int e = 0; e < 16; ++e) { const int n = (int)cnt[e * 64]; tbl[e] = acc; tbl[17 + e] = n; acc += (n + 255) >> 8; } tbl[16] = acc; }
    __syncthreads();
}

constexpr int N_PHASES = 2 + 7 * DEPTH;
__device__ __forceinline__ int opq(int v) { asm volatile("" : "+s"(v)); return v; }
__device__ __forceinline__ LAS unsigned char* opq(LAS unsigned char* v) { unsigned x = (unsigned)(uintptr_t)v; asm volatile("" : "+s"(x)); return (LAS unsigned char*)(uintptr_t)x; }
__global__ void __launch_bounds__(512, 2) trunk_fwd(Params pk) {
    extern __shared__ __attribute__((aligned(16))) unsigned char lds_raw[];
    LAS unsigned char* lds = (LAS unsigned char*)lds_raw;
    volatile LAS unsigned* MISC = (volatile LAS unsigned*)(lds + MISC_OFF);
    LAS int* mtbl = (LAS int*)(lds + MISC_OFF + 256);
#define p kparams()
    const int wv = __builtin_amdgcn_readfirstlane((int)threadIdx.x >> 6);
    for (int u = threadIdx.x; u < (LDS_BYTES - MISC_OFF) / 4; u += 512) ((LAS unsigned*)(lds + MISC_OFF))[u] = 0u;
    __syncthreads();
    unsigned* ctl = (unsigned*)(p->ws + WS_CTL);
    XcdBarrier bar; bar.bar = ctl + CW_BAR; bar.x = 0; bar.st = nullptr; bar.wv = wv;
    const bool multi = (p->ph_hi - p->ph_lo) > 1;
    if (multi) bar = xcd_barrier_post(ctl + CW_BAR, MISC + 8, wv);
    const int lo = p->ph_lo, hi = p->ph_hi;
#define IN(k) (lo <= (k) && (k) < hi)
#define SEAM(k) do { if (IN(k) && IN((k) + 1)) xcd_barrier(bar); } while (0)
    const int G0 = gridDim.x, c0 = blockIdx.x; LAS unsigned char* const lds0 = lds;
#define PHASE_LOCALS const int G = opq(G0), c = opq(c0); LAS unsigned char* const lds = opq(lds0); LAS int* const mtbl = (LAS int*)(lds + MISC_OFF + 256); volatile LAS unsigned* const MISC = (volatile LAS unsigned*)(lds + MISC_OFF); (void)G; (void)c; (void)mtbl; (void)MISC;

    if (PK(0) && IN(0)) { PHASE_LOCALS phase_prologue(p, lds, wv); if (DUP_PHASE == 0) { __syncthreads(); phase_prologue(p, lds, wv); } SEAM(0); }
    for (int l = 0; l < DEPTH; ++l) {
        const int pb = 1 + 7 * l;
        if (PK(1) && IN(pb + 0)) { PHASE_LOCALS phase_norm1(p, l, lds, wv); if (DUP_PHASE == 1) { xcd_barrier(bar); phase_norm1(p, l, lds, wv, true); } SEAM(pb + 0); }
        if (PK(2) && IN(pb + 1)) { PHASE_LOCALS
            if (c < H_FOX) scan_head(p, c, l, lds, wv);
            for (int rep = 0; rep < (DUP_PHASE == 2 ? 2 : 1); ++rep) {
            { pg8::Gemm g{(const bf16_t*)(p->ws + (FP8_PROJ ? WS_OUTB8 : WS_OUTB)), (const bf16_t*)(p->ws + WS_WQK + (size_t)l * NQK * DM * (FP8_PROJ ? 1 : 2)), SEQ, NQK, FP8_PROJ ? DM / 2 : DM};
              pg8::StaticOrder S; S.init(SEQ, NQK, G, c);
              pg8::EpiQK E{(bf16_t*)(p->ws + WS_QKB), p->qnorm_diff + l * 64, p->knorm_diff + l * 64, p->qnorm_fox + l * 128, p->knorm_fox + l * 128, (LAS float*)(lds + TBL_OFF), (const float*)(p->ws + WS_RSTD), p->ws + WS_QKB8};
              pg8::gemm_phase<pg8::EpiQK, pg8::StaticOrder>(lds, g, S, E, wv); }
            { pg8::Gemm g{(const bf16_t*)(p->ws + WS_WV + (size_t)l * NV * DM * (FP8_PROJ ? 1 : 2)), (const bf16_t*)(p->ws + (FP8_PROJ ? WS_OUTB8 : WS_OUTB)), NV, SEQ, FP8_PROJ ? DM / 2 : DM};
              pg8::StaticOrder S; S.init(NV, SEQ, G, c);
              pg8::EpiVT E{(bf16_t*)(p->ws + WS_VT), SEQ, (const float*)(p->ws + WS_RSTD)};
              pg8::gemm_phase<pg8::EpiVT, pg8::StaticOrder>(lds, g, S, E, wv); }
            }
            SEAM(pb + 1);
        }
        if (PK(3) && IN(pb + 2)) { PHASE_LOCALS att::attention_phase(p, l, lds, MISC + 16, wv, l); if (DUP_PHASE == 3) { __syncthreads(); att::attention_phase(p, l, lds, MISC + 16, wv, l + 4, ATT_MASK2); } SEAM(pb + 2); }
        if (PK(4) && IN(pb + 3)) { PHASE_LOCALS
            pg8::Gemm g{(const bf16_t*)(p->ws + WS_MIX), (const bf16_t*)(p->ws + WS_WO + (size_t)l * DM * DM * (FP8_WOUT ? 1 : 2)), SEQ, DM, FP8_WOUT ? DM / 2 : DM};
            pg8::StaticOrder S; S.init(SEQ, DM, G, c);
            pg8::EpiResAdd E{(bf16_t*)(p->ws + WS_OUTB), 1.f, (unsigned*)(p->ws + WS_CTL) + CW_WOC + l * 32 * 64, p->ws + WS_OUTB8};
            pg8::gemm_phase<pg8::EpiResAdd, pg8::StaticOrder>(lds, g, S, E, wv);
        }
        if (PK(5) && IN(pb + 4)) { PHASE_LOCALS phase_route(p, l, lds, wv, l); if (DUP_PHASE == 5) { xcd_barrier(bar); phase_route(p, l, lds, wv, l + 4); } SEAM(pb + 4); }
        if (PK(6) && IN(pb + 5)) { PHASE_LOCALS
            moe_table(p, l, mtbl, wv);
            pg8::Gemm g{(const bf16_t*)(p->ws + WS_OUTB8), (const bf16_t*)(p->ws + WS_WGU + (size_t)l * NEXP * 1024 * DM), MOE_ROWS, NEXP * 1024, DM / 2};
            pg8::MoeOrder<4, true> S{mtbl, (const int*)(p->ws + WS_TOK), G, c, DM / 2};
            pg8::EpiGU E{p->ws + WS_ACT, (const float*)(p->ws + WS_GATE), mtbl, (unsigned*)(p->ws + WS_CTL) + CW_GUC + l * 80 * 64};
            for (int rep = 0; rep < (DUP_PHASE == 6 ? 2 : 1); ++rep)
            pg8::gemm_phase<pg8::EpiGU, pg8::MoeOrder<4, true>>(lds, g, S, E, wv);
        }
        if (PK(7) && IN(pb + 6)) { PHASE_LOCALS
            moe_table(p, l, mtbl, wv);
            pg8::Gemm g{(const bf16_t*)(p->ws + WS_ACT), (const bf16_t*)(p->ws + WS_WD + (size_t)l * NEXP * DM * FEXP), MOE_ROWS, NEXP * DM, FEXP / 2};
            pg8::DownOrder S{mtbl, (unsigned*)(p->ws + WS_CTL) + CW_GUC + l * 80 * 64, (unsigned*)(p->ws + WS_CTL) + CW_BAR + XB_TMO, G, c};
            pg8::EpiDown E{p->ws + WS_Y};
            pg8::gemm_phase<pg8::EpiDown, pg8::DownOrder>(lds, g, S, E, wv);
            SEAM(pb + 6);
        }
    }
    if (PK(1) && IN(N_PHASES - 1)) { PHASE_LOCALS phase_norm1(p, DEPTH, lds, wv); }
#undef IN
#undef SEAM
#undef PHASE_LOCALS
#undef p
}

extern "C" void kernel_launch(void* const* d_in, const int* in_sizes, int n_in, void* d_out, int out_size, void* d_ws, size_t ws_size, hipStream_t stream) {
    static int grid = 0;
    if (grid == 0) {
        if (n_in != 22 || in_sizes[0] != SEQ * DM || out_size != SEQ * DM || ws_size < WS_END) {
            fprintf(stderr, "kernel_launch: unexpected shapes (n_in %d, in0 %d, out %d, ws %zu < %zu); nothing launched\n", n_in, n_in > 0 ? in_sizes[0] : -1, out_size, ws_size, (size_t)WS_END); grid = -1; return; }
        int dev = 0, cus = 0, per_cu = 0;
        if (hipGetDevice(&dev) != hipSuccess || hipDeviceGetAttribute(&cus, hipDeviceAttributeMultiprocessorCount, dev) != hipSuccess) { grid = -1; return; }
        if (hipFuncSetAttribute((const void*)trunk_fwd, hipFuncAttributeMaxDynamicSharedMemorySize, LDS_BYTES) != hipSuccess) { fprintf(stderr, "kernel_launch: hipFuncSetAttribute failed\n"); grid = -1; return; }
        if (hipOccupancyMaxActiveBlocksPerMultiprocessor(&per_cu, (const void*)trunk_fwd, 512, LDS_BYTES) != hipSuccess || per_cu < 1)
            fprintf(stderr, "kernel_launch: note: occupancy query reports %d workgroups per CU\n", per_cu);
        (void)hipGetLastError();
        grid = cus;
    }
    if (grid < 0) return;
    if (hipMemsetAsync((char*)d_ws + WS_CTL, 0, CTL_ZERO_BYTES, stream) != hipSuccess) { fprintf(stderr, "kernel_launch: memset failed\n"); return; }
    Params hp{};
    const float** pp = (const float**)&hp;
    for (int i = 0; i < 22; ++i) pp[i] = (const float*)d_in[i];
    hp.out = (float*)d_out; hp.ws = (unsigned char*)d_ws;
#if MK_ONE_LAUNCH
    hp.ph_lo = 0; hp.ph_hi = N_PHASES;
    hipLaunchKernelGGL(trunk_fwd, dim3(grid), dim3(512), LDS_BYTES, stream, hp);
#else
    for (int ph = 0; ph < N_PHASES; ++ph) { hp.ph_lo = ph; hp.ph_hi = ph + 1; hipLaunchKernelGGL(trunk_fwd, dim3(grid), dim3(512), LDS_BYTES, stream, hp); }
#endif
    const hipError_t le = hipPeekAtLastError();
    if (le != hipSuccess) fprintf(stderr, "kernel_launch: launch failed: %s\n", hipGetErrorName(le));
}
```

```cpp
#include <hip/hip_runtime.h>
#include <cstdio>
#include <cstdint>

#ifndef MK_ONE_LAUNCH
#define MK_ONE_LAUNCH 1
#endif
#ifndef PHASE_MASK
#define PHASE_MASK 0xff
#endif
#define PK(k) (((PHASE_MASK) >> (k)) & 1)
#ifndef FP8_PROJ
#define FP8_PROJ 1
#endif
#ifndef FP8_WOUT
#define FP8_WOUT 1
#endif
#ifndef DUP_PHASE
#define DUP_PHASE -1
#endif
#ifndef ATT_MASK2
#define ATT_MASK2 7
#endif
#ifndef SKIP_A
#define SKIP_A 1
#endif
#ifndef SKIP_B
#define SKIP_B 3
#endif
#ifndef SKIP_C
#define SKIP_C 1
#endif

#define GAS __attribute__((address_space(1)))
#define LAS __attribute__((address_space(3)))
typedef unsigned short bf16_t;
typedef short bf16x8 __attribute__((ext_vector_type(8)));
typedef float f32x4 __attribute__((ext_vector_type(4)));
typedef float f32x16 __attribute__((ext_vector_type(16)));
typedef unsigned u32x4 __attribute__((ext_vector_type(4)));
typedef unsigned u32x2 __attribute__((ext_vector_type(2)));
typedef int i32x4 __attribute__((ext_vector_type(4)));

constexpr int SEQ = 8192, DM = 2048, DEPTH = 4, NQK = 4096, NV = 2048, NEXP = 16, FEXP = 512, NIN = 6149;
constexpr int HD = 128, H_DIFF = 6, H_SB = 5, H_FOX = 5;
constexpr float EPS = 1e-6f;
constexpr float LOG2E = 1.4426950408889634f;
constexpr int MOE_ROWS = 16384 + 16 * 256;

constexpr size_t MiB = 1u << 20;
constexpr size_t WS_CTL = 0, CTL_ZERO_BYTES = 1 * MiB;
constexpr size_t WS_WF = 1 * MiB;
constexpr size_t WS_LAM = 1 * MiB + 512 * 1024;
constexpr size_t WS_LOGF = 2 * MiB;
constexpr size_t WS_DC2 = 3 * MiB;
constexpr size_t WS_TOK = 4 * MiB;
constexpr size_t WS_GATE = 5 * MiB;
constexpr size_t WS_TSEL = 6 * MiB;
constexpr size_t WS_WRT = 7 * MiB;
constexpr size_t WS_RSTD = 8 * MiB;
constexpr size_t WS_WQK = 16 * MiB;
constexpr size_t WS_WV = 80 * MiB;
constexpr size_t WS_WO = 112 * MiB;
constexpr size_t WS_WGU = 144 * MiB;
constexpr size_t WS_WD = 400 * MiB;
constexpr size_t WS_XN = 528 * MiB;
constexpr size_t WS_QKB = 560 * MiB;
constexpr size_t WS_VT = 624 * MiB;
constexpr size_t WS_MIX = 656 * MiB;
constexpr size_t WS_ACT = 688 * MiB;
constexpr size_t WS_Y = 708 * MiB;
constexpr size_t WS_PART = 788 * MiB;
constexpr size_t WS_OUTB = 828 * MiB;
constexpr size_t WS_OUTB8 = 862 * MiB;
constexpr size_t WS_QKB8 = 878 * MiB;
constexpr size_t WS_END = 910 * MiB;
constexpr int CW_BAR = 4096;
constexpr int CW_ATTQ = 16384;
constexpr int CW_CNT = 32768;
constexpr int CW_AFLAG = 65536;
constexpr int CW_WOC = 233472;
constexpr int CW_GUC = 212992;

constexpr int RING_BYTES = 131072;
constexpr int TBL_OFF = RING_BYTES;
constexpr int MISC_OFF = RING_BYTES + 8192;
constexpr int LDS_BYTES = 147456;

typedef float f32x2_t __attribute__((ext_vector_type(2)));
typedef __bf16 bf16x2_t __attribute__((ext_vector_type(2)));
typedef int i32x8 __attribute__((ext_vector_type(8)));
__device__ __forceinline__ unsigned cvt4f8(float a, float b, float c, float d) {
    int w = 0; w = __builtin_amdgcn_cvt_pk_fp8_f32(a, b, w, false); w = __builtin_amdgcn_cvt_pk_fp8_f32(c, d, w, true); return (unsigned)w; }
constexpr float W8_SCALE = 256.f, ACT8_SCALE = 4.f, Y8_SCALE = 32.f;
__device__ __forceinline__ unsigned cvtpk(float lo, float hi) { const f32x2_t v = {lo, hi}; const bf16x2_t b = __builtin_convertvector(v, bf16x2_t); return __builtin_bit_cast(unsigned, b); }
__device__ __forceinline__ float bf_lo(unsigned u) { return __uint_as_float(u << 16); }
__device__ __forceinline__ float bf_hi(unsigned u) { return __uint_as_float(u & 0xffff0000u); }
__device__ __forceinline__ float fexp2(float x) { return __builtin_amdgcn_exp2f(x); }
__device__ __forceinline__ float flog2(float x) { return __builtin_amdgcn_logf(x); }
__device__ __forceinline__ int otid(int wv) { int t; asm volatile("v_mbcnt_lo_u32_b32 %0, -1, 0\n\tv_mbcnt_hi_u32_b32 %0, -1, %0" : "=v"(t)); return wv * 64 + t; }
template <int M> __device__ __forceinline__ float swz_xor(float v) { return __int_as_float(__builtin_amdgcn_ds_swizzle(__float_as_int(v), 0x1F | (M << 10))); }
__device__ __forceinline__ float sum_xor32(float v) { auto rr = __builtin_amdgcn_permlane32_swap(__float_as_uint(v), __float_as_uint(v), false, false); return __uint_as_float(rr[0]) + __uint_as_float(rr[1]); }
__device__ __forceinline__ float wave_sum(float v) {
    v += swz_xor<1>(v); v += swz_xor<2>(v); v += swz_xor<4>(v); v += swz_xor<8>(v); v += swz_xor<16>(v);
    return sum_xor32(v);
}

namespace pg8 {
constexpr int BM = 256, BK = 64, HALF = 128, HTB = HALF * BK * 2, STAGE_BYTES = 8 * HTB, NXCD = 8, WGM = 8;
__host__ __device__ __forceinline__ int lds_byte(int r, int c) { const int st = (r >> 4) * 2 + (c >> 5), rr = r & 15, cc = c & 31, ob = rr * 64 + cc * 2; return st * 1024 + (ob ^ (((ob >> 9) & 1) << 5)); }
__host__ __device__ __forceinline__ void stage_rc(int b, int& R, int& C) { const int st = b / 1024, sb = b % 1024, swz = sb ^ (((sb >> 9) & 1) << 5); R = (st >> 1) * 16 + swz / 64; C = (st & 1) * 32 + (swz % 64) / 2; }
__host__ __device__ __forceinline__ int perm32(int rho) { const int n = rho >> 4, i = rho & 15; return 8 * (i >> 2) + 4 * n + (i & 3); }
__host__ __device__ __forceinline__ int permV(int rho) { const int n = rho >> 4, i = rho & 15; return 16 * (i >> 3) + 8 * n + (i & 7); }
template <int P> __host__ __device__ __forceinline__ int permf(int rho) { return P == 1 ? perm32(rho) : (P == 2 ? permV(rho) : rho); }

struct Unit { int pm, pn, e, rt; };
struct Gemm { const bf16_t* A; const bf16_t* Bt; int M, N, K; };

struct StaticOrder {
    int nM, nN, nwg, G, c;
    __device__ void init(int M, int N, int G_, int c_) { nM = M / BM; nN = N / BM; nwg = nM * nN; G = G_; c = c_; }
    __device__ bool next(int i, Unit& u) const {
        const long L = (long)i * G + c; if (L >= nwg) return false;
        int wgid = (int)L; { const int q = nwg / NXCD, r = nwg % NXCD, xcd = wgid % NXCD, off = wgid / NXCD; wgid = (xcd < r ? xcd * (q + 1) : r * (q + 1) + (xcd - r) * q) + off; }
        const int nig = WGM * nN, gid = wgid / nig, fm = gid * WGM, gsz = (nM - fm) < WGM ? (nM - fm) : WGM;
        u.pm = fm + ((wgid % nig) % gsz); u.pn = (wgid % nig) / gsz; u.e = 0; u.rt = 0; return true;
    }
    __device__ __forceinline__ size_t a_base(const Unit& u, size_t tstep) const { return (size_t)u.pm * tstep; }
    __device__ __forceinline__ unsigned row_off(const Unit&, int r, int K) const { return (unsigned)(r * K) * 2u; }
    __device__ __forceinline__ void a_ready(const Unit&, int) const {}
};

template <int NCT, bool GATHER> struct MoeOrder {
    const LAS int* tbl; const int* tok; int G, c, K;
    __device__ bool next(int i, Unit& u) const {
        const int L = i * G + c, total = __builtin_amdgcn_readfirstlane(tbl[16]) * NCT; if (L >= total) return false;
        const int g = L / NCT, ct = L % NCT; int e = 0;
#pragma unroll
        for (int k = 1; k < 16; ++k) e += (g >= tbl[k]) ? 1 : 0;
        e = __builtin_amdgcn_readfirstlane(e);
        u.pm = g; u.pn = e * NCT + ct; u.e = e; u.rt = __builtin_amdgcn_readfirstlane(g - tbl[e]); return true;
    }
    __device__ __forceinline__ size_t a_base(const Unit& u, size_t tstep) const { return GATHER ? 0 : (size_t)u.pm * tstep; }
    __device__ __forceinline__ unsigned row_off(const Unit& u, int r, int K_) const {
        if (!GATHER) return (unsigned)(r * K_) * 2u;
        const int pos = u.rt * 256 + r; const int n = __builtin_amdgcn_readfirstlane(tbl[17 + u.e]);
        const int t = pos < n ? tok[u.e * SEQ + pos] : 0;
        return (unsigned)(t * K_) * 2u;
    }
    __device__ __forceinline__ void a_ready(const Unit&, int) const {}
};

struct DownOrder {
    const LAS int* tbl; unsigned* cnt; unsigned* tmo; int G, c;
    __device__ bool next(int i, Unit& u) const {
        const int T = __builtin_amdgcn_readfirstlane(tbl[16]);
        const int U1 = 4 * T, nb2 = U1 > G ? U1 - G : 0, F = G - nb2;
        const int g1 = T < (G >> 2) ? T : (G >> 2), E = 8 * g1, Lt = 8 * (T - g1);
        int k = -1, late = 0;
        int ii = i;
        if (c >= nb2) { const int cf = c - nb2; const int nE = E > cf ? (E - cf + F - 1) / F : 0; if (ii < nE) k = cf + ii * F; else ii -= nE; }
        int g, ct;
        if (k >= 0) { g = k >> 3; ct = k & 7; }
        else { const int k0 = (c - nb2 + G) % G; const int kk = k0 + ii * G; if (kk >= Lt) return false; g = g1 + (kk >> 3); ct = kk & 7; late = 1; }
        (void)late;
        int e = 0;
#pragma unroll
        for (int q = 1; q < 16; ++q) e += (g >= tbl[q]) ? 1 : 0;
        e = __builtin_amdgcn_readfirstlane(e);
        u.pm = g; u.pn = e * 8 + ct; u.e = e; u.rt = __builtin_amdgcn_readfirstlane(g - tbl[e]); return true;
    }
    __device__ __forceinline__ size_t a_base(const Unit& u, size_t tstep) const { return (size_t)u.pm * tstep; }
    __device__ __forceinline__ unsigned row_off(const Unit&, int r, int K_) const { return (unsigned)(r * K_) * 2u; }
    __device__ __forceinline__ void a_ready(const Unit& u, int wid) const {
        if (wid == 0) {
            unsigned sp = 0;
            while ((unsigned)__builtin_amdgcn_readfirstlane((int)__hip_atomic_load(cnt + 64 * u.pm, __ATOMIC_RELAXED, __HIP_MEMORY_SCOPE_AGENT)) < 32u) {
                __builtin_amdgcn_s_sleep(2);
                if (++sp > (1u << 22)) { __hip_atomic_store(tmo, 1u, __ATOMIC_RELAXED, __HIP_MEMORY_SCOPE_AGENT); break; }
            }
            __builtin_amdgcn_fence(__ATOMIC_ACQUIRE, "agent");
            asm volatile("s_waitcnt vmcnt(0)" ::: "memory");
        }
        asm volatile("" ::: "memory"); __builtin_amdgcn_s_barrier(); asm volatile("" ::: "memory");
    }
};

template <class Epi, class Sched, bool SP2 = true>
__device__ __forceinline__ void gemm_phase(LAS unsigned char* lds, const Gemm g, const Sched& S, const Epi& E, int wv) {
    const int tid = otid(wv), wid = __builtin_amdgcn_readfirstlane(tid >> 6), lane = tid & 63, wr = wid >> 2, wc = wid & 3, fr = lane & 15, fq = lane >> 4;
    const int K = g.K, nt = K / BK;
    unsigned voffB[2]; int Rr[2], Cc[2];
#pragma unroll
    for (int i = 0; i < 2; ++i) { int R, C; stage_rc(tid * 16 + i * 8192, R, C); const int Rb = (R & ~31) + permf<Epi::PERM>(R & 31);
        Rr[i] = R; Cc[i] = C; voffB[i] = (unsigned)(Rb * K + C) * 2u; }
    const size_t kstep = (size_t)(BK * 2);
    const size_t hstep = (size_t)HALF * K * 2;
    const size_t tstep = 2 * hstep;
    const unsigned ldsw = (unsigned)wid * 1024u;
    const int aoff = lds_byte(wr * 64 + fr, fq * 8), boff = lds_byte(wc * 32 + fr, fq * 8);
#define PG8_SA(b, h) (((b) * 2 + (h)) * HTB)
#define PG8_SB(b, h) ((4 + (b) * 2 + (h)) * HTB)
#define PG8_STAGE(bufoff, gbase, voff) do { _Pragma("unroll") for (int _i = 0; _i < 2; ++_i) \
        __builtin_amdgcn_global_load_lds((const unsigned*)((const char*)(gbase) + (voff)[_i]), (LAS unsigned*)(lds + (bufoff) + ldsw + _i * 8192), 16, 0, 0); } while (0)
#define PG8_LDA(dst, b, h) do { _Pragma("unroll") for (int m = 0; m < 4; ++m) _Pragma("unroll") for (int k = 0; k < 2; ++k) dst[m][k] = *(const LAS bf16x8*)(lds + PG8_SA(b, h) + aoff + m * 2048 + k * 1024); } while (0)
#define PG8_LDB(dst, b, h) do { _Pragma("unroll") for (int n = 0; n < 2; ++n) _Pragma("unroll") for (int k = 0; k < 2; ++k) dst[n][k] = *(const LAS bf16x8*)(lds + PG8_SB(b, h) + boff + n * 2048 + k * 1024); } while (0)
#define PG8_CAT(x) __builtin_shufflevector(__builtin_bit_cast(i32x4, (x)[0]), __builtin_bit_cast(i32x4, (x)[1]), 0, 1, 2, 3, 4, 5, 6, 7)
#define PG8_MMA(ai, bj, At, Bt) do { __builtin_amdgcn_s_setprio(1); \
        if constexpr (Epi::FP8) { _Pragma("unroll") for (int m = 0; m < 4; ++m) _Pragma("unroll") for (int n = 0; n < 2; ++n) \
            asm volatile("v_mfma_scale_f32_16x16x128_f8f6f4 %0, %1, %2, %0, %3, %3 op_sel_hi:[0,0,0]" : "+v"(acc[ai][bj][m][n]) : "v"(PG8_CAT(Bt[n])), "v"(PG8_CAT(At[m])), "v"(one8)); } \
        else { _Pragma("unroll") for (int m = 0; m < 4; ++m) _Pragma("unroll") for (int n = 0; n < 2; ++n) _Pragma("unroll") for (int k = 0; k < 2; ++k) \
            acc[ai][bj][m][n] = __builtin_amdgcn_mfma_f32_16x16x32_bf16(Bt[n][k], At[m][k], acc[ai][bj][m][n], 0, 0, 0); } \
        __builtin_amdgcn_s_setprio(0); } while (0)
#define PG8_WAIT_V(n) asm volatile("s_waitcnt vmcnt(" #n ")" ::: "memory")
#define PG8_WAIT_L(n) asm volatile("s_waitcnt lgkmcnt(" #n ")" ::: "memory")
#define PG8_BAR __builtin_amdgcn_s_barrier()
#define PG8_SCHED __builtin_amdgcn_sched_barrier(0)
    Unit cur, nxt; int ui = 0;
    if (!S.next(0, cur)) return;
    const unsigned one8 = 0x7F7F7F7Fu;
    (void)one8;
    f32x4 acc[2][2][4][2];
    if constexpr (Epi::LOAD_INIT) E.init(acc, cur, wr, wc, fr, fq);
    else {
#pragma unroll
    for (int a = 0; a < 2; ++a)
#pragma unroll
        for (int b = 0; b < 2; ++b)
#pragma unroll
            for (int m = 0; m < 4; ++m)
#pragma unroll
                for (int n = 0; n < 2; ++n) acc[a][b][m][n] = (f32x4){0.f, 0.f, 0.f, 0.f};
    }
    bf16x8 At[4][2], B0[2][2], B1[2][2];
    unsigned oc[2][2], on[2][2];
#pragma unroll
    for (int h = 0; h < 2; ++h)
#pragma unroll
        for (int i = 0; i < 2; ++i) { oc[h][i] = S.row_off(cur, h * HALF + Rr[i], K) + (unsigned)Cc[i] * 2u; on[h][i] = oc[h][i]; }
    const char* cA = (const char*)g.A + S.a_base(cur, tstep); const char* cB = (const char*)g.Bt + (size_t)cur.pn * tstep;
    S.a_ready(cur, wid);
    if constexpr (SP2) {
        PG8_STAGE(PG8_SB(0, 0), cB, voffB); PG8_STAGE(PG8_SB(0, 1), cB + hstep, voffB); PG8_STAGE(PG8_SA(0, 0), cA, oc[0]); PG8_STAGE(PG8_SA(0, 1), cA, oc[1]);
        if (wr == 1) PG8_BAR;
        PG8_WAIT_V(2); PG8_BAR;
        PG8_STAGE(PG8_SB(1, 0), cB + kstep, voffB); PG8_STAGE(PG8_SA(1, 0), cA + kstep, oc[0]); PG8_STAGE(PG8_SB(1, 1), cB + hstep + kstep, voffB);
        PG8_WAIT_V(6); PG8_BAR;
    } else {
        PG8_STAGE(PG8_SB(0, 0), cB, voffB); PG8_STAGE(PG8_SA(0, 0), cA, oc[0]); PG8_STAGE(PG8_SB(0, 1), cB + hstep, voffB); PG8_STAGE(PG8_SA(0, 1), cA, oc[1]);
        if (wr == 1) PG8_BAR;
        PG8_WAIT_V(4); PG8_BAR;
        PG8_STAGE(PG8_SB(1, 0), cB + kstep, voffB); PG8_STAGE(PG8_SA(1, 0), cA + kstep, oc[0]); PG8_STAGE(PG8_SB(1, 1), cB + hstep + kstep, voffB);
        PG8_WAIT_V(6); PG8_BAR;
    }
    for (;;) {
        const bool has_next = S.next(ui + 1, nxt);
        const char* nA = has_next ? (const char*)g.A + S.a_base(nxt, tstep) : cA; const char* nB = has_next ? (const char*)g.Bt + (size_t)nxt.pn * tstep : cB;
        if (has_next) {
#pragma unroll
            for (int h = 0; h < 2; ++h)
#pragma unroll
                for (int i = 0; i < 2; ++i) on[h][i] = S.row_off(nxt, h * HALF + Rr[i], K) + (unsigned)Cc[i] * 2u;
        }
        for (int t = 0; t < nt; t += 2) {
            const bool last = (t == nt - 2);
            if (last && has_next) S.a_ready(nxt, wid);
            const char* a1 = cA + (size_t)(t + 1) * kstep;
            const char* a2 = last ? nA : cA + (size_t)(t + 2) * kstep; const char* b2 = last ? nB : cB + (size_t)(t + 2) * kstep;
            const char* a3 = a2 + kstep; const char* b3 = b2 + kstep;
            unsigned o2a[2], o2b[2];
            o2a[0] = last ? on[0][0] : oc[0][0]; o2a[1] = last ? on[0][1] : oc[0][1]; o2b[0] = last ? on[1][0] : oc[1][0]; o2b[1] = last ? on[1][1] : oc[1][1];
            if constexpr (SP2) {
            PG8_LDB(B0, 0, 0); PG8_LDB(B1, 0, 1); PG8_SCHED; PG8_LDA(At, 0, 0); PG8_STAGE(PG8_SA(1, 1), a1, oc[1]);
            PG8_WAIT_V(8); PG8_WAIT_L(0); PG8_BAR; PG8_MMA(0, 0, At, B0); PG8_MMA(0, 1, At, B1); PG8_BAR; PG8_SCHED;
            PG8_LDA(At, 0, 1); PG8_STAGE(PG8_SB(0, 0), b2, voffB); PG8_STAGE(PG8_SB(0, 1), b2 + hstep, voffB); PG8_STAGE(PG8_SA(0, 0), a2, o2a);
            PG8_WAIT_V(8); PG8_WAIT_L(0); PG8_BAR; PG8_MMA(1, 0, At, B0); PG8_MMA(1, 1, At, B1); PG8_BAR; PG8_SCHED;
            PG8_LDB(B0, 1, 0); PG8_LDB(B1, 1, 1); PG8_SCHED; PG8_LDA(At, 1, 0); PG8_STAGE(PG8_SA(0, 1), a2, o2b);
            PG8_WAIT_V(8); PG8_WAIT_L(0); PG8_BAR; PG8_MMA(0, 0, At, B0); PG8_MMA(0, 1, At, B1); PG8_BAR; PG8_SCHED;
            PG8_LDA(At, 1, 1); PG8_STAGE(PG8_SB(1, 0), b3, voffB); PG8_STAGE(PG8_SB(1, 1), b3 + hstep, voffB); PG8_STAGE(PG8_SA(1, 0), a3, o2a);
            PG8_WAIT_V(8); PG8_WAIT_L(0); PG8_BAR; PG8_MMA(1, 0, At, B0); PG8_MMA(1, 1, At, B1); PG8_BAR; PG8_SCHED;
            } else {
            PG8_LDB(B0, 0, 0); PG8_SCHED; PG8_LDA(At, 0, 0); PG8_STAGE(PG8_SA(1, 1), a1, oc[1]);
            PG8_WAIT_L(8); PG8_BAR; PG8_WAIT_L(0); PG8_MMA(0, 0, At, B0); PG8_BAR; PG8_SCHED;
            PG8_LDB(B1, 0, 1); PG8_STAGE(PG8_SB(0, 0), b2, voffB);
            PG8_BAR; PG8_WAIT_L(0); PG8_MMA(0, 1, At, B1); PG8_BAR;
            PG8_LDA(At, 0, 1); PG8_STAGE(PG8_SA(0, 0), a2, o2a);
            PG8_BAR; PG8_WAIT_L(0); PG8_MMA(1, 0, At, B0); PG8_BAR; PG8_SCHED;
            PG8_STAGE(PG8_SB(0, 1), b2 + hstep, voffB);
            PG8_WAIT_V(6); PG8_BAR; PG8_MMA(1, 1, At, B1); PG8_BAR;
            PG8_LDB(B0, 1, 0); PG8_SCHED; PG8_LDA(At, 1, 0); PG8_STAGE(PG8_SA(0, 1), a2, o2b);
            PG8_WAIT_L(8); PG8_BAR; PG8_WAIT_L(0); PG8_MMA(0, 0, At, B0); PG8_BAR; PG8_SCHED;
            PG8_LDB(B1, 1, 1); PG8_STAGE(PG8_SB(1, 0), b3, voffB);
            PG8_BAR; PG8_WAIT_L(0); PG8_MMA(0, 1, At, B1); PG8_BAR;
            PG8_LDA(At, 1, 1); PG8_STAGE(PG8_SA(1, 0), a3, o2a);
            PG8_BAR; PG8_WAIT_L(0); PG8_MMA(1, 0, At, B0); PG8_BAR; PG8_SCHED;
            PG8_STAGE(PG8_SB(1, 1), b3 + hstep, voffB);
            PG8_WAIT_V(6); PG8_BAR; PG8_MMA(1, 1, At, B1); PG8_BAR;
            }
        }
        if (wr == 0) PG8_BAR;
        if constexpr (Epi::FP8) asm volatile("s_nop 15\n\ts_nop 15" ::: "memory");
        { const int tz = otid(wv) & 63; E(acc, cur, wr, wc, tz & 15, tz >> 4); }
        if (!has_next) break;
#pragma unroll
        for (int a = 0; a < 2; ++a)
#pragma unroll
            for (int b = 0; b < 2; ++b)
#pragma unroll
                for (int m = 0; m < 4; ++m)
#pragma unroll
                    for (int n = 0; n < 2; ++n) acc[a][b][m][n] = (f32x4){0.f, 0.f, 0.f, 0.f};
        if constexpr (Epi::LOAD_INIT) { const int tz2 = otid(wv) & 63; E.init(acc, nxt, wr, wc, tz2 & 15, tz2 >> 4); }
        cur = nxt; cA = nA; cB = nB; ++ui;
#pragma unroll
        for (int h = 0; h < 2; ++h)
#pragma unroll
            for (int i = 0; i < 2; ++i) oc[h][i] = on[h][i];
        if (wr == 1) PG8_BAR;
    }
    PG8_WAIT_V(0);
    PG8_BAR;
#undef PG8_SA
#undef PG8_SB
#undef PG8_STAGE
#undef PG8_LDA
#undef PG8_LDB
#undef PG8_MMA
#undef PG8_CAT
#undef PG8_WAIT_V
#undef PG8_WAIT_L
#undef PG8_BAR
#undef PG8_SCHED
}


struct EpiQK {
    static constexpr int PERM = 1; static constexpr bool LOAD_INIT = false; static constexpr bool FP8 = (FP8_PROJ != 0);
    bf16_t* O; const float *gqd, *gkd, *gqf, *gkf; LAS float* tbl; const float* rstd; unsigned char* O8;
    __device__ __forceinline__ void operator()(const f32x4 (&acc)[2][2][4][2], const Unit& u, int wr, int wc, int fr, int fq) const {
#pragma unroll
        for (int ai = 0; ai < 2; ++ai)
#pragma unroll
            for (int m = 0; m < 4; ++m)
#pragma unroll
                for (int bj = 0; bj < 2; ++bj) {
                    const f32x4 a = acc[ai][bj][m][0], b = acc[ai][bj][m][1];
                    float ss = (a[0] * a[0] + a[1] * a[1]) + (a[2] * a[2] + a[3] * a[3]) + (b[0] * b[0] + b[1] * b[1]) + (b[2] * b[2] + b[3] * b[3]);
                    ss += swz_xor<16>(ss); ss = sum_xor32(ss);
                    if (fq == 0) tbl[(bj * 256 + ai * 128 + wr * 64 + m * 16 + fr) * 4 + wc] = FP8 ? ss * (1.f / (W8_SCALE * W8_SCALE)) : ss;
                }
        asm volatile("s_waitcnt lgkmcnt(0)" ::: "memory"); __builtin_amdgcn_s_barrier(); asm volatile("" ::: "memory");
        const int colh = wc * 32 + fq * 8;
#pragma unroll
        for (int bj = 0; bj < 2; ++bj) {
            const int hh = u.pn * 2 + bj;
            int mode; const float* gp; float extra;
            if (hh < 6) { mode = 0; gp = gqd + (colh & 63); extra = 0.125f * LOG2E * 4.f; }
            else if (hh < 12) { mode = 0; gp = gkd + (colh & 63); extra = 0.25f; }
            else if (hh < 17) { mode = 1; gp = gqf + colh; extra = 0.08838834764831845f * LOG2E * 4.f; }
            else if (hh < 22) { mode = 1; gp = gkf + colh; extra = 0.25f; }
            else if (hh < 27) { mode = 2; gp = gqd; extra = 0.08838834764831845f * LOG2E; }
            else { mode = 2; gp = gqd; extra = 1.f; }
            f32x4 g0 = (f32x4){1.f, 1.f, 1.f, 1.f}, g1 = g0;
            if (mode != 2) { g0 = *(const f32x4*)gp; g1 = *(const f32x4*)(gp + 4); }
            g0 = g0 * (FP8 ? extra * (1.f / W8_SCALE) : extra); g1 = g1 * (FP8 ? extra * (1.f / W8_SCALE) : extra);
#pragma unroll
            for (int ai = 0; ai < 2; ++ai)
#pragma unroll
                for (int m = 0; m < 4; ++m) {
                    const int rl = ai * 128 + wr * 64 + m * 16 + fr;
                    const float rr = rstd[u.pm * 256 + rl];
                    float rs = rr;
                    if (mode != 2) {
                        const f32x4 t = *(const LAS f32x4*)(tbl + (bj * 256 + rl) * 4);
                        const float tot = (mode == 0) ? ((wc < 2) ? (t[0] + t[1]) : (t[2] + t[3])) : ((t[0] + t[1]) + (t[2] + t[3]));
                        rs = rr * __builtin_amdgcn_rsqf(rr * rr * tot * (mode == 0 ? (1.f / 64.f) : (1.f / 128.f)) + EPS);
                    }
                    const f32x4 v0 = acc[ai][bj][m][0] * g0 * rs, v1 = acc[ai][bj][m][1] * g1 * rs;
                    if (mode != 2) { u32x2 w8; w8.x = cvt4f8(v0[0], v0[1], v0[2], v0[3]); w8.y = cvt4f8(v1[0], v1[1], v1[2], v1[3]);
                        *(u32x2*)(O8 + (size_t)(u.pm * 256 + rl) * NQK + u.pn * 256 + bj * 128 + colh) = w8; continue; }
                    u32x4 w; w.x = cvtpk(v0[0], v0[1]); w.y = cvtpk(v0[2], v0[3]); w.z = cvtpk(v1[0], v1[1]); w.w = cvtpk(v1[2], v1[3]);
                    *(u32x4*)(O + (size_t)(u.pm * 256 + rl) * NQK + u.pn * 256 + bj * 128 + colh) = w;
                }
        }
    }
};
struct EpiVT {
    static constexpr int PERM = 2; static constexpr bool LOAD_INIT = false; static constexpr bool FP8 = (FP8_PROJ != 0);
    bf16_t* O; int ldc; const float* rstd;
    __device__ __forceinline__ void operator()(const f32x4 (&acc)[2][2][4][2], const Unit& u, int wr, int wc, int fr, int fq) const {
        f32x4 r0[2], r1[2];
#pragma unroll
        for (int bj = 0; bj < 2; ++bj) { const float* rp = rstd + u.pn * 256 + bj * 128 + wc * 32 + 16 * (fq >> 1) + 4 * (fq & 1);
            r0[bj] = *(const f32x4*)rp; r1[bj] = *(const f32x4*)(rp + 8); if (FP8) { r0[bj] = r0[bj] * (1.f / W8_SCALE); r1[bj] = r1[bj] * (1.f / W8_SCALE); } }
#pragma unroll
        for (int ai = 0; ai < 2; ++ai)
#pragma unroll
            for (int m = 0; m < 4; ++m)
#pragma unroll
                for (int bj = 0; bj < 2; ++bj) {
                    const f32x4 v0 = acc[ai][bj][m][0] * r0[bj], v1 = acc[ai][bj][m][1] * r1[bj];
                    u32x4 w; w.x = cvtpk(v0[0], v0[1]); w.y = cvtpk(v0[2], v0[3]); w.z = cvtpk(v1[0], v1[1]); w.w = cvtpk(v1[2], v1[3]);
                    *(u32x4*)(O + (size_t)(u.pm * 256 + ai * 128 + wr * 64 + m * 16 + fr) * ldc + u.pn * 256 + bj * 128 + wc * 32 + fq * 8) = w;
                }
    }
};
struct EpiResAdd {
    static constexpr int PERM = 1; static constexpr bool LOAD_INIT = true; static constexpr bool FP8 = (FP8_WOUT != 0);
    bf16_t* X; float sc; unsigned* done; unsigned char* X8;
    __device__ __forceinline__ void init(f32x4 (&acc)[2][2][4][2], const Unit& u, int wr, int wc, int fr, int fq) const {
#pragma unroll
        for (int ai = 0; ai < 2; ++ai)
#pragma unroll
            for (int m = 0; m < 4; ++m)
#pragma unroll
                for (int bj = 0; bj < 2; ++bj) {
                    const u32x4 w = *(const u32x4*)(X + (size_t)(u.pm * 256 + ai * 128 + wr * 64 + m * 16 + fr) * DM + u.pn * 256 + bj * 128 + wc * 32 + fq * 8);
                    acc[ai][bj][m][0] = (f32x4){bf_lo(w.x), bf_hi(w.x), bf_lo(w.y), bf_hi(w.y)};
                    acc[ai][bj][m][1] = (f32x4){bf_lo(w.z), bf_hi(w.z), bf_lo(w.w), bf_hi(w.w)};
                    if (FP8) { acc[ai][bj][m][0] = acc[ai][bj][m][0] * W8_SCALE; acc[ai][bj][m][1] = acc[ai][bj][m][1] * W8_SCALE; }
                }
    }
    __device__ __forceinline__ void operator()(const f32x4 (&acc)[2][2][4][2], const Unit& u, int wr, int wc, int fr, int fq) const {
        const __amdgpu_buffer_rsrc_t rsrc = __builtin_amdgcn_make_buffer_rsrc((void*)X, 0, SEQ * DM * 2, 0x00020000);
        const __amdgpu_buffer_rsrc_t rsrc8 = __builtin_amdgcn_make_buffer_rsrc((void*)X8, 0, SEQ * DM, 0x00020000);
#pragma unroll
        for (int ai = 0; ai < 2; ++ai)
#pragma unroll
            for (int m = 0; m < 4; ++m)
#pragma unroll
                for (int bj = 0; bj < 2; ++bj) {
                    const f32x4 v0 = FP8 ? acc[ai][bj][m][0] * (1.f / W8_SCALE) : acc[ai][bj][m][0], v1 = FP8 ? acc[ai][bj][m][1] * (1.f / W8_SCALE) : acc[ai][bj][m][1];
                    u32x4 w; w.x = cvtpk(v0[0], v0[1]); w.y = cvtpk(v0[2], v0[3]); w.z = cvtpk(v1[0], v1[1]); w.w = cvtpk(v1[2], v1[3]);
                    u32x2 w8; w8.x = cvt4f8(v0[0], v0[1], v0[2], v0[3]); w8.y = cvt4f8(v1[0], v1[1], v1[2], v1[3]);
                    __builtin_amdgcn_raw_buffer_store_b64(w8, rsrc8, (int)((u.pm * 256 + ai * 128 + wr * 64 + m * 16 + fr) * DM + u.pn * 256 + bj * 128 + wc * 32 + fq * 8), 0, 16);
                    __builtin_amdgcn_raw_buffer_store_b128(w, rsrc, (int)(((u.pm * 256 + ai * 128 + wr * 64 + m * 16 + fr) * DM + u.pn * 256 + bj * 128 + wc * 32 + fq * 8) * 2), 0, 16);
                }
        asm volatile("s_waitcnt vmcnt(0)" ::: "memory");
        if (fr == 0 && fq == 0) __hip_atomic_fetch_add(done + 64 * u.pm, 1u, __ATOMIC_RELAXED, __HIP_MEMORY_SCOPE_AGENT);
    }
};
struct EpiGU {
    static constexpr int PERM = 1; static constexpr bool LOAD_INIT = false; static constexpr bool FP8 = true;
    unsigned char* ACT; const float* gate; const LAS int* tbl; unsigned* done;
    __device__ __forceinline__ void operator()(const f32x4 (&acc)[2][2][4][2], const Unit& u, int wr, int wc, int fr, int fq) const {
        const int ct = u.pn & 3, n_e = __builtin_amdgcn_readfirstlane(tbl[17 + u.e]);
        const __amdgpu_buffer_rsrc_t rsrc = __builtin_amdgcn_make_buffer_rsrc((void*)ACT, 0, MOE_ROWS * FEXP, 0x00020000);
#pragma unroll
        for (int ai = 0; ai < 2; ++ai)
#pragma unroll
            for (int m = 0; m < 4; ++m) {
                const int rl = ai * 128 + wr * 64 + m * 16 + fr, pos = u.rt * 256 + rl;
                f32x2_t gr2 = {0.f, 0.f}; if (pos < n_e) gr2 = *(const f32x2_t*)(gate + 2 * (u.e * SEQ + pos));
                const float gt = gr2[0] * ACT8_SCALE, rs = gr2[1] * (1.f / W8_SCALE);
                float o[8];
#pragma unroll
                for (int n = 0; n < 2; ++n)
#pragma unroll
                    for (int j = 0; j < 4; ++j) { const float gv = acc[ai][0][m][n][j] * rs, uv = acc[ai][1][m][n][j] * rs;
                        const float sg = gv * __builtin_amdgcn_rcpf(1.f + fexp2(-gv * LOG2E)); o[n * 4 + j] = sg * uv * gt; }
                u32x2 w; w.x = cvt4f8(o[0], o[1], o[2], o[3]); w.y = cvt4f8(o[4], o[5], o[6], o[7]);
                __builtin_amdgcn_raw_buffer_store_b64(w, rsrc, (int)((u.pm * 256 + rl) * FEXP + ct * 128 + wc * 32 + fq * 8), 0, 16);
            }
        asm volatile("s_waitcnt vmcnt(0)" ::: "memory");
        if (fr == 0 && fq == 0) __hip_atomic_fetch_add(done + 64 * u.pm, 1u, __ATOMIC_RELAXED, __HIP_MEMORY_SCOPE_AGENT);
    }
};
struct EpiDown {
    static constexpr int PERM = 1; static constexpr bool LOAD_INIT = false; static constexpr bool FP8 = true;
    unsigned char* Y;
    __device__ __forceinline__ void operator()(const f32x4 (&acc)[2][2][4][2], const Unit& u, int wr, int wc, int fr, int fq) const {
        const int ct = u.pn & 7;
#pragma unroll
        for (int ai = 0; ai < 2; ++ai)
#pragma unroll
            for (int m = 0; m < 4; ++m)
#pragma unroll
                for (int bj = 0; bj < 2; ++bj) {
                    const f32x4 v0 = acc[ai][bj][m][0] * (Y8_SCALE / (W8_SCALE * ACT8_SCALE)), v1 = acc[ai][bj][m][1] * (Y8_SCALE / (W8_SCALE * ACT8_SCALE));
                    u32x2 w; w.x = cvt4f8(v0[0], v0[1], v0[2], v0[3]); w.y = cvt4f8(v1[0], v1[1], v1[2], v1[3]);
                    *(u32x2*)(Y + (size_t)(u.pm * 256 + ai * 128 + wr * 64 + m * 16 + fr) * DM + ct * 256 + bj * 128 + wc * 32 + fq * 8) = w;
                }
    }
};
}

#define XB_TMO      128
#define XB_XCNT(j)  (256  + 64 * (j))
#define XB_XSUB(j)  (1280 + 64 * (j))
#define XB_XGEN(j)  (2304 + 64 * (j))
#define XB_TOP      3328
#define XB_TOPGEN   3392
#define XCD_BAR_WORDS 3456
#define XB_SPIN_CAP (1u << 18)

__device__ __forceinline__ unsigned xb_ld(unsigned* p)              { return __hip_atomic_load(p, __ATOMIC_RELAXED, __HIP_MEMORY_SCOPE_AGENT); }
__device__ __forceinline__ unsigned xb_add(unsigned* p, unsigned v) { return __hip_atomic_fetch_add(p, v, __ATOMIC_RELAXED, __HIP_MEMORY_SCOPE_AGENT); }
__device__ __forceinline__ unsigned xb_xcc_id() { return (unsigned)__builtin_amdgcn_s_getreg((3 << 11) | 20) & 0xFu; }
#define XB_SPIN(cond, bar) do { unsigned _sp = 0; while (cond) { __builtin_amdgcn_s_sleep(1); \
    if ((++_sp & 255u) == 0u) { if (xb_ld(&(bar)[XB_TMO])) break; if (_sp > XB_SPIN_CAP) { atomicAdd(&(bar)[XB_TMO], 1u); break; } } } } while (0)

struct XcdBarrier { unsigned* bar; unsigned x; volatile LAS unsigned* st; int wv; };

__device__ __forceinline__ XcdBarrier xcd_barrier_post(unsigned* bar, volatile LAS unsigned* st, int wv) {
    XcdBarrier b; b.bar = bar; b.x = xb_xcc_id(); b.st = st; b.wv = wv;
    if (otid(wv) == 0) (void)xb_add(&bar[XB_XCNT(b.x)], 1u);
    return b;
}
__device__ __forceinline__ void xcd_barrier_complete(unsigned* bar, unsigned x, unsigned& nloc, unsigned& nx) {
    const unsigned G = gridDim.x * gridDim.y * gridDim.z;
    unsigned sum, cnt, mine, sp = 0u;
    for (;;) {
        sum = 0u; cnt = 0u; mine = 0u;
#pragma unroll
        for (unsigned j = 0; j < 16; ++j) { const unsigned c = xb_ld(&bar[XB_XCNT(j)]); sum += c; cnt += (c > 0u) ? 1u : 0u; mine = (j == x) ? c : mine; }
        if (sum == G) break;
        __builtin_amdgcn_s_sleep(1);
        if ((++sp & 255u) == 0u) { if (xb_ld(&bar[XB_TMO])) break; if (sp > XB_SPIN_CAP) { atomicAdd(&bar[XB_TMO], 1u); break; } }
    }
    nloc = mine > 0u ? mine : 1u; nx = cnt > 0u ? cnt : 1u;
}
__device__ __attribute__((noinline)) void xcd_barrier_impl(unsigned* bar_, unsigned bx, volatile LAS unsigned* bst, int bwv) {
    XcdBarrier b; b.bar = bar_; b.x = bx; b.st = bst; b.wv = bwv;
    asm volatile("s_waitcnt vmcnt(0)" ::: "memory");
    __syncthreads();
    if (otid(b.wv) == 0) {
        unsigned* bar = b.bar;
        __builtin_amdgcn_s_waitcnt(0);
        unsigned nloc = b.st[0], nx = b.st[1];
        if (nloc == 0u) { xcd_barrier_complete(bar, b.x, nloc, nx); b.st[0] = nloc; b.st[1] = nx; }
        const unsigned old = xb_add(&bar[XB_XSUB(b.x)], 1u);
        const unsigned gen = old / nloc;
        if (old + 1u == (gen + 1u) * nloc) {
            __builtin_amdgcn_fence(__ATOMIC_RELEASE, "agent");
            asm volatile("s_waitcnt vmcnt(0)" ::: "memory");
            const unsigned og = xb_add(&bar[XB_TOP], 1u);
            const unsigned tg = og / nx;
            if (og + 1u == (tg + 1u) * nx) xb_add(&bar[XB_TOPGEN], 1u);
            else XB_SPIN(xb_ld(&bar[XB_TOPGEN]) == tg, bar);
            __builtin_amdgcn_fence(__ATOMIC_ACQUIRE, "agent");
            xb_add(&bar[XB_XGEN(b.x)], 1u);
            asm volatile("s_waitcnt vmcnt(0)" ::: "memory");
        } else {
            XB_SPIN(xb_ld(&bar[XB_XGEN(b.x)]) == gen, bar);
            __builtin_amdgcn_fence(__ATOMIC_ACQUIRE, "agent");
            asm volatile("s_waitcnt vmcnt(0)" ::: "memory");
        }
    }
    __syncthreads();
}

__device__ __forceinline__ void xcd_barrier(const XcdBarrier& b) { xcd_barrier_impl(b.bar, b.x, b.st, b.wv); }

struct Params {
    const float *x, *attn_norm, *w_in, *b_forget, *qnorm_diff, *knorm_diff, *lam_q1, *lam_k1, *lam_q2, *lam_k2, *subln_diff, *onorm_sb,
        *qnorm_fox, *knorm_fox, *onorm_fox, *w_out, *ffn_norm, *w_router, *router_bias, *w_gate, *w_up, *w_down;
    float* out; unsigned char* ws; int ph_lo, ph_hi;
};
typedef const __attribute__((address_space(4))) Params* KArgs;
__device__ __forceinline__ KArgs kparams() { KArgs k = (KArgs)__builtin_amdgcn_kernarg_segment_ptr(); asm volatile("" : "+s"(k)); return k; }

__device__ __forceinline__ void transpose_item(const float* W, int ldn, int k0, int n0, bf16_t* WT, int K, int drow, LAS float* scr, int lane, const float* kgain = nullptr, bool f8 = false) {
#pragma unroll 8
    for (int i = 0; i < 32; ++i) { const int kk = 2 * i + (lane >> 5); scr[kk * 33 + (lane & 31)] = W[(size_t)(k0 + kk) * ldn + n0 + (lane & 31)]; }
    asm volatile("s_waitcnt lgkmcnt(0)" ::: "memory");
    const int c = lane & 7;
    f32x4 ga = {1.f, 1.f, 1.f, 1.f}, gb = ga;
    if (kgain) { ga = *(const f32x4*)(kgain + k0 + 8 * c); gb = *(const f32x4*)(kgain + k0 + 8 * c + 4); }
#pragma unroll
    for (int j = 0; j < 4; ++j) { const int n = (lane >> 3) + 8 * j; const LAS float* s = scr + (8 * c) * 33 + n;
        if (f8) { u32x2 o8; o8.x = cvt4f8(s[0 * 33] * ga[0] * W8_SCALE, s[1 * 33] * ga[1] * W8_SCALE, s[2 * 33] * ga[2] * W8_SCALE, s[3 * 33] * ga[3] * W8_SCALE);
            o8.y = cvt4f8(s[4 * 33] * gb[0] * W8_SCALE, s[5 * 33] * gb[1] * W8_SCALE, s[6 * 33] * gb[2] * W8_SCALE, s[7 * 33] * gb[3] * W8_SCALE);
            *(u32x2*)((unsigned char*)WT + (size_t)(drow + n) * K + k0 + 8 * c) = o8; continue; }
        u32x4 o; o.x = cvtpk(s[0 * 33] * ga[0], s[1 * 33] * ga[1]); o.y = cvtpk(s[2 * 33] * ga[2], s[3 * 33] * ga[3]); o.z = cvtpk(s[4 * 33] * gb[0], s[5 * 33] * gb[1]); o.w = cvtpk(s[6 * 33] * gb[2], s[7 * 33] * gb[3]);
        *(u32x4*)(WT + (size_t)(drow + n) * K + k0 + 8 * c) = o; }
    asm volatile("s_waitcnt lgkmcnt(0)" ::: "memory");
}
__device__ __forceinline__ int win_dest(int n0, int& sel) {
    if (n0 < 768) { sel = 0; return n0; }
    if (n0 < 1536) { sel = 0; return n0; }
    if (n0 < 2304) { sel = 1; return n0 - 1536; }
    if (n0 < 2944) { sel = 0; return 2816 + (n0 - 2304); }
    if (n0 < 3584) { sel = 0; return 3456 + (n0 - 2944); }
    if (n0 < 4224) { sel = 1; return 768 + (n0 - 3584); }
    if (n0 < 4864) { sel = 0; return 1536 + (n0 - 4224); }
    if (n0 < 5504) { sel = 0; return 2176 + (n0 - 4864); }
    sel = 1; return 1408 + (n0 - 5504);
}
__device__ __forceinline__ void phase_prologue(KArgs p, LAS unsigned char* lds, int wv) {
    const int tid = otid(wv), lane = tid & 63, wave = tid >> 6;
    LAS float* scr = (LAS float*)(lds + wave * 16384);
    const int gw = blockIdx.x * 8 + wave, NGW = gridDim.x * 8;
    constexpr int I_IN = 32 * 192, I_O = 32 * 64, I_G = 16 * 32 * 16, I_D = 16 * 8 * 64, I_L = I_IN + I_O + 2 * I_G + I_D;
    bf16_t* Wqk = (bf16_t*)(p->ws + WS_WQK); bf16_t* Wv = (bf16_t*)(p->ws + WS_WV); bf16_t* Wo = (bf16_t*)(p->ws + WS_WO);
    bf16_t* Wgu = (bf16_t*)(p->ws + WS_WGU); bf16_t* Wd = (bf16_t*)(p->ws + WS_WD);
    for (int it = gw; it < DEPTH * I_L; it += NGW) {
        const int l = it / I_L; int r = it % I_L;
        if (r < I_IN) { const int kb = r / 192, nb = r % 192; int sel; const int drow = win_dest(nb * 32, sel);
            if (FP8_PROJ) transpose_item(p->w_in + (size_t)l * DM * NIN, NIN, kb * 64, nb * 32, (bf16_t*)(sel ? (unsigned char*)Wv + (size_t)l * NV * DM : (unsigned char*)Wqk + (size_t)l * NQK * DM), DM, drow, scr, lane, p->attn_norm + (size_t)l * DM, true);
            else transpose_item(p->w_in + (size_t)l * DM * NIN, NIN, kb * 64, nb * 32, sel ? Wv + (size_t)l * NV * DM : Wqk + (size_t)l * NQK * DM, DM, drow, scr, lane, p->attn_norm + (size_t)l * DM); continue; }
        r -= I_IN;
        if (r < I_O) { const int kb = r / 64, nb = r % 64;
            if (FP8_WOUT) transpose_item(p->w_out + (size_t)l * DM * DM, DM, kb * 64, nb * 32, (bf16_t*)((unsigned char*)Wo + (size_t)l * DM * DM), DM, nb * 32, scr, lane, nullptr, true);
            else transpose_item(p->w_out + (size_t)l * DM * DM, DM, kb * 64, nb * 32, Wo + (size_t)l * DM * DM, DM, nb * 32, scr, lane); continue; }
        r -= I_O;
        if (r < 2 * I_G) { const int up = r / I_G; r %= I_G; const int e = r / 512, kb = (r % 512) / 16, nb = r % 16; const int n0 = nb * 32;
            const float* src = (up ? p->w_up : p->w_gate) + ((size_t)l * NEXP + e) * DM * FEXP;
            transpose_item(src, FEXP, kb * 64, n0, (bf16_t*)((unsigned char*)Wgu + ((size_t)l * NEXP + e) * 1024 * DM), DM, (n0 >> 7) * 256 + up * 128 + (n0 & 127), scr, lane, p->ffn_norm + (size_t)l * DM, true); continue; }
        r -= 2 * I_G;
        { const int e = r / 512, kb = (r % 512) / 64, nb = r % 64;
            transpose_item(p->w_down + ((size_t)l * NEXP + e) * FEXP * DM, DM, kb * 64, nb * 32, (bf16_t*)((unsigned char*)Wd + ((size_t)l * NEXP + e) * DM * FEXP), FEXP, nb * 32, scr, lane, nullptr, true); }
    }
    { float* WRT = (float*)(p->ws + WS_WRT); for (int i = blockIdx.x * 512 + tid; i < 16 * DM; i += gridDim.x * 512) WRT[(i & 15) * DM + (i >> 4)] = p->w_router[i]; }
    float* WF = (float*)(p->ws + WS_WF);
    for (int i = blockIdx.x * 512 + tid; i < DEPTH * 5 * DM; i += gridDim.x * 512) { const int l = i / (5 * DM), h = (i / DM) % 5, d = i % DM;
        WF[i] = p->w_in[((size_t)l * DM + d) * NIN + 6144 + h]; }
    if (blockIdx.x == 1 && wave < DEPTH) {
        const int l = wave;
        float a = fabsf(p->qnorm_diff[l * 64 + lane]), b = fabsf(p->knorm_diff[l * 64 + lane]);
        float c2 = fmaxf(fabsf(p->qnorm_fox[l * 128 + lane]), fabsf(p->qnorm_fox[l * 128 + 64 + lane])), d2 = fmaxf(fabsf(p->knorm_fox[l * 128 + lane]), fabsf(p->knorm_fox[l * 128 + 64 + lane]));
#pragma unroll
        for (int o = 1; o < 32; o <<= 1) { a = fmaxf(a, __int_as_float(__builtin_amdgcn_ds_bpermute(((lane ^ o) << 2), __float_as_int(a)))); b = fmaxf(b, __int_as_float(__builtin_amdgcn_ds_bpermute(((lane ^ o) << 2), __float_as_int(b))));
            c2 = fmaxf(c2, __int_as_float(__builtin_amdgcn_ds_bpermute(((lane ^ o) << 2), __float_as_int(c2)))); d2 = fmaxf(d2, __int_as_float(__builtin_amdgcn_ds_bpermute(((lane ^ o) << 2), __float_as_int(d2)))); }
        a = fmaxf(a, __int_as_float(__builtin_amdgcn_ds_bpermute(((lane ^ 32) << 2), __float_as_int(a)))); b = fmaxf(b, __int_as_float(__builtin_amdgcn_ds_bpermute(((lane ^ 32) << 2), __float_as_int(b))));
        c2 = fmaxf(c2, __int_as_float(__builtin_amdgcn_ds_bpermute(((lane ^ 32) << 2), __float_as_int(c2)))); d2 = fmaxf(d2, __int_as_float(__builtin_amdgcn_ds_bpermute(((lane ^ 32) << 2), __float_as_int(d2))));
        if (lane == 0) { ((float*)(p->ws + WS_LAM))[8 + 2 * l] = a * b; ((float*)(p->ws + WS_LAM))[8 + 2 * l + 1] = c2 * d2; }
    }
    if (blockIdx.x == 0 && wave < DEPTH) {
        const int l = wave;
        float a = wave_sum(p->lam_q1[l * 64 + lane] * p->lam_k1[l * 64 + lane]), b = wave_sum(p->lam_q2[l * 64 + lane] * p->lam_k2[l * 64 + lane]);
        if (lane == 0) ((float*)(p->ws + WS_LAM))[l] = fexp2(a * LOG2E) - fexp2(b * LOG2E) + (0.8f - 0.6f * fexp2(-0.3f * LOG2E * (float)l));
    }
}

__device__ __forceinline__ float log_sigmoid(float x) { return fminf(x, 0.f) - 0.6931471805599453f * flog2(1.f + fexp2(-fabsf(x) * LOG2E)); }

__device__ __forceinline__ void phase_norm1(KArgs p, int l, LAS unsigned char* lds, int wv, bool probe2 = false) {
    const int tid = otid(wv), lane = tid & 63, wave = tid >> 6;
    LAS float* wf = (LAS float*)lds;
    LAS int* rbase = (LAS int*)(lds + 5 * DM * 4);
    if (l < DEPTH) { const float* WF = (const float*)(p->ws + WS_WF) + (size_t)l * 5 * DM; for (int i = tid; i < 5 * DM; i += 512) wf[i] = WF[i]; }
    if (l > 0 && tid == 0) { const unsigned* cnt = (const unsigned*)(p->ws + WS_CTL) + CW_CNT + (l - 1) * 16 * 64; int acc = 0;
        for (int e = 0; e < 16; ++e) { rbase[e] = acc * 256; acc += ((int)cnt[e * 64] + 255) >> 8; } }
    __syncthreads();
    const bf16_t* Y = (const bf16_t*)(p->ws + WS_Y); const i32x4* tsel = (const i32x4*)(p->ws + WS_TSEL);
    bf16_t* XN = (bf16_t*)(p->ws + WS_XN); float* LOGF = (float*)(p->ws + WS_LOGF);
    const int gw = blockIdx.x * 8 + wave, NGW = gridDim.x * 8;
    for (int t = gw; t < SEQ; t += NGW) {
        asm volatile("" ::: "memory");
        f32x4 v[8];
        if (l == 0 && !probe2) { const f32x4* xr = (const f32x4*)(p->x + (size_t)t * DM) + lane;
#pragma unroll
            for (int j = 0; j < 8; ++j) v[j] = xr[64 * j]; }
        else { const u32x2* xr = (const u32x2*)((const bf16_t*)(p->ws + WS_OUTB) + (size_t)t * DM) + lane;
#pragma unroll
            for (int j = 0; j < 8; ++j) { const u32x2 a = xr[64 * j]; v[j] = (f32x4){bf_lo(a[0]), bf_hi(a[0]), bf_lo(a[1]), bf_hi(a[1])}; } }
        if (l > 0) {
            const float ysc = probe2 ? 0.f : 1.f;
            const i32x4 ts = tsel[t];
            const unsigned* y1 = (const unsigned*)((const unsigned char*)Y + (size_t)(rbase[ts[0]] + ts[1]) * DM) + lane; const unsigned* y2 = (const unsigned*)((const unsigned char*)Y + (size_t)(rbase[ts[2]] + ts[3]) * DM) + lane;
            const float ys8 = ysc * (1.f / Y8_SCALE);
#pragma unroll
            for (int j = 0; j < 8; ++j) { const unsigned a = y1[64 * j], b = y2[64 * j];
                const f32x2_t a0 = __builtin_amdgcn_cvt_pk_f32_fp8((int)a, false), a1 = __builtin_amdgcn_cvt_pk_f32_fp8((int)a, true), b0 = __builtin_amdgcn_cvt_pk_f32_fp8((int)b, false), b1 = __builtin_amdgcn_cvt_pk_f32_fp8((int)b, true);
                v[j][0] += ys8 * (a0[0] + b0[0]); v[j][1] += ys8 * (a0[1] + b0[1]); v[j][2] += ys8 * (a1[0] + b1[0]); v[j][3] += ys8 * (a1[1] + b1[1]); }
        }
        if (l == DEPTH) { f32x4* orow = (f32x4*)(p->out + (size_t)t * DM) + lane;
#pragma unroll
            for (int j = 0; j < 8; ++j) orow[64 * j] = v[j]; }
        else { u32x2* orow = (u32x2*)((bf16_t*)(p->ws + WS_OUTB) + (size_t)t * DM) + lane;
#pragma unroll
            for (int j = 0; j < 8; ++j) { u32x2 w; w[0] = cvtpk(v[j][0], v[j][1]); w[1] = cvtpk(v[j][2], v[j][3]); orow[64 * j] = w; }
            if (FP8_PROJ) { unsigned* orow8 = (unsigned*)(p->ws + WS_OUTB8 + (size_t)t * DM) + lane;
#pragma unroll
                for (int j = 0; j < 8; ++j) orow8[64 * j] = cvt4f8(v[j][0], v[j][1], v[j][2], v[j][3]); } }
        if (l == DEPTH) continue;
        float ss = 0.f;
#pragma unroll
        for (int j = 0; j < 8; ++j) ss += (v[j][0] * v[j][0] + v[j][1] * v[j][1]) + (v[j][2] * v[j][2] + v[j][3] * v[j][3]);
        const float rstd = __builtin_amdgcn_rsqf(wave_sum(ss) * (1.f / DM) + EPS);
        const f32x4* gr = (const f32x4*)(p->attn_norm + (size_t)l * DM) + lane;
        float fc[5] = {0.f, 0.f, 0.f, 0.f, 0.f};
        if (lane == 0) ((float*)(p->ws + WS_RSTD))[t] = rstd;
#pragma unroll
        for (int j = 0; j < 8; ++j) { const f32x4 xn = v[j] * rstd * gr[64 * j];
#pragma unroll
            for (int h = 0; h < 5; ++h) { const f32x4 w4 = *(const LAS f32x4*)(wf + h * DM + 4 * lane + 256 * j); fc[h] += (xn[0] * w4[0] + xn[1] * w4[1]) + (xn[2] * w4[2] + xn[3] * w4[3]); } }
#pragma unroll
        for (int h = 0; h < 5; ++h) { const float s = wave_sum(fc[h]); if (lane == 0) LOGF[h * SEQ + t] = log_sigmoid(s + p->b_forget[l * 5 + h]); }
    }
}

__device__ __forceinline__ void scan_head(KArgs p, int h, int l, LAS unsigned char* lds, int wv) {
    const int tid = otid(wv), lane = tid & 63, wave = tid >> 6;
    const float* src = (const float*)(p->ws + WS_LOGF) + (size_t)h * SEQ + tid * 16; float* dst = (float*)(p->ws + WS_DC2) + (size_t)h * SEQ + tid * 16;
    LAS float* wt = (LAS float*)lds;
    float v[16]; float s = 0.f;
#pragma unroll
    for (int i = 0; i < 4; ++i) { const f32x4 a = ((const f32x4*)src)[i]; v[4 * i] = a[0]; v[4 * i + 1] = a[1]; v[4 * i + 2] = a[2]; v[4 * i + 3] = a[3]; }
#pragma unroll
    for (int i = 0; i < 16; ++i) { s += v[i]; v[i] = s; }
    float inc = s;
#pragma unroll
    for (int o = 1; o < 64; o <<= 1) { const float n = __int_as_float(__builtin_amdgcn_ds_bpermute(((lane - o) & 63) << 2, __float_as_int(inc))); if (lane >= o) inc += n; }
    if (lane == 63) wt[wave] = inc;
    __syncthreads();
    float base = inc - s;
    for (int w = 0; w < wave; ++w) base += wt[w];
#pragma unroll
    for (int i = 0; i < 4; ++i) ((f32x4*)dst)[i] = (f32x4){(v[4 * i] + base) * LOG2E, (v[4 * i + 1] + base) * LOG2E, (v[4 * i + 2] + base) * LOG2E, (v[4 * i + 3] + base) * LOG2E};
    LAS float* dl = (LAS float*)(lds + 64);
#pragma unroll
    for (int i = 0; i < 16; ++i) dl[tid * 16 + i] = (v[i] + base) * LOG2E;
    __syncthreads();
    { const float thr = 39.f + 2.f * 16.3221377f * ((const float*)(p->ws + WS_LAM))[8 + 2 * l + 1];
      const int qb = tid >> 4, part = tid & 15; const float dref = dl[256 * qb]; int cnt = 0;
      for (int i = part; i < 4 * qb; i += 16) cnt += (dref - dl[64 * i + 63] <= -thr) ? 1 : 0;
      float c = (float)cnt; c += swz_xor<1>(c); c += swz_xor<2>(c); c += swz_xor<4>(c); c += swz_xor<8>(c);
      if (part == 0) ((int*)(p->ws + WS_LAM))[64 + h * 32 + qb] = (int)c; }
    __syncthreads();
}

namespace att {
constexpr int KP = 272, VP = 144;
constexpr int KT_BYTES = 64 * KP, VT_BYTES = 128 * VP, KB_BYTES = 256;
constexpr int BUF_BYTES = KT_BYTES + VT_BYTES + KB_BYTES;
constexpr float THR = 8.f;
static_assert(2 * BUF_BYTES <= RING_BYTES && 4 * 128 * 32 * 4 <= RING_BYTES, "attention LDS");

constexpr int KP8 = 144;
struct Stg { u32x4 k0, k1, v0, v1; };
template <bool F8K = false>
__device__ __forceinline__ void stage_load(Stg& s, const bf16_t* Kg, const bf16_t* Vg, int j, int tid) {
    if (F8K) { s.k0 = *(const u32x4*)((const unsigned char*)Kg + (size_t)(64 * j + (tid >> 3)) * NQK + (tid & 7) * 16); }
    else { const bf16_t* kp = Kg + (size_t)(64 * j + (tid >> 3)) * NQK + (tid & 7) * 8;
    s.k0 = *(const u32x4*)kp; s.k1 = *(const u32x4*)(kp + 64); }
    const bf16_t* vp = Vg + (size_t)(tid >> 2) * SEQ + 64 * j + (tid & 3) * 8;
    s.v0 = *(const u32x4*)vp; s.v1 = *(const u32x4*)(vp + 32);
}
template <bool F8K = false>
__device__ __forceinline__ void stage_write(const Stg& s, LAS unsigned char* buf, int tid) {
    if (F8K) { *(LAS u32x4*)(buf + (tid >> 3) * KP8 + (tid & 7) * 16) = s.k0; }
    else { LAS unsigned char* kd = buf + (tid >> 3) * KP + (tid & 7) * 16; *(LAS u32x4*)kd = s.k0; *(LAS u32x4*)(kd + 128) = s.k1; }
    LAS unsigned char* vd = buf + KT_BYTES + (tid >> 2) * VP + (tid & 3) * 16; *(LAS u32x4*)vd = s.v0; *(LAS u32x4*)(vd + 64) = s.v1;
}
template <int NKS>
__device__ __forceinline__ void qk_tile(f32x16& p0, f32x16& p1, const LAS unsigned char* kb, const bf16x8* qr) {
    bf16x8 ka[NKS], kc[NKS];
#pragma unroll
    for (int ks = 0; ks < NKS; ++ks) { ka[ks] = *(const LAS bf16x8*)(kb + ks * 32); kc[ks] = *(const LAS bf16x8*)(kb + 32 * KP + ks * 32); }
    __builtin_amdgcn_sched_barrier(0);
#pragma unroll
    for (int ks = 0; ks < NKS; ++ks) {
        p0 = __builtin_amdgcn_mfma_f32_32x32x16_bf16(ka[ks], qr[ks], p0, 0, 0, 0);
        p1 = __builtin_amdgcn_mfma_f32_32x32x16_bf16(kc[ks], qr[ks], p1, 0, 0, 0);
    }
    __builtin_amdgcn_sched_barrier(0);
}
__device__ __forceinline__ bf16x8 pack8(const f32x16& p, int b) {
    u32x4 w = {cvtpk(p[b + 0], p[b + 1]), cvtpk(p[b + 2], p[b + 3]), cvtpk(p[b + 4], p[b + 5]), cvtpk(p[b + 6], p[b + 7])};
    return *reinterpret_cast<bf16x8*>(&w);
}
__device__ __forceinline__ void pv_tile(f32x16 (&o)[4], const LAS unsigned char* vb, const f32x16& p0, const f32x16& p1) {
    const bf16x8 pb0 = pack8(p0, 0), pb1 = pack8(p0, 8), pb2 = pack8(p1, 0), pb3 = pack8(p1, 8);
#pragma unroll
    for (int dh = 0; dh < 2; ++dh) {
        bf16x8 va[8];
#pragma unroll
        for (int i = 0; i < 8; ++i) va[i] = *(const LAS bf16x8*)(vb + (2 * dh + (i >> 2)) * 32 * VP + (i & 3) * 32);
        __builtin_amdgcn_sched_barrier(0);
#pragma unroll
        for (int i = 0; i < 8; ++i) { const int d0 = 2 * dh + (i >> 2), s4 = i & 3;
            o[d0] = __builtin_amdgcn_mfma_f32_32x32x16_bf16(va[i], s4 == 0 ? pb0 : (s4 == 1 ? pb1 : (s4 == 2 ? pb2 : pb3)), o[d0], 0, 0, 0); }
        __builtin_amdgcn_sched_barrier(0);
    }
}
template <int NKS>
__device__ __forceinline__ void tile_fixed(f32x16 (&o)[4], const LAS unsigned char* kb, const LAS unsigned char* vb, const bf16x8* qr, f32x16& y0, f32x16& y1, float& l) {
    bf16x8 ka[NKS], kc[NKS];
#pragma unroll
    for (int ks = 0; ks < NKS; ++ks) { ka[ks] = *(const LAS bf16x8*)(kb + ks * 32); kc[ks] = *(const LAS bf16x8*)(kb + 32 * KP + ks * 32); }
    __builtin_amdgcn_sched_barrier(0);
#pragma unroll
    for (int ks = 0; ks < NKS; ++ks) y0 = __builtin_amdgcn_mfma_f32_32x32x16_bf16(ka[ks], qr[ks], y0, 0, 0, 0);
    __builtin_amdgcn_sched_barrier(0);
    asm volatile("" : "+v"(y0));
#pragma unroll
    for (int ks = 0; ks < NKS; ++ks) y1 = __builtin_amdgcn_mfma_f32_32x32x16_bf16(kc[ks], qr[ks], y1, 0, 0, 0);
    float s = 0.f;
#pragma unroll
    for (int r = 0; r < 16; ++r) { y0[r] = fexp2(y0[r]); s += y0[r]; }
    const bf16x8 pb0 = pack8(y0, 0), pb1 = pack8(y0, 8);
#pragma unroll
    for (int q = 0; q < NKS; ++q) { __builtin_amdgcn_sched_group_barrier(0x008, 1, 0);
#pragma unroll
        for (int h = 0; h < 8 / NKS; ++h) { __builtin_amdgcn_sched_group_barrier(0x400, 2, 0); __builtin_amdgcn_sched_group_barrier(0x002, 3, 0); } }
    __builtin_amdgcn_sched_barrier(0);
    bf16x8 va[8];
#pragma unroll
    for (int i = 0; i < 8; ++i) va[i] = *(const LAS bf16x8*)(vb + (i >> 1) * 32 * VP + (i & 1) * 32);
    __builtin_amdgcn_sched_barrier(0);
    asm volatile("" : "+v"(y1));
#pragma unroll
    for (int i = 0; i < 8; ++i) o[i >> 1] = __builtin_amdgcn_mfma_f32_32x32x16_bf16(va[i], (i & 1) ? pb1 : pb0, o[i >> 1], 0, 0, 0);
    float s1 = 0.f;
#pragma unroll
    for (int r = 0; r < 16; ++r) { y1[r] = fexp2(y1[r]); s1 += y1[r]; }
    const bf16x8 pb2 = pack8(y1, 0), pb3 = pack8(y1, 8);
#pragma unroll
    for (int q = 0; q < 8; ++q) { __builtin_amdgcn_sched_group_barrier(0x008, 1, 0); __builtin_amdgcn_sched_group_barrier(0x400, 2, 0); __builtin_amdgcn_sched_group_barrier(0x002, 3, 0); }
    __builtin_amdgcn_sched_barrier(0);
    l += s + s1;
    bf16x8 vb2[8];
#pragma unroll
    for (int i = 0; i < 8; ++i) vb2[i] = *(const LAS bf16x8*)(vb + (i >> 1) * 32 * VP + 64 + (i & 1) * 32);
    __builtin_amdgcn_sched_barrier(0);
#pragma unroll
    for (int i = 0; i < 8; ++i) o[i >> 1] = __builtin_amdgcn_mfma_f32_32x32x16_bf16(vb2[i], (i & 1) ? pb3 : pb2, o[i >> 1], 0, 0, 0);
    __builtin_amdgcn_sched_barrier(0);
}
template <int NKS>
__device__ __forceinline__ void tile_fixed8(f32x16 (&o)[4], const LAS unsigned char* kb, const LAS unsigned char* vb, const i32x8* qr, f32x16& y0, f32x16& y1, float& l) {
    typedef float f32x8_t __attribute__((ext_vector_type(8)));
    i32x8 ka[NKS], kc[NKS];
#pragma unroll
    for (int ks = 0; ks < NKS; ++ks) { const i32x4 a0 = *(const LAS i32x4*)(kb + ks * 64), a1 = *(const LAS i32x4*)(kb + ks * 64 + 16), c0 = *(const LAS i32x4*)(kb + 32 * KP8 + ks * 64), c1 = *(const LAS i32x4*)(kb + 32 * KP8 + ks * 64 + 16);
        ka[ks] = __builtin_shufflevector(a0, a1, 0, 1, 2, 3, 4, 5, 6, 7); kc[ks] = __builtin_shufflevector(c0, c1, 0, 1, 2, 3, 4, 5, 6, 7); }
    __builtin_amdgcn_sched_barrier(0);
#pragma unroll
    for (int ks = 0; ks < NKS; ++ks) y0 = __builtin_amdgcn_mfma_scale_f32_32x32x64_f8f6f4(ka[ks], qr[ks], y0, 0, 0, 0, 0x7F7F7F7F, 0, 0x7F7F7F7F);
    __builtin_amdgcn_sched_barrier(0);
    f32x8_t a0 = __builtin_shufflevector(y0, y0, 0, 1, 2, 3, 4, 5, 6, 7), a1 = __builtin_shufflevector(y0, y0, 8, 9, 10, 11, 12, 13, 14, 15);
    asm volatile("" : "+v"(a0));
#pragma unroll
    for (int ks = 0; ks < NKS; ++ks) y1 = __builtin_amdgcn_mfma_scale_f32_32x32x64_f8f6f4(kc[ks], qr[ks], y1, 0, 0, 0, 0x7F7F7F7F, 0, 0x7F7F7F7F);
    float s = 0.f;
#pragma unroll
    for (int r = 0; r < 8; ++r) { a0[r] = fexp2(a0[r]); s += a0[r]; }
    bf16x8 pb0; { u32x4 w = {cvtpk(a0[0], a0[1]), cvtpk(a0[2], a0[3]), cvtpk(a0[4], a0[5]), cvtpk(a0[6], a0[7])}; pb0 = *reinterpret_cast<bf16x8*>(&w); }
#pragma unroll
    for (int q = 0; q < NKS; ++q) { __builtin_amdgcn_sched_group_barrier(0x008, 1, 0);
#pragma unroll
        for (int h = 0; h < 4 / NKS; ++h) { __builtin_amdgcn_sched_group_barrier(0x400, 2, 0); __builtin_amdgcn_sched_group_barrier(0x002, 3, 0); } }
    __builtin_amdgcn_sched_barrier(0);
    bf16x8 va[8];
#pragma unroll
    for (int i = 0; i < 8; ++i) va[i] = *(const LAS bf16x8*)(vb + (i & 3) * 32 * VP + (i >> 2) * 32);
    __builtin_amdgcn_sched_barrier(0);
    f32x8_t b0 = __builtin_shufflevector(y1, y1, 0, 1, 2, 3, 4, 5, 6, 7), b1 = __builtin_shufflevector(y1, y1, 8, 9, 10, 11, 12, 13, 14, 15);
    asm volatile("" : "+v"(a1));
#pragma unroll
    for (int i = 0; i < 4; ++i) o[i] = __builtin_amdgcn_mfma_f32_32x32x16_bf16(va[i], pb0, o[i], 0, 0, 0);
#pragma unroll
    for (int r = 0; r < 8; ++r) { a1[r] = fexp2(a1[r]); s += a1[r]; }
    bf16x8 pb1; { u32x4 w = {cvtpk(a1[0], a1[1]), cvtpk(a1[2], a1[3]), cvtpk(a1[4], a1[5]), cvtpk(a1[6], a1[7])}; pb1 = *reinterpret_cast<bf16x8*>(&w); }
#pragma unroll
    for (int q = 0; q < 4; ++q) { __builtin_amdgcn_sched_group_barrier(0x008, 1, 0); __builtin_amdgcn_sched_group_barrier(0x400, 2, 0); __builtin_amdgcn_sched_group_barrier(0x002, 3, 0); }
    __builtin_amdgcn_sched_barrier(0);
    bf16x8 vb2[8];
#pragma unroll
    for (int i = 0; i < 8; ++i) vb2[i] = *(const LAS bf16x8*)(vb + (i & 3) * 32 * VP + 64 + (i >> 2) * 32);
    asm volatile("" : "+v"(b0));
#pragma unroll
    for (int i = 0; i < 4; ++i) o[i] = __builtin_amdgcn_mfma_f32_32x32x16_bf16(va[4 + i], pb1, o[i], 0, 0, 0);
#pragma unroll
    for (int r = 0; r < 8; ++r) { b0[r] = fexp2(b0[r]); s += b0[r]; }
    bf16x8 pb2; { u32x4 w = {cvtpk(b0[0], b0[1]), cvtpk(b0[2], b0[3]), cvtpk(b0[4], b0[5]), cvtpk(b0[6], b0[7])}; pb2 = *reinterpret_cast<bf16x8*>(&w); }
#pragma unroll
    for (int q = 0; q < 4; ++q) { __builtin_amdgcn_sched_group_barrier(0x008, 1, 0); __builtin_amdgcn_sched_group_barrier(0x400, 2, 0); __builtin_amdgcn_sched_group_barrier(0x002, 3, 0); }
    __builtin_amdgcn_sched_barrier(0);
    asm volatile("" : "+v"(b1));
#pragma unroll
    for (int i = 0; i < 4; ++i) o[i] = __builtin_amdgcn_mfma_f32_32x32x16_bf16(vb2[i], pb2, o[i], 0, 0, 0);
#pragma unroll
    for (int r = 0; r < 8; ++r) { b1[r] = fexp2(b1[r]); s += b1[r]; }
    bf16x8 pb3; { u32x4 w = {cvtpk(b1[0], b1[1]), cvtpk(b1[2], b1[3]), cvtpk(b1[4], b1[5]), cvtpk(b1[6], b1[7])}; pb3 = *reinterpret_cast<bf16x8*>(&w); }
#pragma unroll
    for (int q = 0; q < 4; ++q) { __builtin_amdgcn_sched_group_barrier(0x008, 1, 0); __builtin_amdgcn_sched_group_barrier(0x400, 2, 0); __builtin_amdgcn_sched_group_barrier(0x002, 3, 0); }
    __builtin_amdgcn_sched_barrier(0);
    l += s;
#pragma unroll
    for (int i = 0; i < 4; ++i) o[i] = __builtin_amdgcn_mfma_f32_32x32x16_bf16(vb2[4 + i], pb3, o[i], 0, 0, 0);
    __builtin_amdgcn_sched_barrier(0);
}
__device__ __forceinline__ float swap_max(float v) { auto rr = __builtin_amdgcn_permlane32_swap(__float_as_uint(v), __float_as_uint(v), false, false); return fmaxf(__uint_as_float(rr[0]), __uint_as_float(rr[1])); }
__device__ __forceinline__ float swap_sum(float v) { auto rr = __builtin_amdgcn_permlane32_swap(__float_as_uint(v), __float_as_uint(v), false, false); return __uint_as_float(rr[0]) + __uint_as_float(rr[1]); }
__device__ __forceinline__ void softmax_step(f32x16& y0, f32x16& y1, float A, float& m, float& l, f32x16 (&o)[4]) {
    float mx = y0[0];
#pragma unroll
    for (int r = 1; r < 16; ++r) mx = fmaxf(mx, y0[r]);
#pragma unroll
    for (int r = 0; r < 16; ++r) mx = fmaxf(mx, y1[r]);
    mx = swap_max(mx) + A;
    if (__any(mx > m + THR)) {
        const float mn = fmaxf(m, mx), al = fexp2(m - mn); m = mn; l *= al;
#pragma unroll
        for (int d0 = 0; d0 < 4; ++d0)
#pragma unroll
            for (int r = 0; r < 16; ++r) o[d0][r] *= al;
    }
    const float mA = m - A; float s = 0.f;
#pragma unroll
    for (int r = 0; r < 16; ++r) { y0[r] = fexp2(y0[r] - mA); s += y0[r]; }
#pragma unroll
    for (int r = 0; r < 16; ++r) { y1[r] = fexp2(y1[r] - mA); s += y1[r]; }
    l += s;
}
__device__ __forceinline__ void softmax_fixed(f32x16& y0, f32x16& y1, float c, float& l) {
    float s = 0.f;
#pragma unroll
    for (int r = 0; r < 16; ++r) { y0[r] = fexp2(y0[r] + c); s += y0[r]; }
#pragma unroll
    for (int r = 0; r < 16; ++r) { y1[r] = fexp2(y1[r] + c); s += y1[r]; }
    l += s;
}
#define KIDX(r) (((r) & 3) + 8 * ((r) >> 2))

template <int TY>
__device__ __forceinline__ void att_item(KArgs p, int l, int head, int qb, LAS unsigned char* lds, int wv, int part = 0) {
    const int tid = otid(wv), wid = __builtin_amdgcn_readfirstlane(tid >> 6), lane = tid & 63, r32 = lane & 31, hi = lane >> 5;
    constexpr int NKS = (TY == 0) ? 4 : 8;
    const int br = (TY == 0) ? (wid >> 2) : 0, rg = (TY == 0) ? (wid & 3) : wid;
    const int t0w = (TY == 0) ? (128 * qb + 32 * rg) : (256 * qb + 32 * wid);
    const int trow = t0w + r32;
    const int NT = (TY == 0) ? (2 * qb + 2) : (4 * qb + 4);
    const int qcol = (TY == 0) ? (128 * head + 64 * br) : (TY == 1 ? 2816 + 128 * head : 1536 + 128 * head);
    const int kcol = (TY == 0) ? (768 + 128 * head) : (TY == 1 ? 3456 + 128 * head : 2176 + 128 * head);
    const int hv = (TY == 0) ? head : (TY == 1 ? 6 + head : 11 + head);
    const bf16_t* QKB = (const bf16_t*)(p->ws + WS_QKB);
    constexpr bool F8 = (TY != 1);
    const unsigned char* QKB8 = p->ws + WS_QKB8;
    const bf16_t* Kg = F8 ? (const bf16_t*)(QKB8 + kcol) : QKB + kcol; const bf16_t* Vg = (const bf16_t*)(p->ws + WS_VT) + (size_t)hv * HD * SEQ;
    const float* dc2 = (const float*)(p->ws + WS_DC2) + (size_t)head * SEQ;
    const float dcref = (TY == 2) ? dc2[256 * qb] : 0.f;
    const float slope2 = (TY == 0) ? fexp2(-8.0f * (float)(head + 1) / 6.0f) * LOG2E : 0.f;
    const float Bfix = (TY == 0) ? (11.5415603f * 1.01f * ((const float*)(p->ws + WS_LAM))[8 + 2 * l] + 0.25f) : (16.3221377f * 1.01f * ((const float*)(p->ws + WS_LAM))[8 + 2 * l + 1] + 0.25f);
    const float cfix = (TY == 2) ? (dc2[trow] - dcref - Bfix) : -Bfix;

    int j_lo = 0;
    if (TY == 0 && SKIP_A) {
        const float Bq = 11.5415603f * ((const float*)(p->ws + WS_LAM))[8 + 2 * l];
        const float x = ((float)(128 * qb - 63) - (39.f + 2.f * Bq) / slope2) * (1.f / 64.f);
        j_lo = x < 0.f ? 0 : (int)x + 1;
    } else if (TY == 2 && SKIP_C) {
        j_lo = ((const int*)(p->ws + WS_LAM))[64 + head * 32 + qb];
    }
    j_lo = __builtin_amdgcn_readfirstlane(j_lo);
    const int NTP = NT - j_lo;
    const bool elig = (TY == 2) ? (qb >= 8) : ((TY == 0) ? (head >= 4 && qb >= 16) : false);
    const bool split = elig && NTP > 32;
    if (part == 1 && !split) return;
    const int mid = j_lo + (NTP >> 1);
    const int jtop = (part == 1) ? mid - 1 : NT - 1;
    const int cntT = (part == 1) ? (mid - j_lo) : (split ? NT - mid : NTP);
    const int sidx = (TY == 2) ? (head * 32 + qb) : (160 + head * 64 + qb);
    unsigned long long* pay = (unsigned long long*)(p->ws + WS_PART) + ((size_t)sidx * 8 + wid) * 17 * 64 + lane;
    unsigned* aflag = (unsigned*)(p->ws + WS_CTL) + CW_AFLAG + (l * 544 + sidx) * 64;
    LAS unsigned char* buf0 = lds; LAS unsigned char* buf1 = lds + BUF_BYTES;
    LAS int* flags = (LAS int*)(lds + 2 * BUF_BYTES);
    if (TY == 1 && tid < 16) flags[tid] = 0;
    Stg st; float kbv = 0.f;
    stage_load<F8>(st, Kg, Vg, jtop, tid);
    if (TY == 2 && tid < 64) kbv = dcref - dc2[64 * jtop + tid];
    bf16x8 qr[NKS]; constexpr int NK8 = (TY == 0) ? 1 : 2; i32x8 q8[NK8];
    if (F8) {
#pragma unroll
        for (int ks = 0; ks < NK8; ++ks) { const i32x4 a = *(const i32x4*)(QKB8 + (size_t)trow * NQK + qcol + ks * 64 + hi * 32), b = *(const i32x4*)(QKB8 + (size_t)trow * NQK + qcol + ks * 64 + hi * 32 + 16);
            q8[ks] = __builtin_shufflevector(a, b, 0, 1, 2, 3, 4, 5, 6, 7); }
    } else {
#pragma unroll
        for (int ks = 0; ks < NKS; ++ks) qr[ks] = *(const bf16x8*)(QKB + (size_t)trow * NQK + qcol + ks * 16 + hi * 8);
    }
    stage_write<F8>(st, buf0, tid);
    if (TY == 2 && tid < 64) *(LAS float*)(buf0 + KT_BYTES + VT_BYTES + tid * 4) = kbv;
    if (cntT > 1) { stage_load<F8>(st, Kg, Vg, jtop - 1, tid); if (TY == 2 && tid < 64) kbv = dcref - dc2[64 * (jtop - 1) + tid]; }
    __syncthreads();

    f32x16 o[4];
#pragma unroll
    for (int d0 = 0; d0 < 4; ++d0)
#pragma unroll
        for (int r = 0; r < 16; ++r) o[d0][r] = 0.f;
    float m = 0.f, lsum = 0.f, R = 0.f;
    const int koff = F8 ? (r32 * KP8 + hi * 32 + ((TY == 0) ? br * 64 : 0)) : (r32 * KP + hi * 16 + ((TY == 0) ? br * 128 : 0)), voff = KT_BYTES + r32 * VP + hi * 16;

    for (int it = 0; it < cntT; ++it) {
        if (TY == 1 && (SKIP_B & 1) && it > 0) { const i32x4 f0 = *(const LAS i32x4*)(flags + ((it - 1) & 1) * 8), f1 = *(const LAS i32x4*)(flags + ((it - 1) & 1) * 8 + 4);
            if (__builtin_amdgcn_readfirstlane((f0[0] & f0[1] & f0[2] & f0[3] & f1[0] & f1[1] & f1[2] & f1[3])) != 0) break; }
        const int j = jtop - it;
        LAS unsigned char* cur = (it & 1) ? buf1 : buf0; LAS unsigned char* oth = (it & 1) ? buf0 : buf1;
        const bool more = it + 1 < cntT;
        if (TY == 0) {
            const int cw = 2 * qb + (rg >> 1);
            if (j <= cw) {
                f32x16 y0, y1;
                const int trel = trow - 64 * j;
                if (j == cw) {
                    const float tq = (float)(trel - 4 * hi);
#pragma unroll
                    for (int r = 0; r < 16; ++r) { y0[r] = fmaf(-slope2, fabsf(tq - (float)KIDX(r)), cfix); y1[r] = fmaf(-slope2, fabsf(tq - (float)(KIDX(r) + 32)), cfix); }
                } else {
                    const float A = fmaf(-slope2, (float)(trel - 4 * hi), cfix);
#pragma unroll
                    for (int r = 0; r < 16; ++r) { y0[r] = fmaf(slope2, (float)KIDX(r), A); y1[r] = fmaf(slope2, (float)(KIDX(r) + 32), A); }
                }
                tile_fixed8<NK8>(o, cur + koff, cur + voff, q8, y0, y1, lsum);
            }
        } else {
            const int jj = j - 4 * qb;
            if (jj <= (wid >> 1) && !(TY == 1 && (SKIP_B & 2) && __all(R <= -40.f))) {
                const bool partial = (jj == (wid >> 1));
                const int tin = 32 * (wid & 1) + r32 - 4 * hi;
                f32x16 y0, y1;
                if (TY == 2) {
                    const LAS f32x4* kbp = (const LAS f32x4*)(cur + KT_BYTES + VT_BYTES) + hi;
#pragma unroll
                    for (int g = 0; g < 4; ++g) { const f32x4 b0 = kbp[2 * g], b1 = kbp[2 * g + 8];
#pragma unroll
                        for (int i = 0; i < 4; ++i) { y0[4 * g + i] = b0[i] + cfix; y1[4 * g + i] = b1[i] + cfix; } }
                    if (partial) {
#pragma unroll
                        for (int r = 0; r < 16; ++r) { if (KIDX(r) > tin) y0[r] = -__builtin_inff(); if (KIDX(r) + 32 > tin) y1[r] = -__builtin_inff(); }
                    }
                    tile_fixed8<NK8>(o, cur + koff, cur + voff, q8, y0, y1, lsum);
                } else {
#pragma unroll
                    for (int r = 0; r < 16; ++r) { y0[r] = 0.f; y1[r] = 0.f; }
                    qk_tile<NKS>(y0, y1, cur + koff, qr);
                    f32x16 lb0, lb1;
#pragma unroll
                    for (int r = 0; r < 16; ++r) {
                        { const float z = fminf(fmaxf(y0[r], -100.f), 100.f), b = -flog2(1.f + fexp2(-z)); float k = b - z, bb = b;
                          if (partial && KIDX(r) >= tin) { k = 0.f; bb = -__builtin_inff(); } lb0[r] = bb; y0[r] = k; }
                        { const float z = fminf(fmaxf(y1[r], -100.f), 100.f), b = -flog2(1.f + fexp2(-z)); float k = b - z, bb = b;
                          if (partial && KIDX(r) + 32 >= tin) { k = 0.f; bb = -__builtin_inff(); } lb1[r] = bb; y1[r] = k; }
                    }
                    float gs0[4], gs1[4];
#pragma unroll
                    for (int g = 0; g < 4; ++g) {
                        { const float e0 = y0[4 * g], e1 = y0[4 * g + 1], e2 = y0[4 * g + 2], e3 = y0[4 * g + 3]; const float s2 = e3, s1 = e3 + e2, s0 = s1 + e1;
                          y0[4 * g + 3] = 0.f; y0[4 * g + 2] = s2; y0[4 * g + 1] = s1; y0[4 * g] = s0; gs0[g] = s0 + e0; }
                        { const float e0 = y1[4 * g], e1 = y1[4 * g + 1], e2 = y1[4 * g + 2], e3 = y1[4 * g + 3]; const float s2 = e3, s1 = e3 + e2, s0 = s1 + e1;
                          y1[4 * g + 3] = 0.f; y1[4 * g + 2] = s2; y1[4 * g + 1] = s1; y1[4 * g] = s0; gs1[g] = s0 + e0; }
                    }
                    float run = R;
#pragma unroll
                    for (int half = 1; half >= 0; --half)
#pragma unroll
                        for (int g = 3; g >= 0; --g) {
                            const float mine = half ? gs1[g] : gs0[g];
                            auto rr = __builtin_amdgcn_permlane32_swap(__float_as_uint(mine), __float_as_uint(mine), false, false);
                            const float g_lo = __uint_as_float(rr[0]), g_hi = __uint_as_float(rr[1]);
                            const float off_hi = run; run += g_hi; const float off_lo = run; run += g_lo;
                            const float off = hi ? off_hi : off_lo;
#pragma unroll
                            for (int i = 0; i < 4; ++i) {
                                if (half) y1[4 * g + i] = fexp2(lb1[4 * g + i] + y1[4 * g + i] + off);
                                else y0[4 * g + i] = fexp2(lb0[4 * g + i] + y0[4 * g + i] + off);
                            }
                        }
                    R = run;
                    pv_tile(o, cur + voff, y0, y1);
                }
            }
        }
        if (TY == 1) { const int dn = __all(R <= -40.f) ? 1 : 0; if (lane == 0) flags[(it & 1) * 8 + wid] = dn; }
        if (more) { stage_write<F8>(st, oth, tid); if (TY == 2 && tid < 64) *(LAS float*)(oth + KT_BYTES + VT_BYTES + tid * 4) = kbv; }
        if (it + 2 < cntT) { stage_load<F8>(st, Kg, Vg, j - 2, tid); if (TY == 2 && tid < 64) kbv = dcref - dc2[64 * (j - 2) + tid]; }
        __syncthreads();
    }

    bf16_t* MIX = (bf16_t*)(p->ws + WS_MIX);
    float inv = 1.f;
    if (TY != 1) {
        float lt = swap_sum(lsum);
        if (part == 1) {
            __hip_atomic_store(pay, ((unsigned long long)__float_as_uint(lt) << 32) | __float_as_uint(m), __ATOMIC_RELAXED, __HIP_MEMORY_SCOPE_AGENT);
#pragma unroll
            for (int d0 = 0; d0 < 4; ++d0)
#pragma unroll
                for (int g = 0; g < 4; ++g)
                    __hip_atomic_store(pay + (1 + d0 * 4 + g) * 64, ((unsigned long long)cvtpk(o[d0][4 * g + 2], o[d0][4 * g + 3]) << 32) | cvtpk(o[d0][4 * g], o[d0][4 * g + 1]), __ATOMIC_RELAXED, __HIP_MEMORY_SCOPE_AGENT);
            asm volatile("s_waitcnt vmcnt(0)" ::: "memory");
            __syncthreads();
            if (tid == 0) __hip_atomic_store(aflag, 1u, __ATOMIC_RELAXED, __HIP_MEMORY_SCOPE_AGENT);
            __syncthreads();
            return;
        }
        if (split) {
            if (tid == 0) { unsigned sp = 0; while (__hip_atomic_load(aflag, __ATOMIC_RELAXED, __HIP_MEMORY_SCOPE_AGENT) == 0u && ++sp < (1u << 22)) __builtin_amdgcn_s_sleep(2);
                __builtin_amdgcn_fence(__ATOMIC_ACQUIRE, "agent"); asm volatile("s_waitcnt vmcnt(0)" ::: "memory"); }
            __syncthreads();
            const unsigned long long ml = __hip_atomic_load(pay, __ATOMIC_RELAXED, __HIP_MEMORY_SCOPE_AGENT);
            const float mf = __uint_as_float((unsigned)ml), lf = __uint_as_float((unsigned)(ml >> 32));
            const float mn = fmaxf(m, mf), a0 = fexp2(m - mn), a1 = fexp2(mf - mn);
            lt = a0 * lt + a1 * lf;
#pragma unroll
            for (int d0 = 0; d0 < 4; ++d0)
#pragma unroll
                for (int g = 0; g < 4; ++g) {
                    const unsigned long long w = __hip_atomic_load(pay + (1 + d0 * 4 + g) * 64, __ATOMIC_RELAXED, __HIP_MEMORY_SCOPE_AGENT);
                    const unsigned w0 = (unsigned)w, w1 = (unsigned)(w >> 32);
                    o[d0][4 * g] = a0 * o[d0][4 * g] + a1 * bf_lo(w0); o[d0][4 * g + 1] = a0 * o[d0][4 * g + 1] + a1 * bf_hi(w0);
                    o[d0][4 * g + 2] = a0 * o[d0][4 * g + 2] + a1 * bf_lo(w1); o[d0][4 * g + 3] = a0 * o[d0][4 * g + 3] + a1 * bf_hi(w1);
                }
        }
        inv = 1.f / lt;
    }
    float post = 1.f; const float* gain;
    if (TY == 0) {
        const float lam = ((const float*)(p->ws + WS_LAM))[l];
        LAS float* X = (LAS float*)lds + (size_t)rg * 128 * 32;
        if (br == 1) {
            const float sc = inv * lam;
#pragma unroll
            for (int d0 = 0; d0 < 4; ++d0)
#pragma unroll
                for (int r = 0; r < 16; ++r) X[(32 * d0 + KIDX(r) + 4 * hi) * 32 + r32] = o[d0][r] * sc;
        }
        __syncthreads();
        if (br == 0) {
#pragma unroll
            for (int d0 = 0; d0 < 4; ++d0)
#pragma unroll
                for (int r = 0; r < 16; ++r) o[d0][r] = o[d0][r] * inv - X[(32 * d0 + KIDX(r) + 4 * hi) * 32 + r32];
        }
        inv = 1.f;
        post = 1.f - (0.8f - 0.6f * fexp2(-0.3f * LOG2E * (float)l));
        gain = p->subln_diff + l * HD;
    } else if (TY == 1) gain = p->onorm_sb + l * HD;
    else gain = p->onorm_fox + l * HD;
    if (TY != 0 || br == 0) {
        float ss = 0.f;
#pragma unroll
        for (int d0 = 0; d0 < 4; ++d0)
#pragma unroll
            for (int r = 0; r < 16; ++r) { const float v = o[d0][r] * inv; ss += v * v; }
        ss = swap_sum(ss);
        const float sc = inv * post * __builtin_amdgcn_rsqf(ss * (1.f / HD) + EPS);
        bf16_t* orow = MIX + (size_t)trow * DM + hv * HD + 4 * hi;
#pragma unroll
        for (int d0 = 0; d0 < 4; ++d0)
#pragma unroll
            for (int g = 0; g < 4; ++g) {
                const f32x4 g4 = *(const f32x4*)(gain + 32 * d0 + 8 * g + 4 * hi);
                if (FP8_WOUT) { *(unsigned*)((unsigned char*)MIX + (size_t)trow * DM + hv * HD + 4 * hi + 32 * d0 + 8 * g) = cvt4f8(o[d0][4 * g] * sc * g4[0], o[d0][4 * g + 1] * sc * g4[1], o[d0][4 * g + 2] * sc * g4[2], o[d0][4 * g + 3] * sc * g4[3]); continue; }
                u32x2 w; w[0] = cvtpk(o[d0][4 * g] * sc * g4[0], o[d0][4 * g + 1] * sc * g4[1]); w[1] = cvtpk(o[d0][4 * g + 2] * sc * g4[2], o[d0][4 * g + 3] * sc * g4[3]);
                *(u32x2*)(orow + 32 * d0 + 8 * g) = w;
            }
    }
    __syncthreads();
}

constexpr int N_FAR = 5 * 24 + 2 * 48;
constexpr int N_ITEMS = N_FAR + 32 * 22;
__device__ __forceinline__ void attention_phase(KArgs p, int l, LAS unsigned char* lds, volatile LAS unsigned* itemw, int wv, int qi, int tmask = 7) {
    unsigned* q = (unsigned*)(p->ws + WS_CTL) + CW_ATTQ + qi * 64;
    for (;;) {
        if (otid(wv) == 0) *itemw = __hip_atomic_fetch_add(q, 1u, __ATOMIC_RELAXED, __HIP_MEMORY_SCOPE_AGENT);
        __syncthreads();
        int item = (int)*itemw;
        __syncthreads();
        if (item >= N_ITEMS) break;
        if (item < N_FAR) {
            if (item < 120) { if (tmask & 1) att_item<2>(p, l, item % 5, 31 - item / 5, lds, wv, 1); }
            else { const int i2 = item - 120; if (tmask & 2) att_item<0>(p, l, 5 - (i2 & 1), 63 - (i2 >> 1), lds, wv, 1); }
            continue;
        }
        item -= N_FAR;
        if (item < 288) { const int w = item % 9, pp = 31 - item / 9;
            if (w < 5) { if (tmask & 1) att_item<2>(p, l, w, pp, lds, wv); }
            else if (tmask & 2) att_item<0>(p, l, 5 - ((w - 5) >> 1), 2 * pp + 1 - ((w - 5) & 1), lds, wv); }
        else if (item < 544) { const int it2 = item - 288, w = it2 % 8, pp = 31 - it2 / 8;
            if (tmask & 2) att_item<0>(p, l, 3 - (w >> 1), 2 * pp + 1 - (w & 1), lds, wv); }
        else if (tmask & 4) { const int it3 = item - 544; att_item<1>(p, l, it3 % 5, 31 - it3 / 5, lds, wv); }
    }
}
}

__device__ __forceinline__ void phase_route(KArgs p, int l, LAS unsigned char* lds, int wv, int ci, bool waitp = true) {
    const int tid = otid(wv), lane = tid & 63, wave = tid >> 6;
    LAS float* wrt = (LAS float*)lds;
    LAS int* bsel = (LAS int*)(lds + 16 * DM * 4);
    LAS float* bsc = (LAS float*)(bsel + 64);
    LAS float* bgate = bsc + 64;
    LAS float* brs = bgate + 64;
    { const f32x4* src = (const f32x4*)(p->ws + WS_WRT); for (int i = tid; i < 16 * DM / 4; i += 512) ((LAS f32x4*)wrt)[i] = src[i]; }
    __syncthreads();
    bf16_t* XN = (bf16_t*)(p->ws + WS_XN);
    for (int blk = blockIdx.x; blk < SEQ / 32; blk += gridDim.x) {
        const int tid = otid(wv), lane = tid & 63, wave = tid >> 6;
        if (waitp) { if (wave == 0) {
            const unsigned* wc = (const unsigned*)(p->ws + WS_CTL) + CW_WOC + l * 32 * 64 + 64 * (blk >> 3);
            unsigned sp = 0;
            while ((unsigned)__builtin_amdgcn_readfirstlane((int)__hip_atomic_load(wc, __ATOMIC_RELAXED, __HIP_MEMORY_SCOPE_AGENT)) < 64u && ++sp < (1u << 22)) __builtin_amdgcn_s_sleep(2);
            __builtin_amdgcn_fence(__ATOMIC_ACQUIRE, "agent");
            asm volatile("s_waitcnt vmcnt(0)" ::: "memory");
            } __syncthreads(); }
        const int tb = blk * 32 + wave * 4;
        f32x4 hx[4][8];
#pragma unroll
        for (int i = 0; i < 4; ++i) { const u32x2* xr = (const u32x2*)((const bf16_t*)(p->ws + WS_OUTB) + (size_t)(tb + i) * DM) + lane;
#pragma unroll
            for (int j = 0; j < 8; ++j) { const u32x2 a = xr[64 * j]; hx[i][j] = (f32x4){bf_lo(a[0]), bf_hi(a[0]), bf_lo(a[1]), bf_hi(a[1])}; } }
#pragma unroll
        for (int i = 0; i < 4; ++i) {
            float ss = 0.f;
#pragma unroll
            for (int j = 0; j < 8; ++j) ss += (hx[i][j][0] * hx[i][j][0] + hx[i][j][1] * hx[i][j][1]) + (hx[i][j][2] * hx[i][j][2] + hx[i][j][3] * hx[i][j][3]);
            const float rstd = __builtin_amdgcn_rsqf(wave_sum(ss) * (1.f / DM) + EPS);
            if (lane == 0) brs[wave * 4 + i] = rstd;
            const f32x4* gr = (const f32x4*)(p->ffn_norm + (size_t)l * DM) + lane;
#pragma unroll
            for (int j = 0; j < 8; ++j) hx[i][j] = hx[i][j] * rstd * gr[64 * j];
        }
#pragma unroll
        for (int h2 = 0; h2 < 2; ++h2) {
            f32x4 (&hn)[2][8] = *reinterpret_cast<f32x4 (*)[2][8]>(&hx[2 * h2]);
            asm volatile("" ::: "memory"); __builtin_amdgcn_sched_barrier(0);
            float acc[32];
#pragma unroll
            for (int k = 0; k < 32; ++k) acc[k] = 0.f;
#pragma unroll
            for (int j = 0; j < 8; ++j)
#pragma unroll
                for (int eh = 0; eh < 2; ++eh) {
#pragma unroll
                    for (int e = 8 * eh; e < 8 * eh + 8; ++e) { const f32x4 w4 = *(const LAS f32x4*)(wrt + e * DM + 4 * lane + 256 * j);
#pragma unroll
                        for (int i = 0; i < 2; ++i) acc[i * 16 + e] += (hn[i][j][0] * w4[0] + hn[i][j][1] * w4[1]) + (hn[i][j][2] * w4[2] + hn[i][j][3] * w4[3]); }
                    __builtin_amdgcn_sched_barrier(0);
                }
#pragma unroll
            for (int k = 0; k < 32; ++k) acc[k] = sum_xor32(acc[k]);
#define RSTEP(H) { const bool up = (lane & H) != 0; _Pragma("unroll") for (int k = 0; k < H; ++k) { const float a = acc[k], b = acc[k + H]; const float give = up ? a : b, keep = up ? b : a; acc[k] = keep + swz_xor<H>(give); } }
            RSTEP(16) RSTEP(8) RSTEP(4) RSTEP(2) RSTEP(1)
#undef RSTEP
            const float logit = acc[0];
            const float score = __builtin_amdgcn_rcpf(1.f + fexp2(-logit * LOG2E));
            const float sel = score + p->router_bias[lane & 15];
            const float v1 = swz_xor<1>(sel), v2 = swz_xor<2>(sel), v3 = swz_xor<3>(sel);
            const float a = fmaxf(sel, v1), b = fminf(sel, v1), c = fmaxf(v2, v3), d = fminf(v2, v3);
            const float gs = fmaxf(a, c) + fmaxf(fminf(a, c), fmaxf(b, d));
            const float g1 = swz_xor<4>(gs), g2 = swz_xor<8>(gs), g3 = swz_xor<12>(gs);
            const int myg = (lane >> 2) & 3, k = lane & 3;
            const bool best = (gs > g1 || (gs == g1 && myg < (myg ^ 1))) && (gs > g2 || (gs == g2 && myg < (myg ^ 2))) && (gs > g3 || (gs == g3 && myg < (myg ^ 3)));
            const int rank = ((v1 > sel || (v1 == sel && (k ^ 1) < k)) ? 1 : 0) + ((v2 > sel || (v2 == sel && (k ^ 2) < k)) ? 1 : 0) + ((v3 > sel || (v3 == sel && (k ^ 3) < k)) ? 1 : 0);
            if (best && rank < 2 && lane < 32) { const int row = wave * 4 + h2 * 2 + (lane >> 4); bsel[row * 2 + rank] = lane & 15; bsc[row * 2 + rank] = score; }
        }
        asm volatile("s_waitcnt lgkmcnt(0)" ::: "memory");
        if (lane < 8) { const int idx = wave * 8 + lane; const float sm = bsc[idx], so = bsc[idx ^ 1]; bgate[idx] = sm / (sm + so); }
        __syncthreads();
        if (wave == 0) {
            unsigned* cnt = (unsigned*)(p->ws + WS_CTL) + CW_CNT + ci * 16 * 64;
            const int mye = bsel[lane]; int myrank = 0, n = 0;
            const unsigned long long below = (1ull << lane) - 1ull;
#pragma unroll
            for (int e = 0; e < 16; ++e) { const unsigned long long mk = __ballot(mye == e); if (mye == e) myrank = (int)__popcll(mk & below); if (lane == e) n = (int)__popcll(mk); }
            int base = 0;
            if (lane < 16 && n) base = (int)__hip_atomic_fetch_add(cnt + lane * 64, (unsigned)n, __ATOMIC_RELAXED, __HIP_MEMORY_SCOPE_AGENT);
            const int pos = __builtin_amdgcn_ds_bpermute(mye << 2, base) + myrank, tok = blk * 32 + (lane >> 1);
            ((int*)(p->ws + WS_TOK))[mye * SEQ + pos] = tok; ((f32x2_t*)(p->ws + WS_GATE))[mye * SEQ + pos] = (f32x2_t){bgate[lane], brs[lane >> 1]};
            int* ts = (int*)(p->ws + WS_TSEL) + tok * 4 + (lane & 1) * 2; ts[0] = mye; ts[1] = pos;
        }
        __syncthreads();
    }
}

__device__ __forceinline__ void moe_table(KArgs p, int l, LAS int* tbl, int wv) {
    if (otid(wv) == 0) { const unsigned* cnt = (const unsigned*)(p->ws + WS_CTL) + CW_CNT + l * 16 * 64; int acc = 0;
        for (int e = 0; e < 16; ++e) { const int n = (int)cnt[e * 64]; tbl[e] = acc; tbl[17 + e] = n; acc += (n + 255) >> 8; } tbl[16] = acc; }
    __syncthreads();
}

constexpr int N_PHASES = 2 + 7 * DEPTH;
__device__ __forceinline__ int opq(int v) { asm volatile("" : "+s"(v)); return v; }
__device__ __forceinline__ LAS unsigned char* opq(LAS unsigned char* v) { unsigned x = (unsigned)(uintptr_t)v; asm volatile("" : "+s"(x)); return (LAS unsigned char*)(uintptr_t)x; }
__global__ void __launch_bounds__(512, 2) trunk_fwd(Params pk) {
    extern __shared__ __attribute__((aligned(16))) unsigned char lds_raw[];
    LAS unsigned char* lds = (LAS unsigned char*)lds_raw;
    volatile LAS unsigned* MISC = (volatile LAS unsigned*)(lds + MISC_OFF);
    LAS int* mtbl = (LAS int*)(lds + MISC_OFF + 256);
#define p kparams()
    const int wv = __builtin_amdgcn_readfirstlane((int)threadIdx.x >> 6);
    for (int u = threadIdx.x; u < (LDS_BYTES - MISC_OFF) / 4; u += 512) ((LAS unsigned*)(lds + MISC_OFF))[u] = 0u;
    __syncthreads();
    unsigned* ctl = (unsigned*)(p->ws + WS_CTL);
    XcdBarrier bar; bar.bar = ctl + CW_BAR; bar.x = 0; bar.st = nullptr; bar.wv = wv;
    const bool multi = (p->ph_hi - p->ph_lo) > 1;
    if (multi) bar = xcd_barrier_post(ctl + CW_BAR, MISC + 8, wv);
    const int lo = p->ph_lo, hi = p->ph_hi;
#define IN(k) (lo <= (k) && (k) < hi)
#define SEAM(k) do { if (IN(k) && IN((k) + 1)) xcd_barrier(bar); } while (0)
    const int G0 = gridDim.x, c0 = blockIdx.x; LAS unsigned char* const lds0 = lds;
#define PHASE_LOCALS const int G = opq(G0), c = opq(c0); LAS unsigned char* const lds = opq(lds0); LAS int* const mtbl = (LAS int*)(lds + MISC_OFF + 256); volatile LAS unsigned* const MISC = (volatile LAS unsigned*)(lds + MISC_OFF); (void)G; (void)c; (void)mtbl; (void)MISC;

    if (PK(0) && IN(0)) { PHASE_LOCALS phase_prologue(p, lds, wv); if (DUP_PHASE == 0) { __syncthreads(); phase_prologue(p, lds, wv); } SEAM(0); }
    for (int l = 0; l < DEPTH; ++l) {
        const int pb = 1 + 7 * l;
        if (PK(1) && IN(pb + 0)) { PHASE_LOCALS phase_norm1(p, l, lds, wv); if (DUP_PHASE == 1) { xcd_barrier(bar); phase_norm1(p, l, lds, wv, true); } SEAM(pb + 0); }
        if (PK(2) && IN(pb + 1)) { PHASE_LOCALS
            if (c < H_FOX) scan_head(p, c, l, lds, wv);
            for (int rep = 0; rep < (DUP_PHASE == 2 ? 2 : 1); ++rep) {
            { pg8::Gemm g{(const bf16_t*)(p->ws + (FP8_PROJ ? WS_OUTB8 : WS_OUTB)), (const bf16_t*)(p->ws + WS_WQK + (size_t)l * NQK * DM * (FP8_PROJ ? 1 : 2)), SEQ, NQK, FP8_PROJ ? DM / 2 : DM};
              pg8::StaticOrder S; S.init(SEQ, NQK, G, c);
              pg8::EpiQK E{(bf16_t*)(p->ws + WS_QKB), p->qnorm_diff + l * 64, p->knorm_diff + l * 64, p->qnorm_fox + l * 128, p->knorm_fox + l * 128, (LAS float*)(lds + TBL_OFF), (const float*)(p->ws + WS_RSTD), p->ws + WS_QKB8};
              pg8::gemm_phase<pg8::EpiQK, pg8::StaticOrder>(lds, g, S, E, wv); }
            { pg8::Gemm g{(const bf16_t*)(p->ws + WS_WV + (size_t)l * NV * DM * (FP8_PROJ ? 1 : 2)), (const bf16_t*)(p->ws + (FP8_PROJ ? WS_OUTB8 : WS_OUTB)), NV, SEQ, FP8_PROJ ? DM / 2 : DM};
              pg8::StaticOrder S; S.init(NV, SEQ, G, c);
              pg8::EpiVT E{(bf16_t*)(p->ws + WS_VT), SEQ, (const float*)(p->ws + WS_RSTD)};
              pg8::gemm_phase<pg8::EpiVT, pg8::StaticOrder>(lds, g, S, E, wv); }
            }
            SEAM(pb + 1);
        }
        if (PK(3) && IN(pb + 2)) { PHASE_LOCALS att::attention_phase(p, l, lds, MISC + 16, wv, l); if (DUP_PHASE == 3) { __syncthreads(); att::attention_phase(p, l, lds, MISC + 16, wv, l + 4, ATT_MASK2); } SEAM(pb + 2); }
        if (PK(4) && IN(pb + 3)) { PHASE_LOCALS
            pg8::Gemm g{(const bf16_t*)(p->ws + WS_MIX), (const bf16_t*)(p->ws + WS_WO + (size_t)l * DM * DM * (FP8_WOUT ? 1 : 2)), SEQ, DM, FP8_WOUT ? DM / 2 : DM};
            pg8::StaticOrder S; S.init(SEQ, DM, G, c);
            pg8::EpiResAdd E{(bf16_t*)(p->ws + WS_OUTB), 1.f, (unsigned*)(p->ws + WS_CTL) + CW_WOC + l * 32 * 64, p->ws + WS_OUTB8};
            pg8::gemm_phase<pg8::EpiResAdd, pg8::StaticOrder>(lds, g, S, E, wv);
        }
        if (PK(5) && IN(pb + 4)) { PHASE_LOCALS phase_route(p, l, lds, wv, l); if (DUP_PHASE == 5) { xcd_barrier(bar); phase_route(p, l, lds, wv, l + 4); } SEAM(pb + 4); }
        if (PK(6) && IN(pb + 5)) { PHASE_LOCALS
            moe_table(p, l, mtbl, wv);
            pg8::Gemm g{(const bf16_t*)(p->ws + WS_OUTB8), (const bf16_t*)(p->ws + WS_WGU + (size_t)l * NEXP * 1024 * DM), MOE_ROWS, NEXP * 1024, DM / 2};
            pg8::MoeOrder<4, true> S{mtbl, (const int*)(p->ws + WS_TOK), G, c, DM / 2};
            pg8::EpiGU E{p->ws + WS_ACT, (const float*)(p->ws + WS_GATE), mtbl, (unsigned*)(p->ws + WS_CTL) + CW_GUC + l * 80 * 64};
            for (int rep = 0; rep < (DUP_PHASE == 6 ? 2 : 1); ++rep)
            pg8::gemm_phase<pg8::EpiGU, pg8::MoeOrder<4, true>>(lds, g, S, E, wv);
        }
        if (PK(7) && IN(pb + 6)) { PHASE_LOCALS
            moe_table(p, l, mtbl, wv);
            pg8::Gemm g{(const bf16_t*)(p->ws + WS_ACT), (const bf16_t*)(p->ws + WS_WD + (size_t)l * NEXP * DM * FEXP), MOE_ROWS, NEXP * DM, FEXP / 2};
            pg8::DownOrder S{mtbl, (unsigned*)(p->ws + WS_CTL) + CW_GUC + l * 80 * 64, (unsigned*)(p->ws + WS_CTL) + CW_BAR + XB_TMO, G, c};
            pg8::EpiDown E{p->ws + WS_Y};
            pg8::gemm_phase<pg8::EpiDown, pg8::DownOrder>(lds, g, S, E, wv);
            SEAM(pb + 6);
        }
    }
    if (PK(1) && IN(N_PHASES - 1)) { PHASE_LOCALS phase_norm1(p, DEPTH, lds, wv); }
#undef IN
#undef SEAM
#undef PHASE_LOCALS
#undef p
}

extern "C" void kernel_launch(void* const* d_in, const int* in_sizes, int n_in, void* d_out, int out_size, void* d_ws, size_t ws_size, hipStream_t stream) {
    static int grid = 0;
    if (grid == 0) {
        if (n_in != 22 || in_sizes[0] != SEQ * DM || out_size != SEQ * DM || ws_size < WS_END) {
            fprintf(stderr, "kernel_launch: unexpected shapes (n_in %d, in0 %d, out %d, ws %zu < %zu); nothing launched\n", n_in, n_in > 0 ? in_sizes[0] : -1, out_size, ws_size, (size_t)WS_END); grid = -1; return; }
        int dev = 0, cus = 0, per_cu = 0;
        if (hipGetDevice(&dev) != hipSuccess || hipDeviceGetAttribute(&cus, hipDeviceAttributeMultiprocessorCount, dev) != hipSuccess) { grid = -1; return; }
        if (hipFuncSetAttribute((const void*)trunk_fwd, hipFuncAttributeMaxDynamicSharedMemorySize, LDS_BYTES) != hipSuccess) { fprintf(stderr, "kernel_launch: hipFuncSetAttribute failed\n"); grid = -1; return; }
        if (hipOccupancyMaxActiveBlocksPerMultiprocessor(&per_cu, (const void*)trunk_fwd, 512, LDS_BYTES) != hipSuccess || per_cu < 1)
            fprintf(stderr, "kernel_launch: note: occupancy query reports %d workgroups per CU\n", per_cu);
        (void)hipGetLastError();
        grid = cus;
    }
    if (grid < 0) return;
    if (hipMemsetAsync((char*)d_ws + WS_CTL, 0, CTL_ZERO_BYTES, stream) != hipSuccess) { fprintf(stderr, "kernel_launch: memset failed\n"); return; }
    Params hp{};
    const float** pp = (const float**)&hp;
    for (int i = 0; i < 22; ++i) pp[i] = (const float*)d_in[i];
    hp.out = (float*)d_out; hp.ws = (unsigned char*)d_ws;
#if MK_ONE_LAUNCH
    hp.ph_lo = 0; hp.ph_hi = N_PHASES;
    hipLaunchKernelGGL(trunk_fwd, dim3(grid), dim3(512), LDS_BYTES, stream, hp);
#else
    for (int ph = 0; ph < N_PHASES; ++ph) { hp.ph_lo = ph; hp.ph_hi = ph + 1; hipLaunchKernelGGL(trunk_fwd, dim3(grid), dim3(512), LDS_BYTES, stream, hp); }
#endif
    const hipError_t le = hipPeekAtLastError();
    if (le != hipSuccess) fprintf(stderr, "kernel_launch: launch failed: %s\n", hipGetErrorName(le));
}
```

```cpp
#include <hip/hip_runtime.h>
#include <cstdio>
#include <cstdint>

#ifndef MK_ONE_LAUNCH
#define MK_ONE_LAUNCH 1
#endif
#ifndef PHASE_MASK
#define PHASE_MASK 0xff
#endif
#define PK(k) (((PHASE_MASK) >> (k)) & 1)
#ifndef FP8_PROJ
#define FP8_PROJ 1
#endif
#ifndef FP8_WOUT
#define FP8_WOUT 1
#endif
#ifndef DUP_PHASE
#define DUP_PHASE -1
#endif
#ifndef ATT_MASK2
#define ATT_MASK2 7
#endif
#ifndef SKIP_A
#define SKIP_A 1
#endif
#ifndef SKIP_B
#define SKIP_B 3
#endif
#ifndef SKIP_C
#define SKIP_C 1
#endif

#define GAS __attribute__((address_space(1)))
#define LAS __attribute__((address_space(3)))
typedef unsigned short bf16_t;
typedef short bf16x8 __attribute__((ext_vector_type(8)));
typedef float f32x4 __attribute__((ext_vector_type(4)));
typedef float f32x16 __attribute__((ext_vector_type(16)));
typedef unsigned u32x4 __attribute__((ext_vector_type(4)));
typedef unsigned u32x2 __attribute__((ext_vector_type(2)));
typedef int i32x4 __attribute__((ext_vector_type(4)));

constexpr int SEQ = 8192, DM = 2048, DEPTH = 4, NQK = 4096, NV = 2048, NEXP = 16, FEXP = 512, NIN = 6149;
constexpr int HD = 128, H_DIFF = 6, H_SB = 5, H_FOX = 5;
constexpr float EPS = 1e-6f;
constexpr float LOG2E = 1.4426950408889634f;
constexpr int MOE_ROWS = 16384 + 16 * 256;

constexpr size_t MiB = 1u << 20;
constexpr size_t WS_CTL = 0, CTL_ZERO_BYTES = 1 * MiB;
constexpr size_t WS_WF = 1 * MiB;
constexpr size_t WS_LAM = 1 * MiB + 512 * 1024;
constexpr size_t WS_LOGF = 2 * MiB;
constexpr size_t WS_DC2 = 3 * MiB;
constexpr size_t WS_TOK = 4 * MiB;
constexpr size_t WS_GATE = 5 * MiB;
constexpr size_t WS_TSEL = 6 * MiB;
constexpr size_t WS_WRT = 7 * MiB;
constexpr size_t WS_RSTD = 8 * MiB;
constexpr size_t WS_WQK = 16 * MiB;
constexpr size_t WS_WV = 80 * MiB;
constexpr size_t WS_WO = 112 * MiB;
constexpr size_t WS_WGU = 144 * MiB;
constexpr size_t WS_WD = 400 * MiB;
constexpr size_t WS_XN = 528 * MiB;
constexpr size_t WS_QKB = 560 * MiB;
constexpr size_t WS_VT = 624 * MiB;
constexpr size_t WS_MIX = 656 * MiB;
constexpr size_t WS_ACT = 688 * MiB;
constexpr size_t WS_Y = 708 * MiB;
constexpr size_t WS_PART = 788 * MiB;
constexpr size_t WS_OUTB = 828 * MiB;
constexpr size_t WS_OUTB8 = 862 * MiB;
constexpr size_t WS_QKB8 = 878 * MiB;
constexpr size_t WS_END = 910 * MiB;
constexpr int CW_BAR = 4096;
constexpr int CW_ATTQ = 16384;
constexpr int CW_CNT = 32768;
constexpr int CW_AFLAG = 65536;
constexpr int CW_WOC = 233472;
constexpr int CW_GUC = 212992;

constexpr int RING_BYTES = 131072;
constexpr int TBL_OFF = RING_BYTES;
constexpr int MISC_OFF = RING_BYTES + 8192;
constexpr int LDS_BYTES = 147456;

typedef float f32x2_t __attribute__((ext_vector_type(2)));
typedef __bf16 bf16x2_t __attribute__((ext_vector_type(2)));
typedef int i32x8 __attribute__((ext_vector_type(8)));
__device__ __forceinline__ unsigned cvt4f8(float a, float b, float c, float d) {
    int w = 0; w = __builtin_amdgcn_cvt_pk_fp8_f32(a, b, w, false); w = __builtin_amdgcn_cvt_pk_fp8_f32(c, d, w, true); return (unsigned)w; }
constexpr float W8_SCALE = 256.f, ACT8_SCALE = 4.f, Y8_SCALE = 32.f;
__device__ __forceinline__ unsigned cvtpk(float lo, float hi) { const f32x2_t v = {lo, hi}; const bf16x2_t b = __builtin_convertvector(v, bf16x2_t); return __builtin_bit_cast(unsigned, b); }
__device__ __forceinline__ float bf_lo(unsigned u) { return __uint_as_float(u << 16); }
__device__ __forceinline__ float bf_hi(unsigned u) { return __uint_as_float(u & 0xffff0000u); }
__device__ __forceinline__ float fexp2(float x) { return __builtin_amdgcn_exp2f(x); }
__device__ __forceinline__ float flog2(float x) { return __builtin_amdgcn_logf(x); }
__device__ __forceinline__ int otid(int wv) { int t; asm volatile("v_mbcnt_lo_u32_b32 %0, -1, 0\n\tv_mbcnt_hi_u32_b32 %0, -1, %0" : "=v"(t)); return wv * 64 + t; }
template <int M> __device__ __forceinline__ float swz_xor(float v) { return __int_as_float(__builtin_amdgcn_ds_swizzle(__float_as_int(v), 0x1F | (M << 10))); }
__device__ __forceinline__ float sum_xor32(float v) { auto rr = __builtin_amdgcn_permlane32_swap(__float_as_uint(v), __float_as_uint(v), false, false); return __uint_as_float(rr[0]) + __uint_as_float(rr[1]); }
__device__ __forceinline__ float wave_sum(float v) {
    v += swz_xor<1>(v); v += swz_xor<2>(v); v += swz_xor<4>(v); v += swz_xor<8>(v); v += swz_xor<16>(v);
    return sum_xor32(v);
}

namespace pg8 {
constexpr int BM = 256, BK = 64, HALF = 128, HTB = HALF * BK * 2, STAGE_BYTES = 8 * HTB, NXCD = 8, WGM = 8;
__host__ __device__ __forceinline__ int lds_byte(int r, int c) { const int st = (r >> 4) * 2 + (c >> 5), rr = r & 15, cc = c & 31, ob = rr * 64 + cc * 2; return st * 1024 + (ob ^ (((ob >> 9) & 1) << 5)); }
__host__ __device__ __forceinline__ void stage_rc(int b, int& R, int& C) { const int st = b / 1024, sb = b % 1024, swz = sb ^ (((sb >> 9) & 1) << 5); R = (st >> 1) * 16 + swz / 64; C = (st & 1) * 32 + (swz % 64) / 2; }
__host__ __device__ __forceinline__ int perm32(int rho) { const int n = rho >> 4, i = rho & 15; return 8 * (i >> 2) + 4 * n + (i & 3); }
__host__ __device__ __forceinline__ int permV(int rho) { const int n = rho >> 4, i = rho & 15; return 16 * (i >> 3) + 8 * n + (i & 7); }
template <int P> __host__ __device__ __forceinline__ int permf(int rho) { return P == 1 ? perm32(rho) : (P == 2 ? permV(rho) : rho); }

struct Unit { int pm, pn, e, rt; };
struct Gemm { const bf16_t* A; const bf16_t* Bt; int M, N, K; };

struct StaticOrder {
    int nM, nN, nwg, G, c;
    __device__ void init(int M, int N, int G_, int c_) { nM = M / BM; nN = N / BM; nwg = nM * nN; G = G_; c = c_; }
    __device__ bool next(int i, Unit& u) const {
        const long L = (long)i * G + c; if (L >= nwg) return false;
        int wgid = (int)L; { const int q = nwg / NXCD, r = nwg % NXCD, xcd = wgid % NXCD, off = wgid / NXCD; wgid = (xcd < r ? xcd * (q + 1) : r * (q + 1) + (xcd - r) * q) + off; }
        const int nig = WGM * nN, gid = wgid / nig, fm = gid * WGM, gsz = (nM - fm) < WGM ? (nM - fm) : WGM;
        u.pm = fm + ((wgid % nig) % gsz); u.pn = (wgid % nig) / gsz; u.e = 0; u.rt = 0; return true;
    }
    __device__ __forceinline__ size_t a_base(const Unit& u, size_t tstep) const { return (size_t)u.pm * tstep; }
    __device__ __forceinline__ unsigned row_off(const Unit&, int r, int K) const { return (unsigned)(r * K) * 2u; }
    __device__ __forceinline__ void a_ready(const Unit&, int) const {}
};

template <int NCT, bool GATHER> struct MoeOrder {
    const LAS int* tbl; const int* tok; int G, c, K;
    __device__ bool next(int i, Unit& u) const {
        const int L = i * G + c, total = __builtin_amdgcn_readfirstlane(tbl[16]) * NCT; if (L >= total) return false;
        const int g = L / NCT, ct = L % NCT; int e = 0;
#pragma unroll
        for (int k = 1; k < 16; ++k) e += (g >= tbl[k]) ? 1 : 0;
        e = __builtin_amdgcn_readfirstlane(e);
        u.pm = g; u.pn = e * NCT + ct; u.e = e; u.rt = __builtin_amdgcn_readfirstlane(g - tbl[e]); return true;
    }
    __device__ __forceinline__ size_t a_base(const Unit& u, size_t tstep) const { return GATHER ? 0 : (size_t)u.pm * tstep; }
    __device__ __forceinline__ unsigned row_off(const Unit& u, int r, int K_) const {
        if (!GATHER) return (unsigned)(r * K_) * 2u;
        const int pos = u.rt * 256 + r; const int n = __builtin_amdgcn_readfirstlane(tbl[17 + u.e]);
        const int t = pos < n ? tok[u.e * SEQ + pos] : 0;
        return (unsigned)(t * K_) * 2u;
    }
    __device__ __forceinline__ void a_ready(const Unit&, int) const {}
};

struct DownOrder {
    const LAS int* tbl; unsigned* cnt; unsigned* tmo; int G, c;
    __device__ bool next(int i, Unit& u) const {
        const int T = __builtin_amdgcn_readfirstlane(tbl[16]);
        const int U1 = 4 * T, nb2 = U1 > G ? U1 - G : 0, F = G - nb2;
        const int g1 = T < (G >> 2) ? T : (G >> 2), E = 8 * g1, Lt = 8 * (T - g1);
        int k = -1, late = 0;
        int ii = i;
        if (c >= nb2) { const int cf = c - nb2; const int nE = E > cf ? (E - cf + F - 1) / F : 0; if (ii < nE) k = cf + ii * F; else ii -= nE; }
        int g, ct;
        if (k >= 0) { g = k >> 3; ct = k & 7; }
        else { const int k0 = (c - nb2 + G) % G; const int kk = k0 + ii * G; if (kk >= Lt) return false; g = g1 + (kk >> 3); ct = kk & 7; late = 1; }
        (void)late;
        int e = 0;
#pragma unroll
        for (int q = 1; q < 16; ++q) e += (g >= tbl[q]) ? 1 : 0;
        e = __builtin_amdgcn_readfirstlane(e);
        u.pm = g; u.pn = e * 8 + ct; u.e = e; u.rt = __builtin_amdgcn_readfirstlane(g - tbl[e]); return true;
    }
    __device__ __forceinline__ size_t a_base(const Unit& u, size_t tstep) const { return (size_t)u.pm * tstep; }
    __device__ __forceinline__ unsigned row_off(const Unit&, int r, int K_) const { return (unsigned)(r * K_) * 2u; }
    __device__ __forceinline__ void a_ready(const Unit& u, int wid) const {
        if (wid == 0) {
            unsigned sp = 0;
            while ((unsigned)__builtin_amdgcn_readfirstlane((int)__hip_atomic_load(cnt + 64 * u.pm, __ATOMIC_RELAXED, __HIP_MEMORY_SCOPE_AGENT)) < 32u) {
                __builtin_amdgcn_s_sleep(2);
                if (++sp > (1u << 22)) { __hip_atomic_store(tmo, 1u, __ATOMIC_RELAXED, __HIP_MEMORY_SCOPE_AGENT); break; }
            }
            __builtin_amdgcn_fence(__ATOMIC_ACQUIRE, "agent");
            asm volatile("s_waitcnt vmcnt(0)" ::: "memory");
        }
        asm volatile("" ::: "memory"); __builtin_amdgcn_s_barrier(); asm volatile("" ::: "memory");
    }
};

template <class Epi, class Sched, bool SP2 = true>
__device__ __forceinline__ void gemm_phase(LAS unsigned char* lds, const Gemm g, const Sched& S, const Epi& E, int wv) {
    const int tid = otid(wv), wid = __builtin_amdgcn_readfirstlane(tid >> 6), lane = tid & 63, wr = wid >> 2, wc = wid & 3, fr = lane & 15, fq = lane >> 4;
    const int K = g.K, nt = K / BK;
    unsigned voffB[2]; int Rr[2], Cc[2];
#pragma unroll
    for (int i = 0; i < 2; ++i) { int R, C; stage_rc(tid * 16 + i * 8192, R, C); const int Rb = (R & ~31) + permf<Epi::PERM>(R & 31);
        Rr[i] = R; Cc[i] = C; voffB[i] = (unsigned)(Rb * K + C) * 2u; }
    const size_t kstep = (size_t)(BK * 2);
    const size_t hstep = (size_t)HALF * K * 2;
    const size_t tstep = 2 * hstep;
    const unsigned ldsw = (unsigned)wid * 1024u;
    const int aoff = lds_byte(wr * 64 + fr, fq * 8), boff = lds_byte(wc * 32 + fr, fq * 8);
#define PG8_SA(b, h) (((b) * 2 + (h)) * HTB)
#define PG8_SB(b, h) ((4 + (b) * 2 + (h)) * HTB)
#define PG8_STAGE(bufoff, gbase, voff) do { _Pragma("unroll") for (int _i = 0; _i < 2; ++_i) \
        __builtin_amdgcn_global_load_lds((const unsigned*)((const char*)(gbase) + (voff)[_i]), (LAS unsigned*)(lds + (bufoff) + ldsw + _i * 8192), 16, 0, 0); } while (0)
#define PG8_LDA(dst, b, h) do { _Pragma("unroll") for (int m = 0; m < 4; ++m) _Pragma("unroll") for (int k = 0; k < 2; ++k) dst[m][k] = *(const LAS bf16x8*)(lds + PG8_SA(b, h) + aoff + m * 2048 + k * 1024); } while (0)
#define PG8_LDB(dst, b, h) do { _Pragma("unroll") for (int n = 0; n < 2; ++n) _Pragma("unroll") for (int k = 0; k < 2; ++k) dst[n][k] = *(const LAS bf16x8*)(lds + PG8_SB(b, h) + boff + n * 2048 + k * 1024); } while (0)
#define PG8_CAT(x) __builtin_shufflevector(__builtin_bit_cast(i32x4, (x)[0]), __builtin_bit_cast(i32x4, (x)[1]), 0, 1, 2, 3, 4, 5, 6, 7)
#define PG8_MMA(ai, bj, At, Bt) do { __builtin_amdgcn_s_setprio(1); \
        if constexpr (Epi::FP8) { _Pragma("unroll") for (int m = 0; m < 4; ++m) _Pragma("unroll") for (int n = 0; n < 2; ++n) \
            asm volatile("v_mfma_scale_f32_16x16x128_f8f6f4 %0, %1, %2, %0, %3, %3 op_sel_hi:[0,0,0]" : "+v"(acc[ai][bj][m][n]) : "v"(PG8_CAT(Bt[n])), "v"(PG8_CAT(At[m])), "v"(one8)); } \
        else { _Pragma("unroll") for (int m = 0; m < 4; ++m) _Pragma("unroll") for (int n = 0; n < 2; ++n) _Pragma("unroll") for (int k = 0; k < 2; ++k) \
            acc[ai][bj][m][n] = __builtin_amdgcn_mfma_f32_16x16x32_bf16(Bt[n][k], At[m][k], acc[ai][bj][m][n], 0, 0, 0); } \
        __builtin_amdgcn_s_setprio(0); } while (0)
#define PG8_WAIT_V(n) asm volatile("s_waitcnt vmcnt(" #n ")" ::: "memory")
#define PG8_WAIT_L(n) asm volatile("s_waitcnt lgkmcnt(" #n ")" ::: "memory")
#define PG8_BAR __builtin_amdgcn_s_barrier()
#define PG8_SCHED __builtin_amdgcn_sched_barrier(0)
    Unit cur, nxt; int ui = 0;
    if (!S.next(0, cur)) return;
    const unsigned one8 = 0x7F7F7F7Fu;
    (void)one8;
    f32x4 acc[2][2][4][2];
    if constexpr (Epi::LOAD_INIT) E.init(acc, cur, wr, wc, fr, fq);
    else {
#pragma unroll
    for (int a = 0; a < 2; ++a)
#pragma unroll
        for (int b = 0; b < 2; ++b)
#pragma unroll
            for (int m = 0; m < 4; ++m)
#pragma unroll
                for (int n = 0; n < 2; ++n) acc[a][b][m][n] = (f32x4){0.f, 0.f, 0.f, 0.f};
    }
    bf16x8 At[4][2], B0[2][2], B1[2][2];
    unsigned oc[2][2], on[2][2];
#pragma unroll
    for (int h = 0; h < 2; ++h)
#pragma unroll
        for (int i = 0; i < 2; ++i) { oc[h][i] = S.row_off(cur, h * HALF + Rr[i], K) + (unsigned)Cc[i] * 2u; on[h][i] = oc[h][i]; }
    const char* cA = (const char*)g.A + S.a_base(cur, tstep); const char* cB = (const char*)g.Bt + (size_t)cur.pn * tstep;
    S.a_ready(cur, wid);
    if constexpr (SP2) {
        PG8_STAGE(PG8_SB(0, 0), cB, voffB); PG8_STAGE(PG8_SB(0, 1), cB + hstep, voffB); PG8_STAGE(PG8_SA(0, 0), cA, oc[0]); PG8_STAGE(PG8_SA(0, 1), cA, oc[1]);
        if (wr == 1) PG8_BAR;
        PG8_WAIT_V(2); PG8_BAR;
        PG8_STAGE(PG8_SB(1, 0), cB + kstep, voffB); PG8_STAGE(PG8_SA(1, 0), cA + kstep, oc[0]); PG8_STAGE(PG8_SB(1, 1), cB + hstep + kstep, voffB);
        PG8_WAIT_V(6); PG8_BAR;
    } else {
        PG8_STAGE(PG8_SB(0, 0), cB, voffB); PG8_STAGE(PG8_SA(0, 0), cA, oc[0]); PG8_STAGE(PG8_SB(0, 1), cB + hstep, voffB); PG8_STAGE(PG8_SA(0, 1), cA, oc[1]);
        if (wr == 1) PG8_BAR;
        PG8_WAIT_V(4); PG8_BAR;
        PG8_STAGE(PG8_SB(1, 0), cB + kstep, voffB); PG8_STAGE(PG8_SA(1, 0), cA + kstep, oc[0]); PG8_STAGE(PG8_SB(1, 1), cB + hstep + kstep, voffB);
        PG8_WAIT_V(6); PG8_BAR;
    }
    for (;;) {
        const bool has_next = S.next(ui + 1, nxt);
        const char* nA = has_next ? (const char*)g.A + S.a_base(nxt, tstep) : cA; const char* nB = has_next ? (const char*)g.Bt + (size_t)nxt.pn * tstep : cB;
        if (has_next) {
#pragma unroll
            for (int h = 0; h < 2; ++h)
#pragma unroll
                for (int i = 0; i < 2; ++i) on[h][i] = S.row_off(nxt, h * HALF + Rr[i], K) + (unsigned)Cc[i] * 2u;
        }
        for (int t = 0; t < nt; t += 2) {
            const bool last = (t == nt - 2);
            if (last && has_next) S.a_ready(nxt, wid);
            const char* a1 = cA + (size_t)(t + 1) * kstep;
            const char* a2 = last ? nA : cA + (size_t)(t + 2) * kstep; const char* b2 = last ? nB : cB + (size_t)(t + 2) * kstep;
            const char* a3 = a2 + kstep; const char* b3 = b2 + kstep;
            unsigned o2a[2], o2b[2];
            o2a[0] = last ? on[0][0] : oc[0][0]; o2a[1] = last ? on[0][1] : oc[0][1]; o2b[0] = last ? on[1][0] : oc[1][0]; o2b[1] = last ? on[1][1] : oc[1][1];
            if constexpr (SP2) {
            PG8_LDB(B0, 0, 0); PG8_LDB(B1, 0, 1); PG8_SCHED; PG8_LDA(At, 0, 0); PG8_STAGE(PG8_SA(1, 1), a1, oc[1]);
            PG8_WAIT_V(8); PG8_WAIT_L(0); PG8_BAR; PG8_MMA(0, 0, At, B0); PG8_MMA(0, 1, At, B1); PG8_BAR; PG8_SCHED;
            PG8_LDA(At, 0, 1); PG8_STAGE(PG8_SB(0, 0), b2, voffB); PG8_STAGE(PG8_SB(0, 1), b2 + hstep, voffB); PG8_STAGE(PG8_SA(0, 0), a2, o2a);
            PG8_WAIT_V(8); PG8_WAIT_L(0); PG8_BAR; PG8_MMA(1, 0, At, B0); PG8_MMA(1, 1, At, B1); PG8_BAR; PG8_SCHED;
            PG8_LDB(B0, 1, 0); PG8_LDB(B1, 1, 1); PG8_SCHED; PG8_LDA(At, 1, 0); PG8_STAGE(PG8_SA(0, 1), a2, o2b);
            PG8_WAIT_V(8); PG8_WAIT_L(0); PG8_BAR; PG8_MMA(0, 0, At, B0); PG8_MMA(0, 1, At, B1); PG8_BAR; PG8_SCHED;
            PG8_LDA(At, 1, 1); PG8_STAGE(PG8_SB(1, 0), b3, voffB); PG8_STAGE(PG8_SB(1, 1), b3 + hstep, voffB); PG8_STAGE(PG8_SA(1, 0), a3, o2a);
            PG8_WAIT_V(8); PG8_WAIT_L(0); PG8_BAR; PG8_MMA(1, 0, At, B0); PG8_MMA(1, 1, At, B1); PG8_BAR; PG8_SCHED;
            } else {
            PG8_LDB(B0, 0, 0); PG8_SCHED; PG8_LDA(At, 0, 0); PG8_STAGE(PG8_SA(1, 1), a1, oc[1]);
            PG8_WAIT_L(8); PG8_BAR; PG8_WAIT_L(0); PG8_MMA(0, 0, At, B0); PG8_BAR; PG8_SCHED;
            PG8_LDB(B1, 0, 1); PG8_STAGE(PG8_SB(0, 0), b2, voffB);
            PG8_BAR; PG8_WAIT_L(0); PG8_MMA(0, 1, At, B1); PG8_BAR;
            PG8_LDA(At, 0, 1); PG8_STAGE(PG8_SA(0, 0), a2, o2a);
            PG8_BAR; PG8_WAIT_L(0); PG8_MMA(1, 0, At, B0); PG8_BAR; PG8_SCHED;
            PG8_STAGE(PG8_SB(0, 1), b2 + hstep, voffB);
            PG8_WAIT_V(6); PG8_BAR; PG8_MMA(1, 1, At, B1); PG8_BAR;
            PG8_LDB(B0, 1, 0); PG8_SCHED; PG8_LDA(At, 1, 0); PG8_STAGE(PG8_SA(0, 1), a2, o2b);
            PG8_WAIT_L(8); PG8_BAR; PG8_WAIT_L(0); PG8_MMA(0, 0, At, B0); PG8_BAR; PG8_SCHED;
            PG8_LDB(B1, 1, 1); PG8_STAGE(PG8_SB(1, 0), b3, voffB);
            PG8_BAR; PG8_WAIT_L(0); PG8_MMA(0, 1, At, B1); PG8_BAR;
            PG8_LDA(At, 1, 1); PG8_STAGE(PG8_SA(1, 0), a3, o2a);
            PG8_BAR; PG8_WAIT_L(0); PG8_MMA(1, 0, At, B0); PG8_BAR; PG8_SCHED;
            PG8_STAGE(PG8_SB(1, 1), b3 + hstep, voffB);
            PG8_WAIT_V(6); PG8_BAR; PG8_MMA(1, 1, At, B1); PG8_BAR;
            }
        }
        if (wr == 0) PG8_BAR;
        if constexpr (Epi::FP8) asm volatile("s_nop 15\n\ts_nop 15" ::: "memory");
        { const int tz = otid(wv) & 63; E(acc, cur, wr, wc, tz & 15, tz >> 4); }
        if (!has_next) break;
#pragma unroll
        for (int a = 0; a < 2; ++a)
#pragma unroll
            for (int b = 0; b < 2; ++b)
#pragma unroll
                for (int m = 0; m < 4; ++m)
#pragma unroll
                    for (int n = 0; n < 2; ++n) acc[a][b][m][n] = (f32x4){0.f, 0.f, 0.f, 0.f};
        if constexpr (Epi::LOAD_INIT) { const int tz2 = otid(wv) & 63; E.init(acc, nxt, wr, wc, tz2 & 15, tz2 >> 4); }
        cur = nxt; cA = nA; cB = nB; ++ui;
#pragma unroll
        for (int h = 0; h < 2; ++h)
#pragma unroll
            for (int i = 0; i < 2; ++i) oc[h][i] = on[h][i];
        if (wr == 1) PG8_BAR;
    }
    PG8_WAIT_V(0);
    PG8_BAR;
#undef PG8_SA
#undef PG8_SB
#undef PG8_STAGE
#undef PG8_LDA
#undef PG8_LDB
#undef PG8_MMA
#undef PG8_CAT
#undef PG8_WAIT_V
#undef PG8_WAIT_L
#undef PG8_BAR
#undef PG8_SCHED
}


struct EpiQK {
    static constexpr int PERM = 1; static constexpr bool LOAD_INIT = false; static constexpr bool FP8 = (FP8_PROJ != 0);
    bf16_t* O; const float *gqd, *gkd, *gqf, *gkf; LAS float* tbl; const float* rstd; unsigned char* O8;
    __device__ __forceinline__ void operator()(const f32x4 (&acc)[2][2][4][2], const Unit& u, int wr, int wc, int fr, int fq) const {
#pragma unroll
        for (int ai = 0; ai < 2; ++ai)
#pragma unroll
            for (int m = 0; m < 4; ++m)
#pragma unroll
                for (int bj = 0; bj < 2; ++bj) {
                    const f32x4 a = acc[ai][bj][m][0], b = acc[ai][bj][m][1];
                    float ss = (a[0] * a[0] + a[1] * a[1]) + (a[2] * a[2] + a[3] * a[3]) + (b[0] * b[0] + b[1] * b[1]) + (b[2] * b[2] + b[3] * b[3]);
                    ss += swz_xor<16>(ss); ss = sum_xor32(ss);
                    if (fq == 0) tbl[(bj * 256 + ai * 128 + wr * 64 + m * 16 + fr) * 4 + wc] = FP8 ? ss * (1.f / (W8_SCALE * W8_SCALE)) : ss;
                }
        asm volatile("s_waitcnt lgkmcnt(0)" ::: "memory"); __builtin_amdgcn_s_barrier(); asm volatile("" ::: "memory");
        const int colh = wc * 32 + fq * 8;
#pragma unroll
        for (int bj = 0; bj < 2; ++bj) {
            const int hh = u.pn * 2 + bj;
            int mode; const float* gp; float extra;
            if (hh < 6) { mode = 0; gp = gqd + (colh & 63); extra = 0.125f * LOG2E * 4.f; }
            else if (hh < 12) { mode = 0; gp = gkd + (colh & 63); extra = 0.25f; }
            else if (hh < 17) { mode = 1; gp = gqf + colh; extra = 0.08838834764831845f * LOG2E * 4.f; }
            else if (hh < 22) { mode = 1; gp = gkf + colh; extra = 0.25f; }
            else if (hh < 27) { mode = 2; gp = gqd; extra = 0.08838834764831845f * LOG2E; }
            else { mode = 2; gp = gqd; extra = 1.f; }
            f32x4 g0 = (f32x4){1.f, 1.f, 1.f, 1.f}, g1 = g0;
            if (mode != 2) { g0 = *(const f32x4*)gp; g1 = *(const f32x4*)(gp + 4); }
            g0 = g0 * (FP8 ? extra * (1.f / W8_SCALE) : extra); g1 = g1 * (FP8 ? extra * (1.f / W8_SCALE) : extra);
#pragma unroll
            for (int ai = 0; ai < 2; ++ai)
#pragma unroll
                for (int m = 0; m < 4; ++m) {
                    const int rl = ai * 128 + wr * 64 + m * 16 + fr;
                    const float rr = rstd[u.pm * 256 + rl];
                    float rs = rr;
                    if (mode != 2) {
                        const f32x4 t = *(const LAS f32x4*)(tbl + (bj * 256 + rl) * 4);
                        const float tot = (mode == 0) ? ((wc < 2) ? (t[0] + t[1]) : (t[2] + t[3])) : ((t[0] + t[1]) + (t[2] + t[3]));
                        rs = rr * __builtin_amdgcn_rsqf(rr * rr * tot * (mode == 0 ? (1.f / 64.f) : (1.f / 128.f)) + EPS);
                    }
                    const f32x4 v0 = acc[ai][bj][m][0] * g0 * rs, v1 = acc[ai][bj][m][1] * g1 * rs;
                    if (mode != 2) { u32x2 w8; w8.x = cvt4f8(v0[0], v0[1], v0[2], v0[3]); w8.y = cvt4f8(v1[0], v1[1], v1[2], v1[3]);
                        *(u32x2*)(O8 + (size_t)(u.pm * 256 + rl) * NQK + u.pn * 256 + bj * 128 + colh) = w8; continue; }
                    u32x4 w; w.x = cvtpk(v0[0], v0[1]); w.y = cvtpk(v0[2], v0[3]); w.z = cvtpk(v1[0], v1[1]); w.w = cvtpk(v1[2], v1[3]);
                    *(u32x4*)(O + (size_t)(u.pm * 256 + rl) * NQK + u.pn * 256 + bj * 128 + colh) = w;
                }
        }
    }
};
struct EpiVT {
    static constexpr int PERM = 2; static constexpr bool LOAD_INIT = false; static constexpr bool FP8 = (FP8_PROJ != 0);
    bf16_t* O; int ldc; const float* rstd;
    __device__ __forceinline__ void operator()(const f32x4 (&acc)[2][2][4][2], const Unit& u, int wr, int wc, int fr, int fq) const {
        f32x4 r0[2], r1[2];
#pragma unroll
        for (int bj = 0; bj < 2; ++bj) { const float* rp = rstd + u.pn * 256 + bj * 128 + wc * 32 + 16 * (fq >> 1) + 4 * (fq & 1);
            r0[bj] = *(const f32x4*)rp; r1[bj] = *(const f32x4*)(rp + 8); if (FP8) { r0[bj] = r0[bj] * (1.f / W8_SCALE); r1[bj] = r1[bj] * (1.f / W8_SCALE); } }
#pragma unroll
        for (int ai = 0; ai < 2; ++ai)
#pragma unroll
            for (int m = 0; m < 4; ++m)
#pragma unroll
                for (int bj = 0; bj < 2; ++bj) {
                    const f32x4 v0 = acc[ai][bj][m][0] * r0[bj], v1 = acc[ai][bj][m][1] * r1[bj];
                    u32x4 w; w.x = cvtpk(v0[0], v0[1]); w.y = cvtpk(v0[2], v0[3]); w.z = cvtpk(v1[0], v1[1]); w.w = cvtpk(v1[2], v1[3]);
                    *(u32x4*)(O + (size_t)(u.pm * 256 + ai * 128 + wr * 64 + m * 16 + fr) * ldc + u.pn * 256 + bj * 128 + wc * 32 + fq * 8) = w;
                }
    }
};
struct EpiResAdd {
    static constexpr int PERM = 1; static constexpr bool LOAD_INIT = true; static constexpr bool FP8 = (FP8_WOUT != 0);
    bf16_t* X; float sc; unsigned* done; unsigned char* X8;
    __device__ __forceinline__ void init(f32x4 (&acc)[2][2][4][2], const Unit& u, int wr, int wc, int fr, int fq) const {
#pragma unroll
        for (int ai = 0; ai < 2; ++ai)
#pragma unroll
            for (int m = 0; m < 4; ++m)
#pragma unroll
                for (int bj = 0; bj < 2; ++bj) {
                    const u32x4 w = *(const u32x4*)(X + (size_t)(u.pm * 256 + ai * 128 + wr * 64 + m * 16 + fr) * DM + u.pn * 256 + bj * 128 + wc * 32 + fq * 8);
                    acc[ai][bj][m][0] = (f32x4){bf_lo(w.x), bf_hi(w.x), bf_lo(w.y), bf_hi(w.y)};
                    acc[ai][bj][m][1] = (f32x4){bf_lo(w.z), bf_hi(w.z), bf_lo(w.w), bf_hi(w.w)};
                    if (FP8) { acc[ai][bj][m][0] = acc[ai][bj][m][0] * W8_SCALE; acc[ai][bj][m][1] = acc[ai][bj][m][1] * W8_SCALE; }
                }
    }
    __device__ __forceinline__ void operator()(const f32x4 (&acc)[2][2][4][2], const Unit& u, int wr, int wc, int fr, int fq) const {
        const __amdgpu_buffer_rsrc_t rsrc = __builtin_amdgcn_make_buffer_rsrc((void*)X, 0, SEQ * DM * 2, 0x00020000);
        const __amdgpu_buffer_rsrc_t rsrc8 = __builtin_amdgcn_make_buffer_rsrc((void*)X8, 0, SEQ * DM, 0x00020000);
#pragma unroll
        for (int ai = 0; ai < 2; ++ai)
#pragma unroll
            for (int m = 0; m < 4; ++m)
#pragma unroll
                for (int bj = 0; bj < 2; ++bj) {
                    const f32x4 v0 = FP8 ? acc[ai][bj][m][0] * (1.f / W8_SCALE) : acc[ai][bj][m][0], v1 = FP8 ? acc[ai][bj][m][1] * (1.f / W8_SCALE) : acc[ai][bj][m][1];
                    u32x4 w; w.x = cvtpk(v0[0], v0[1]); w.y = cvtpk(v0[2], v0[3]); w.z = cvtpk(v1[0], v1[1]); w.w = cvtpk(v1[2], v1[3]);
                    u32x2 w8; w8.x = cvt4f8(v0[0], v0[1], v0[2], v0[3]); w8.y = cvt4f8(v1[0], v1[1], v1[2], v1[3]);
                    __builtin_amdgcn_raw_buffer_store_b64(w8, rsrc8, (int)((u.pm * 256 + ai * 128 + wr * 64 + m * 16 + fr) * DM + u.pn * 256 + bj * 128 + wc * 32 + fq * 8), 0, 16);
                    __builtin_amdgcn_raw_buffer_store_b128(w, rsrc, (int)(((u.pm * 256 + ai * 128 + wr * 64 + m * 16 + fr) * DM + u.pn * 256 + bj * 128 + wc * 32 + fq * 8) * 2), 0, 16);
                }
        asm volatile("s_waitcnt vmcnt(0)" ::: "memory");
        if (fr == 0 && fq == 0) __hip_atomic_fetch_add(done + 64 * u.pm, 1u, __ATOMIC_RELAXED, __HIP_MEMORY_SCOPE_AGENT);
    }
};
struct EpiGU {
    static constexpr int PERM = 1; static constexpr bool LOAD_INIT = false; static constexpr bool FP8 = true;
    unsigned char* ACT; const float* gate; const LAS int* tbl; unsigned* done;
    __device__ __forceinline__ void operator()(const f32x4 (&acc)[2][2][4][2], const Unit& u, int wr, int wc, int fr, int fq) const {
        const int ct = u.pn & 3, n_e = __builtin_amdgcn_readfirstlane(tbl[17 + u.e]);
        const __amdgpu_buffer_rsrc_t rsrc = __builtin_amdgcn_make_buffer_rsrc((void*)ACT, 0, MOE_ROWS * FEXP, 0x00020000);
#pragma unroll
        for (int ai = 0; ai < 2; ++ai)
#pragma unroll
            for (int m = 0; m < 4; ++m) {
                const int rl = ai * 128 + wr * 64 + m * 16 + fr, pos = u.rt * 256 + rl;
                f32x2_t gr2 = {0.f, 0.f}; if (pos < n_e) gr2 = *(const f32x2_t*)(gate + 2 * (u.e * SEQ + pos));
                const float gt = gr2[0] * ACT8_SCALE, rs = gr2[1] * (1.f / W8_SCALE);
                float o[8];
#pragma unroll
                for (int n = 0; n < 2; ++n)
#pragma unroll
                    for (int j = 0; j < 4; ++j) { const float gv = acc[ai][0][m][n][j] * rs, uv = acc[ai][1][m][n][j] * rs;
                        const float sg = gv * __builtin_amdgcn_rcpf(1.f + fexp2(-gv * LOG2E)); o[n * 4 + j] = sg * uv * gt; }
                u32x2 w; w.x = cvt4f8(o[0], o[1], o[2], o[3]); w.y = cvt4f8(o[4], o[5], o[6], o[7]);
                __builtin_amdgcn_raw_buffer_store_b64(w, rsrc, (int)((u.pm * 256 + rl) * FEXP + ct * 128 + wc * 32 + fq * 8), 0, 16);
            }
        asm volatile("s_waitcnt vmcnt(0)" ::: "memory");
        if (fr == 0 && fq == 0) __hip_atomic_fetch_add(done + 64 * u.pm, 1u, __ATOMIC_RELAXED, __HIP_MEMORY_SCOPE_AGENT);
    }
};
struct EpiDown {
    static constexpr int PERM = 1; static constexpr bool LOAD_INIT = false; static constexpr bool FP8 = true;
    unsigned char* Y;
    __device__ __forceinline__ void operator()(const f32x4 (&acc)[2][2][4][2], const Unit& u, int wr, int wc, int fr, int fq) const {
        const int ct = u.pn & 7;
#pragma unroll
        for (int ai = 0; ai < 2; ++ai)
#pragma unroll
            for (int m = 0; m < 4; ++m)
#pragma unroll
                for (int bj = 0; bj < 2; ++bj) {
                    const f32x4 v0 = acc[ai][bj][m][0] * (Y8_SCALE / (W8_SCALE * ACT8_SCALE)), v1 = acc[ai][bj][m][1] * (Y8_SCALE / (W8_SCALE * ACT8_SCALE));
                    u32x2 w; w.x = cvt4f8(v0[0], v0[1], v0[2], v0[3]); w.y = cvt4f8(v1[0], v1[1], v1[2], v1[3]);
                    *(u32x2*)(Y + (size_t)(u.pm * 256 + ai * 128 + wr * 64 + m * 16 + fr) * DM + ct * 256 + bj * 128 + wc * 32 + fq * 8) = w;
                }
    }
};
}

#define XB_TMO      128
#define XB_XCNT(j)  (256  + 64 * (j))
#define XB_XSUB(j)  (1280 + 64 * (j))
#define XB_XGEN(j)  (2304 + 64 * (j))
#define XB_TOP      3328
#define XB_TOPGEN   3392
#define XCD_BAR_WORDS 3456
#define XB_SPIN_CAP (1u << 18)

__device__ __forceinline__ unsigned xb_ld(unsigned* p)              { return __hip_atomic_load(p, __ATOMIC_RELAXED, __HIP_MEMORY_SCOPE_AGENT); }
__device__ __forceinline__ unsigned xb_add(unsigned* p, unsigned v) { return __hip_atomic_fetch_add(p, v, __ATOMIC_RELAXED, __HIP_MEMORY_SCOPE_AGENT); }
__device__ __forceinline__ unsigned xb_xcc_id() { return (unsigned)__builtin_amdgcn_s_getreg((3 << 11) | 20) & 0xFu; }
#define XB_SPIN(cond, bar) do { unsigned _sp = 0; while (cond) { __builtin_amdgcn_s_sleep(1); \
    if ((++_sp & 255u) == 0u) { if (xb_ld(&(bar)[XB_TMO])) break; if (_sp > XB_SPIN_CAP) { atomicAdd(&(bar)[XB_TMO], 1u); break; } } } } while (0)

struct XcdBarrier { unsigned* bar; unsigned x; volatile LAS unsigned* st; int wv; };

__device__ __forceinline__ XcdBarrier xcd_barrier_post(unsigned* bar, volatile LAS unsigned* st, int wv) {
    XcdBarrier b; b.bar = bar; b.x = xb_xcc_id(); b.st = st; b.wv = wv;
    if (otid(wv) == 0) (void)xb_add(&bar[XB_XCNT(b.x)], 1u);
    return b;
}
__device__ __forceinline__ void xcd_barrier_complete(unsigned* bar, unsigned x, unsigned& nloc, unsigned& nx) {
    const unsigned G = gridDim.x * gridDim.y * gridDim.z;
    unsigned sum, cnt, mine, sp = 0u;
    for (;;) {
        sum = 0u; cnt = 0u; mine = 0u;
#pragma unroll
        for (unsigned j = 0; j < 16; ++j) { const unsigned c = xb_ld(&bar[XB_XCNT(j)]); sum += c; cnt += (c > 0u) ? 1u : 0u; mine = (j == x) ? c : mine; }
        if (sum == G) break;
        __builtin_amdgcn_s_sleep(1);
        if ((++sp & 255u) == 0u) { if (xb_ld(&bar[XB_TMO])) break; if (sp > XB_SPIN_CAP) { atomicAdd(&bar[XB_TMO], 1u); break; } }
    }
    nloc = mine > 0u ? mine : 1u; nx = cnt > 0u ? cnt : 1u;
}
__device__ __attribute__((noinline)) void xcd_barrier_impl(unsigned* bar_, unsigned bx, volatile LAS unsigned* bst, int bwv) {
    XcdBarrier b; b.bar = bar_; b.x = bx; b.st = bst; b.wv = bwv;
    asm volatile("s_waitcnt vmcnt(0)" ::: "memory");
    __syncthreads();
    if (otid(b.wv) == 0) {
        unsigned* bar = b.bar;
        __builtin_amdgcn_s_waitcnt(0);
        unsigned nloc = b.st[0], nx = b.st[1];
        if (nloc == 0u) { xcd_barrier_complete(bar, b.x, nloc, nx); b.st[0] = nloc; b.st[1] = nx; }
        const unsigned old = xb_add(&bar[XB_XSUB(b.x)], 1u);
        const unsigned gen = old / nloc;
        if (old + 1u == (gen + 1u) * nloc) {
            __builtin_amdgcn_fence(__ATOMIC_RELEASE, "agent");
            asm volatile("s_waitcnt vmcnt(0)" ::: "memory");
            const unsigned og = xb_add(&bar[XB_TOP], 1u);
            const unsigned tg = og / nx;
            if (og + 1u == (tg + 1u) * nx) xb_add(&bar[XB_TOPGEN], 1u);
            else XB_SPIN(xb_ld(&bar[XB_TOPGEN]) == tg, bar);
            __builtin_amdgcn_fence(__ATOMIC_ACQUIRE, "agent");
            xb_add(&bar[XB_XGEN(b.x)], 1u);
            asm volatile("s_waitcnt vmcnt(0)" ::: "memory");
        } else {
            XB_SPIN(xb_ld(&bar[XB_XGEN(b.x)]) == gen, bar);
            __builtin_amdgcn_fence(__ATOMIC_ACQUIRE, "agent");
            asm volatile("s_waitcnt vmcnt(0)" ::: "memory");
        }
    }
    __syncthreads();
}

__device__ __forceinline__ void xcd_barrier(const XcdBarrier& b) { xcd_barrier_impl(b.bar, b.x, b.st, b.wv); }

struct Params {
    const float *x, *attn_norm, *w_in, *b_forget, *qnorm_diff, *knorm_diff, *lam_q1, *lam_k1, *lam_q2, *lam_k2, *subln_diff, *onorm_sb,
        *qnorm_fox, *knorm_fox, *onorm_fox, *w_out, *ffn_norm, *w_router, *router_bias, *w_gate, *w_up, *w_down;
    float* out; unsigned char* ws; int ph_lo, ph_hi;
};
typedef const __attribute__((address_space(4))) Params* KArgs;
__device__ __forceinline__ KArgs kparams() { KArgs k = (KArgs)__builtin_amdgcn_kernarg_segment_ptr(); asm volatile("" : "+s"(k)); return k; }

__device__ __forceinline__ void transpose_item(const float* W, int ldn, int k0, int n0, bf16_t* WT, int K, int drow, LAS float* scr, int lane, const float* kgain = nullptr, bool f8 = false) {
#pragma unroll 8
    for (int i = 0; i < 32; ++i) { const int kk = 2 * i + (lane >> 5); scr[kk * 33 + (lane & 31)] = W[(size_t)(k0 + kk) * ldn + n0 + (lane & 31)]; }
    asm volatile("s_waitcnt lgkmcnt(0)" ::: "memory");
    const int c = lane & 7;
    f32x4 ga = {1.f, 1.f, 1.f, 1.f}, gb = ga;
    if (kgain) { ga = *(const f32x4*)(kgain + k0 + 8 * c); gb = *(const f32x4*)(kgain + k0 + 8 * c + 4); }
#pragma unroll
    for (int j = 0; j < 4; ++j) { const int n = (lane >> 3) + 8 * j; const LAS float* s = scr + (8 * c) * 33 + n;
        if (f8) { u32x2 o8; o8.x = cvt4f8(s[0 * 33] * ga[0] * W8_SCALE, s[1 * 33] * ga[1] * W8_SCALE, s[2 * 33] * ga[2] * W8_SCALE, s[3 * 33] * ga[3] * W8_SCALE);
            o8.y = cvt4f8(s[4 * 33] * gb[0] * W8_SCALE, s[5 * 33] * gb[1] * W8_SCALE, s[6 * 33] * gb[2] * W8_SCALE, s[7 * 33] * gb[3] * W8_SCALE);
            *(u32x2*)((unsigned char*)WT + (size_t)(drow + n) * K + k0 + 8 * c) = o8; continue; }
        u32x4 o; o.x = cvtpk(s[0 * 33] * ga[0], s[1 * 33] * ga[1]); o.y = cvtpk(s[2 * 33] * ga[2], s[3 * 33] * ga[3]); o.z = cvtpk(s[4 * 33] * gb[0], s[5 * 33] * gb[1]); o.w = cvtpk(s[6 * 33] * gb[2], s[7 * 33] * gb[3]);
        *(u32x4*)(WT + (size_t)(drow + n) * K + k0 + 8 * c) = o; }
    asm volatile("s_waitcnt lgkmcnt(0)" ::: "memory");
}
__device__ __forceinline__ int win_dest(int n0, int& sel) {
    if (n0 < 768) { sel = 0; return n0; }
    if (n0 < 1536) { sel = 0; return n0; }
    if (n0 < 2304) { sel = 1; return n0 - 1536; }
    if (n0 < 2944) { sel = 0; return 2816 + (n0 - 2304); }
    if (n0 < 3584) { sel = 0; return 3456 + (n0 - 2944); }
    if (n0 < 4224) { sel = 1; return 768 + (n0 - 3584); }
    if (n0 < 4864) { sel = 0; return 1536 + (n0 - 4224); }
    if (n0 < 5504) { sel = 0; return 2176 + (n0 - 4864); }
    sel = 1; return 1408 + (n0 - 5504);
}
__device__ __forceinline__ void phase_prologue(KArgs p, LAS unsigned char* lds, int wv) {
    const int tid = otid(wv), lane = tid & 63, wave = tid >> 6;
    LAS float* scr = (LAS float*)(lds + wave * 16384);
    const int gw = blockIdx.x * 8 + wave, NGW = gridDim.x * 8;
    constexpr int I_IN = 32 * 192, I_O = 32 * 64, I_G = 16 * 32 * 16, I_D = 16 * 8 * 64, I_L = I_IN + I_O + 2 * I_G + I_D;
    bf16_t* Wqk = (bf16_t*)(p->ws + WS_WQK); bf16_t* Wv = (bf16_t*)(p->ws + WS_WV); bf16_t* Wo = (bf16_t*)(p->ws + WS_WO);
    bf16_t* Wgu = (bf16_t*)(p->ws + WS_WGU); bf16_t* Wd = (bf16_t*)(p->ws + WS_WD);
    for (int it = gw; it < DEPTH * I_L; it += NGW) {
        const int l = it / I_L; int r = it % I_L;
        if (r < I_IN) { const int kb = r / 192, nb = r % 192; int sel; const int drow = win_dest(nb * 32, sel);
            if (FP8_PROJ) transpose_item(p->w_in + (size_t)l * DM * NIN, NIN, kb * 64, nb * 32, (bf16_t*)(sel ? (unsigned char*)Wv + (size_t)l * NV * DM : (unsigned char*)Wqk + (size_t)l * NQK * DM), DM, drow, scr, lane, p->attn_norm + (size_t)l * DM, true);
            else transpose_item(p->w_in + (size_t)l * DM * NIN, NIN, kb * 64, nb * 32, sel ? Wv + (size_t)l * NV * DM : Wqk + (size_t)l * NQK * DM, DM, drow, scr, lane, p->attn_norm + (size_t)l * DM); continue; }
        r -= I_IN;
        if (r < I_O) { const int kb = r / 64, nb = r % 64;
            if (FP8_WOUT) transpose_item(p->w_out + (size_t)l * DM * DM, DM, kb * 64, nb * 32, (bf16_t*)((unsigned char*)Wo + (size_t)l * DM * DM), DM, nb * 32, scr, lane, nullptr, true);
            else transpose_item(p->w_out + (size_t)l * DM * DM, DM, kb * 64, nb * 32, Wo + (size_t)l * DM * DM, DM, nb * 32, scr, lane); continue; }
        r -= I_O;
        if (r < 2 * I_G) { const int up = r / I_G; r %= I_G; const int e = r / 512, kb = (r % 512) / 16, nb = r % 16; const int n0 = nb * 32;
            const float* src = (up ? p->w_up : p->w_gate) + ((size_t)l * NEXP + e) * DM * FEXP;
            transpose_item(src, FEXP, kb * 64, n0, (bf16_t*)((unsigned char*)Wgu + ((size_t)l * NEXP + e) * 1024 * DM), DM, (n0 >> 7) * 256 + up * 128 + (n0 & 127), scr, lane, p->ffn_norm + (size_t)l * DM, true); continue; }
        r -= 2 * I_G;
        { const int e = r / 512, kb = (r % 512) / 64, nb = r % 64;
            transpose_item(p->w_down + ((size_t)l * NEXP + e) * FEXP * DM, DM, kb * 64, nb * 32, (bf16_t*)((unsigned char*)Wd + ((size_t)l * NEXP + e) * DM * FEXP), FEXP, nb * 32, scr, lane, nullptr, true); }
    }
    { float* WRT = (float*)(p->ws + WS_WRT); for (int i = blockIdx.x * 512 + tid; i < 16 * DM; i += gridDim.x * 512) WRT[(i & 15) * DM + (i >> 4)] = p->w_router[i]; }
    float* WF = (float*)(p->ws + WS_WF);
    for (int i = blockIdx.x * 512 + tid; i < DEPTH * 5 * DM; i += gridDim.x * 512) { const int l = i / (5 * DM), h = (i / DM) % 5, d = i % DM;
        WF[i] = p->w_in[((size_t)l * DM + d) * NIN + 6144 + h]; }
    if (blockIdx.x == 1 && wave < DEPTH) {
        const int l = wave;
        float a = fabsf(p->qnorm_diff[l * 64 + lane]), b = fabsf(p->knorm_diff[l * 64 + lane]);
        float c2 = fmaxf(fabsf(p->qnorm_fox[l * 128 + lane]), fabsf(p->qnorm_fox[l * 128 + 64 + lane])), d2 = fmaxf(fabsf(p->knorm_fox[l * 128 + lane]), fabsf(p->knorm_fox[l * 128 + 64 + lane]));
#pragma unroll
        for (int o = 1; o < 32; o <<= 1) { a = fmaxf(a, __int_as_float(__builtin_amdgcn_ds_bpermute(((lane ^ o) << 2), __float_as_int(a)))); b = fmaxf(b, __int_as_float(__builtin_amdgcn_ds_bpermute(((lane ^ o) << 2), __float_as_int(b))));
            c2 = fmaxf(c2, __int_as_float(__builtin_amdgcn_ds_bpermute(((lane ^ o) << 2), __float_as_int(c2)))); d2 = fmaxf(d2, __int_as_float(__builtin_amdgcn_ds_bpermute(((lane ^ o) << 2), __float_as_int(d2)))); }
        a = fmaxf(a, __int_as_float(__builtin_amdgcn_ds_bpermute(((lane ^ 32) << 2), __float_as_int(a)))); b = fmaxf(b, __int_as_float(__builtin_amdgcn_ds_bpermute(((lane ^ 32) << 2), __float_as_int(b))));
        c2 = fmaxf(c2, __int_as_float(__builtin_amdgcn_ds_bpermute(((lane ^ 32) << 2), __float_as_int(c2)))); d2 = fmaxf(d2, __int_as_float(__builtin_amdgcn_ds_bpermute(((lane ^ 32) << 2), __float_as_int(d2))));
        if (lane == 0) { ((float*)(p->ws + WS_LAM))[8 + 2 * l] = a * b; ((float*)(p->ws + WS_LAM))[8 + 2 * l + 1] = c2 * d2; }
    }
    if (blockIdx.x == 0 && wave < DEPTH) {
        const int l = wave;
        float a = wave_sum(p->lam_q1[l * 64 + lane] * p->lam_k1[l * 64 + lane]), b = wave_sum(p->lam_q2[l * 64 + lane] * p->lam_k2[l * 64 + lane]);
        if (lane == 0) ((float*)(p->ws + WS_LAM))[l] = fexp2(a * LOG2E) - fexp2(b * LOG2E) + (0.8f - 0.6f * fexp2(-0.3f * LOG2E * (float)l));
    }
}

__device__ __forceinline__ float log_sigmoid(float x) { return fminf(x, 0.f) - 0.6931471805599453f * flog2(1.f + fexp2(-fabsf(x) * LOG2E)); }

__device__ __forceinline__ void phase_norm1(KArgs p, int l, LAS unsigned char* lds, int wv, bool probe2 = false) {
    const int tid = otid(wv), lane = tid & 63, wave = tid >> 6;
    LAS float* wf = (LAS float*)lds;
    LAS int* rbase = (LAS int*)(lds + 5 * DM * 4);
    if (l < DEPTH) { const float* WF = (const float*)(p->ws + WS_WF) + (size_t)l * 5 * DM; for (int i = tid; i < 5 * DM; i += 512) wf[i] = WF[i]; }
    if (l > 0 && tid == 0) { const unsigned* cnt = (const unsigned*)(p->ws + WS_CTL) + CW_CNT + (l - 1) * 16 * 64; int acc = 0;
        for (int e = 0; e < 16; ++e) { rbase[e] = acc * 256; acc += ((int)cnt[e * 64] + 255) >> 8; } }
    __syncthreads();
    const bf16_t* Y = (const bf16_t*)(p->ws + WS_Y); const i32x4* tsel = (const i32x4*)(p->ws + WS_TSEL);
    bf16_t* XN = (bf16_t*)(p->ws + WS_XN); float* LOGF = (float*)(p->ws + WS_LOGF);
    const int gw = blockIdx.x * 8 + wave, NGW = gridDim.x * 8;
    for (int t = gw; t < SEQ; t += NGW) {
        asm volatile("" ::: "memory");
        f32x4 v[8];
        if (l == 0 && !probe2) { const f32x4* xr = (const f32x4*)(p->x + (size_t)t * DM) + lane;
#pragma unroll
            for (int j = 0; j < 8; ++j) v[j] = xr[64 * j]; }
        else { const u32x2* xr = (const u32x2*)((const bf16_t*)(p->ws + WS_OUTB) + (size_t)t * DM) + lane;
#pragma unroll
            for (int j = 0; j < 8; ++j) { const u32x2 a = xr[64 * j]; v[j] = (f32x4){bf_lo(a[0]), bf_hi(a[0]), bf_lo(a[1]), bf_hi(a[1])}; } }
        if (l > 0) {
            const float ysc = probe2 ? 0.f : 1.f;
            const i32x4 ts = tsel[t];
            const unsigned* y1 = (const unsigned*)((const unsigned char*)Y + (size_t)(rbase[ts[0]] + ts[1]) * DM) + lane; const unsigned* y2 = (const unsigned*)((const unsigned char*)Y + (size_t)(rbase[ts[2]] + ts[3]) * DM) + lane;
            const float ys8 = ysc * (1.f / Y8_SCALE);
#pragma unroll
            for (int j = 0; j < 8; ++j) { const unsigned a = y1[64 * j], b = y2[64 * j];
                const f32x2_t a0 = __builtin_amdgcn_cvt_pk_f32_fp8((int)a, false), a1 = __builtin_amdgcn_cvt_pk_f32_fp8((int)a, true), b0 = __builtin_amdgcn_cvt_pk_f32_fp8((int)b, false), b1 = __builtin_amdgcn_cvt_pk_f32_fp8((int)b, true);
                v[j][0] += ys8 * (a0[0] + b0[0]); v[j][1] += ys8 * (a0[1] + b0[1]); v[j][2] += ys8 * (a1[0] + b1[0]); v[j][3] += ys8 * (a1[1] + b1[1]); }
        }
        if (l == DEPTH) { f32x4* orow = (f32x4*)(p->out + (size_t)t * DM) + lane;
#pragma unroll
            for (int j = 0; j < 8; ++j) orow[64 * j] = v[j]; }
        else { u32x2* orow = (u32x2*)((bf16_t*)(p->ws + WS_OUTB) + (size_t)t * DM) + lane;
#pragma unroll
            for (int j = 0; j < 8; ++j) { u32x2 w; w[0] = cvtpk(v[j][0], v[j][1]); w[1] = cvtpk(v[j][2], v[j][3]); orow[64 * j] = w; }
            if (FP8_PROJ) { unsigned* orow8 = (unsigned*)(p->ws + WS_OUTB8 + (size_t)t * DM) + lane;
#pragma unroll
                for (int j = 0; j < 8; ++j) orow8[64 * j] = cvt4f8(v[j][0], v[j][1], v[j][2], v[j][3]); } }
        if (l == DEPTH) continue;
        float ss = 0.f;
#pragma unroll
        for (int j = 0; j < 8; ++j) ss += (v[j][0] * v[j][0] + v[j][1] * v[j][1]) + (v[j][2] * v[j][2] + v[j][3] * v[j][3]);
        const float rstd = __builtin_amdgcn_rsqf(wave_sum(ss) * (1.f / DM) + EPS);
        const f32x4* gr = (const f32x4*)(p->attn_norm + (size_t)l * DM) + lane;
        float fc[5] = {0.f, 0.f, 0.f, 0.f, 0.f};
        if (lane == 0) ((float*)(p->ws + WS_RSTD))[t] = rstd;
#pragma unroll
        for (int j = 0; j < 8; ++j) { const f32x4 xn = v[j] * rstd * gr[64 * j];
#pragma unroll
            for (int h = 0; h < 5; ++h) { const f32x4 w4 = *(const LAS f32x4*)(wf + h * DM + 4 * lane + 256 * j); fc[h] += (xn[0] * w4[0] + xn[1] * w4[1]) + (xn[2] * w4[2] + xn[3] * w4[3]); } }
#pragma unroll
        for (int h = 0; h < 5; ++h) { const float s = wave_sum(fc[h]); if (lane == 0) LOGF[h * SEQ + t] = log_sigmoid(s + p->b_forget[l * 5 + h]); }
    }
}

__device__ __forceinline__ void scan_head(KArgs p, int h, int l, LAS unsigned char* lds, int wv) {
    const int tid = otid(wv), lane = tid & 63, wave = tid >> 6;
    const float* src = (const float*)(p->ws + WS_LOGF) + (size_t)h * SEQ + tid * 16; float* dst = (float*)(p->ws + WS_DC2) + (size_t)h * SEQ + tid * 16;
    LAS float* wt = (LAS float*)lds;
    float v[16]; float s = 0.f;
#pragma unroll
    for (int i = 0; i < 4; ++i) { const f32x4 a = ((const f32x4*)src)[i]; v[4 * i] = a[0]; v[4 * i + 1] = a[1]; v[4 * i + 2] = a[2]; v[4 * i + 3] = a[3]; }
#pragma unroll
    for (int i = 0; i < 16; ++i) { s += v[i]; v[i] = s; }
    float inc = s;
#pragma unroll
    for (int o = 1; o < 64; o <<= 1) { const float n = __int_as_float(__builtin_amdgcn_ds_bpermute(((lane - o) & 63) << 2, __float_as_int(inc))); if (lane >= o) inc += n; }
    if (lane == 63) wt[wave] = inc;
    __syncthreads();
    float base = inc - s;
    for (int w = 0; w < wave; ++w) base += wt[w];
#pragma unroll
    for (int i = 0; i < 4; ++i) ((f32x4*)dst)[i] = (f32x4){(v[4 * i] + base) * LOG2E, (v[4 * i + 1] + base) * LOG2E, (v[4 * i + 2] + base) * LOG2E, (v[4 * i + 3] + base) * LOG2E};
    LAS float* dl = (LAS float*)(lds + 64);
#pragma unroll
    for (int i = 0; i < 16; ++i) dl[tid * 16 + i] = (v[i] + base) * LOG2E;
    __syncthreads();
    { const float thr = 39.f + 2.f * 16.3221377f * ((const float*)(p->ws + WS_LAM))[8 + 2 * l + 1];
      const int qb = tid >> 4, part = tid & 15; const float dref = dl[256 * qb]; int cnt = 0;
      for (int i = part; i < 4 * qb; i += 16) cnt += (dref - dl[64 * i + 63] <= -thr) ? 1 : 0;
      float c = (float)cnt; c += swz_xor<1>(c); c += swz_xor<2>(c); c += swz_xor<4>(c); c += swz_xor<8>(c);
      if (part == 0) ((int*)(p->ws + WS_LAM))[64 + h * 32 + qb] = (int)c; }
    __syncthreads();
}

namespace att {
constexpr int KP = 272, VP = 144;
constexpr int KT_BYTES = 64 * KP, VT_BYTES = 128 * VP, KB_BYTES = 256;
constexpr int BUF_BYTES = KT_BYTES + VT_BYTES + KB_BYTES;
constexpr float THR = 8.f;
static_assert(2 * BUF_BYTES <= RING_BYTES && 4 * 128 * 32 * 4 <= RING_BYTES, "attention LDS");

constexpr int KP8 = 144;
struct Stg { u32x4 k0, k1, v0, v1; };
template <bool F8K = false>
__device__ __forceinline__ void stage_load(Stg& s, const bf16_t* Kg, const bf16_t* Vg, int j, int tid) {
    if (F8K) { s.k0 = *(const u32x4*)((const unsigned char*)Kg + (size_t)(64 * j + (tid >> 3)) * NQK + (tid & 7) * 16); }
    else { const bf16_t* kp = Kg + (size_t)(64 * j + (tid >> 3)) * NQK + (tid & 7) * 8;
    s.k0 = *(const u32x4*)kp; s.k1 = *(const u32x4*)(kp + 64); }
    const bf16_t* vp = Vg + (size_t)(tid >> 2) * SEQ + 64 * j + (tid & 3) * 8;
    s.v0 = *(const u32x4*)vp; s.v1 = *(const u32x4*)(vp + 32);
}
template <bool F8K = false>
__device__ __forceinline__ void stage_write(const Stg& s, LAS unsigned char* buf, int tid) {
    if (F8K) { *(LAS u32x4*)(buf + (tid >> 3) * KP8 + (tid & 7) * 16) = s.k0; }
    else { LAS unsigned char* kd = buf + (tid >> 3) * KP + (tid & 7) * 16; *(LAS u32x4*)kd = s.k0; *(LAS u32x4*)(kd + 128) = s.k1; }
    LAS unsigned char* vd = buf + KT_BYTES + (tid >> 2) * VP + (tid & 3) * 16; *(LAS u32x4*)vd = s.v0; *(LAS u32x4*)(vd + 64) = s.v1;
}
template <int NKS>
__device__ __forceinline__ void qk_tile(f32x16& p0, f32x16& p1, const LAS unsigned char* kb, const bf16x8* qr) {
    bf16x8 ka[NKS], kc[NKS];
#pragma unroll
    for (int ks = 0; ks < NKS; ++ks) { ka[ks] = *(const LAS bf16x8*)(kb + ks * 32); kc[ks] = *(const LAS bf16x8*)(kb + 32 * KP + ks * 32); }
    __builtin_amdgcn_sched_barrier(0);
#pragma unroll
    for (int ks = 0; ks < NKS; ++ks) {
        p0 = __builtin_amdgcn_mfma_f32_32x32x16_bf16(ka[ks], qr[ks], p0, 0, 0, 0);
        p1 = __builtin_amdgcn_mfma_f32_32x32x16_bf16(kc[ks], qr[ks], p1, 0, 0, 0);
    }
    __builtin_amdgcn_sched_barrier(0);
}
__device__ __forceinline__ bf16x8 pack8(const f32x16& p, int b) {
    u32x4 w = {cvtpk(p[b + 0], p[b + 1]), cvtpk(p[b + 2], p[b + 3]), cvtpk(p[b + 4], p[b + 5]), cvtpk(p[b + 6], p[b + 7])};
    return *reinterpret_cast<bf16x8*>(&w);
}
__device__ __forceinline__ void pv_tile(f32x16 (&o)[4], const LAS unsigned char* vb, const f32x16& p0, const f32x16& p1) {
    const bf16x8 pb0 = pack8(p0, 0), pb1 = pack8(p0, 8), pb2 = pack8(p1, 0), pb3 = pack8(p1, 8);
#pragma unroll
    for (int dh = 0; dh < 2; ++dh) {
        bf16x8 va[8];
#pragma unroll
        for (int i = 0; i < 8; ++i) va[i] = *(const LAS bf16x8*)(vb + (2 * dh + (i >> 2)) * 32 * VP + (i & 3) * 32);
        __builtin_amdgcn_sched_barrier(0);
#pragma unroll
        for (int i = 0; i < 8; ++i) { const int d0 = 2 * dh + (i >> 2), s4 = i & 3;
            o[d0] = __builtin_amdgcn_mfma_f32_32x32x16_bf16(va[i], s4 == 0 ? pb0 : (s4 == 1 ? pb1 : (s4 == 2 ? pb2 : pb3)), o[d0], 0, 0, 0); }
        __builtin_amdgcn_sched_barrier(0);
    }
}
template <int NKS>
__device__ __forceinline__ void tile_fixed(f32x16 (&o)[4], const LAS unsigned char* kb, const LAS unsigned char* vb, const bf16x8* qr, f32x16& y0, f32x16& y1, float& l) {
    bf16x8 ka[NKS], kc[NKS];
#pragma unroll
    for (int ks = 0; ks < NKS; ++ks) { ka[ks] = *(const LAS bf16x8*)(kb + ks * 32); kc[ks] = *(const LAS bf16x8*)(kb + 32 * KP + ks * 32); }
    __builtin_amdgcn_sched_barrier(0);
#pragma unroll
    for (int ks = 0; ks < NKS; ++ks) y0 = __builtin_amdgcn_mfma_f32_32x32x16_bf16(ka[ks], qr[ks], y0, 0, 0, 0);
    __builtin_amdgcn_sched_barrier(0);
    asm volatile("" : "+v"(y0));
#pragma unroll
    for (int ks = 0; ks < NKS; ++ks) y1 = __builtin_amdgcn_mfma_f32_32x32x16_bf16(kc[ks], qr[ks], y1, 0, 0, 0);
    float s = 0.f;
#pragma unroll
    for (int r = 0; r < 16; ++r) { y0[r] = fexp2(y0[r]); s += y0[r]; }
    const bf16x8 pb0 = pack8(y0, 0), pb1 = pack8(y0, 8);
#pragma unroll
    for (int q = 0; q < NKS; ++q) { __builtin_amdgcn_sched_group_barrier(0x008, 1, 0);
#pragma unroll
        for (int h = 0; h < 8 / NKS; ++h) { __builtin_amdgcn_sched_group_barrier(0x400, 2, 0); __builtin_amdgcn_sched_group_barrier(0x002, 3, 0); } }
    __builtin_amdgcn_sched_barrier(0);
    bf16x8 va[8];
#pragma unroll
    for (int i = 0; i < 8; ++i) va[i] = *(const LAS bf16x8*)(vb + (i >> 1) * 32 * VP + (i & 1) * 32);
    __builtin_amdgcn_sched_barrier(0);
    asm volatile("" : "+v"(y1));
#pragma unroll
    for (int i = 0; i < 8; ++i) o[i >> 1] = __builtin_amdgcn_mfma_f32_32x32x16_bf16(va[i], (i & 1) ? pb1 : pb0, o[i >> 1], 0, 0, 0);
    float s1 = 0.f;
#pragma unroll
    for (int r = 0; r < 16; ++r) { y1[r] = fexp2(y1[r]); s1 += y1[r]; }
    const bf16x8 pb2 = pack8(y1, 0), pb3 = pack8(y1, 8);
#pragma unroll
    for (int q = 0; q < 8; ++q) { __builtin_amdgcn_sched_group_barrier(0x008, 1, 0); __builtin_amdgcn_sched_group_barrier(0x400, 2, 0); __builtin_amdgcn_sched_group_barrier(0x002, 3, 0); }
    __builtin_amdgcn_sched_barrier(0);
    l += s + s1;
    bf16x8 vb2[8];
#pragma unroll
    for (int i = 0; i < 8; ++i) vb2[i] = *(const LAS bf16x8*)(vb + (i >> 1) * 32 * VP + 64 + (i & 1) * 32);
    __builtin_amdgcn_sched_barrier(0);
#pragma unroll
    for (int i = 0; i < 8; ++i) o[i >> 1] = __builtin_amdgcn_mfma_f32_32x32x16_bf16(vb2[i], (i & 1) ? pb3 : pb2, o[i >> 1], 0, 0, 0);
    __builtin_amdgcn_sched_barrier(0);
}
template <int NKS>
__device__ __forceinline__ void tile_fixed8(f32x16 (&o)[4], const LAS unsigned char* kb, const LAS unsigned char* vb, const i32x8* qr, f32x16& y0, f32x16& y1, float& l) {
    typedef float f32x8_t __attribute__((ext_vector_type(8)));
    i32x8 ka[NKS], kc[NKS];
#pragma unroll
    for (int ks = 0; ks < NKS; ++ks) { const i32x4 a0 = *(const LAS i32x4*)(kb + ks * 64), a1 = *(const LAS i32x4*)(kb + ks * 64 + 16), c0 = *(const LAS i32x4*)(kb + 32 * KP8 + ks * 64), c1 = *(const LAS i32x4*)(kb + 32 * KP8 + ks * 64 + 16);
        ka[ks] = __builtin_shufflevector(a0, a1, 0, 1, 2, 3, 4, 5, 6, 7); kc[ks] = __builtin_shufflevector(c0, c1, 0, 1, 2, 3, 4, 5, 6, 7); }
    __builtin_amdgcn_sched_barrier(0);
#pragma unroll
    for (int ks = 0; ks < NKS; ++ks) y0 = __builtin_amdgcn_mfma_scale_f32_32x32x64_f8f6f4(ka[ks], qr[ks], y0, 0, 0, 0, 0x7F7F7F7F, 0, 0x7F7F7F7F);
    __builtin_amdgcn_sched_barrier(0);
    f32x8_t a0 = __builtin_shufflevector(y0, y0, 0, 1, 2, 3, 4, 5, 6, 7), a1 = __builtin_shufflevector(y0, y0, 8, 9, 10, 11, 12, 13, 14, 15);
    asm volatile("" : "+v"(a0));
#pragma unroll
    for (int ks = 0; ks < NKS; ++ks) y1 = __builtin_amdgcn_mfma_scale_f32_32x32x64_f8f6f4(kc[ks], qr[ks], y1, 0, 0, 0, 0x7F7F7F7F, 0, 0x7F7F7F7F);
#pragma unroll
    for (int r = 0; r < 8; ++r) a0[r] = fexp2(a0[r]);
    f32x8_t vs = a0;
    bf16x8 pb0; { u32x4 w = {cvtpk(a0[0], a0[1]), cvtpk(a0[2], a0[3]), cvtpk(a0[4], a0[5]), cvtpk(a0[6], a0[7])}; pb0 = *reinterpret_cast<bf16x8*>(&w); }
#pragma unroll
    for (int q = 0; q < NKS; ++q) { __builtin_amdgcn_sched_group_barrier(0x008, 1, 0);
#pragma unroll
        for (int h = 0; h < 4 / NKS; ++h) { __builtin_amdgcn_sched_group_barrier(0x400, 2, 0); __builtin_amdgcn_sched_group_barrier(0x002, 3, 0); } }
    __builtin_amdgcn_sched_barrier(0);
    bf16x8 va[8];
#pragma unroll
    for (int i = 0; i < 8; ++i) va[i] = *(const LAS bf16x8*)(vb + (i & 3) * 32 * VP + (i >> 2) * 32);
    __builtin_amdgcn_sched_barrier(0);
    f32x8_t b0 = __builtin_shufflevector(y1, y1, 0, 1, 2, 3, 4, 5, 6, 7), b1 = __builtin_shufflevector(y1, y1, 8, 9, 10, 11, 12, 13, 14, 15);
    asm volatile("" : "+v"(a1));
#pragma unroll
    for (int i = 0; i < 4; ++i) o[i] = __builtin_amdgcn_mfma_f32_32x32x16_bf16(va[i], pb0, o[i], 0, 0, 0);
#pragma unroll
    for (int r = 0; r < 8; ++r) a1[r] = fexp2(a1[r]);
    vs += a1;
    bf16x8 pb1; { u32x4 w = {cvtpk(a1[0], a1[1]), cvtpk(a1[2], a1[3]), cvtpk(a1[4], a1[5]), cvtpk(a1[6], a1[7])}; pb1 = *reinterpret_cast<bf16x8*>(&w); }
#pragma unroll
    for (int q = 0; q < 4; ++q) { __builtin_amdgcn_sched_group_barrier(0x008, 1, 0); __builtin_amdgcn_sched_group_barrier(0x400, 2, 0); __builtin_amdgcn_sched_group_barrier(0x002, 3, 0); }
    __builtin_amdgcn_sched_barrier(0);
    bf16x8 vb2[8];
#pragma unroll
    for (int i = 0; i < 8; ++i) vb2[i] = *(const LAS bf16x8*)(vb + (i & 3) * 32 * VP + 64 + (i >> 2) * 32);
    asm volatile("" : "+v"(b0));
#pragma unroll
    for (int i = 0; i < 4; ++i) o[i] = __builtin_amdgcn_mfma_f32_32x32x16_bf16(va[4 + i], pb1, o[i], 0, 0, 0);
#pragma unroll
    for (int r = 0; r < 8; ++r) b0[r] = fexp2(b0[r]);
    vs += b0;
    bf16x8 pb2; { u32x4 w = {cvtpk(b0[0], b0[1]), cvtpk(b0[2], b0[3]), cvtpk(b0[4], b0[5]), cvtpk(b0[6], b0[7])}; pb2 = *reinterpret_cast<bf16x8*>(&w); }
#pragma unroll
    for (int q = 0; q < 4; ++q) { __builtin_amdgcn_sched_group_barrier(0x008, 1, 0); __builtin_amdgcn_sched_group_barrier(0x400, 2, 0); __builtin_amdgcn_sched_group_barrier(0x002, 3, 0); }
    __builtin_amdgcn_sched_barrier(0);
    asm volatile("" : "+v"(b1));
#pragma unroll
    for (int i = 0; i < 4; ++i) o[i] = __builtin_amdgcn_mfma_f32_32x32x16_bf16(vb2[i], pb2, o[i], 0, 0, 0);
#pragma unroll
    for (int r = 0; r < 8; ++r) b1[r] = fexp2(b1[r]);
    vs += b1;
    bf16x8 pb3; { u32x4 w = {cvtpk(b1[0], b1[1]), cvtpk(b1[2], b1[3]), cvtpk(b1[4], b1[5]), cvtpk(b1[6], b1[7])}; pb3 = *reinterpret_cast<bf16x8*>(&w); }
#pragma unroll
    for (int q = 0; q < 4; ++q) { __builtin_amdgcn_sched_group_barrier(0x008, 1, 0); __builtin_amdgcn_sched_group_barrier(0x400, 2, 0); __builtin_amdgcn_sched_group_barrier(0x002, 3, 0); }
    __builtin_amdgcn_sched_barrier(0);
    l += ((vs[0] + vs[1]) + (vs[2] + vs[3])) + ((vs[4] + vs[5]) + (vs[6] + vs[7]));
#pragma unroll
    for (int i = 0; i < 4; ++i) o[i] = __builtin_amdgcn_mfma_f32_32x32x16_bf16(vb2[4 + i], pb3, o[i], 0, 0, 0);
    __builtin_amdgcn_sched_barrier(0);
}
__device__ __forceinline__ float swap_max(float v) { auto rr = __builtin_amdgcn_permlane32_swap(__float_as_uint(v), __float_as_uint(v), false, false); return fmaxf(__uint_as_float(rr[0]), __uint_as_float(rr[1])); }
__device__ __forceinline__ float swap_sum(float v) { auto rr = __builtin_amdgcn_permlane32_swap(__float_as_uint(v), __float_as_uint(v), false, false); return __uint_as_float(rr[0]) + __uint_as_float(rr[1]); }
__device__ __forceinline__ void softmax_step(f32x16& y0, f32x16& y1, float A, float& m, float& l, f32x16 (&o)[4]) {
    float mx = y0[0];
#pragma unroll
    for (int r = 1; r < 16; ++r) mx = fmaxf(mx, y0[r]);
#pragma unroll
    for (int r = 0; r < 16; ++r) mx = fmaxf(mx, y1[r]);
    mx = swap_max(mx) + A;
    if (__any(mx > m + THR)) {
        const float mn = fmaxf(m, mx), al = fexp2(m - mn); m = mn; l *= al;
#pragma unroll
        for (int d0 = 0; d0 < 4; ++d0)
#pragma unroll
            for (int r = 0; r < 16; ++r) o[d0][r] *= al;
    }
    const float mA = m - A; float s = 0.f;
#pragma unroll
    for (int r = 0; r < 16; ++r) { y0[r] = fexp2(y0[r] - mA); s += y0[r]; }
#pragma unroll
    for (int r = 0; r < 16; ++r) { y1[r] = fexp2(y1[r] - mA); s += y1[r]; }
    l += s;
}
__device__ __forceinline__ void softmax_fixed(f32x16& y0, f32x16& y1, float c, float& l) {
    float s = 0.f;
#pragma unroll
    for (int r = 0; r < 16; ++r) { y0[r] = fexp2(y0[r] + c); s += y0[r]; }
#pragma unroll
    for (int r = 0; r < 16; ++r) { y1[r] = fexp2(y1[r] + c); s += y1[r]; }
    l += s;
}
#define KIDX(r) (((r) & 3) + 8 * ((r) >> 2))

template <int TY>
__device__ __forceinline__ void att_item(KArgs p, int l, int head, int qb, LAS unsigned char* lds, int wv, int part = 0) {
    const int tid = otid(wv), wid = __builtin_amdgcn_readfirstlane(tid >> 6), lane = tid & 63, r32 = lane & 31, hi = lane >> 5;
    constexpr int NKS = (TY == 0) ? 4 : 8;
    const int br = (TY == 0) ? (wid >> 2) : 0, rg = (TY == 0) ? (wid & 3) : wid;
    const int t0w = (TY == 0) ? (128 * qb + 32 * rg) : (256 * qb + 32 * wid);
    const int trow = t0w + r32;
    const int NT = (TY == 0) ? (2 * qb + 2) : (4 * qb + 4);
    const int qcol = (TY == 0) ? (128 * head + 64 * br) : (TY == 1 ? 2816 + 128 * head : 1536 + 128 * head);
    const int kcol = (TY == 0) ? (768 + 128 * head) : (TY == 1 ? 3456 + 128 * head : 2176 + 128 * head);
    const int hv = (TY == 0) ? head : (TY == 1 ? 6 + head : 11 + head);
    const bf16_t* QKB = (const bf16_t*)(p->ws + WS_QKB);
    constexpr bool F8 = (TY != 1);
    const unsigned char* QKB8 = p->ws + WS_QKB8;
    const bf16_t* Kg = F8 ? (const bf16_t*)(QKB8 + kcol) : QKB + kcol; const bf16_t* Vg = (const bf16_t*)(p->ws + WS_VT) + (size_t)hv * HD * SEQ;
    const float* dc2 = (const float*)(p->ws + WS_DC2) + (size_t)head * SEQ;
    const float dcref = (TY == 2) ? dc2[256 * qb] : 0.f;
    const float slope2 = (TY == 0) ? fexp2(-8.0f * (float)(head + 1) / 6.0f) * LOG2E : 0.f;
    const float Bfix = (TY == 0) ? (11.5415603f * 1.01f * ((const float*)(p->ws + WS_LAM))[8 + 2 * l] + 0.25f) : (16.3221377f * 1.01f * ((const float*)(p->ws + WS_LAM))[8 + 2 * l + 1] + 0.25f);
    const float cfix = (TY == 2) ? (dc2[trow] - dcref - Bfix) : -Bfix;

    int j_lo = 0;
    if (TY == 0 && SKIP_A) {
        const float Bq = 11.5415603f * ((const float*)(p->ws + WS_LAM))[8 + 2 * l];
        const float x = ((float)(128 * qb - 63) - (39.f + 2.f * Bq) / slope2) * (1.f / 64.f);
        j_lo = x < 0.f ? 0 : (int)x + 1;
    } else if (TY == 2 && SKIP_C) {
        j_lo = ((const int*)(p->ws + WS_LAM))[64 + head * 32 + qb];
    }
    j_lo = __builtin_amdgcn_readfirstlane(j_lo);
    const int NTP = NT - j_lo;
    const bool elig = (TY == 2) ? (qb >= 8) : ((TY == 0) ? (head >= 4 && qb >= 16) : false);
    const bool split = elig && NTP > 32;
    if (part == 1 && !split) return;
    const int mid = j_lo + (NTP >> 1);
    const int jtop = (part == 1) ? mid - 1 : NT - 1;
    const int cntT = (part == 1) ? (mid - j_lo) : (split ? NT - mid : NTP);
    const int sidx = (TY == 2) ? (head * 32 + qb) : (160 + head * 64 + qb);
    unsigned long long* pay = (unsigned long long*)(p->ws + WS_PART) + ((size_t)sidx * 8 + wid) * 17 * 64 + lane;
    unsigned* aflag = (unsigned*)(p->ws + WS_CTL) + CW_AFLAG + (l * 544 + sidx) * 64;
    LAS unsigned char* buf0 = lds; LAS unsigned char* buf1 = lds + BUF_BYTES;
    LAS int* flags = (LAS int*)(lds + 2 * BUF_BYTES);
    if (TY == 1 && tid < 16) flags[tid] = 0;
    Stg st; float kbv = 0.f;
    stage_load<F8>(st, Kg, Vg, jtop, tid);
    if (TY == 2 && tid < 64) kbv = dcref - dc2[64 * jtop + tid];
    bf16x8 qr[NKS]; constexpr int NK8 = (TY == 0) ? 1 : 2; i32x8 q8[NK8];
    if (F8) {
#pragma unroll
        for (int ks = 0; ks < NK8; ++ks) { const i32x4 a = *(const i32x4*)(QKB8 + (size_t)trow * NQK + qcol + ks * 64 + hi * 32), b = *(const i32x4*)(QKB8 + (size_t)trow * NQK + qcol + ks * 64 + hi * 32 + 16);
            q8[ks] = __builtin_shufflevector(a, b, 0, 1, 2, 3, 4, 5, 6, 7); }
    } else {
#pragma unroll
        for (int ks = 0; ks < NKS; ++ks) qr[ks] = *(const bf16x8*)(QKB + (size_t)trow * NQK + qcol + ks * 16 + hi * 8);
    }
    stage_write<F8>(st, buf0, tid);
    if (TY == 2 && tid < 64) *(LAS float*)(buf0 + KT_BYTES + VT_BYTES + tid * 4) = kbv;
    if (cntT > 1) { stage_load<F8>(st, Kg, Vg, jtop - 1, tid); if (TY == 2 && tid < 64) kbv = dcref - dc2[64 * (jtop - 1) + tid]; }
    __syncthreads();

    f32x16 o[4];
#pragma unroll
    for (int d0 = 0; d0 < 4; ++d0)
#pragma unroll
        for (int r = 0; r < 16; ++r) o[d0][r] = 0.f;
    float m = 0.f, lsum = 0.f, R = 0.f;
    const int koff = F8 ? (r32 * KP8 + hi * 32 + ((TY == 0) ? br * 64 : 0)) : (r32 * KP + hi * 16 + ((TY == 0) ? br * 128 : 0)), voff = KT_BYTES + r32 * VP + hi * 16;

    for (int it = 0; it < cntT; ++it) {
        if (TY == 1 && (SKIP_B & 1) && it > 0) { const i32x4 f0 = *(const LAS i32x4*)(flags + ((it - 1) & 1) * 8), f1 = *(const LAS i32x4*)(flags + ((it - 1) & 1) * 8 + 4);
            if (__builtin_amdgcn_readfirstlane((f0[0] & f0[1] & f0[2] & f0[3] & f1[0] & f1[1] & f1[2] & f1[3])) != 0) break; }
        const int j = jtop - it;
        LAS unsigned char* cur = (it & 1) ? buf1 : buf0; LAS unsigned char* oth = (it & 1) ? buf0 : buf1;
        const bool more = it + 1 < cntT;
        if (TY == 0) {
            const int cw = 2 * qb + (rg >> 1);
            if (j <= cw) {
                f32x16 y0, y1;
                const int trel = trow - 64 * j;
                if (j == cw) {
                    const float tq = (float)(trel - 4 * hi);
#pragma unroll
                    for (int r = 0; r < 16; ++r) { y0[r] = fmaf(-slope2, fabsf(tq - (float)KIDX(r)), cfix); y1[r] = fmaf(-slope2, fabsf(tq - (float)(KIDX(r) + 32)), cfix); }
                } else {
                    const float A = fmaf(-slope2, (float)(trel - 4 * hi), cfix);
#pragma unroll
                    for (int r = 0; r < 16; ++r) { y0[r] = fmaf(slope2, (float)KIDX(r), A); y1[r] = fmaf(slope2, (float)(KIDX(r) + 32), A); }
                }
                tile_fixed8<NK8>(o, cur + koff, cur + voff, q8, y0, y1, lsum);
            }
        } else {
            const int jj = j - 4 * qb;
            if (jj <= (wid >> 1) && !(TY == 1 && (SKIP_B & 2) && __all(R <= -40.f))) {
                const bool partial = (jj == (wid >> 1));
                const int tin = 32 * (wid & 1) + r32 - 4 * hi;
                f32x16 y0, y1;
                if (TY == 2) {
                    const LAS f32x4* kbp = (const LAS f32x4*)(cur + KT_BYTES + VT_BYTES) + hi;
#pragma unroll
                    for (int g = 0; g < 4; ++g) { const f32x4 b0 = kbp[2 * g], b1 = kbp[2 * g + 8];
#pragma unroll
                        for (int i = 0; i < 4; ++i) { y0[4 * g + i] = b0[i] + cfix; y1[4 * g + i] = b1[i] + cfix; } }
                    if (partial) {
#pragma unroll
                        for (int r = 0; r < 16; ++r) { if (KIDX(r) > tin) y0[r] = -__builtin_inff(); if (KIDX(r) + 32 > tin) y1[r] = -__builtin_inff(); }
                    }
                    tile_fixed8<NK8>(o, cur + koff, cur + voff, q8, y0, y1, lsum);
                } else {
#pragma unroll
                    for (int r = 0; r < 16; ++r) { y0[r] = 0.f; y1[r] = 0.f; }
                    qk_tile<NKS>(y0, y1, cur + koff, qr);
                    f32x16 lb0, lb1;
#pragma unroll
                    for (int r = 0; r < 16; ++r) {
                        { const float z = fminf(fmaxf(y0[r], -100.f), 100.f), b = -flog2(1.f + fexp2(-z)); float k = b - z, bb = b;
                          if (partial && KIDX(r) >= tin) { k = 0.f; bb = -__builtin_inff(); } lb0[r] = bb; y0[r] = k; }
                        { const float z = fminf(fmaxf(y1[r], -100.f), 100.f), b = -flog2(1.f + fexp2(-z)); float k = b - z, bb = b;
                          if (partial && KIDX(r) + 32 >= tin) { k = 0.f; bb = -__builtin_inff(); } lb1[r] = bb; y1[r] = k; }
                    }
                    float gs0[4], gs1[4];
#pragma unroll
                    for (int g = 0; g < 4; ++g) {
                        { const float e0 = y0[4 * g], e1 = y0[4 * g + 1], e2 = y0[4 * g + 2], e3 = y0[4 * g + 3]; const float s2 = e3, s1 = e3 + e2, s0 = s1 + e1;
                          y0[4 * g + 3] = 0.f; y0[4 * g + 2] = s2; y0[4 * g + 1] = s1; y0[4 * g] = s0; gs0[g] = s0 + e0; }
                        { const float e0 = y1[4 * g], e1 = y1[4 * g + 1], e2 = y1[4 * g + 2], e3 = y1[4 * g + 3]; const float s2 = e3, s1 = e3 + e2, s0 = s1 + e1;
                          y1[4 * g + 3] = 0.f; y1[4 * g + 2] = s2; y1[4 * g + 1] = s1; y1[4 * g] = s0; gs1[g] = s0 + e0; }
                    }
                    float run = R;
#pragma unroll
                    for (int half = 1; half >= 0; --half)
#pragma unroll
                        for (int g = 3; g >= 0; --g) {
                            const float mine = half ? gs1[g] : gs0[g];
                            auto rr = __builtin_amdgcn_permlane32_swap(__float_as_uint(mine), __float_as_uint(mine), false, false);
                            const float g_lo = __uint_as_float(rr[0]), g_hi = __uint_as_float(rr[1]);
                            const float off_hi = run; run += g_hi; const float off_lo = run; run += g_lo;
                            const float off = hi ? off_hi : off_lo;
#pragma unroll
                            for (int i = 0; i < 4; ++i) {
                                if (half) y1[4 * g + i] = fexp2(lb1[4 * g + i] + y1[4 * g + i] + off);
                                else y0[4 * g + i] = fexp2(lb0[4 * g + i] + y0[4 * g + i] + off);
                            }
                        }
                    R = run;
                    pv_tile(o, cur + voff, y0, y1);
                }
            }
        }
        if (TY == 1) { const int dn = __all(R <= -40.f) ? 1 : 0; if (lane == 0) flags[(it & 1) * 8 + wid] = dn; }
        if (more) { stage_write<F8>(st, oth, tid); if (TY == 2 && tid < 64) *(LAS float*)(oth + KT_BYTES + VT_BYTES + tid * 4) = kbv; }
        if (it + 2 < cntT) { stage_load<F8>(st, Kg, Vg, j - 2, tid); if (TY == 2 && tid < 64) kbv = dcref - dc2[64 * (j - 2) + tid]; }
        __syncthreads();
    }

    bf16_t* MIX = (bf16_t*)(p->ws + WS_MIX);
    float inv = 1.f;
    if (TY != 1) {
        float lt = swap_sum(lsum);
        if (part == 1) {
            __hip_atomic_store(pay, ((unsigned long long)__float_as_uint(lt) << 32) | __float_as_uint(m), __ATOMIC_RELAXED, __HIP_MEMORY_SCOPE_AGENT);
#pragma unroll
            for (int d0 = 0; d0 < 4; ++d0)
#pragma unroll
                for (int g = 0; g < 4; ++g)
                    __hip_atomic_store(pay + (1 + d0 * 4 + g) * 64, ((unsigned long long)cvtpk(o[d0][4 * g + 2], o[d0][4 * g + 3]) << 32) | cvtpk(o[d0][4 * g], o[d0][4 * g + 1]), __ATOMIC_RELAXED, __HIP_MEMORY_SCOPE_AGENT);
            asm volatile("s_waitcnt vmcnt(0)" ::: "memory");
            __syncthreads();
            if (tid == 0) __hip_atomic_store(aflag, 1u, __ATOMIC_RELAXED, __HIP_MEMORY_SCOPE_AGENT);
            __syncthreads();
            return;
        }
        if (split) {
            if (tid == 0) { unsigned sp = 0; while (__hip_atomic_load(aflag, __ATOMIC_RELAXED, __HIP_MEMORY_SCOPE_AGENT) == 0u && ++sp < (1u << 22)) __builtin_amdgcn_s_sleep(2);
                __builtin_amdgcn_fence(__ATOMIC_ACQUIRE, "agent"); asm volatile("s_waitcnt vmcnt(0)" ::: "memory"); }
            __syncthreads();
            const unsigned long long ml = __hip_atomic_load(pay, __ATOMIC_RELAXED, __HIP_MEMORY_SCOPE_AGENT);
            const float mf = __uint_as_float((unsigned)ml), lf = __uint_as_float((unsigned)(ml >> 32));
            const float mn = fmaxf(m, mf), a0 = fexp2(m - mn), a1 = fexp2(mf - mn);
            lt = a0 * lt + a1 * lf;
#pragma unroll
            for (int d0 = 0; d0 < 4; ++d0)
#pragma unroll
                for (int g = 0; g < 4; ++g) {
                    const unsigned long long w = __hip_atomic_load(pay + (1 + d0 * 4 + g) * 64, __ATOMIC_RELAXED, __HIP_MEMORY_SCOPE_AGENT);
                    const unsigned w0 = (unsigned)w, w1 = (unsigned)(w >> 32);
                    o[d0][4 * g] = a0 * o[d0][4 * g] + a1 * bf_lo(w0); o[d0][4 * g + 1] = a0 * o[d0][4 * g + 1] + a1 * bf_hi(w0);
                    o[d0][4 * g + 2] = a0 * o[d0][4 * g + 2] + a1 * bf_lo(w1); o[d0][4 * g + 3] = a0 * o[d0][4 * g + 3] + a1 * bf_hi(w1);
                }
        }
        inv = 1.f / lt;
    }
    float post = 1.f; const float* gain;
    if (TY == 0) {
        const float lam = ((const float*)(p->ws + WS_LAM))[l];
        LAS float* X = (LAS float*)lds + (size_t)rg * 128 * 32;
        if (br == 1) {
            const float sc = inv * lam;
#pragma unroll
            for (int d0 = 0; d0 < 4; ++d0)
#pragma unroll
                for (int r = 0; r < 16; ++r) X[(32 * d0 + KIDX(r) + 4 * hi) * 32 + r32] = o[d0][r] * sc;
        }
        __syncthreads();
        if (br == 0) {
#pragma unroll
            for (int d0 = 0; d0 < 4; ++d0)
#pragma unroll
                for (int r = 0; r < 16; ++r) o[d0][r] = o[d0][r] * inv - X[(32 * d0 + KIDX(r) + 4 * hi) * 32 + r32];
        }
        inv = 1.f;
        post = 1.f - (0.8f - 0.6f * fexp2(-0.3f * LOG2E * (float)l));
        gain = p->subln_diff + l * HD;
    } else if (TY == 1) gain = p->onorm_sb + l * HD;
    else gain = p->onorm_fox + l * HD;
    if (TY != 0 || br == 0) {
        float ss = 0.f;
#pragma unroll
        for (int d0 = 0; d0 < 4; ++d0)
#pragma unroll
            for (int r = 0; r < 16; ++r) { const float v = o[d0][r] * inv; ss += v * v; }
        ss = swap_sum(ss);
        const float sc = inv * post * __builtin_amdgcn_rsqf(ss * (1.f / HD) + EPS);
        bf16_t* orow = MIX + (size_t)trow * DM + hv * HD + 4 * hi;
#pragma unroll
        for (int d0 = 0; d0 < 4; ++d0)
#pragma unroll
            for (int g = 0; g < 4; ++g) {
                const f32x4 g4 = *(const f32x4*)(gain + 32 * d0 + 8 * g + 4 * hi);
                if (FP8_WOUT) { *(unsigned*)((unsigned char*)MIX + (size_t)trow * DM + hv * HD + 4 * hi + 32 * d0 + 8 * g) = cvt4f8(o[d0][4 * g] * sc * g4[0], o[d0][4 * g + 1] * sc * g4[1], o[d0][4 * g + 2] * sc * g4[2], o[d0][4 * g + 3] * sc * g4[3]); continue; }
                u32x2 w; w[0] = cvtpk(o[d0][4 * g] * sc * g4[0], o[d0][4 * g + 1] * sc * g4[1]); w[1] = cvtpk(o[d0][4 * g + 2] * sc * g4[2], o[d0][4 * g + 3] * sc * g4[3]);
                *(u32x2*)(orow + 32 * d0 + 8 * g) = w;
            }
    }
    __syncthreads();
}

constexpr int N_FAR = 5 * 24 + 2 * 48;
constexpr int N_ITEMS = N_FAR + 32 * 22;
__device__ __forceinline__ void attention_phase(KArgs p, int l, LAS unsigned char* lds, volatile LAS unsigned* itemw, int wv, int qi, int tmask = 7) {
    unsigned* q = (unsigned*)(p->ws + WS_CTL) + CW_ATTQ + qi * 64;
    for (;;) {
        if (otid(wv) == 0) *itemw = __hip_atomic_fetch_add(q, 1u, __ATOMIC_RELAXED, __HIP_MEMORY_SCOPE_AGENT);
        __syncthreads();
        int item = (int)*itemw;
        __syncthreads();
        if (item >= N_ITEMS) break;
        if (item < N_FAR) {
            if (item < 120) { if (tmask & 1) att_item<2>(p, l, item % 5, 31 - item / 5, lds, wv, 1); }
            else { const int i2 = item - 120; if (tmask & 2) att_item<0>(p, l, 5 - (i2 & 1), 63 - (i2 >> 1), lds, wv, 1); }
            continue;
        }
        item -= N_FAR;
        if (item < 288) { const int w = item % 9, pp = 31 - item / 9;
            if (w < 5) { if (tmask & 1) att_item<2>(p, l, w, pp, lds, wv); }
            else if (tmask & 2) att_item<0>(p, l, 5 - ((w - 5) >> 1), 2 * pp + 1 - ((w - 5) & 1), lds, wv); }
        else if (item < 544) { const int it2 = item - 288, w = it2 % 8, pp = 31 - it2 / 8;
            if (tmask & 2) att_item<0>(p, l, 3 - (w >> 1), 2 * pp + 1 - (w & 1), lds, wv); }
        else if (tmask & 4) { const int it3 = item - 544; att_item<1>(p, l, it3 % 5, 31 - it3 / 5, lds, wv); }
    }
}
}

__device__ __forceinline__ void phase_route(KArgs p, int l, LAS unsigned char* lds, int wv, int ci, bool waitp = true) {
    const int tid = otid(wv), lane = tid & 63, wave = tid >> 6;
    LAS float* wrt = (LAS float*)lds;
    LAS int* bsel = (LAS int*)(lds + 16 * DM * 4);
    LAS float* bsc = (LAS float*)(bsel + 64);
    LAS float* bgate = bsc + 64;
    LAS float* brs = bgate + 64;
    { const f32x4* src = (const f32x4*)(p->ws + WS_WRT); for (int i = tid; i < 16 * DM / 4; i += 512) ((LAS f32x4*)wrt)[i] = src[i]; }
    __syncthreads();
    bf16_t* XN = (bf16_t*)(p->ws + WS_XN);
    for (int blk = blockIdx.x; blk < SEQ / 32; blk += gridDim.x) {
        const int tid = otid(wv), lane = tid & 63, wave = tid >> 6;
        if (waitp) { if (wave == 0) {
            const unsigned* wc = (const unsigned*)(p->ws + WS_CTL) + CW_WOC + l * 32 * 64 + 64 * (blk >> 3);
            unsigned sp = 0;
            while ((unsigned)__builtin_amdgcn_readfirstlane((int)__hip_atomic_load(wc, __ATOMIC_RELAXED, __HIP_MEMORY_SCOPE_AGENT)) < 64u && ++sp < (1u << 22)) __builtin_amdgcn_s_sleep(2);
            __builtin_amdgcn_fence(__ATOMIC_ACQUIRE, "agent");
            asm volatile("s_waitcnt vmcnt(0)" ::: "memory");
            } __syncthreads(); }
        const int tb = blk * 32 + wave * 4;
        f32x4 hx[4][8];
#pragma unroll
        for (int i = 0; i < 4; ++i) { const u32x2* xr = (const u32x2*)((const bf16_t*)(p->ws + WS_OUTB) + (size_t)(tb + i) * DM) + lane;
#pragma unroll
            for (int j = 0; j < 8; ++j) { const u32x2 a = xr[64 * j]; hx[i][j] = (f32x4){bf_lo(a[0]), bf_hi(a[0]), bf_lo(a[1]), bf_hi(a[1])}; } }
#pragma unroll
        for (int i = 0; i < 4; ++i) {
            float ss = 0.f;
#pragma unroll
            for (int j = 0; j < 8; ++j) ss += (hx[i][j][0] * hx[i][j][0] + hx[i][j][1] * hx[i][j][1]) + (hx[i][j][2] * hx[i][j][2] + hx[i][j][3] * hx[i][j][3]);
            const float rstd = __builtin_amdgcn_rsqf(wave_sum(ss) * (1.f / DM) + EPS);
            if (lane == 0) brs[wave * 4 + i] = rstd;
            const f32x4* gr = (const f32x4*)(p->ffn_norm + (size_t)l * DM) + lane;
#pragma unroll
            for (int j = 0; j < 8; ++j) hx[i][j] = hx[i][j] * rstd * gr[64 * j];
        }
#pragma unroll
        for (int h2 = 0; h2 < 2; ++h2) {
            f32x4 (&hn)[2][8] = *reinterpret_cast<f32x4 (*)[2][8]>(&hx[2 * h2]);
            asm volatile("" ::: "memory"); __builtin_amdgcn_sched_barrier(0);
            float acc[32];
#pragma unroll
            for (int k = 0; k < 32; ++k) acc[k] = 0.f;
#pragma unroll
            for (int j = 0; j < 8; ++j)
#pragma unroll
                for (int eh = 0; eh < 2; ++eh) {
#pragma unroll
                    for (int e = 8 * eh; e < 8 * eh + 8; ++e) { const f32x4 w4 = *(const LAS f32x4*)(wrt + e * DM + 4 * lane + 256 * j);
#pragma unroll
                        for (int i = 0; i < 2; ++i) acc[i * 16 + e] += (hn[i][j][0] * w4[0] + hn[i][j][1] * w4[1]) + (hn[i][j][2] * w4[2] + hn[i][j][3] * w4[3]); }
                    __builtin_amdgcn_sched_barrier(0);
                }
#pragma unroll
            for (int k = 0; k < 32; ++k) acc[k] = sum_xor32(acc[k]);
#define RSTEP(H) { const bool up = (lane & H) != 0; _Pragma("unroll") for (int k = 0; k < H; ++k) { const float a = acc[k], b = acc[k + H]; const float give = up ? a : b, keep = up ? b : a; acc[k] = keep + swz_xor<H>(give); } }
            RSTEP(16) RSTEP(8) RSTEP(4) RSTEP(2) RSTEP(1)
#undef RSTEP
            const float logit = acc[0];
            const float score = __builtin_amdgcn_rcpf(1.f + fexp2(-logit * LOG2E));
            const float sel = score + p->router_bias[lane & 15];
            const float v1 = swz_xor<1>(sel), v2 = swz_xor<2>(sel), v3 = swz_xor<3>(sel);
            const float a = fmaxf(sel, v1), b = fminf(sel, v1), c = fmaxf(v2, v3), d = fminf(v2, v3);
            const float gs = fmaxf(a, c) + fmaxf(fminf(a, c), fmaxf(b, d));
            const float g1 = swz_xor<4>(gs), g2 = swz_xor<8>(gs), g3 = swz_xor<12>(gs);
            const int myg = (lane >> 2) & 3, k = lane & 3;
            const bool best = (gs > g1 || (gs == g1 && myg < (myg ^ 1))) && (gs > g2 || (gs == g2 && myg < (myg ^ 2))) && (gs > g3 || (gs == g3 && myg < (myg ^ 3)));
            const int rank = ((v1 > sel || (v1 == sel && (k ^ 1) < k)) ? 1 : 0) + ((v2 > sel || (v2 == sel && (k ^ 2) < k)) ? 1 : 0) + ((v3 > sel || (v3 == sel && (k ^ 3) < k)) ? 1 : 0);
            if (best && rank < 2 && lane < 32) { const int row = wave * 4 + h2 * 2 + (lane >> 4); bsel[row * 2 + rank] = lane & 15; bsc[row * 2 + rank] = score; }
        }
        asm volatile("s_waitcnt lgkmcnt(0)" ::: "memory");
        if (lane < 8) { const int idx = wave * 8 + lane; const float sm = bsc[idx], so = bsc[idx ^ 1]; bgate[idx] = sm / (sm + so); }
        __syncthreads();
        if (wave == 0) {
            unsigned* cnt = (unsigned*)(p->ws + WS_CTL) + CW_CNT + ci * 16 * 64;
            const int mye = bsel[lane]; int myrank = 0, n = 0;
            const unsigned long long below = (1ull << lane) - 1ull;
#pragma unroll
            for (int e = 0; e < 16; ++e) { const unsigned long long mk = __ballot(mye == e); if (mye == e) myrank = (int)__popcll(mk & below); if (lane == e) n = (int)__popcll(mk); }
            int base = 0;
            if (lane < 16 && n) base = (int)__hip_atomic_fetch_add(cnt + lane * 64, (unsigned)n, __ATOMIC_RELAXED, __HIP_MEMORY_SCOPE_AGENT);
            const int pos = __builtin_amdgcn_ds_bpermute(mye << 2, base) + myrank, tok = blk * 32 + (lane >> 1);
            ((int*)(p->ws + WS_TOK))[mye * SEQ + pos] = tok; ((f32x2_t*)(p->ws + WS_GATE))[mye * SEQ + pos] = (f32x2_t){bgate[lane], brs[lane >> 1]};
            int* ts = (int*)(p->ws + WS_TSEL) + tok * 4 + (lane & 1) * 2; ts[0] = mye; ts[1] = pos;
        }
        __syncthreads();
    }
}

__device__ __forceinline__ void moe_table(KArgs p, int l, LAS int* tbl, int wv) {
    if (otid(wv) == 0) { const unsigned* cnt = (const unsigned*)(p->ws + WS_CTL) + CW_CNT + l * 16 * 64; int acc = 0;
        for (int e = 0; e < 16; ++e) { const int n = (int)cnt[e * 64]; tbl[e] = acc; tbl[17 + e] = n; acc += (n + 255) >> 8; } tbl[16] = acc; }
    __syncthreads();
}

constexpr int N_PHASES = 2 + 7 * DEPTH;
__device__ __forceinline__ int opq(int v) { asm volatile("" : "+s"(v)); return v; }
__device__ __forceinline__ LAS unsigned char* opq(LAS unsigned char* v) { unsigned x = (unsigned)(uintptr_t)v; asm volatile("" : "+s"(x)); return (LAS unsigned char*)(uintptr_t)x; }
__global__ void __launch_bounds__(512, 2) trunk_fwd(Params pk) {
    extern __shared__ __attribute__((aligned(16))) unsigned char lds_raw[];
    LAS unsigned char* lds = (LAS unsigned char*)lds_raw;
    volatile LAS unsigned* MISC = (volatile LAS unsigned*)(lds + MISC_OFF);
    LAS int* mtbl = (LAS int*)(lds + MISC_OFF + 256);
#define p kparams()
    const int wv = __builtin_amdgcn_readfirstlane((int)threadIdx.x >> 6);
    for (int u = threadIdx.x; u < (LDS_BYTES - MISC_OFF) / 4; u += 512) ((LAS unsigned*)(lds + MISC_OFF))[u] = 0u;
    __syncthreads();
    unsigned* ctl = (unsigned*)(p->ws + WS_CTL);
    XcdBarrier bar; bar.bar = ctl + CW_BAR; bar.x = 0; bar.st = nullptr; bar.wv = wv;
    const bool multi = (p->ph_hi - p->ph_lo) > 1;
    if (multi) bar = xcd_barrier_post(ctl + CW_BAR, MISC + 8, wv);
    const int lo = p->ph_lo, hi = p->ph_hi;
#define IN(k) (lo <= (k) && (k) < hi)
#define SEAM(k) do { if (IN(k) && IN((k) + 1)) xcd_barrier(bar); } while (0)
    const int G0 = gridDim.x, c0 = blockIdx.x; LAS unsigned char* const lds0 = lds;
#define PHASE_LOCALS const int G = opq(G0), c = opq(c0); LAS unsigned char* const lds = opq(lds0); LAS int* const mtbl = (LAS int*)(lds + MISC_OFF + 256); volatile LAS unsigned* const MISC = (volatile LAS unsigned*)(lds + MISC_OFF); (void)G; (void)c; (void)mtbl; (void)MISC;

    if (PK(0) && IN(0)) { PHASE_LOCALS phase_prologue(p, lds, wv); if (DUP_PHASE == 0) { __syncthreads(); phase_prologue(p, lds, wv); } SEAM(0); }
    for (int l = 0; l < DEPTH; ++l) {
        const int pb = 1 + 7 * l;
        if (PK(1) && IN(pb + 0)) { PHASE_LOCALS phase_norm1(p, l, lds, wv); if (DUP_PHASE == 1) { xcd_barrier(bar); phase_norm1(p, l, lds, wv, true); } SEAM(pb + 0); }
        if (PK(2) && IN(pb + 1)) { PHASE_LOCALS
            if (c < H_FOX) scan_head(p, c, l, lds, wv);
            for (int rep = 0; rep < (DUP_PHASE == 2 ? 2 : 1); ++rep) {
            { pg8::Gemm g{(const bf16_t*)(p->ws + (FP8_PROJ ? WS_OUTB8 : WS_OUTB)), (const bf16_t*)(p->ws + WS_WQK + (size_t)l * NQK * DM * (FP8_PROJ ? 1 : 2)), SEQ, NQK, FP8_PROJ ? DM / 2 : DM};
              pg8::StaticOrder S; S.init(SEQ, NQK, G, c);
              pg8::EpiQK E{(bf16_t*)(p->ws + WS_QKB), p->qnorm_diff + l * 64, p->knorm_diff + l * 64, p->qnorm_fox + l * 128, p->knorm_fox + l * 128, (LAS float*)(lds + TBL_OFF), (const float*)(p->ws + WS_RSTD), p->ws + WS_QKB8};
              pg8::gemm_phase<pg8::EpiQK, pg8::StaticOrder>(lds, g, S, E, wv); }
            { pg8::Gemm g{(const bf16_t*)(p->ws + WS_WV + (size_t)l * NV * DM * (FP8_PROJ ? 1 : 2)), (const bf16_t*)(p->ws + (FP8_PROJ ? WS_OUTB8 : WS_OUTB)), NV, SEQ, FP8_PROJ ? DM / 2 : DM};
              pg8::StaticOrder S; S.init(NV, SEQ, G, c);
              pg8::EpiVT E{(bf16_t*)(p->ws + WS_VT), SEQ, (const float*)(p->ws + WS_RSTD)};
              pg8::gemm_phase<pg8::EpiVT, pg8::StaticOrder>(lds, g, S, E, wv); }
            }
            SEAM(pb + 1);
        }
        if (PK(3) && IN(pb + 2)) { PHASE_LOCALS att::attention_phase(p, l, lds, MISC + 16, wv, l); if (DUP_PHASE == 3) { __syncthreads(); att::attention_phase(p, l, lds, MISC + 16, wv, l + 4, ATT_MASK2); } SEAM(pb + 2); }
        if (PK(4) && IN(pb + 3)) { PHASE_LOCALS
            pg8::Gemm g{(const bf16_t*)(p->ws + WS_MIX), (const bf16_t*)(p->ws + WS_WO + (size_t)l * DM * DM * (FP8_WOUT ? 1 : 2)), SEQ, DM, FP8_WOUT ? DM / 2 : DM};
            pg8::StaticOrder S; S.init(SEQ, DM, G, c);
            pg8::EpiResAdd E{(bf16_t*)(p->ws + WS_OUTB), 1.f, (unsigned*)(p->ws + WS_CTL) + CW_WOC + l * 32 * 64, p->ws + WS_OUTB8};
            pg8::gemm_phase<pg8::EpiResAdd, pg8::StaticOrder>(lds, g, S, E, wv);
        }
        if (PK(5) && IN(pb + 4)) { PHASE_LOCALS phase_route(p, l, lds, wv, l); if (DUP_PHASE == 5) { xcd_barrier(bar); phase_route(p, l, lds, wv, l + 4); } SEAM(pb + 4); }
        if (PK(6) && IN(pb + 5)) { PHASE_LOCALS
            moe_table(p, l, mtbl, wv);
            pg8::Gemm g{(const bf16_t*)(p->ws + WS_OUTB8), (const bf16_t*)(p->ws + WS_WGU + (size_t)l * NEXP * 1024 * DM), MOE_ROWS, NEXP * 1024, DM / 2};
            pg8::MoeOrder<4, true> S{mtbl, (const int*)(p->ws + WS_TOK), G, c, DM / 2};
            pg8::EpiGU E{p->ws + WS_ACT, (const float*)(p->ws + WS_GATE), mtbl, (unsigned*)(p->ws + WS_CTL) + CW_GUC + l * 80 * 64};
            for (int rep = 0; rep < (DUP_PHASE == 6 ? 2 : 1); ++rep)
            pg8::gemm_phase<pg8::EpiGU, pg8::MoeOrder<4, true>>(lds, g, S, E, wv);
        }
        if (PK(7) && IN(pb + 6)) { PHASE_LOCALS
            moe_table(p, l, mtbl, wv);
            pg8::Gemm g{(const bf16_t*)(p->ws + WS_ACT), (const bf16_t*)(p->ws + WS_WD + (size_t)l * NEXP * DM * FEXP), MOE_ROWS, NEXP * DM, FEXP / 2};
            pg8::DownOrder S{mtbl, (unsigned*)(p->ws + WS_CTL) + CW_GUC + l * 80 * 64, (unsigned*)(p->ws + WS_CTL) + CW_BAR + XB_TMO, G, c};
            pg8::EpiDown E{p->ws + WS_Y};
            pg8::gemm_phase<pg8::EpiDown, pg8::DownOrder>(lds, g, S, E, wv);
            SEAM(pb + 6);
        }
    }
    if (PK(1) && IN(N_PHASES - 1)) { PHASE_LOCALS phase_norm1(p, DEPTH, lds, wv); }
#undef IN
#undef SEAM
#undef PHASE_LOCALS
#undef p
}

extern "C" void kernel_launch(void* const* d_in, const int* in_sizes, int n_in, void* d_out, int out_size, void* d_ws, size_t ws_size, hipStream_t stream) {
    static int grid = 0;
    if (grid == 0) {
        if (n_in != 22 || in_sizes[0] != SEQ * DM || out_size != SEQ * DM || ws_size < WS_END) {
            fprintf(stderr, "kernel_launch: unexpected shapes (n_in %d, in0 %d, out %d, ws %zu < %zu); nothing launched\n", n_in, n_in > 0 ? in_sizes[0] : -1, out_size, ws_size, (size_t)WS_END); grid = -1; return; }
        int dev = 0, cus = 0, per_cu = 0;
        if (hipGetDevice(&dev) != hipSuccess || hipDeviceGetAttribute(&cus, hipDeviceAttributeMultiprocessorCount, dev) != hipSuccess) { grid = -1; return; }
        if (hipFuncSetAttribute((const void*)trunk_fwd, hipFuncAttributeMaxDynamicSharedMemorySize, LDS_BYTES) != hipSuccess) { fprintf(stderr, "kernel_launch: hipFuncSetAttribute failed\n"); grid = -1; return; }
        if (hipOccupancyMaxActiveBlocksPerMultiprocessor(&per_cu, (const void*)trunk_fwd, 512, LDS_BYTES) != hipSuccess || per_cu < 1)
            fprintf(stderr, "kernel_launch: note: occupancy query reports %d workgroups per CU\n", per_cu);
        (void)hipGetLastError();
        grid = cus;
    }
    if (grid < 0) return;
    if (hipMemsetAsync((char*)d_ws + WS_CTL, 0, CTL_ZERO_BYTES, stream) != hipSuccess) { fprintf(stderr, "kernel_launch: memset failed\n"); return; }
    Params hp{};
    const float** pp = (const float**)&hp;
    for (int i = 0; i < 22; ++i) pp[i] = (const float*)d_in[i];
    hp.out = (float*)d_out; hp.ws = (unsigned char*)d_ws;
#if MK_ONE_LAUNCH
    hp.ph_lo = 0; hp.ph_hi = N_PHASES;
    hipLaunchKernelGGL(trunk_fwd, dim3(grid), dim3(512), LDS_BYTES, stream, hp);
#else
    for (int ph = 0; ph < N_PHASES; ++ph) { hp.ph_lo = ph; hp.ph_hi = ph + 1; hipLaunchKernelGGL(trunk_fwd, dim3(grid), dim3(512), LDS_BYTES, stream, hp); }
#endif
    const hipError_t le = hipPeekAtLastError();
    if (le != hipSuccess) fprintf(stderr, "kernel_launch: launch failed: %s\n", hipGetErrorName(le));
}
```
